# Optimizing an MI355X kernel written in HIP

```python
import math
import jax
import jax.numpy as jnp
from jax import lax
import numpy as np

D_MODEL = 1024
BATCH = 8
SEQ = 2048
DEPTH = 4

GRID_W = 64
CTX_LEN = 256
F32 = jnp.float32

N_EVEN = (DEPTH + 1) // 2
N_ODD = DEPTH // 2

A_HEADS = 4
A_DK = 128
A_DV = 128
A_WIDTH = A_HEADS * A_DK
A_CHUNK = 64
A_IN = 5 * A_WIDTH

B_HEADS = 8
B_KV_HEADS = 2
B_HEAD_DIM = 64
B_QW = B_HEADS * B_HEAD_DIM
B_KVW = B_KV_HEADS * B_HEAD_DIM
B_IN = B_QW + 2 * B_KVW
B_WINDOW = 128
B_BLOCK = 128
ROPE_BASE = 10000.0

EVEN_IN = A_IN + B_IN
EVEN_OUT = A_HEADS * A_DV + B_QW

C_GROUP = 16
C_GROUPS = 32
C_WIDTH = C_GROUP * C_GROUPS
C_STATE = 64

R_HEADS = 8
R_HEAD = 64
R_WIDTH = R_HEADS * R_HEAD
R_LORA_W = 64
R_LORA_A = 64
R_LORA_G = 128
R_SPLITS = (R_WIDTH, R_WIDTH, R_WIDTH, R_LORA_W, R_LORA_W, R_LORA_A, R_LORA_A, R_LORA_G)
R_IN = sum(R_SPLITS)

ODD_IN = C_WIDTH + R_IN
ODD_OUT = C_WIDTH + R_WIDTH

D_FF = 2816
N_EXPERTS = 8
TOP_K = 2
E_FF = 2816

DEEPNORM_ALPHA = (2 * DEPTH) ** 0.25
DEEPNORM_BETA = (8 * DEPTH) ** -0.25
LN_EPS = 1e-5
RWKV_GN_EPS = 64e-5

kernel_name = "hybrid_hgrn2_swa_s5_rwkv7_moe_dit"


def _split(x, sizes):
    idx = np.cumsum(sizes)[:-1].tolist()
    return jnp.split(x, idx, axis=-1)


def layer_norm(x, g, b):
    xf = x.astype(F32)
    mu = jnp.mean(xf, -1, keepdims=True)
    var = jnp.mean(jnp.square(xf - mu), -1, keepdims=True)
    return ((xf - mu) * lax.rsqrt(var + LN_EPS)).astype(x.dtype) * g + b


def axial_rope_tables(rows):
    row = jnp.repeat(jnp.arange(rows, dtype=F32), GRID_W)
    col = jnp.tile(jnp.arange(GRID_W, dtype=F32), rows)
    n_freq = B_HEAD_DIM // 4
    inv = ROPE_BASE ** (-jnp.arange(n_freq, dtype=F32) / n_freq)
    ang = jnp.concatenate([row[:, None] * inv, col[:, None] * inv], axis=-1)
    return jnp.cos(ang), jnp.sin(ang)


def apply_rope(x, cos, sin):
    half = x.shape[-1] // 2
    x1, x2 = x[..., :half], x[..., half:]
    cos = cos.astype(x.dtype)
    sin = sin.astype(x.dtype)
    return jnp.concatenate([x1 * cos - x2 * sin, x1 * sin + x2 * cos], axis=-1)


def _gla_chunk_scan(q, k, v, logf, s0):
    bsz, h, L, _ = q.shape
    n = L // A_CHUNK

    def to_chunks(t):
        return t.reshape(bsz, h, n, A_CHUNK, t.shape[-1]).transpose(2, 0, 1, 3, 4)

    tri = jnp.tril(jnp.ones((A_CHUNK, A_CHUNK), bool))[:, :, None]

    def step(s, inp):
        qi, ki, vi, gi = inp
        b = jnp.cumsum(gi, axis=-2)
        diff = b[..., :, None, :] - b[..., None, :, :]
        decay = jnp.where(tri, jnp.exp(jnp.where(tri, diff, 0.0)), 0.0)
        att = jnp.einsum('bhtd,bhsd,bhtsd->bhts', qi, ki, decay)
        o = att @ vi + jnp.einsum('bhtd,bhdv->bhtv', qi * jnp.exp(b), s)
        b_last = b[..., -1:, :]
        s_new = jnp.exp(b_last[..., 0, :])[..., None] * s + jnp.einsum(
            'bhsd,bhsv->bhdv', ki * jnp.exp(b_last - b), vi)
        return s_new, o

    s_fin, o = lax.scan(step, s0, (to_chunks(q), to_chunks(k), to_chunks(v), to_chunks(logf)))
    o = o.transpose(1, 2, 0, 3, 4).reshape(bsz, h, L, -1)
    return o, s_fin


def hgrn2_mixer(pc, pl, lb, norm_g, need_ctx):
    def heads(t):
        b, l, _ = t.shape
        return t.astype(F32).reshape(b, l, A_HEADS, -1).transpose(0, 2, 1, 3)

    def prep(p):
        q, f_fw, f_bw, i, g = _split(p, (A_WIDTH,) * 5)
        q = heads(jax.nn.silu(q)) * A_DK ** -0.5
        dirs = []
        for fl in (f_fw, f_bw):
            f = lb + (1.0 - lb) * jax.nn.sigmoid(fl.astype(F32))
            dirs.append((heads(1.0 - f), heads(jnp.log(f))))
        return q, heads(i), dirs, g

    qc, ic, dc, gc = prep(pc)
    ql, il, dl, gl = prep(pl)
    zero = jnp.zeros((pl.shape[0], A_HEADS, A_DK, A_DV), F32)
    rev = lambda t: jnp.flip(t, axis=2)
    oc_f, sc_f = _gla_chunk_scan(qc, dc[0][0], ic, dc[0][1], zero)
    ol_f, _ = _gla_chunk_scan(ql, dl[0][0], il, dl[0][1], sc_f)
    oc_b, sc_b = _gla_chunk_scan(rev(qc), rev(dc[1][0]), rev(ic), rev(dc[1][1]), zero)
    ol_b, _ = _gla_chunk_scan(rev(ql), rev(dl[1][0]), rev(il), rev(dl[1][1]), sc_b)

    def finish(o, g):
        o = o * lax.rsqrt(jnp.mean(jnp.square(o), -1, keepdims=True) + 1e-6)
        b, h, l, dv = o.shape
        o = o.transpose(0, 2, 1, 3).reshape(b, l, h * dv).astype(g.dtype)
        return o * norm_g * jax.nn.silu(g)

    out_l = finish(ol_f + rev(ol_b), gl)
    out_c = finish(oc_f + rev(oc_b), gc) if need_ctx else None
    return out_c, out_l


def window_gqa_mixer(pc, pl, sink, cos, sin, need_ctx):
    bsz, L, _ = pl.shape
    Lc = pc.shape[1]
    G, R, dh = B_KV_HEADS, B_HEADS // B_KV_HEADS, B_HEAD_DIM
    scale = dh ** -0.5

    def qkv(p):
        b, l, _ = p.shape
        q, k, v = _split(p, (B_QW, B_KVW, B_KVW))
        return q.reshape(b, l, G, R, dh), k.reshape(b, l, G, dh), v.reshape(b, l, G, dh)

    qc, kc, vc = qkv(pc)
    ql, kl, vl = qkv(pl)
    ql = apply_rope(ql, cos[:, None, None, :], sin[:, None, None, :])
    kl = apply_rope(kl, cos[:, None, :], sin[:, None, :])
    sink_gr = sink.astype(F32).reshape(G, R)

    nb = L // B_BLOCK
    qb = ql.reshape(bsz, nb, B_BLOCK, G, R, dh)

    def band(t):
        tp = jnp.pad(t, ((0, 0), (B_BLOCK, B_BLOCK), (0, 0), (0, 0))).reshape(bsz, nb + 2, B_BLOCK, G, dh)
        return jnp.concatenate([tp[:, :-2], tp[:, 1:-1], tp[:, 2:]], axis=2)

    kb, vb = band(kl), band(vl)
    blk = jnp.arange(nb)[:, None]
    qpos = blk * B_BLOCK + jnp.arange(B_BLOCK)[None, :]
    kpos = (blk - 1) * B_BLOCK + jnp.arange(3 * B_BLOCK)[None, :]
    mask = (jnp.abs(qpos[:, :, None] - kpos[:, None, :]) <= B_WINDOW) & ((kpos >= 0) & (kpos < L))[:, None, :]
    s_win = jnp.einsum('bnqgrd,bnkgd->bngrqk', qb, kb).astype(F32) * scale
    s_win = jnp.where(mask[None, :, None, None], s_win, -jnp.inf)
    s_ctx = jnp.einsum('bnqgrd,bcgd->bngrqc', qb, kc).astype(F32) * scale
    s_sink = jnp.broadcast_to(sink_gr[None, None, :, :, None, None], s_win.shape[:-1] + (1,))
    p = jax.nn.softmax(jnp.concatenate([s_win, s_ctx, s_sink], axis=-1), axis=-1).astype(pl.dtype)
    nk = 3 * B_BLOCK
    ol = (jnp.einsum('bngrqk,bnkgd->bnqgrd', p[..., :nk], vb)
          + jnp.einsum('bngrqc,bcgd->bnqgrd', p[..., nk:nk + Lc], vc)).reshape(bsz, L, B_QW)

    oc = None
    if need_ctx:
        s_cc = jnp.einsum('bqgrd,bkgd->bgrqk', qc, kc).astype(F32) * scale
        sk = jnp.broadcast_to(sink_gr[None, :, :, None, None], s_cc.shape[:-1] + (1,))
        pcc = jax.nn.softmax(jnp.concatenate([s_cc, sk], axis=-1), axis=-1).astype(pc.dtype)
        oc = jnp.einsum('bgrqk,bkgd->bqgrd', pcc[..., :Lc], vc).reshape(bsz, Lc, B_QW)
    return oc, ol


def _cplx_combine(e1, e2):
    a1r, a1i, b1r, b1i = e1
    a2r, a2i, b2r, b2i = e2
    return (a1r * a2r - a1i * a2i, a1r * a2i + a1i * a2r,
            a2r * b1r - a2i * b1i + b2r, a2r * b1i + a2i * b1r + b2i)


def s5_discretize(lam_re, lam_im, log_dt, b_re, b_im):
    lam_re = jnp.minimum(lam_re.astype(F32), -1e-4)
    lam_im = lam_im.astype(F32)
    dt = jnp.exp(log_dt.astype(F32))[:, None]
    mag = jnp.exp(lam_re * dt)
    ab_re, ab_im = mag * jnp.cos(lam_im * dt), mag * jnp.sin(lam_im * dt)
    den = lam_re ** 2 + lam_im ** 2
    nr = ab_re - 1.0
    co_re = (nr * lam_re + ab_im * lam_im) / den
    co_im = (ab_im * lam_re - nr * lam_im) / den
    b_re, b_im = b_re.astype(F32), b_im.astype(F32)
    bb_re = co_re[..., None] * b_re - co_im[..., None] * b_im
    bb_im = co_re[..., None] * b_im + co_im[..., None] * b_re
    return ab_re, ab_im, bb_re, bb_im


def s5_scan(u, ab_re, ab_im, bb_re, bb_im, x0_re, x0_im):
    bu_re = jnp.einsum('lbgh,gph->lbgp', u, bb_re)
    bu_im = jnp.einsum('lbgh,gph->lbgp', u, bb_im)
    shape = (u.shape[0], 1) + ab_re.shape
    a_re, a_im = jnp.broadcast_to(ab_re, shape), jnp.broadcast_to(ab_im, shape)
    ac_re, ac_im, x_re, x_im = lax.associative_scan(_cplx_combine, (a_re, a_im, bu_re, bu_im), axis=0)
    x_re = x_re + ac_re * x0_re - ac_im * x0_im
    x_im = x_im + ac_re * x0_im + ac_im * x0_re
    return x_re, x_im


def s5_mixer(uc, ul, lam_re, lam_im, log_dt, b_re, b_im, c_re, c_im, d_skip, glu_w, need_ctx):
    def groups(u):
        b, l, _ = u.shape
        return u.astype(F32).reshape(b, l, C_GROUPS, C_GROUP).transpose(1, 0, 2, 3)

    g_c, g_l = groups(uc), groups(ul)
    zero = jnp.zeros((ul.shape[0], C_GROUPS, C_STATE), F32)
    fw = s5_discretize(lam_re[0], lam_im[0], log_dt[0], b_re, b_im)
    bw = s5_discretize(lam_re[1], lam_im[1], log_dt[1], b_re, b_im)
    xcf = s5_scan(g_c, *fw, zero, zero)
    xlf = s5_scan(g_l, *fw, xcf[0][-1], xcf[1][-1])
    xcb = s5_scan(g_c[::-1], *bw, zero, zero)
    xlb = s5_scan(g_l[::-1], *bw, xcb[0][-1], xcb[1][-1])
    cr, ci = c_re.astype(F32), c_im.astype(F32)
    dsk = d_skip.astype(F32).reshape(C_GROUPS, C_GROUP)

    def readout(u, xf, xb, dtype):
        x_re = xf[0] + xb[0][::-1]
        x_im = xf[1] + xb[1][::-1]
        y = jnp.einsum('lbgp,ghp->lbgh', x_re, cr) - jnp.einsum('lbgp,ghp->lbgh', x_im, ci) + dsk * u
        l, b = y.shape[:2]
        y = jax.nn.gelu(y.transpose(1, 0, 2, 3).reshape(b, l, C_WIDTH).astype(dtype))
        return y * jax.nn.sigmoid(y @ glu_w)

    out_l = readout(g_l, xlf, xlb, ul.dtype)
    out_c = readout(g_c, xcf, xcb, uc.dtype) if need_ctx else None
    return out_c, out_l


def centred_shift(x):
    prev = jnp.pad(x[:, :-1], ((0, 0), (1, 0), (0, 0)))
    nxt = jnp.pad(x[:, 1:], ((0, 0), (0, 1), (0, 0)))
    return 0.5 * (prev + nxt)


def _rwkv7_scan(r, w, k, v, a, b, s0):
    def step(s, inp):
        rt, wt, kt, vt, at, bt = inp
        sa = jnp.einsum('bhij,bhj->bhi', s, at)
        s = s * wt[:, :, None, :] + sa[..., None] * bt[:, :, None, :] + vt[..., None] * kt[:, :, None, :]
        return s, jnp.einsum('bhij,bhj->bhi', s, rt)

    xs = tuple(jnp.swapaxes(t, 0, 1) for t in (r, w, k, v, a, b))
    s_fin, o = lax.scan(step, s0, xs)
    return jnp.swapaxes(o, 0, 1), s_fin


def rwkv7_mixer(pc, pl, mu, w0, w2, a0, a2, g2, k_k, k_a, r_k, lnx_g, lnx_b, need_ctx):
    def heads(t):
        b, l, _ = t.shape
        return t.astype(F32).reshape(b, l, R_HEADS, R_HEAD)

    def prep(p):
        p = p + mu * (centred_shift(p) - p)
        r, k, v, wd_f, wd_b, ad_f, ad_b, gd = _split(p, R_SPLITS)
        g = jax.nn.sigmoid(gd) @ g2
        kk = heads(k * k_k)
        kk = kk / jnp.maximum(jnp.sqrt(jnp.sum(jnp.square(kk), -1, keepdims=True)), 1e-12)
        dirs = []
        for d, (wd, ad) in enumerate(((wd_f, ad_f), (wd_b, ad_b))):
            w = -jax.nn.softplus(-(w0[d] + jnp.tanh(wd) @ w2[d])) - 0.5
            decay = jnp.exp(-jnp.exp(heads(w)))
            a = jax.nn.sigmoid(a0[d] + ad @ a2[d])
            kd = heads(k * (1.0 + (a - 1.0) * k_a))
            dirs.append((decay, kd, -kk, kk * heads(a)))
        return heads(r), heads(k), heads(v), dirs, g

    rc, kc, vc, dc, gc = prep(pc)
    rl, kl, vl, dl, gl = prep(pl)
    zero = jnp.zeros((pl.shape[0], R_HEADS, R_HEAD, R_HEAD), F32)
    rev = lambda t: jnp.flip(t, axis=1)
    oc_f, sc_f = _rwkv7_scan(rc, dc[0][0], dc[0][1], vc, dc[0][2], dc[0][3], zero)
    ol_f, _ = _rwkv7_scan(rl, dl[0][0], dl[0][1], vl, dl[0][2], dl[0][3], sc_f)
    oc_b, sc_b = _rwkv7_scan(*[rev(t) for t in (rc, dc[1][0], dc[1][1], vc, dc[1][2], dc[1][3])], zero)
    ol_b, _ = _rwkv7_scan(*[rev(t) for t in (rl, dl[1][0], dl[1][1], vl, dl[1][2], dl[1][3])], sc_b)

    def finish(o, r, k, v, g):
        m = jnp.mean(o, -1, keepdims=True)
        var = jnp.mean(jnp.square(o - m), -1, keepdims=True)
        o = (o - m) * lax.rsqrt(var + RWKV_GN_EPS)
        b, l = o.shape[:2]
        o = o.reshape(b, l, R_WIDTH).astype(g.dtype) * lnx_g + lnx_b
        bonus = (jnp.sum(r * k * r_k, -1, keepdims=True) * v).reshape(b, l, R_WIDTH).astype(g.dtype)
        return (o + bonus) * g

    out_l = finish(ol_f + rev(ol_b), rl, kl, vl, gl)
    out_c = finish(oc_f + rev(oc_b), rc, kc, vc, gc) if need_ctx else None
    return out_c, out_l


def swiglu(h, wg, wu, wd):
    return (jax.nn.silu(h @ wg) * (h @ wu)) @ wd


def moe_swiglu(h, router_w, router_b, wg, wu, wd):
    logits = (h @ router_w + router_b).astype(F32)
    top_v, top_i = lax.top_k(logits, TOP_K)
    top_p = jax.nn.softmax(top_v, axis=-1)
    gates = jnp.sum(jax.nn.one_hot(top_i, N_EXPERTS, dtype=F32) * top_p[..., None], axis=-2).astype(h.dtype)
    out = jnp.zeros_like(h)
    for e in range(N_EXPERTS):
        out = out + gates[..., e:e + 1] * swiglu(h, wg[e], wu[e], wd[e])
    return out


def setup_inputs(seed: int = 0) -> dict:
    key = jax.random.key(seed)
    keys = iter(jax.random.split(key, 48))

    def nrm(shape, std):
        return std * jax.random.normal(next(keys), shape, F32)

    def uni(shape, lo, hi):
        return jax.random.uniform(next(keys), shape, F32, lo, hi)

    D = D_MODEL
    beta = DEEPNORM_BETA
    lam_im = jnp.pi * jnp.arange(C_STATE, dtype=F32) + nrm((N_ODD, 2, C_GROUPS, C_STATE), 0.01)
    return {
        "x": nrm((BATCH, SEQ, D), 1.0),
        "c": nrm((BATCH, D), 1.0),
        "ctx": nrm((BATCH, CTX_LEN, D), 1.0),
        "c_ctx": nrm((D,), 1.0),
        "ada_w": nrm((DEPTH, D, 6 * D), 0.5 * D ** -0.5),
        "ada_b": nrm((DEPTH, 6 * D), 0.02),
        "ln_g": 1.0 + nrm((DEPTH, 2, D), 0.02),
        "ln_b": nrm((DEPTH, 2, D), 0.02),
        "ev_w_in": nrm((N_EVEN, D, EVEN_IN), D ** -0.5),
        "ev_w_out": nrm((N_EVEN, EVEN_OUT, D), beta * EVEN_OUT ** -0.5),
        "hg_lb": 1.0 + nrm((N_EVEN, A_WIDTH), 0.1),
        "hg_norm_g": 1.0 + nrm((N_EVEN, A_WIDTH), 0.02),
        "attn_sink": nrm((N_EVEN, B_HEADS), 0.5),
        "ffn_w_gate": nrm((N_EVEN, D, D_FF), D ** -0.5),
        "ffn_w_up": nrm((N_EVEN, D, D_FF), D ** -0.5),
        "ffn_w_down": nrm((N_EVEN, D_FF, D), beta * D_FF ** -0.5),
        "od_w_in": nrm((N_ODD, D, ODD_IN), D ** -0.5),
        "od_w_out": nrm((N_ODD, ODD_OUT, D), beta * ODD_OUT ** -0.5),
        "s5_lam_re": -0.5 + nrm((N_ODD, 2, C_GROUPS, C_STATE), 0.01),
        "s5_lam_im": lam_im,
        "s5_log_dt": uni((N_ODD, 2, C_GROUPS), math.log(0.001), math.log(0.1)),
        "s5_b_re": nrm((N_ODD, C_GROUPS, C_STATE, C_GROUP), (2 * C_GROUP) ** -0.5),
        "s5_b_im": nrm((N_ODD, C_GROUPS, C_STATE, C_GROUP), (2 * C_GROUP) ** -0.5),
        "s5_c_re": nrm((N_ODD, C_GROUPS, C_GROUP, C_STATE), C_STATE ** -0.5),
        "s5_c_im": nrm((N_ODD, C_GROUPS, C_GROUP, C_STATE), C_STATE ** -0.5),
        "s5_d": nrm((N_ODD, C_WIDTH), 1.0),
        "s5_glu_w": nrm((N_ODD, C_WIDTH, C_WIDTH), C_WIDTH ** -0.5),
        "rwkv_mu": uni((N_ODD, R_IN), 0.0, 1.0),
        "rwkv_w0": uni((N_ODD, 2, R_WIDTH), -5.5, -0.5),
        "rwkv_w2": nrm((N_ODD, 2, R_LORA_W, R_WIDTH), 0.5 * R_LORA_W ** -0.5),
        "rwkv_a0": nrm((N_ODD, 2, R_WIDTH), 0.5),
        "rwkv_a2": nrm((N_ODD, 2, R_LORA_A, R_WIDTH), 0.5 * R_LORA_A ** -0.5),
        "rwkv_g2": nrm((N_ODD, R_LORA_G, R_WIDTH), R_LORA_G ** -0.5),
        "rwkv_k_k": 0.85 + nrm((N_ODD, R_WIDTH), 0.05),
        "rwkv_k_a": 1.0 + nrm((N_ODD, R_WIDTH), 0.05),
        "rwkv_r_k": nrm((N_ODD, R_HEADS, R_HEAD), 0.1),
        "rwkv_ln_g": 1.0 + nrm((N_ODD, R_WIDTH), 0.02),
        "rwkv_ln_b": nrm((N_ODD, R_WIDTH), 0.02),
        "moe_router_w": nrm((N_ODD, D, N_EXPERTS), D ** -0.5),
        "moe_router_b": nrm((N_ODD, N_EXPERTS), 0.01),
        "moe_w_gate": nrm((N_ODD, N_EXPERTS, D, E_FF), D ** -0.5),
        "moe_w_up": nrm((N_ODD, N_EXPERTS, D, E_FF), D ** -0.5),
        "moe_w_down": nrm((N_ODD, N_EXPERTS, E_FF, D), beta * E_FF ** -0.5),
    }


def reference(x, c, ctx, c_ctx, ada_w, ada_b, ln_g, ln_b,
              ev_w_in, ev_w_out, hg_lb, hg_norm_g, attn_sink, ffn_w_gate, ffn_w_up, ffn_w_down,
              od_w_in, od_w_out, s5_lam_re, s5_lam_im, s5_log_dt, s5_b_re, s5_b_im, s5_c_re, s5_c_im,
              s5_d, s5_glu_w, rwkv_mu, rwkv_w0, rwkv_w2, rwkv_a0, rwkv_a2, rwkv_g2, rwkv_k_k, rwkv_k_a,
              rwkv_r_k, rwkv_ln_g, rwkv_ln_b, moe_router_w, moe_router_b, moe_w_gate, moe_w_up, moe_w_down):
    L = x.shape[1]
    rows = L // GRID_W
    cos, sin = axial_rope_tables(rows)
    lb_soft = jax.nn.softmax(hg_lb.astype(F32), axis=0)
    lb_all = jnp.cumsum(lb_soft, axis=0) - lb_soft[0:1]
    cond_l = jax.nn.silu(c)[:, None, :]
    cond_c = jax.nn.silu(c_ctx)[None, None, :]
    xl, xc = x, ctx
    Lc = ctx.shape[1]
    for layer in range(DEPTH):
        j = layer // 2
        need_ctx = layer < DEPTH - 1
        sh1, sc1, gt1, sh2, sc2, gt2 = _split(cond_l @ ada_w[layer] + ada_b[layer], (D_MODEL,) * 6)
        csh1, csc1, cgt1, csh2, csc2, cgt2 = _split(cond_c @ ada_w[layer] + ada_b[layer], (D_MODEL,) * 6)
        hl = xl * (1.0 + sc1) + sh1
        hc = xc * (1.0 + csc1) + csh1
        if layer % 2 == 0:
            w_in, w_out = ev_w_in[j], ev_w_out[j]
            pc, pl = hc @ w_in, hl @ w_in
            oa_c, oa_l = hgrn2_mixer(pc[..., :A_IN], pl[..., :A_IN], lb_all[j], hg_norm_g[j], need_ctx)
            ob_c, ob_l = window_gqa_mixer(pc[..., A_IN:], pl[..., A_IN:], attn_sink[j], cos, sin, need_ctx)
            yl = jnp.concatenate([oa_l, ob_l], axis=-1)
            yc = jnp.concatenate([oa_c, ob_c], axis=-1) if need_ctx else None
        else:
            w_in, w_out = od_w_in[j], od_w_out[j]
            pc, pl = hc @ w_in, hl @ w_in
            oc_c, oc_l = s5_mixer(pc[..., :C_WIDTH], pl[..., :C_WIDTH], s5_lam_re[j], s5_lam_im[j],
                                  s5_log_dt[j], s5_b_re[j], s5_b_im[j], s5_c_re[j], s5_c_im[j],
                                  s5_d[j], s5_glu_w[j], need_ctx)
            od_c, od_l = rwkv7_mixer(pc[..., C_WIDTH:], pl[..., C_WIDTH:], rwkv_mu[j], rwkv_w0[j], rwkv_w2[j],
                                     rwkv_a0[j], rwkv_a2[j], rwkv_g2[j], rwkv_k_k[j], rwkv_k_a[j],
                                     rwkv_r_k[j], rwkv_ln_g[j], rwkv_ln_b[j], need_ctx)
            yl = jnp.concatenate([oc_l, od_l], axis=-1)
            yc = jnp.concatenate([oc_c, od_c], axis=-1) if need_ctx else None
        xl = layer_norm(DEEPNORM_ALPHA * xl + gt1 * (yl @ w_out), ln_g[layer, 0], ln_b[layer, 0])
        hl = xl * (1.0 + sc2) + sh2
        if need_ctx:
            xc = layer_norm(DEEPNORM_ALPHA * xc + cgt1 * (yc @ w_out), ln_g[layer, 0], ln_b[layer, 0])
            h = jnp.concatenate([xc * (1.0 + csc2) + csh2, hl], axis=1)
        else:
            h = hl
        if layer % 2 == 0:
            f = swiglu(h, ffn_w_gate[j], ffn_w_up[j], ffn_w_down[j])
        else:
            f = moe_swiglu(h, moe_router_w[j], moe_router_b[j], moe_w_gate[j], moe_w_up[j], moe_w_down[j])
        if need_ctx:
            xc = layer_norm(DEEPNORM_ALPHA * xc + cgt2 * f[:, :Lc], ln_g[layer, 1], ln_b[layer, 1])
            f = f[:, Lc:]
        xl = layer_norm(DEEPNORM_ALPHA * xl + gt2 * f, ln_g[layer, 1], ln_b[layer, 1])
    return xl
```

```cpp
#include <hip/hip_runtime.h>
#include <stdint.h>
#include <stdio.h>
#include <string.h>

#ifndef PROBE_DUP
#define PROBE_DUP 0
#endif
#define REP(k) for (int rep_ = 0; rep_ < 1 + ((PROBE_DUP >> (k)) & 1); ++rep_)
#define DUPB(k) ((PROBE_DUP >> (k)) & 1)
#ifndef MK_SINGLE
#define MK_SINGLE 1
#endif

#define LAS __attribute__((address_space(3)))
typedef unsigned short bf16_t;
typedef short bf16x8 __attribute__((ext_vector_type(8)));
typedef short s16x4 __attribute__((ext_vector_type(4)));
typedef float f32x2 __attribute__((ext_vector_type(2)));
typedef float f32x4 __attribute__((ext_vector_type(4)));
typedef float f32x16 __attribute__((ext_vector_type(16)));
typedef unsigned u32x2 __attribute__((ext_vector_type(2)));
typedef unsigned u32x4 __attribute__((ext_vector_type(4)));
typedef __bf16 bfv2 __attribute__((ext_vector_type(2)));

constexpr int TT = 18432;
constexpr int SB = 2304;
constexpr int DM = 1024;
constexpr int NPH = 42;
constexpr float ALPHA = 1.6817928305074290f;
constexpr int SPLIT_S = 2;

constexpr size_t OFF_BAR = 0;
constexpr size_t OFF_CNT = 16384;
constexpr size_t ZERO_BYTES = 32768;
constexpr size_t OFF_MOD = 32768;
constexpr size_t OFF_COS = OFF_MOD + 884736;
constexpr size_t OFF_SIN = OFF_COS + 262144;
constexpr size_t OFF_LB = OFF_SIN + 262144;
constexpr size_t OFF_AB = OFF_LB + 4096;
constexpr size_t OFF_BBR = OFF_AB + 65536;
constexpr size_t OFF_BBI = OFF_BBR + 524288;
constexpr size_t OFF_ROUTE = OFF_BBI + 524288;
constexpr size_t OFF_WINE = OFF_ROUTE + 589824;
constexpr size_t SZ_WINE = (size_t)3328 * 1024 * 2;
constexpr size_t OFF_WOUTE = OFF_WINE + 2 * SZ_WINE;
constexpr size_t SZ_WSQ = (size_t)1024 * 1024 * 2;
constexpr size_t OFF_WFFN1 = OFF_WOUTE + 2 * SZ_WSQ;
constexpr size_t SZ_WFFN1 = (size_t)5632 * 1024 * 2;
constexpr size_t OFF_WFFN2 = OFF_WFFN1 + 2 * SZ_WFFN1;
constexpr size_t SZ_WFFN2 = (size_t)1024 * 2816 * 2;
constexpr size_t OFF_WINO = OFF_WFFN2 + 2 * SZ_WFFN2;
constexpr size_t SZ_WINO = (size_t)2560 * 1024 * 2;
constexpr size_t OFF_WOUTO = OFF_WINO + 2 * SZ_WINO;
constexpr size_t OFF_WLORA = OFF_WOUTO + 2 * SZ_WSQ;
constexpr size_t SZ_WLORA = (size_t)2560 * 384 * 2;
constexpr size_t OFF_WGLU = OFF_WLORA + 2 * SZ_WLORA;
constexpr size_t SZ_WGLU = (size_t)512 * 512 * 2;
constexpr size_t OFF_WMOE1 = OFF_WGLU + 2 * SZ_WGLU;
constexpr size_t OFF_WMOE2 = OFF_WMOE1 + 8 * SZ_WFFN1;
constexpr size_t OFF_X = OFF_WMOE2 + 8 * SZ_WFFN2;
constexpr size_t OFF_H = OFF_X + (size_t)TT * 1024 * 4;
constexpr size_t OFF_AR = OFF_H + (size_t)TT * 1024 * 2;
constexpr size_t AE_P = 0, AE_OF = 122683392, AE_OB = AE_OF + 37748736, AE_Y = AE_OB + 37748736;
constexpr size_t AO_P = 0, AO_OF = 94371840, AO_OB = AO_OF + 37748736, AO_PR = AO_OB + 37748736, AO_L = AO_PR + 56623104, AO_YG = AO_L + 14155776, AO_Y = AO_YG + 18874368;
constexpr size_t AM_A = 0, AM_H = 79691776;
constexpr size_t AR_SIZE = 298844160;
constexpr size_t OFF_KN = OFF_AR + AR_SIZE;
constexpr size_t OFF_GE = OFF_KN + 589824;
constexpr size_t OFF_GW = OFF_GE + (size_t)18432 * 8192;
constexpr size_t OFF_S5F = OFF_GW + (size_t)18432 * 256;
constexpr size_t OFF_S5B = OFF_S5F + (size_t)TT * 512 * 4;
constexpr size_t OFF_INV = OFF_S5B + (size_t)TT * 512 * 4;
constexpr size_t WS_END = OFF_INV + (size_t)8 * TT * 4;

struct Job { const float* src; bf16_t* dst; int K, N, ldd, mode, tile0, aux; };
constexpr int MAXJOBS = 72;
struct Params {
    const float* in[43];
    float* out;
    unsigned char* ws;
    int lo, hi;
    int nj0, njm, nj1;
    int nt0, ntm, nt1;
    int ntc;
    Job jobs[MAXJOBS];
};

__device__ __forceinline__ float bf2f(unsigned v) { return __uint_as_float(v << 16); }
__device__ __forceinline__ unsigned pk2(float lo, float hi) { f32x2 v = {lo, hi}; bfv2 b = __builtin_convertvector(v, bfv2); return __builtin_bit_cast(unsigned, b); }
__device__ __forceinline__ void unpk8(const u32x4 v, float* f) {
    f[0] = __uint_as_float(v.x << 16); f[1] = __uint_as_float(v.x & 0xffff0000u);
    f[2] = __uint_as_float(v.y << 16); f[3] = __uint_as_float(v.y & 0xffff0000u);
    f[4] = __uint_as_float(v.z << 16); f[5] = __uint_as_float(v.z & 0xffff0000u);
    f[6] = __uint_as_float(v.w << 16); f[7] = __uint_as_float(v.w & 0xffff0000u);
}
__device__ __forceinline__ void unpk4(const u32x2 v, float* f) {
    f[0] = __uint_as_float(v.x << 16); f[1] = __uint_as_float(v.x & 0xffff0000u);
    f[2] = __uint_as_float(v.y << 16); f[3] = __uint_as_float(v.y & 0xffff0000u);
}
__device__ __forceinline__ f32x4 unpk4v(const u32x2 v) { f32x4 r; r[0] = __uint_as_float(v.x << 16); r[1] = __uint_as_float(v.x & 0xffff0000u); r[2] = __uint_as_float(v.y << 16); r[3] = __uint_as_float(v.y & 0xffff0000u); return r; }
typedef _Float16 hf4 __attribute__((ext_vector_type(4)));
__device__ __forceinline__ u32x2 f2h4(const f32x4 v) { const hf4 h = __builtin_convertvector(v, hf4); return __builtin_bit_cast(u32x2, h); }
__device__ __forceinline__ f32x4 h2f4(const u32x2 u) { const hf4 h = __builtin_bit_cast(hf4, u); return __builtin_convertvector(h, f32x4); }
__device__ __forceinline__ u32x4 pk8(const float* f) { u32x4 r; r.x = pk2(f[0], f[1]); r.y = pk2(f[2], f[3]); r.z = pk2(f[4], f[5]); r.w = pk2(f[6], f[7]); return r; }
template <int CTRL> __device__ __forceinline__ float dppf(float v) { return __builtin_bit_cast(float, __builtin_amdgcn_update_dpp(0, __builtin_bit_cast(int, v), CTRL, 0xF, 0xF, true)); }
__device__ __forceinline__ float sum8(float v) { v += dppf<0xB1>(v); v += dppf<0x4E>(v); v += dppf<0x141>(v); return v; }
__device__ __forceinline__ float sum16(float v) { v = sum8(v); v += dppf<0x140>(v); return v; }
__device__ __forceinline__ float xsum16(float x) { const unsigned xb = __builtin_bit_cast(unsigned, x); auto r = __builtin_amdgcn_permlane16_swap(xb, xb, false, false);
    return __builtin_bit_cast(float, (unsigned)r[0]) + __builtin_bit_cast(float, (unsigned)r[1]); }
__device__ __forceinline__ float xsum32(float x) { const unsigned xb = __builtin_bit_cast(unsigned, x); auto r = __builtin_amdgcn_permlane32_swap(xb, xb, false, false);
    return __builtin_bit_cast(float, (unsigned)r[0]) + __builtin_bit_cast(float, (unsigned)r[1]); }
__device__ __forceinline__ float sum64(float v) { v = sum16(v); v = xsum16(v); v = xsum32(v); return v; }
__device__ __forceinline__ float sigm(float x) { return __builtin_amdgcn_rcpf(1.0f + __builtin_amdgcn_exp2f(-1.4426950408889634f * x)); }
__device__ __forceinline__ float siluf(float x) { return x * __builtin_amdgcn_rcpf(1.0f + __builtin_amdgcn_exp2f(-1.4426950408889634f * x)); }
__device__ __forceinline__ float tanh_f(float x) { const float e = __builtin_amdgcn_exp2f(-2.8853900817779268f * fabsf(x)); const float t = (1.0f - e) * __builtin_amdgcn_rcpf(1.0f + e); return x < 0.f ? -t : t; }
__device__ __forceinline__ void my_sincos(float x, float& s, float& c) {
    const float q = rintf(x * 0.636619772f);
    float r = fmaf(-q, 1.57079637f, x); r = fmaf(-q, -4.37113883e-8f, r);
    const float r2 = r * r;
    const float sp = r + r * r2 * (-1.6666654611e-1f + r2 * (8.3321608736e-3f + r2 * (-1.9515295891e-4f)));
    const float cp = 1.0f - 0.5f * r2 + r2 * r2 * (4.166664568298827e-2f + r2 * (-1.388731625493765e-3f + r2 * 2.443315711809948e-5f));
    const int qi = ((int)q) & 3;
    s = (qi == 0) ? sp : (qi == 1) ? cp : (qi == 2) ? -sp : -cp;
    c = (qi == 0) ? cp : (qi == 1) ? -sp : (qi == 2) ? -cp : sp;
}
__device__ __forceinline__ unsigned char* ows(unsigned char* q) { const unsigned long long t0 = (unsigned long long)q; unsigned lo = __builtin_amdgcn_readfirstlane((unsigned)t0), hi = __builtin_amdgcn_readfirstlane((unsigned)(t0 >> 32)); asm volatile("" : "+s"(lo), "+s"(hi)); const unsigned long long t = ((unsigned long long)hi << 32) | lo; return (unsigned char*)(__attribute__((address_space(1))) unsigned char*)t; }
#define LDS_BARRIER() do { asm volatile("s_waitcnt lgkmcnt(0)" ::: "memory"); __builtin_amdgcn_s_barrier(); asm volatile("" ::: "memory"); } while (0)
__device__ __forceinline__ int otid() { int t = threadIdx.x; asm volatile("" : "+v"(t)); return t; }
__device__ __forceinline__ int mod_index(int row) { const int b = row / SB, s = row - b * SB; return s < 256 ? 8 : b; }

#define XB_TMO      128
#define XB_XCNT(j)  (256  + 64 * (j))
#define XB_XSUB(j)  (1280 + 64 * (j))
#define XB_XGEN(j)  (2304 + 64 * (j))
#define XB_TOP      3328
#define XB_TOPGEN   3392
#define XCD_BAR_WORDS 3456
#define XB_SPIN_CAP (1u << 18)
__device__ __forceinline__ unsigned xb_ld(unsigned* p)              { return __hip_atomic_load(p, __ATOMIC_RELAXED, __HIP_MEMORY_SCOPE_AGENT); }
__device__ __forceinline__ unsigned xb_add(unsigned* p, unsigned v) { return __hip_atomic_fetch_add(p, v, __ATOMIC_RELAXED, __HIP_MEMORY_SCOPE_AGENT); }
__device__ __forceinline__ unsigned xb_xcc_id() { return (unsigned)__builtin_amdgcn_s_getreg((3 << 11) | 20) & 0xFu; }
#define XB_SPIN(cond, bar) do { unsigned _sp = 0; while (cond) { __builtin_amdgcn_s_sleep(1); \
    if ((++_sp & 255u) == 0u) { if (xb_ld(&(bar)[XB_TMO])) break; if (_sp > XB_SPIN_CAP) { atomicAdd(&(bar)[XB_TMO], 1u); break; } } } } while (0)
struct XcdBarrier { unsigned* bar; unsigned x; volatile LAS unsigned* st; };
__device__ __forceinline__ XcdBarrier xcd_barrier_post(unsigned* bar, volatile LAS unsigned* st) {
    XcdBarrier b; b.bar = bar; b.x = xb_xcc_id(); b.st = st;
    if (threadIdx.x == 0) (void)xb_add(&bar[XB_XCNT(b.x)], 1u);
    return b;
}
__device__ __forceinline__ void xcd_barrier_complete(unsigned* bar, unsigned x, unsigned& nloc, unsigned& nx) {
    const unsigned G = gridDim.x * gridDim.y * gridDim.z;
    unsigned sum, cnt, mine, sp = 0u;
    for (;;) {
        sum = 0u; cnt = 0u; mine = 0u;
#pragma unroll
        for (unsigned j = 0; j < 16; ++j) { const unsigned c = xb_ld(&bar[XB_XCNT(j)]); sum += c; cnt += (c > 0u) ? 1u : 0u; mine = (j == x) ? c : mine; }
        if (sum == G) break;
        __builtin_amdgcn_s_sleep(1);
        if ((++sp & 255u) == 0u) { if (xb_ld(&bar[XB_TMO])) break; if (sp > XB_SPIN_CAP) { atomicAdd(&bar[XB_TMO], 1u); break; } }
    }
    nloc = mine > 0u ? mine : 1u; nx = cnt > 0u ? cnt : 1u;
}
__device__ __forceinline__ void xcd_barrier(const XcdBarrier& b) {
    asm volatile("s_waitcnt vmcnt(0)" ::: "memory");
    __syncthreads();
    if (threadIdx.x == 0) {
        unsigned* bar = b.bar;
        __builtin_amdgcn_s_waitcnt(0);
        unsigned nloc = b.st[0], nx = b.st[1];
        if (nloc == 0u) { xcd_barrier_complete(bar, b.x, nloc, nx); b.st[0] = nloc; b.st[1] = nx; }
        const unsigned old = xb_add(&bar[XB_XSUB(b.x)], 1u);
        const unsigned gen = old / nloc;
        if (old + 1u == (gen + 1u) * nloc) {
            __builtin_amdgcn_fence(__ATOMIC_RELEASE, "agent");
            asm volatile("s_waitcnt vmcnt(0)" ::: "memory");
            const unsigned og = xb_add(&bar[XB_TOP], 1u);
            const unsigned tg = og / nx;
            if (og + 1u == (tg + 1u) * nx) xb_add(&bar[XB_TOPGEN], 1u);
            else XB_SPIN(xb_ld(&bar[XB_TOPGEN]) == tg, bar);
            __builtin_amdgcn_fence(__ATOMIC_ACQUIRE, "agent");
            xb_add(&bar[XB_XGEN(b.x)], 1u);
            asm volatile("s_waitcnt vmcnt(0)" ::: "memory");
        } else {
            XB_SPIN(xb_ld(&bar[XB_XGEN(b.x)]) == gen, bar);
            __builtin_amdgcn_fence(__ATOMIC_ACQUIRE, "agent");
            asm volatile("s_waitcnt vmcnt(0)" ::: "memory");
        }
    }
    __syncthreads();
}

namespace pg8 {
constexpr int BM = 256, BK = 64, HALF = 128, HTB = HALF * BK * 2, STAGE_BYTES = 8 * HTB, NXCD = 8, WGM = 8;
__device__ __forceinline__ int lds_byte(int r, int c) { const int st = (r >> 4) * 2 + (c >> 5), rr = r & 15, cc = c & 31, ob = rr * 64 + cc * 2; return st * 1024 + (ob ^ (((ob >> 9) & 1) << 5)); }
__device__ __forceinline__ void stage_rc(int b, int& R, int& C) { const int st = b / 1024, sb = b % 1024, swz = sb ^ (((sb >> 9) & 1) << 5); R = (st >> 1) * 16 + swz / 64; C = (st & 1) * 32 + (swz % 64) / 2; }
__device__ __forceinline__ int perm32(int rho) { const int n = rho >> 4, i = rho & 15; return 8 * (i >> 2) + 4 * n + (i & 3); }
struct Unit { int pm, pn, e, kt0, nkt, ks; };
struct Gemm { const bf16_t* A; const bf16_t* Bt; int K; size_t bstride; };
struct StaticOrder {
    int nM, nN, nwg, G, c, nkt;
    __device__ __forceinline__ void init(int M, int N, int G_, int c_, int K_) { nM = M / BM; nN = N / BM; nwg = nM * nN; G = G_; c = c_; nkt = K_ / BK; }
    __device__ __forceinline__ bool next(int i, Unit& u) const {
        const long L = (long)i * G + c; if (L >= nwg) return false;
        int wgid = (int)L; { const int q = nwg / NXCD, r = nwg % NXCD, xcd = wgid % NXCD, off = wgid / NXCD; wgid = (xcd < r ? xcd * (q + 1) : r * (q + 1) + (xcd - r) * q) + off; }
        const int nig = WGM * nN, gid = wgid / nig, fm = gid * WGM, gsz = (nM - fm) < WGM ? (nM - fm) : WGM;
        u.pm = fm + ((wgid % nig) % gsz); u.pn = (wgid % nig) / gsz; u.e = 0; u.kt0 = 0; u.nkt = nkt; u.ks = -1; return true;
    }
};
struct LoraOrder {
    StaticOrder so;
    __device__ __forceinline__ void init(int M, int N, int G_, int c_, int K_) { so.init(M, N, G_, c_, K_); }
    __device__ __forceinline__ bool next(int i, Unit& u) const {
        if (!so.next(i, u)) return false;
        u.kt0 = (u.pn >> 2) * 2; u.nkt = 2; return true;
    }
};
struct MoeOrder {
    int nN, G, c, npan, nkt, nfullU; int pend[8];
    __device__ __forceinline__ void init(const unsigned* cnt, int nN_, int G_, int c_, int K_, bool split = false) {
        nN = nN_; G = G_; c = c_; nkt = K_ / BK; int acc = 0;
#pragma unroll
        for (int e = 0; e < 8; ++e) { acc += ((int)cnt[e * 64] + 255) >> 8; pend[e] = acc; }
        npan = acc; nfullU = split ? ((npan * nN) / G) * G : 0x40000000;
    }
    __device__ __forceinline__ bool next(int i, Unit& u) const {
        const int q0 = i * G + (c & 7) * (G >> 3) + (c >> 3);
        const bool sub = q0 >= nfullU;
        const int q = sub ? nfullU + ((q0 - nfullU) >> 1) : q0, ksub = (q0 - nfullU) & 1;
        const int per = 4 * nN, nfull = npan >> 2, g4 = q / per;
        int pan, pn; bool ok = true;
        if (g4 < nfull) { const int r = q - g4 * per; pn = r >> 2; pan = g4 * 4 + (r & 3); }
        else { const int q2 = q - nfull * per, gp = npan - 4 * nfull; const int gpd = gp > 0 ? gp : 1; ok = q2 < gp * nN; pn = q2 / gpd; pan = 4 * nfull + (q2 - pn * gpd); }
        int e = 0;
#pragma unroll
        for (int k = 0; k < 7; ++k) e += (pan >= pend[k]) ? 1 : 0;
        u.pm = pan; u.pn = pn; u.e = e; u.kt0 = sub ? ksub * (nkt >> 1) : 0; u.nkt = sub ? (nkt >> 1) : nkt; u.ks = sub ? ksub : -1;
        return ok;
    }
};
struct CtxSplitOrder {
    StaticOrder lat; int G, c, nkt, S;
    __device__ __forceinline__ void init(int G_, int c_, int K_, int S_) { lat.init(64 * BM, 1024, G_, c_, K_); G = G_; c = c_; nkt = K_ / BK; S = S_; }
    __device__ __forceinline__ bool next(int i, Unit& u) const {
        const int L = i * G + c;
        const bool islat = L < 256;
        Unit r; const bool okl = lat.next(islat ? i : 0, r);
        r.pm = (r.pm >> 3) * 9 + 1 + (r.pm & 7);
        const int L2 = islat ? 0 : L - 256, Sd = S > 0 ? S : 1, uid = L2 / Sd, ks = L2 - uid * Sd, sub = nkt / Sd;
        u.pm = islat ? r.pm : (uid >> 2) * 9; u.pn = islat ? r.pn : (uid & 3); u.e = 0;
        u.kt0 = islat ? 0 : ks * sub; u.nkt = islat ? nkt : sub; u.ks = islat ? -1 : ks;
        return islat ? okl : (L2 < 32 * S);
    }
};
template <class Epi, class Sched, bool GA = false>
__device__ __forceinline__ void gemm_phase(LAS unsigned char* lds, const Gemm g, const Sched& S, const Epi& E, const LAS int* ridx = nullptr) {
    const int tid = otid(), wid = __builtin_amdgcn_readfirstlane(tid >> 6), lane = tid & 63, wr = wid >> 2, wc = wid & 3, fr = lane & 15, fq = lane >> 4;
    const int K = g.K;
    unsigned voffA[2], voffB[2]; int RA[2]; unsigned CA2[2];
#pragma unroll
    for (int i = 0; i < 2; ++i) { int R, C; stage_rc(tid * 16 + i * 8192, R, C); const int Rb = Epi::PERM ? ((R & ~31) + perm32(R & 31)) : R;
        voffA[i] = (unsigned)(R * K + C) * 2u; voffB[i] = (unsigned)(Rb * K + C) * 2u; RA[i] = R; CA2[i] = (unsigned)C * 2u; }
    unsigned vA[2][2], nvA[2][2], v2[2][2];
#define PG8_GIDX(dst, ui_) do { _Pragma("unroll") for (int _h = 0; _h < 2; ++_h) _Pragma("unroll") for (int _i = 0; _i < 2; ++_i) \
        dst[_h][_i] = (unsigned)ridx[(ui_) * 256 + _h * HALF + RA[_i]] * (unsigned)(K * 2) + CA2[_i]; } while (0)
#define PG8_STGA(bufoff, abase, h, vsel) do { if (GA) PG8_STAGE(bufoff, abase, vsel[h]); else PG8_STAGE(bufoff, (abase) + (h) * hstep, voffA); } while (0)
    const size_t kstep = (size_t)(BK * 2);
    const size_t hstep = (size_t)HALF * K * 2;
    const size_t tstep = 2 * hstep;
    const unsigned ldsw = (unsigned)wid * 1024u;
    const int aoff = lds_byte(wr * 64 + fr, fq * 8), boff = lds_byte(wc * 32 + fr, fq * 8);
#define PG8_SA(b, h) (((b) * 2 + (h)) * HTB)
#define PG8_SB(b, h) ((4 + (b) * 2 + (h)) * HTB)
#define PG8_STAGE(bufoff, gbase, voff) do { _Pragma("unroll") for (int _i = 0; _i < 2; ++_i) \
        __builtin_amdgcn_global_load_lds((const unsigned*)((const char*)(gbase) + (voff)[_i]), (LAS unsigned*)(lds + (bufoff) + ldsw + _i * 8192), 16, 0, 0); } while (0)
#define PG8_LDA(dst, b, h) do { _Pragma("unroll") for (int m = 0; m < 4; ++m) _Pragma("unroll") for (int k = 0; k < 2; ++k) dst[m][k] = *(const LAS bf16x8*)(lds + PG8_SA(b, h) + aoff + m * 2048 + k * 1024); } while (0)
#define PG8_LDB(dst, b, h) do { _Pragma("unroll") for (int n = 0; n < 2; ++n) _Pragma("unroll") for (int k = 0; k < 2; ++k) dst[n][k] = *(const LAS bf16x8*)(lds + PG8_SB(b, h) + boff + n * 2048 + k * 1024); } while (0)
#define PG8_MMA(ai, bj, At, Bt) do { __builtin_amdgcn_s_setprio(1); _Pragma("unroll") for (int m = 0; m < 4; ++m) _Pragma("unroll") for (int n = 0; n < 2; ++n) _Pragma("unroll") for (int k = 0; k < 2; ++k) \
        acc[ai][bj][m][n] = __builtin_amdgcn_mfma_f32_16x16x32_bf16(Bt[n][k], At[m][k], acc[ai][bj][m][n], 0, 0, 0); __builtin_amdgcn_s_setprio(0); } while (0)
#define PG8_WAIT_V(n) asm volatile("s_waitcnt vmcnt(" #n ")" ::: "memory")
#define PG8_WAIT_L(n) asm volatile("s_waitcnt lgkmcnt(" #n ")" ::: "memory")
#define PG8_BAR __builtin_amdgcn_s_barrier()
#define PG8_SCHED __builtin_amdgcn_sched_barrier(0)
    Unit cur, nxt; int ui = 0;
    if (!S.next(0, cur)) return;
    f32x4 acc[2][2][4][2];
#pragma unroll
    for (int a = 0; a < 2; ++a)
#pragma unroll
        for (int b = 0; b < 2; ++b)
#pragma unroll
            for (int m = 0; m < 4; ++m)
#pragma unroll
                for (int n = 0; n < 2; ++n) acc[a][b][m][n] = (f32x4){0.f, 0.f, 0.f, 0.f};
    bf16x8 At[4][2], B0[2][2], B1[2][2];
    const char* cA = (const char*)g.A + (GA ? (size_t)0 : (size_t)cur.pm * tstep) + (size_t)cur.kt0 * kstep; const char* cB = (const char*)g.Bt + (size_t)cur.e * g.bstride + (size_t)cur.pn * tstep + (size_t)cur.kt0 * kstep;
    if (GA) PG8_GIDX(vA, 0);
    PG8_STAGE(PG8_SB(0, 0), cB, voffB); PG8_STGA(PG8_SA(0, 0), cA, 0, vA); PG8_STAGE(PG8_SB(0, 1), cB + hstep, voffB); PG8_STGA(PG8_SA(0, 1), cA, 1, vA);
    if (wr == 1) PG8_BAR;
    PG8_WAIT_V(4); PG8_BAR;
    PG8_STAGE(PG8_SB(1, 0), cB + kstep, voffB); PG8_STGA(PG8_SA(1, 0), cA + kstep, 0, vA); PG8_STAGE(PG8_SB(1, 1), cB + hstep + kstep, voffB);
    PG8_WAIT_V(6); PG8_BAR;
    for (;;) {
        const bool has_next = S.next(ui + 1, nxt);
        const char* nA = has_next ? (const char*)g.A + (GA ? (size_t)0 : (size_t)nxt.pm * tstep) + (size_t)nxt.kt0 * kstep : cA; const char* nB = has_next ? (const char*)g.Bt + (size_t)nxt.e * g.bstride + (size_t)nxt.pn * tstep + (size_t)nxt.kt0 * kstep : cB;
        const int nt = cur.nkt;
        if (GA) { if (has_next) PG8_GIDX(nvA, ui + 1); else {
#pragma unroll
            for (int _h = 0; _h < 2; ++_h) { nvA[_h][0] = vA[_h][0]; nvA[_h][1] = vA[_h][1]; } } }
        for (int t = 0; t < nt; t += 2) {
            const bool last = (t == nt - 2);
            if (GA) {
#pragma unroll
                for (int _h = 0; _h < 2; ++_h) { v2[_h][0] = last ? nvA[_h][0] : vA[_h][0]; v2[_h][1] = last ? nvA[_h][1] : vA[_h][1]; } }
            const char* a1 = cA + (size_t)(t + 1) * kstep;
            const char* a2 = last ? nA : cA + (size_t)(t + 2) * kstep; const char* b2 = last ? nB : cB + (size_t)(t + 2) * kstep;
            const char* a3 = a2 + kstep; const char* b3 = b2 + kstep;
            PG8_LDB(B0, 0, 0); PG8_SCHED; PG8_LDA(At, 0, 0); PG8_STGA(PG8_SA(1, 1), a1, 1, vA);
            PG8_WAIT_L(8); PG8_BAR; PG8_WAIT_L(0); PG8_MMA(0, 0, At, B0); PG8_BAR; PG8_SCHED;
            PG8_LDB(B1, 0, 1); PG8_STAGE(PG8_SB(0, 0), b2, voffB);
            PG8_BAR; PG8_WAIT_L(0); PG8_MMA(0, 1, At, B1); PG8_BAR;
            PG8_LDA(At, 0, 1); PG8_STGA(PG8_SA(0, 0), a2, 0, v2);
            PG8_BAR; PG8_WAIT_L(0); PG8_MMA(1, 0, At, B0); PG8_BAR; PG8_SCHED;
            PG8_STAGE(PG8_SB(0, 1), b2 + hstep, voffB);
            PG8_WAIT_V(6); PG8_BAR; PG8_MMA(1, 1, At, B1); PG8_BAR;
            PG8_LDB(B0, 1, 0); PG8_SCHED; PG8_LDA(At, 1, 0); PG8_STGA(PG8_SA(0, 1), a2, 1, v2);
            PG8_WAIT_L(8); PG8_BAR; PG8_WAIT_L(0); PG8_MMA(0, 0, At, B0); PG8_BAR; PG8_SCHED;
            PG8_LDB(B1, 1, 1); PG8_STAGE(PG8_SB(1, 0), b3, voffB);
            PG8_BAR; PG8_WAIT_L(0); PG8_MMA(0, 1, At, B1); PG8_BAR;
            PG8_LDA(At, 1, 1); PG8_STGA(PG8_SA(1, 0), a3, 0, v2);
            PG8_BAR; PG8_WAIT_L(0); PG8_MMA(1, 0, At, B0); PG8_BAR; PG8_SCHED;
            PG8_STAGE(PG8_SB(1, 1), b3 + hstep, voffB);
            PG8_WAIT_V(6); PG8_BAR; PG8_MMA(1, 1, At, B1); PG8_BAR;
        }
        E(acc, cur, wr, wc, fr, fq);
        if (!has_next) break;
#pragma unroll
        for (int a = 0; a < 2; ++a)
#pragma unroll
            for (int b = 0; b < 2; ++b)
#pragma unroll
                for (int m = 0; m < 4; ++m)
#pragma unroll
                    for (int n = 0; n < 2; ++n) acc[a][b][m][n] = (f32x4){0.f, 0.f, 0.f, 0.f};
        cur = nxt; cA = nA; cB = nB; ++ui;
        if (GA) {
#pragma unroll
            for (int _h = 0; _h < 2; ++_h) { vA[_h][0] = nvA[_h][0]; vA[_h][1] = nvA[_h][1]; } }
    }
    PG8_WAIT_V(0);
    if (wr == 0) PG8_BAR;
    PG8_BAR;
#undef PG8_SA
#undef PG8_SB
#undef PG8_STAGE
#undef PG8_STGA
#undef PG8_GIDX
#undef PG8_LDA
#undef PG8_LDB
#undef PG8_MMA
#undef PG8_WAIT_V
#undef PG8_WAIT_L
#undef PG8_BAR
#undef PG8_SCHED
}

struct EpiBf16 {
    static constexpr bool PERM = true;
    bf16_t* O; int ldc; bf16_t* O2;
    __device__ __forceinline__ void operator()(const f32x4 (&acc)[2][2][4][2], const Unit& u, int wr, int wc, int fr, int fq) const {
        const int row0 = u.pm * BM + wr * 64 + fr, col0 = u.pn * BM + wc * 32 + 8 * fq;
        bf16_t* Ob = (u.ks == 1) ? O2 : O;
#pragma unroll
        for (int ai = 0; ai < 2; ++ai)
#pragma unroll
            for (int m = 0; m < 4; ++m) { bf16_t* rowp = Ob + (size_t)(row0 + ai * HALF + m * 16) * ldc + col0;
#pragma unroll
                for (int bj = 0; bj < 2; ++bj) { const f32x4 v0 = acc[ai][bj][m][0], v1 = acc[ai][bj][m][1];
                    u32x4 w; w.x = pk2(v0[0], v0[1]); w.y = pk2(v0[2], v0[3]); w.z = pk2(v1[0], v1[1]); w.w = pk2(v1[2], v1[3]);
                    *(u32x4*)(rowp + bj * HALF) = w; } }
    }
};
struct EpiEvenIn {
    static constexpr bool PERM = true;
    bf16_t* O; const LAS float* lb;
    __device__ __forceinline__ void operator()(const f32x4 (&acc)[2][2][4][2], const Unit& u, int wr, int wc, int fr, int fq) const {
        const int row0 = u.pm * BM + wr * 64 + fr, col0 = u.pn * BM + wc * 32 + 8 * fq;
        const int kind = (u.pn < 2) ? 1 : (u.pn < 6) ? 2 : (u.pn == 8 || u.pn == 9) ? 3 : 0;
        float lbv[2][8];
        if (kind == 2) {
#pragma unroll
            for (int bj = 0; bj < 2; ++bj)
#pragma unroll
                for (int j = 0; j < 8; ++j) lbv[bj][j] = lb[(col0 + bj * HALF + j) & 511];
        }
#pragma unroll
        for (int ai = 0; ai < 2; ++ai)
#pragma unroll
            for (int m = 0; m < 4; ++m) { bf16_t* rowp = O + (size_t)(row0 + ai * HALF + m * 16) * 3328 + col0;
#pragma unroll
                for (int bj = 0; bj < 2; ++bj) { float v[8];
#pragma unroll
                    for (int j = 0; j < 4; ++j) { v[j] = acc[ai][bj][m][0][j]; v[4 + j] = acc[ai][bj][m][1][j]; }
                    if (kind == 1) {
#pragma unroll
                        for (int j = 0; j < 8; ++j) v[j] = siluf(v[j]) * 0.08838834764831845f; }
                    else if (kind == 2) {
#pragma unroll
                        for (int j = 0; j < 8; ++j) v[j] = __builtin_amdgcn_logf(lbv[bj][j] + (1.0f - lbv[bj][j]) * sigm(v[j])); }
                    else if (kind == 3) {
#pragma unroll
                        for (int j = 0; j < 8; ++j) v[j] = siluf(v[j]); }
                    *(u32x4*)(rowp + bj * HALF) = pk8(v); } }
    }
};
struct EpiResid {
    static constexpr bool PERM = true;
    bf16_t* D0; const float* gate; bf16_t* D1;
    __device__ __forceinline__ void operator()(const f32x4 (&acc)[2][2][4][2], const Unit& u, int wr, int wc, int fr, int fq) const {
        const int row0 = u.pm * BM + wr * 64 + fr, col0 = u.pn * BM + wc * 32 + 8 * fq;
        const int b = u.pm / 9, isctx = (u.pm - b * 9 == 0), mi = isctx ? 8 : b;
        const float* gp = gate + (size_t)mi * 6144 + col0;
        f32x4 gv[2][2];
#pragma unroll
        for (int bj = 0; bj < 2; ++bj)
#pragma unroll
            for (int n = 0; n < 2; ++n) gv[bj][n] = *(const f32x4*)(gp + bj * HALF + 4 * n);
        bf16_t* Db = (u.ks == 1) ? D1 : D0;
#pragma unroll
        for (int ai = 0; ai < 2; ++ai)
#pragma unroll
            for (int m = 0; m < 4; ++m) { bf16_t* rowp = Db + (size_t)(row0 + ai * HALF + m * 16) * 1024 + col0;
#pragma unroll
                for (int bj = 0; bj < 2; ++bj) { const f32x4 v0 = acc[ai][bj][m][0] * gv[bj][0], v1 = acc[ai][bj][m][1] * gv[bj][1];
                    u32x4 w; w.x = pk2(v0[0], v0[1]); w.y = pk2(v0[2], v0[3]); w.z = pk2(v1[0], v1[1]); w.w = pk2(v1[2], v1[3]);
                    *(u32x4*)(rowp + bj * HALF) = w; } }
    }
};
struct EpiSwiGLU {
    static constexpr bool PERM = true;
    bf16_t* O; int ldc;
    __device__ __forceinline__ void operator()(const f32x4 (&acc)[2][2][4][2], const Unit& u, int wr, int wc, int fr, int fq) const {
        const int row0 = u.pm * BM + wr * 64 + fr, col0 = u.pn * HALF + wc * 32 + 8 * fq;
#pragma unroll
        for (int ai = 0; ai < 2; ++ai)
#pragma unroll
            for (int m = 0; m < 4; ++m) { bf16_t* rowp = O + (size_t)(row0 + ai * HALF + m * 16) * ldc + col0;
                float o[8];
#pragma unroll
                for (int n = 0; n < 2; ++n)
#pragma unroll
                    for (int j = 0; j < 4; j += 2) {
                        const f32x2 g2 = {acc[ai][0][m][n][j], acc[ai][0][m][n][j + 1]}, u2 = {acc[ai][1][m][n][j], acc[ai][1][m][n][j + 1]};
                        const f32x2 t = g2 * (-1.4426950408889634f);
                        f32x2 e; e.x = __builtin_amdgcn_exp2f(t.x); e.y = __builtin_amdgcn_exp2f(t.y);
                        const f32x2 d = e + 1.0f;
                        f32x2 r; r.x = __builtin_amdgcn_rcpf(d.x); r.y = __builtin_amdgcn_rcpf(d.y);
                        const f32x2 y = (g2 * u2) * r;
                        o[n * 4 + j] = y.x; o[n * 4 + j + 1] = y.y; }
                *(u32x4*)rowp = pk8(o); }
    }
};
struct EpiGLU {
    static constexpr bool PERM = true;
    const bf16_t* YG; bf16_t* Y;
    __device__ __forceinline__ void operator()(const f32x4 (&acc)[2][2][4][2], const Unit& u, int wr, int wc, int fr, int fq) const {
        const int row0 = u.pm * BM + wr * 64 + fr, col0 = u.pn * BM + wc * 32 + 8 * fq;
#pragma unroll
        for (int ai = 0; ai < 2; ++ai)
#pragma unroll
            for (int m = 0; m < 4; ++m) { const size_t row = (size_t)(row0 + ai * HALF + m * 16);
#pragma unroll
                for (int bj = 0; bj < 2; ++bj) { const int col = col0 + bj * HALF;
                    float y[8], o[8]; unpk8(*(const u32x4*)(YG + row * 512 + col), y);
#pragma unroll
                    for (int n = 0; n < 2; ++n)
#pragma unroll
                        for (int j = 0; j < 4; ++j) o[n * 4 + j] = y[n * 4 + j] * sigm(acc[ai][bj][m][n][j]);
                    *(u32x4*)(Y + row * 1024 + col) = pk8(o); } }
    }
};
}

__device__ __forceinline__ void ada_item(const Params& p, int item, unsigned char* sm) {
    unsigned char* const ws = ows(p.ws);
    const int tid = otid();
    const int l = item / 48, n0 = (item % 48) * 128;
    float* sc = (float*)sm;
    float* red = (float*)(sm + 49152);
    for (int i = tid; i < 9 * 1024; i += 512) { const int m = i >> 10, k = i & 1023; const float v = (m < 8) ? p.in[1][m * 1024 + k] : p.in[3][k]; sc[k * 12 + m] = siluf(v); }
    __syncthreads();
    const int col = tid & 127, kg = tid >> 7;
    float a0 = 0, a1 = 0, a2 = 0, a3 = 0, a4 = 0, a5 = 0, a6 = 0, a7 = 0, a8 = 0;
    const float* w = p.in[4] + (size_t)l * 1024 * 6144 + n0 + col;
#pragma unroll 8
    for (int k = kg * 256; k < kg * 256 + 256; ++k) {
        const float wv = w[(size_t)k * 6144];
        const f32x4 s0 = *(const f32x4*)&sc[k * 12], s1 = *(const f32x4*)&sc[k * 12 + 4]; const float s8 = sc[k * 12 + 8];
        a0 += s0[0] * wv; a1 += s0[1] * wv; a2 += s0[2] * wv; a3 += s0[3] * wv; a4 += s1[0] * wv; a5 += s1[1] * wv; a6 += s1[2] * wv; a7 += s1[3] * wv; a8 += s8 * wv;
    }
    float* rp = red + (kg * 9) * 128 + col;
    rp[0] = a0; rp[128] = a1; rp[256] = a2; rp[384] = a3; rp[512] = a4; rp[640] = a5; rp[768] = a6; rp[896] = a7; rp[1024] = a8;
    __syncthreads();
    float* mod = (float*)(ws + OFF_MOD);
    for (int i = tid; i < 9 * 128; i += 512) { const int m = i >> 7, cc = i & 127;
        const float s = red[(0 * 9 + m) * 128 + cc] + red[(1 * 9 + m) * 128 + cc] + red[(2 * 9 + m) * 128 + cc] + red[(3 * 9 + m) * 128 + cc];
        mod[(size_t)(l * 9 + m) * 6144 + n0 + cc] = s + p.in[5][l * 6144 + n0 + cc]; }
}
__device__ __forceinline__ void rope_item(const Params& p) {
    unsigned char* const ws = ows(p.ws);
    float* COS = (float*)(ws + OFF_COS); float* SIN = (float*)(ws + OFF_SIN);
    for (int i = threadIdx.x; i < 2048 * 32; i += 512) { const int pos = i >> 5, f = i & 31, fi = f & 15;
        const float inv = exp2f(-(float)fi * (13.287712379549449f / 16.0f));
        const float ang = (float)(f < 16 ? (pos >> 6) : (pos & 63)) * inv;
        float s, c; my_sincos(ang, s, c); COS[i] = c; SIN[i] = s; }
}
__device__ __forceinline__ void s5disc_item(const Params& p) {
    unsigned char* const ws = ows(p.ws);
    float* AB = (float*)(ws + OFF_AB); float* BBR = (float*)(ws + OFF_BBR); float* BBI = (float*)(ws + OFF_BBI); float* LB = (float*)(ws + OFF_LB);
    for (int idx = threadIdx.x; idx < 8192; idx += 512) {
        const int pp = idx & 63, g = (idx >> 6) & 31, jd = idx >> 11, jo = jd >> 1;
        const float lr = fminf(p.in[18][idx], -1e-4f), li = p.in[19][idx];
        const float dt = expf(p.in[20][jd * 32 + g]);
        const float mag = expf(lr * dt); float s, c; my_sincos(li * dt, s, c);
        const float abr = mag * c, abi = mag * s, den = lr * lr + li * li, nr = abr - 1.0f;
        const float cor = (nr * lr + abi * li) / den, coi = (abi * lr - nr * li) / den;
        AB[idx * 2] = abr; AB[idx * 2 + 1] = abi;
        const float* br = p.in[21] + (size_t)((jo * 32 + g) * 64 + pp) * 16; const float* bi = p.in[22] + (size_t)((jo * 32 + g) * 64 + pp) * 16;
        for (int h = 0; h < 16; ++h) { BBR[idx * 16 + h] = cor * br[h] - coi * bi[h]; BBI[idx * 16 + h] = cor * bi[h] + coi * br[h]; }
    }
    for (int c = threadIdx.x; c < 512; c += 512) { const float e0 = expf(p.in[10][c]), e1 = expf(p.in[10][512 + c]); LB[c] = 0.f; LB[512 + c] = e1 / (e0 + e1); }
}
struct TrTile { bf16_t* dp; int mode; };
__device__ __forceinline__ void tr_load(const Params& p, int tile, int& j, int jhi, f32x4 (&v)[8], int& k0, int& n0, Job& jb, int tid) {
    while (j + 1 < jhi && tile >= p.jobs[j + 1].tile0) ++j;
    jb = p.jobs[j]; const int t = tile - jb.tile0;
    const int nkt = jb.K >> 7, kt = t % nkt, ntl = t / nkt; k0 = kt * 128; n0 = ntl * 128;
    if (jb.mode == 3) {
#pragma unroll
        for (int i = 0; i < 8; ++i) v[i] = (f32x4){0.f, 0.f, 0.f, 0.f};
    } else if (jb.mode == 4) {
        const int blk = n0 >> 9, jo = jb.aux, sn0 = n0 & 511;
        const float* src = (blk < 4) ? (blk < 2 ? p.in[29] : p.in[31]) + (size_t)(jo * 2 + (blk & 1)) * 64 * 512 : p.in[32] + (size_t)jo * 128 * 512;
        const int klo = (blk < 4) ? 64 * blk : 256, khi = (blk < 4) ? 64 * blk + 64 : 384;
#pragma unroll
        for (int i = 0; i < 8; ++i) { const int idx = tid + 512 * i, kk = k0 + (idx >> 5), n4 = (idx & 31) * 4;
            v[i] = (kk >= klo && kk < khi) ? *(const f32x4*)(src + (size_t)(kk - klo) * 512 + sn0 + n4) : (f32x4){0.f, 0.f, 0.f, 0.f}; }
    } else {
#pragma unroll
        for (int i = 0; i < 8; ++i) { const int idx = tid + 512 * i, kk = idx >> 5, n4 = (idx & 31) * 4;
            v[i] = *(const f32x4*)(jb.src + (size_t)(k0 + kk) * jb.N + n0 + n4); }
    }
}
__device__ __forceinline__ void tr_loop(const Params& p, int first, int stride, int ntiles, int jlo, int jhi, unsigned char* sm) {
    const int tid = otid();
    bf16_t* Lb = (bf16_t*)sm;
    if (first >= ntiles) return;
    int j = jlo, k0, n0; Job jb; f32x4 v[8];
    tr_load(p, first, j, jhi, v, k0, n0, jb, tid);
    for (int tile = first; tile < ntiles; tile += stride) {
#pragma unroll
        for (int i = 0; i < 8; ++i) { const int idx = tid + 512 * i, kk = idx >> 5, n4 = (idx & 31) * 4;
            u32x2 w2; w2.x = pk2(v[i][0], v[i][1]); w2.y = pk2(v[i][2], v[i][3]); *(u32x2*)(Lb + kk * 132 + n4) = w2; }
        const int nn = tid >> 2, kq = tid & 3, ng = n0 + nn;
        int drow = ng;
        if (jb.mode == 1) drow = (ng >> 7) * 256 + (ng & 127);
        else if (jb.mode == 2) drow = (ng >> 7) * 256 + 128 + (ng & 127);
        bf16_t* dp = jb.dst + (size_t)drow * jb.ldd + k0;
        __syncthreads();
        if (tile + stride < ntiles) tr_load(p, tile + stride, j, jhi, v, k0, n0, jb, tid);
#pragma unroll
        for (int g = 0; g < 4; ++g) { const int k8 = g * 32 + kq * 8;
            u32x4 o;
            o.x = (unsigned)Lb[(k8 + 0) * 132 + nn] | ((unsigned)Lb[(k8 + 1) * 132 + nn] << 16); o.y = (unsigned)Lb[(k8 + 2) * 132 + nn] | ((unsigned)Lb[(k8 + 3) * 132 + nn] << 16);
            o.z = (unsigned)Lb[(k8 + 4) * 132 + nn] | ((unsigned)Lb[(k8 + 5) * 132 + nn] << 16); o.w = (unsigned)Lb[(k8 + 6) * 132 + nn] | ((unsigned)Lb[(k8 + 7) * 132 + nn] << 16);
            *(u32x4*)(dp + k8) = o; }
        __syncthreads();
    }
}
__device__ __forceinline__ void phase_prologue_a(const Params& p, unsigned char* sm) {
    const int cb = blockIdx.x, G = gridDim.x;
    for (int item = cb; item < 194; item += G) {
        if (item < 192) ada_item(p, item, sm);
        else if (item == 192) rope_item(p);
        else s5disc_item(p);
        __syncthreads();
    }
    tr_loop(p, (cb + 62) % G, G, p.nt0, 0, p.nj0, sm);
    if (DUPB(10)) { __syncthreads(); tr_loop(p, (cb + 62) % G, G, p.nt0, 0, p.nj0, sm); }
    if (DUPB(11)) { __syncthreads(); for (int item = cb; item < 192; item += G) { ada_item(p, item, sm); __syncthreads(); } }
}
__device__ __forceinline__ void phase_prologue_b(const Params& p) {
    unsigned char* const ws = ows(p.ws);
    const int tid_ = otid(); const int lane = tid_ & 63, w = tid_ >> 6;
    _Float16* X = (_Float16*)(ws + OFF_X); bf16_t* H = (bf16_t*)(ws + OFF_H); const float* mod = (const float*)(ws + OFF_MOD);
    f32x4 shr[4], scr[4]; int cur_mi = -1;
#pragma unroll
    for (int i = 0; i < 4; ++i) { shr[i] = (f32x4){0.f, 0.f, 0.f, 0.f}; scr[i] = shr[i]; }
    const int nwv = gridDim.x * 8, rpw = (TT + nwv - 1) / nwv, row_lo = (blockIdx.x * 8 + w) * rpw, row_hi = row_lo + rpw < TT ? row_lo + rpw : TT;
    for (int row = row_lo; row < row_hi; ++row) {
        const int b = row / SB, s = row - b * SB; const int mi = s < 256 ? 8 : b;
        const float* src = s < 256 ? p.in[2] + ((size_t)b * 256 + s) * 1024 : p.in[0] + ((size_t)b * 2048 + (s - 256)) * 1024;
        if (mi != cur_mi) { cur_mi = mi; const float* mp = mod + (size_t)mi * 6144;
#pragma unroll
            for (int i = 0; i < 4; ++i) { shr[i] = *(const f32x4*)(mp + 4 * lane + 256 * i); scr[i] = *(const f32x4*)(mp + 1024 + 4 * lane + 256 * i); } }
#pragma unroll
        for (int i = 0; i < 4; ++i) { const int c = 4 * lane + 256 * i; const f32x4 v = *(const f32x4*)(src + c);
            *(u32x2*)(X + (size_t)row * 1024 + c) = f2h4(v * ALPHA);
            const f32x4 sh = shr[i], sc = scr[i];
            u32x2 o; o.x = pk2(v[0] * (1.f + sc[0]) + sh[0], v[1] * (1.f + sc[1]) + sh[1]); o.y = pk2(v[2] * (1.f + sc[2]) + sh[2], v[3] * (1.f + sc[3]) + sh[3]);
            *(u32x2*)(H + (size_t)row * 1024 + c) = o; }
    }
}

template <int MODE, bool ROUTE, bool DRY = false>
__device__ __forceinline__ void phase_ln(const Params& p, int layer, size_t part_off, int nsplit, unsigned char* sm) {
    unsigned char* const ws = ows(p.ws);
    const int tid_ = otid(); const int lane = tid_ & 63, w = tid_ >> 6;
    _Float16* X = (_Float16*)(ws + OFF_X); bf16_t* H = (bf16_t*)(ws + OFF_H); const float* mod = (const float*)(ws + OFF_MOD);
    const int which = MODE == 0 ? 0 : 1;
    const float* lg = p.in[6] + (size_t)(layer * 2 + which) * 1024; const float* lbp = p.in[7] + (size_t)(layer * 2 + which) * 1024;
    const bool last = (layer == 3);
    const int jo = layer >> 1;
    unsigned* route = (unsigned*)(ws + OFF_ROUTE);
    unsigned* cnt = (unsigned*)(ws + OFF_CNT) + jo * 512;
    int offs[8];
    int split_row = 0x7fffffff;
    if (MODE == 2) { int acc = 0;
#pragma unroll
        for (int e = 0; e < 8; ++e) { offs[e] = acc; acc += (((int)cnt[e * 64] + 255) >> 8) << 8; }
        const int npan = acc >> 8, G_ = gridDim.x; split_row = ((((npan * 4) / G_) * G_) >> 2) << 8; }
    f32x4 rwr[4][4][2];
    if (ROUTE) { const float* rwg = p.in[38] + (size_t)jo * 8192;
#pragma unroll
        for (int i = 0; i < 4; ++i)
#pragma unroll
            for (int q = 0; q < 4; ++q) { const float* rp = rwg + (size_t)(4 * lane + 256 * i + q) * 8; rwr[i][q][0] = *(const f32x4*)rp; rwr[i][q][1] = *(const f32x4*)(rp + 4); } }
    f32x4 g4r[4], b4r[4], shr[4], scr[4];
#pragma unroll
    for (int i = 0; i < 4; ++i) { g4r[i] = *(const f32x4*)(lg + 4 * lane + 256 * i); b4r[i] = *(const f32x4*)(lbp + 4 * lane + 256 * i); shr[i] = (f32x4){0.f, 0.f, 0.f, 0.f}; scr[i] = shr[i]; }
    int cur_mi = -1, cur_gi = -1; f32x4 gtr[4];
#pragma unroll
    for (int i = 0; i < 4; ++i) gtr[i] = (f32x4){0.f, 0.f, 0.f, 0.f};
    const int nwv = gridDim.x * 8, rpw = (TT + nwv - 1) / nwv, row_lo = (blockIdx.x * 8 + w) * rpw, row_hi = row_lo + rpw < TT ? row_lo + rpw : TT;
    u32x4 rtn4 = {0u, 0u, 0u, 0u}; u32x2 rtn2 = {0u, 0u};
    if (MODE == 2 && row_lo < row_hi) { rtn4 = *(const u32x4*)(route + (size_t)row_lo * 8); rtn2 = *(const u32x2*)(route + (size_t)row_lo * 8 + 4); }
    for (int row = row_lo; row < row_hi; ++row) {
        const int b = row / SB, s = row - b * SB; const int mi = s < 256 ? 8 : b;
        const u32x4 rtc4 = rtn4; const u32x2 rtc2 = rtn2;
        if (MODE == 2) { const int nr = (row + 1 < row_hi) ? row + 1 : row; rtn4 = *(const u32x4*)(route + (size_t)nr * 8); rtn2 = *(const u32x2*)(route + (size_t)nr * 8 + 4); }
        if (last && s < 256 && (MODE != 0 || ROUTE)) {
            if (ROUTE && lane == 0 && !DRY) route[(size_t)row * 8] = 0xffffffffu;
            continue;
        }
        f32x4 v[4];
        _Float16* xr = X + (size_t)row * 1024;
        _Float16* xw = DRY ? (_Float16*)(ws + OFF_S5F) + (size_t)row * 1024 : xr; bf16_t* hw = DRY ? (bf16_t*)(ws + OFF_S5B) + (size_t)row * 1024 : H + (size_t)row * 1024;
#pragma unroll
        for (int i = 0; i < 4; ++i) v[i] = h2f4(*(const u32x2*)(xr + 4 * lane + 256 * i));
        if (MODE != 2) {
            const bf16_t* d0 = (const bf16_t*)(ws + part_off) + (size_t)row * 1024 + 4 * lane;
            const bool two = (s < 256 && nsplit > 0);
#pragma unroll
            for (int i = 0; i < 4; ++i) { v[i] += unpk4v(*(const u32x2*)(d0 + 256 * i)); if (two) v[i] += unpk4v(*(const u32x2*)(d0 + (size_t)TT * 1024 + 256 * i)); }
        }
        if (MODE == 2) {
            const int e1 = (int)rtc4.x, e2 = (int)rtc4.y; const int r1 = (int)rtc4.z, r2 = (int)rtc4.w; const float p1 = __uint_as_float(rtc2.x), p2 = __uint_as_float(rtc2.y);
            int o1 = 0, o2 = 0;
#pragma unroll
            for (int e = 0; e < 8; ++e) { o1 = (e == e1) ? offs[e] : o1; o2 = (e == e2) ? offs[e] : o2; }
            const bf16_t* F = (const bf16_t*)(ws + OFF_AR + AM_A);
            const bf16_t* f1 = F + (size_t)(o1 + r1) * 1024; const bf16_t* f2 = F + (size_t)(o2 + r2) * 1024;
            const bf16_t* F2 = (const bf16_t*)(ws + OFF_GE);
            const bool s1 = (o1 + r1) >= split_row, s2 = (o2 + r2) >= split_row;
            if (mi != cur_gi) { cur_gi = mi; const float* gt = mod + (size_t)(layer * 9 + mi) * 6144 + 5120;
#pragma unroll
                for (int i = 0; i < 4; ++i) gtr[i] = *(const f32x4*)(gt + 4 * lane + 256 * i); }
#pragma unroll
            for (int i = 0; i < 4; ++i) { const int c = 4 * lane + 256 * i; float a[4], bb[4]; unpk4(*(const u32x2*)(f1 + c), a); unpk4(*(const u32x2*)(f2 + c), bb);
                if (s1) { float t_[4]; unpk4(*(const u32x2*)(F2 + (size_t)(o1 + r1) * 1024 + c), t_); a[0] += t_[0]; a[1] += t_[1]; a[2] += t_[2]; a[3] += t_[3]; }
                if (s2) { float t_[4]; unpk4(*(const u32x2*)(F2 + (size_t)(o2 + r2) * 1024 + c), t_); bb[0] += t_[0]; bb[1] += t_[1]; bb[2] += t_[2]; bb[3] += t_[3]; }
                const f32x4 g4 = gtr[i];
#pragma unroll
                for (int q = 0; q < 4; ++q) v[i][q] = v[i][q] + g4[q] * (p1 * a[q] + p2 * bb[q]); }
        }
        float sm_ = 0.f;
#pragma unroll
        for (int i = 0; i < 4; ++i) sm_ += (v[i][0] + v[i][1]) + (v[i][2] + v[i][3]);
        const float mean = sum64(sm_) * (1.0f / 1024.0f);
        float sq = 0.f;
#pragma unroll
        for (int i = 0; i < 4; ++i) { const f32x4 d = v[i] - mean; sq += (d[0] * d[0] + d[1] * d[1]) + (d[2] * d[2] + d[3] * d[3]); }
        const float rstd = rsqrtf(sum64(sq) * (1.0f / 1024.0f) + 1e-5f);
        if (mi != cur_mi) { cur_mi = mi;
            const float* mp = (MODE == 0) ? mod + (size_t)(layer * 9 + mi) * 6144 + 3072 : mod + (size_t)((last ? 0 : layer + 1) * 9 + mi) * 6144;
#pragma unroll
            for (int i = 0; i < 4; ++i) { shr[i] = *(const f32x4*)(mp + 4 * lane + 256 * i); scr[i] = *(const f32x4*)(mp + 1024 + 4 * lane + 256 * i); } }
        float lg8[8];
#pragma unroll
        for (int e = 0; e < 8; ++e) lg8[e] = 0.f;
#pragma unroll
        for (int i = 0; i < 4; ++i) { const int c = 4 * lane + 256 * i;
            const f32x4 y = (v[i] - mean) * rstd * g4r[i] + b4r[i];
            if (MODE != 0 && last) { if (!DRY) *(f32x4*)(p.out + ((size_t)b * 2048 + (s - 256)) * 1024 + c) = y; else *(u32x2*)(xw + c) = f2h4(y); }
            else {
                *(u32x2*)(xw + c) = f2h4(y * ALPHA);
                const f32x4 h = y * (1.0f + scr[i]) + shr[i];
                u32x2 o; o.x = pk2(h[0], h[1]); o.y = pk2(h[2], h[3]);
                *(u32x2*)(hw + c) = o;
                if (ROUTE) {
#pragma unroll
                    for (int e = 0; e < 8; ++e) lg8[e] += (h[0] * rwr[i][0][e >> 2][e & 3] + h[1] * rwr[i][1][e >> 2][e & 3]) + (h[2] * rwr[i][2][e >> 2][e & 3] + h[3] * rwr[i][3][e >> 2][e & 3]); }
            }
        }
        if (ROUTE) {
#pragma unroll
            for (int e = 0; e < 8; ++e) lg8[e] = sum64(lg8[e]) + p.in[39][jo * 8 + e];
            int e1 = 0; float v1 = lg8[0];
#pragma unroll
            for (int e = 1; e < 8; ++e) if (lg8[e] > v1) { v1 = lg8[e]; e1 = e; }
            int e2 = -1; float v2 = -3.0e38f;
#pragma unroll
            for (int e = 0; e < 8; ++e) if (e != e1 && lg8[e] > v2) { v2 = lg8[e]; e2 = e; }
            if (lane == 0 && !DRY) {
                const float p1 = 1.0f / (1.0f + __expf(v2 - v1)), p2 = 1.0f - p1;
                const unsigned r1 = atomicAdd(&cnt[e1 * 64], 1u), r2 = atomicAdd(&cnt[e2 * 64], 1u);
                unsigned* rt = route + (size_t)row * 8;
                rt[0] = (unsigned)e1; rt[1] = (unsigned)e2; rt[2] = r1; rt[3] = r2; rt[4] = __float_as_uint(p1); rt[5] = __float_as_uint(p2);
                unsigned* inv = (unsigned*)(ws + OFF_INV); inv[(size_t)e1 * TT + r1] = (unsigned)row; inv[(size_t)e2 * TT + r2] = (unsigned)row;
            }
        }
    }
}
__device__ __forceinline__ int scan_row(int dir, int n) { return dir == 0 ? n : (n < 256 ? 255 - n : 2559 - n); }
__device__ __forceinline__ void hgrn_chunk_unit(const Params& p, int j, int u, unsigned char* sm) {
    unsigned char* const ws = ows(p.ws);
    const int tid = otid(), lane = tid & 63, w = tid >> 6, l15 = lane & 15, kg = lane >> 4;
    const int chf = u & 1, dir = (u >> 1) & 1, h = (u >> 2) & 3, b = u >> 4;
    const int ct = 4 * chf + (w & 3);
    const bf16_t* P = (const bf16_t*)(ws + OFF_AR + AE_P);
    bf16_t* O = (bf16_t*)(ws + OFF_AR + (dir ? AE_OB : AE_OF));
    const size_t rb = (size_t)b * SB;
    const int pd = tid >> 2, tq = tid & 3;
    const int ppos = (pd & ~31) + 8 * ((pd & 15) >> 2) + 4 * ((pd >> 4) & 1) + (pd & 3);
    const int rstep = dir ? -1 : 1;
    constexpr int RAW0 = 2 * 21504, RAWSZ = 3 * 16 * 136 * 2;
    const int t4 = tid & 255, lt = t4 >> 4, lc = t4 & 15;
    u32x4 gq, gf, gv;
#define HG_LOAD(c) do { const size_t row = rb + scan_row(dir, (c) * 16 + lt); const bf16_t* pr = P + row * 3328 + h * 128 + 8 * lc; \
        gq = *(const u32x4*)pr; gf = *(const u32x4*)(pr + 512 + dir * 512); gv = *(const u32x4*)(pr + 1536); } while (0)
#define HG_RAWW(bi) do { bf16_t* rw = (bf16_t*)(sm + RAW0 + (bi) * RAWSZ) + lt * 136 + 8 * lc; \
        *(u32x4*)rw = gq; *(u32x4*)(rw + 16 * 136) = gf; *(u32x4*)(rw + 32 * 136) = gv; } while (0)
    unsigned short rq[4], rf[4], rv[4];
#define HG_RAWR(bi) do { const bf16_t* rr_ = (const bf16_t*)(sm + RAW0 + (bi) * RAWSZ) + (4 * tq) * 136 + pd; \
        _Pragma("unroll") for (int k = 0; k < 4; ++k) { rq[k] = rr_[k * 136]; rf[k] = rr_[(16 + k) * 136]; rv[k] = rr_[(32 + k) * 136]; } } while (0)
#define HG_PREP(bufi) do { \
        bf16_t* Qd = (bf16_t*)(sm + (bufi) * 21504); bf16_t* Kd = Qd + 16 * 136; bf16_t* KeT = Kd + 16 * 136; bf16_t* Vt = KeT + 128 * 24; float* dec = (float*)(Vt + 128 * 24); \
        float qv[4], kk[4], cl[4]; float run = 0.f; \
        _Pragma("unroll") for (int k = 0; k < 4; ++k) { const float lg = bf2f(rf[k]); \
            qv[k] = bf2f(rq[k]); kk[k] = 1.0f - __builtin_amdgcn_exp2f(lg); run += lg; cl[k] = run; } \
        float x1 = dppf<0x93>(run); x1 = (tq >= 1) ? x1 : 0.f;            \
        float s2 = run + x1; float x2 = dppf<0x4E>(s2); x2 = (tq >= 2) ? x2 : 0.f; \
        const float incl = s2 + x2; const float off = incl - run; \
        const float btot = dppf<0xFF>(incl);                                  \
        const float etot = __builtin_amdgcn_exp2f(btot); \
        float ke[4]; \
        _Pragma("unroll") for (int k = 0; k < 4; ++k) { const float bl = off + cl[k]; const float E = __builtin_amdgcn_exp2f(bl); const float iE = __builtin_amdgcn_rcpf(E); \
            const float qd = qv[k] * E, kd = kk[k] * iE; ke[k] = kd * etot; \
            Qd[(4 * tq + k) * 136 + ppos] = (bf16_t)(pk2(qd, 0.f) & 0xffff); Kd[(4 * tq + k) * 136 + ppos] = (bf16_t)(pk2(kd, 0.f) & 0xffff); } \
        { u32x2 w2; w2.x = pk2(ke[0], ke[1]); w2.y = pk2(ke[2], ke[3]); *(u32x2*)(KeT + pd * 24 + 4 * tq) = w2; \
          u32x2 v2; v2.x = (unsigned)rv[0] | ((unsigned)rv[1] << 16); v2.y = (unsigned)rv[2] | ((unsigned)rv[3] << 16); *(u32x2*)(Vt + pd * 24 + 4 * tq) = v2; } \
        if (tq == 0) dec[pd] = etot; } while (0)
    f32x4 S[8];
#pragma unroll
    for (int i = 0; i < 8; ++i) S[i] = (f32x4){0.f, 0.f, 0.f, 0.f};
    if (w >= 4) { HG_LOAD(0); HG_RAWW(0); HG_LOAD(1); }
    LDS_BARRIER();
    HG_RAWR(0); HG_PREP(0);
    if (w >= 4) { HG_RAWW(1); HG_LOAD(2); }
    LDS_BARRIER();
    for (int c = 0; c < 144; ++c) {
        if (c + 1 < 144) { HG_RAWR((c + 1) & 1); HG_PREP((c + 1) & 1); }
        if (w >= 4) { if (c + 2 < 144) { HG_RAWW(c & 1); } if (c + 3 < 144) { HG_LOAD(c + 3); } }
        if (w < 4) {
            const bf16_t* Qd = (const bf16_t*)(sm + (c & 1) * 21504); const bf16_t* Kd = Qd + 16 * 136; const bf16_t* KeT = Kd + 16 * 136; const bf16_t* Vt = KeT + 128 * 24; const float* dec = (const float*)(Vt + 128 * 24);
            f32x4 AT = {0.f, 0.f, 0.f, 0.f};
            bf16x8 qf[4];
#pragma unroll
            for (int ks = 0; ks < 4; ++ks) { const bf16x8 kf = *(const bf16x8*)(Kd + l15 * 136 + 32 * ks + 8 * kg); qf[ks] = *(const bf16x8*)(Qd + l15 * 136 + 32 * ks + 8 * kg);
                AT = __builtin_amdgcn_mfma_f32_16x16x32_bf16(kf, qf[ks], AT, 0, 0, 0); }
            u32x4 aw;
            aw.x = pk2((4 * kg + 0 <= l15) ? AT[0] : 0.f, (4 * kg + 1 <= l15) ? AT[1] : 0.f); aw.y = pk2((4 * kg + 2 <= l15) ? AT[2] : 0.f, (4 * kg + 3 <= l15) ? AT[3] : 0.f); aw.z = 0u; aw.w = 0u;
            const bf16x8 afrag = __builtin_bit_cast(bf16x8, aw);
            u32x4 vw; { const u32x2 v2 = *(const u32x2*)(Vt + (16 * ct + l15) * 24 + 4 * kg); vw.x = v2.x; vw.y = v2.y; vw.z = 0u; vw.w = 0u; }
            const bf16x8 vfrag = __builtin_bit_cast(bf16x8, vw);
            f32x4 Oa = {0.f, 0.f, 0.f, 0.f};
            Oa = __builtin_amdgcn_mfma_f32_16x16x32_bf16(afrag, vfrag, Oa, 0, 0, 0);
#pragma unroll
            for (int pi = 0; pi < 4; ++pi) {
                u32x4 sw; sw.x = pk2(S[2 * pi][0], S[2 * pi][1]); sw.y = pk2(S[2 * pi][2], S[2 * pi][3]); sw.z = pk2(S[2 * pi + 1][0], S[2 * pi + 1][1]); sw.w = pk2(S[2 * pi + 1][2], S[2 * pi + 1][3]);
                Oa = __builtin_amdgcn_mfma_f32_16x16x32_bf16(qf[pi], __builtin_bit_cast(bf16x8, sw), Oa, 0, 0, 0);
            }
            { bf16_t* op = O + (rb + scan_row(dir, c * 16 + 4 * kg)) * 512 + h * 128 + 16 * ct + l15;
#pragma unroll
              for (int i = 0; i < 4; ++i) op[(ptrdiff_t)(rstep * i) * 512] = (bf16_t)(pk2(Oa[i], 0.f) & 0xffff); }
#pragma unroll
            for (int dt = 0; dt < 8; ++dt) {
                const f32x4 dv = *(const f32x4*)(dec + 16 * dt + 4 * kg);
                u32x4 kw; { const u32x2 k2 = *(const u32x2*)(KeT + (16 * dt + l15) * 24 + 4 * kg); kw.x = k2.x; kw.y = k2.y; kw.z = 0u; kw.w = 0u; }
                S[dt] = __builtin_amdgcn_mfma_f32_16x16x32_bf16(__builtin_bit_cast(bf16x8, kw), vfrag, S[dt] * dv, 0, 0, 0);
            }
        }
        LDS_BARRIER();
    }
#undef HG_LOAD
#undef HG_RAWW
#undef HG_RAWR
#undef HG_PREP
}
__device__ __forceinline__ void hgrn_finish_rows(const Params& p, int j) {
    unsigned char* const ws = ows(p.ws);
    const int tid_ = otid(); const int lane = tid_ & 63, w = tid_ >> 6;
    const bf16_t* P = (const bf16_t*)(ws + OFF_AR + AE_P);
    const bf16_t* OF = (const bf16_t*)(ws + OFF_AR + AE_OF); const bf16_t* OB = (const bf16_t*)(ws + OFF_AR + AE_OB);
    bf16_t* Y = (bf16_t*)(ws + OFF_AR + AE_Y);
    const int c0 = lane * 8;
    const int nwv = gridDim.x * 8, rpw = (TT + nwv - 1) / nwv, row_lo = (blockIdx.x * 8 + w) * rpw, row_hi = (row_lo + rpw < TT) ? row_lo + rpw : TT;
    const f32x4 ng0 = *(const f32x4*)(p.in[11] + j * 512 + c0), ng1 = *(const f32x4*)(p.in[11] + j * 512 + c0 + 4);
    for (int row = row_lo; row < row_hi; ++row) {
        float o[8], g[8];
        { float fa[8], fb[8]; unpk8(*(const u32x4*)(OF + (size_t)row * 512 + c0), fa); unpk8(*(const u32x4*)(OB + (size_t)row * 512 + c0), fb);
#pragma unroll
          for (int i = 0; i < 8; ++i) o[i] = fa[i] + fb[i]; }
        unpk8(*(const u32x4*)(P + (size_t)row * 3328 + 2048 + c0), g);
        float ssq = 0.f;
#pragma unroll
        for (int i = 0; i < 8; ++i) ssq += o[i] * o[i];
        ssq = sum16(ssq);
        const float r = rsqrtf(ssq * (1.0f / 128.0f) + 1e-6f);
        float y[8];
#pragma unroll
        for (int i = 0; i < 4; ++i) { y[i] = o[i] * r * ng0[i] * g[i]; y[4 + i] = o[4 + i] * r * ng1[i] * g[4 + i]; }
        *(u32x4*)(Y + (size_t)row * 1024 + c0) = pk8(y);
    }
}

__device__ __forceinline__ void attn_unit(const Params& p, int j, int u, unsigned char* sm) {
    unsigned char* const ws = ows(p.ws);
    const int tid = otid(), lane = tid & 63, w = tid >> 6;
    const int b = u / 72, rem = u - b * 72, g = rem / 36, qb = rem - g * 36;
    const int r4 = w & 3, sub = w >> 2, hh = g * 4 + r4, l31 = lane & 31, hf = lane >> 5;
    bf16_t* Ks = (bf16_t*)sm; bf16_t* Vt = Ks + 64 * 72;
    const bf16_t* P = (const bf16_t*)(ws + OFF_AR + AE_P); bf16_t* Y = (bf16_t*)(ws + OFF_AR + AE_Y);
    const float* COS = (const float*)(ws + OFF_COS); const float* SIN = (const float*)(ws + OFF_SIN);
    const bool isl = qb < 32;
    const int q0 = isl ? qb * 64 : (qb - 32) * 64;
    const size_t rb = (size_t)b * SB;
    const int qpos = q0 + sub * 32 + l31;
    const size_t qrow = rb + (isl ? 256 : 0) + qpos;
    bf16x8 qf[4];
    {
        const bf16_t* qp = P + qrow * 3328 + 2560 + hh * 64;
        float x1a[8], x1b[8], x2a[8], x2b[8];
        unpk8(*(const u32x4*)(qp + 8 * hf), x1a); unpk8(*(const u32x4*)(qp + 16 + 8 * hf), x1b);
        unpk8(*(const u32x4*)(qp + 32 + 8 * hf), x2a); unpk8(*(const u32x4*)(qp + 48 + 8 * hf), x2b);
        const float sc = 0.125f * 1.4426950408889634f;
        float o0[8], o1[8], o2[8], o3[8];
        if (isl) {
            const float* cp = COS + qpos * 32 + 8 * hf; const float* sp = SIN + qpos * 32 + 8 * hf;
#pragma unroll
            for (int i = 0; i < 8; ++i) { const float ca = cp[i], sa = sp[i], cb = cp[16 + i], sb = sp[16 + i];
                o0[i] = (x1a[i] * ca - x2a[i] * sa) * sc; o2[i] = (x1a[i] * sa + x2a[i] * ca) * sc;
                o1[i] = (x1b[i] * cb - x2b[i] * sb) * sc; o3[i] = (x1b[i] * sb + x2b[i] * cb) * sc; }
        } else {
#pragma unroll
            for (int i = 0; i < 8; ++i) { o0[i] = x1a[i] * sc; o1[i] = x1b[i] * sc; o2[i] = x2a[i] * sc; o3[i] = x2b[i] * sc; }
        }
        qf[0] = __builtin_bit_cast(bf16x8, pk8(o0)); qf[1] = __builtin_bit_cast(bf16x8, pk8(o1)); qf[2] = __builtin_bit_cast(bf16x8, pk8(o2)); qf[3] = __builtin_bit_cast(bf16x8, pk8(o3));
    }
    float m = p.in[12][j * 8 + hh] * 1.4426950408889634f;
    float lsum = hf == 0 ? 1.0f : 0.0f;
    f32x16 O0, O1;
#pragma unroll
    for (int i = 0; i < 16; ++i) { O0[i] = 0.f; O1[i] = 0.f; }
    const int nch = isl ? 9 : 4;
    for (int ci = 0; ci < nch; ++ci) {
        const bool win = isl && ci < 5;
        int w0 = 0; size_t krow0;
        if (win) { w0 = q0 - 128 + 64 * ci; if (w0 < 0 || w0 >= 2048) continue; krow0 = rb + 256 + w0; }
        else { const int cc = isl ? ci - 5 : ci; krow0 = rb + cc * 64; }
        __syncthreads();
        if (tid < 256) {
            const int key = tid >> 2, dq = tid & 3;
            const bf16_t* src = P + (krow0 + key) * 3328 + 2560 + 512 + g * 64;
            u32x4 r1 = *(const u32x4*)(src + dq * 8), r2 = *(const u32x4*)(src + 32 + dq * 8);
            if (win) {
                float x1[8], x2[8], y1[8], y2[8]; unpk8(r1, x1); unpk8(r2, x2);
                const float* cp = COS + (w0 + key) * 32 + dq * 8; const float* sp = SIN + (w0 + key) * 32 + dq * 8;
#pragma unroll
                for (int i = 0; i < 8; ++i) { const float c_ = cp[i], s_ = sp[i]; y1[i] = x1[i] * c_ - x2[i] * s_; y2[i] = x1[i] * s_ + x2[i] * c_; }
                r1 = pk8(y1); r2 = pk8(y2);
            }
            *(u32x4*)(Ks + key * 72 + dq * 8) = r1; *(u32x4*)(Ks + key * 72 + 32 + dq * 8) = r2;
        } else {
            const int t2 = tid - 256, key = t2 >> 2, dq = t2 & 3;
            const bf16_t* src = P + (krow0 + key) * 3328 + 2560 + 640 + g * 64 + dq * 16;
            const u32x4 r1 = *(const u32x4*)src, r2 = *(const u32x4*)(src + 8);
            bf16_t* vp = Vt + (dq * 16) * 72 + key;
            vp[0 * 72] = (bf16_t)(r1.x & 0xffff); vp[1 * 72] = (bf16_t)(r1.x >> 16); vp[2 * 72] = (bf16_t)(r1.y & 0xffff); vp[3 * 72] = (bf16_t)(r1.y >> 16);
            vp[4 * 72] = (bf16_t)(r1.z & 0xffff); vp[5 * 72] = (bf16_t)(r1.z >> 16); vp[6 * 72] = (bf16_t)(r1.w & 0xffff); vp[7 * 72] = (bf16_t)(r1.w >> 16);
            vp[8 * 72] = (bf16_t)(r2.x & 0xffff); vp[9 * 72] = (bf16_t)(r2.x >> 16); vp[10 * 72] = (bf16_t)(r2.y & 0xffff); vp[11 * 72] = (bf16_t)(r2.y >> 16);
            vp[12 * 72] = (bf16_t)(r2.z & 0xffff); vp[13 * 72] = (bf16_t)(r2.z >> 16); vp[14 * 72] = (bf16_t)(r2.w & 0xffff); vp[15 * 72] = (bf16_t)(r2.w >> 16);
        }
        __syncthreads();
        f32x16 s0, s1;
#pragma unroll
        for (int i = 0; i < 16; ++i) { s0[i] = 0.f; s1[i] = 0.f; }
#pragma unroll
        for (int s = 0; s < 4; ++s) {
            const bf16x8 a0 = *(const bf16x8*)(Ks + l31 * 72 + 16 * s + 8 * hf), a1 = *(const bf16x8*)(Ks + (32 + l31) * 72 + 16 * s + 8 * hf);
            s0 = __builtin_amdgcn_mfma_f32_32x32x16_bf16(a0, qf[s], s0, 0, 0, 0);
            s1 = __builtin_amdgcn_mfma_f32_32x32x16_bf16(a1, qf[s], s1, 0, 0, 0);
        }
        if (win) {
#pragma unroll
            for (int i = 0; i < 16; ++i) { const int key = 8 * (i >> 2) + 4 * hf + (i & 3); const int d0 = qpos - (w0 + key), d1 = d0 - 32;
                if (d0 > 128 || d0 < -128) s0[i] = -INFINITY;
                if (d1 > 128 || d1 < -128) s1[i] = -INFINITY; }
        }
        float mt = s0[0];
#pragma unroll
        for (int i = 1; i < 16; ++i) mt = fmaxf(mt, s0[i]);
#pragma unroll
        for (int i = 0; i < 16; ++i) mt = fmaxf(mt, s1[i]);
        mt = fmaxf(mt, __shfl_xor(mt, 32));
        const float mnew = fmaxf(m, mt), alpha = __builtin_amdgcn_exp2f(m - mnew);
        m = mnew;
        float rs = 0.f;
#pragma unroll
        for (int i = 0; i < 16; ++i) { s0[i] = __builtin_amdgcn_exp2f(s0[i] - mnew); s1[i] = __builtin_amdgcn_exp2f(s1[i] - mnew); rs += s0[i] + s1[i]; }
        lsum = lsum * alpha + rs;
#pragma unroll
        for (int i = 0; i < 16; ++i) { O0[i] *= alpha; O1[i] *= alpha; }
#pragma unroll
        for (int kt = 0; kt < 2; ++kt)
#pragma unroll
            for (int s2 = 0; s2 < 2; ++s2) {
                u32x4 pw;
                if (kt == 0) { pw.x = pk2(s0[8 * s2], s0[8 * s2 + 1]); pw.y = pk2(s0[8 * s2 + 2], s0[8 * s2 + 3]); pw.z = pk2(s0[8 * s2 + 4], s0[8 * s2 + 5]); pw.w = pk2(s0[8 * s2 + 6], s0[8 * s2 + 7]); }
                else { pw.x = pk2(s1[8 * s2], s1[8 * s2 + 1]); pw.y = pk2(s1[8 * s2 + 2], s1[8 * s2 + 3]); pw.z = pk2(s1[8 * s2 + 4], s1[8 * s2 + 5]); pw.w = pk2(s1[8 * s2 + 6], s1[8 * s2 + 7]); }
                const bf16x8 pf = __builtin_bit_cast(bf16x8, pw);
#pragma unroll
                for (int mt2 = 0; mt2 < 2; ++mt2) {
                    const bf16_t* vp = Vt + (mt2 * 32 + l31) * 72 + kt * 32 + 16 * s2 + 4 * hf;
                    const u32x2 lo = *(const u32x2*)vp, hi = *(const u32x2*)(vp + 8);
                    u32x4 vv; vv.x = lo.x; vv.y = lo.y; vv.z = hi.x; vv.w = hi.y;
                    const bf16x8 vf = __builtin_bit_cast(bf16x8, vv);
                    if (mt2 == 0) O0 = __builtin_amdgcn_mfma_f32_32x32x16_bf16(vf, pf, O0, 0, 0, 0);
                    else O1 = __builtin_amdgcn_mfma_f32_32x32x16_bf16(vf, pf, O1, 0, 0, 0);
                }
            }
    }
    const float ltot = lsum + __shfl_xor(lsum, 32);
    const float inv = 1.0f / ltot;
    bf16_t* yp = Y + qrow * 1024 + 512 + hh * 64;
#pragma unroll
    for (int ib = 0; ib < 4; ++ib) {
        u32x2 o; o.x = pk2(O0[4 * ib] * inv, O0[4 * ib + 1] * inv); o.y = pk2(O0[4 * ib + 2] * inv, O0[4 * ib + 3] * inv);
        *(u32x2*)(yp + 8 * ib + 4 * hf) = o;
        u32x2 o2; o2.x = pk2(O1[4 * ib] * inv, O1[4 * ib + 1] * inv); o2.y = pk2(O1[4 * ib + 2] * inv, O1[4 * ib + 3] * inv);
        *(u32x2*)(yp + 32 + 8 * ib + 4 * hf) = o2;
    }
    __syncthreads();
}

__device__ __forceinline__ float partner32(float x) {
    const unsigned xb = __builtin_bit_cast(unsigned, x);
    auto r = __builtin_amdgcn_permlane32_swap(xb, xb, false, false);
    const unsigned pb = (r[0] == xb) ? r[1] : r[0];
    return __builtin_bit_cast(float, pb);
}
__device__ __forceinline__ void s5_scan_task(const Params& p, int jo, int task, unsigned char* smw) {
    unsigned char* const ws = ows(p.ws);
    const int lane = otid() & 63, l31 = lane & 31, hf = lane >> 5, l15 = lane & 15, kg = lane >> 4;
    const int dir = task & 1, g = (task >> 1) & 31, b = task >> 6;
    bf16_t* Xs = (bf16_t*)smw;
    const bf16_t* P = (const bf16_t*)(ws + OFF_AR + AO_YG);
    bf16_t* Yd = (bf16_t*)(ws + (dir ? OFF_S5B : OFF_S5F));
    const size_t rb = (size_t)b * SB;
    const int idx0 = ((jo * 2 + dir) * 32 + g) * 64 + l31, idx1 = idx0 + 32;
    const float* AB = (const float*)(ws + OFF_AB);
    const float ar0 = AB[idx0 * 2], ai0 = AB[idx0 * 2 + 1], ar1 = AB[idx1 * 2], ai1 = AB[idx1 * 2 + 1];
    bf16x8 bbf[4];
    { const float* BR = (const float*)(ws + OFF_BBR); const float* BI = (const float*)(ws + OFF_BBI);
      float t8[8];
#pragma unroll
      for (int j = 0; j < 8; ++j) t8[j] = BR[(size_t)idx0 * 16 + 8 * hf + j];
      bbf[0] = __builtin_bit_cast(bf16x8, pk8(t8));
#pragma unroll
      for (int j = 0; j < 8; ++j) t8[j] = BR[(size_t)idx1 * 16 + 8 * hf + j];
      bbf[1] = __builtin_bit_cast(bf16x8, pk8(t8));
#pragma unroll
      for (int j = 0; j < 8; ++j) t8[j] = BI[(size_t)idx0 * 16 + 8 * hf + j];
      bbf[2] = __builtin_bit_cast(bf16x8, pk8(t8));
#pragma unroll
      for (int j = 0; j < 8; ++j) t8[j] = BI[(size_t)idx1 * 16 + 8 * hf + j];
      bbf[3] = __builtin_bit_cast(bf16x8, pk8(t8)); }
    bf16x8 cmf[4], dskf;
    { const float* c1 = p.in[23] + (size_t)((jo * 32 + g) * 16 + l15) * 64; const float* c2 = p.in[24] + (size_t)((jo * 32 + g) * 16 + l15) * 64;
#pragma unroll
      for (int ks = 0; ks < 4; ++ks) { float t8[8];
#pragma unroll
          for (int j = 0; j < 8; ++j) { const int n = 8 * ks + 2 * kg + (j >> 2), q = j & 3; const int pp = n + 32 * (q & 1); t8[j] = (q < 2) ? c1[pp] : -c2[pp]; }
          cmf[ks] = __builtin_bit_cast(bf16x8, pk8(t8)); }
      float t8[8]; const float dv = p.in[25][jo * 512 + g * 16 + l15];
#pragma unroll
      for (int j = 0; j < 8; ++j) t8[j] = (kg < 2 && 8 * kg + j == l15) ? dv : 0.f;
      dskf = __builtin_bit_cast(bf16x8, pk8(t8)); }
    float xr0 = 0.f, xi0 = 0.f, xr1 = 0.f, xi1 = 0.f;
    u32x4 ua = *(const u32x4*)(P + (rb + scan_row(dir, l31)) * 512 + g * 16 + 8 * hf);
    for (int c = 0; c < 72; ++c) {
        f32x16 D0, D1, D2, D3;
#pragma unroll
        for (int i = 0; i < 16; ++i) { D0[i] = 0.f; D1[i] = 0.f; D2[i] = 0.f; D3[i] = 0.f; }
        { const bf16x8 uf = __builtin_bit_cast(bf16x8, ua);
          D0 = __builtin_amdgcn_mfma_f32_32x32x16_bf16(uf, bbf[0], D0, 0, 0, 0); D1 = __builtin_amdgcn_mfma_f32_32x32x16_bf16(uf, bbf[1], D1, 0, 0, 0);
          D2 = __builtin_amdgcn_mfma_f32_32x32x16_bf16(uf, bbf[2], D2, 0, 0, 0); D3 = __builtin_amdgcn_mfma_f32_32x32x16_bf16(uf, bbf[3], D3, 0, 0, 0); }
        if (c + 1 < 72) ua = *(const u32x4*)(P + (rb + scan_row(dir, (c + 1) * 32 + l31)) * 512 + g * 16 + 8 * hf);
#pragma unroll
        for (int m = 0; m < 4; ++m) {
            float A_[4][4], B_[4][4];
#pragma unroll
            for (int k = 0; k < 4; ++k) { const int i = 4 * m + k;
                const float n0r = ar0 * xr0 - ai0 * xi0 + D0[i], n0i = ar0 * xi0 + ai0 * xr0 + D2[i];
                const float n1r = ar1 * xr1 - ai1 * xi1 + D1[i], n1i = ar1 * xi1 + ai1 * xr1 + D3[i];
                xr0 = n0r; xi0 = n0i; xr1 = n1r; xi1 = n1i; A_[k][0] = xr0; A_[k][1] = xr1; A_[k][2] = xi0; A_[k][3] = xi1; }
            { const float q0 = partner32(xr0), q1 = partner32(xi0), q2 = partner32(xr1), q3 = partner32(xi1);
              xr0 = hf ? q0 : xr0; xi0 = hf ? q1 : xi0; xr1 = hf ? q2 : xr1; xi1 = hf ? q3 : xi1; }
#pragma unroll
            for (int k = 0; k < 4; ++k) { const int i = 4 * m + k;
                const float n0r = ar0 * xr0 - ai0 * xi0 + D0[i], n0i = ar0 * xi0 + ai0 * xr0 + D2[i];
                const float n1r = ar1 * xr1 - ai1 * xi1 + D1[i], n1i = ar1 * xi1 + ai1 * xr1 + D3[i];
                xr0 = n0r; xi0 = n0i; xr1 = n1r; xi1 = n1i; B_[k][0] = xr0; B_[k][1] = xr1; B_[k][2] = xi0; B_[k][3] = xi1; }
            { const float q0 = partner32(xr0), q1 = partner32(xi0), q2 = partner32(xr1), q3 = partner32(xi1);
              xr0 = hf ? xr0 : q0; xi0 = hf ? xi0 : q1; xr1 = hf ? xr1 : q2; xi1 = hf ? xi1 : q3; }
#pragma unroll
            for (int k = 0; k < 4; ++k) { const int t = 8 * m + 4 * hf + k;
                u32x2 w2; w2.x = pk2(hf ? B_[k][0] : A_[k][0], hf ? B_[k][1] : A_[k][1]); w2.y = pk2(hf ? B_[k][2] : A_[k][2], hf ? B_[k][3] : A_[k][3]);
                *(u32x2*)(Xs + t * 136 + 4 * l31) = w2; }
        }
        asm volatile("s_waitcnt lgkmcnt(0)" ::: "memory"); __builtin_amdgcn_wave_barrier();
#pragma unroll
        for (int tt = 0; tt < 2; ++tt) {
            f32x4 acc = {0.f, 0.f, 0.f, 0.f};
#pragma unroll
            for (int ks = 0; ks < 4; ++ks) { const bf16x8 a = *(const bf16x8*)(Xs + (16 * tt + l15) * 136 + 32 * ks + 8 * kg);
                acc = __builtin_amdgcn_mfma_f32_16x16x32_bf16(a, cmf[ks], acc, 0, 0, 0); }
#pragma unroll
            for (int i = 0; i < 4; ++i) { const size_t row = rb + scan_row(dir, c * 32 + 16 * tt + 4 * kg + i); Yd[row * 512 + g * 16 + l15] = (bf16_t)(pk2(acc[i], 0.f) & 0xffff); }
        }
        asm volatile("s_waitcnt lgkmcnt(0)" ::: "memory"); __builtin_amdgcn_wave_barrier();
    }
}
__device__ __forceinline__ void rwkv_prep_rows(const Params& p, int jo) {
    unsigned char* const ws = ows(p.ws);
    const int tid_ = otid(); const int lane = tid_ & 63, w = tid_ >> 6;
    const bf16_t* P = (const bf16_t*)(ws + OFF_AR + AO_P);
    bf16_t* PR = (bf16_t*)(ws + OFF_AR + AO_PR); bf16_t* Lb = (bf16_t*)(ws + OFF_AR + AO_L);
    bf16_t* YGu = (bf16_t*)(ws + OFF_AR + AO_YG);
    float* KN = (float*)(ws + OFF_KN);
    const int nwv = gridDim.x * 8, rpw = (TT + nwv - 1) / nwv, row_lo = (blockIdx.x * 8 + w) * rpw, row_hi = (row_lo + rpw < TT) ? row_lo + rpw : TT;
    if (row_lo >= row_hi) return;
    const bool l3 = lane < 48;
    f32x4 mu4[4][2];
#pragma unroll
    for (int it = 0; it < 4; ++it) { const int c0 = (lane + 64 * it) * 8;
        if (it < 3 || l3) { mu4[it][0] = *(const f32x4*)(p.in[27] + jo * 1920 + c0); mu4[it][1] = *(const f32x4*)(p.in[27] + jo * 1920 + c0 + 4); }
        else { mu4[it][0] = f32x4{0.f, 0.f, 0.f, 0.f}; mu4[it][1] = mu4[it][0]; } }
    const f32x4 kk0 = *(const f32x4*)(p.in[33] + jo * 512 + lane * 8), kk1 = *(const f32x4*)(p.in[33] + jo * 512 + lane * 8 + 4);
    u32x4 pa[4], px[4], pn[4];
    { const int rp = row_lo > 0 ? row_lo - 1 : 0;
#pragma unroll
      for (int it = 0; it < 4; ++it) { const int c0 = (lane + 64 * it) * 8;
        if (it < 3 || l3) { pa[it] = *(const u32x4*)(P + (size_t)rp * 2560 + 512 + c0); px[it] = *(const u32x4*)(P + (size_t)row_lo * 2560 + 512 + c0); }
        else { pa[it] = u32x4{0u, 0u, 0u, 0u}; px[it] = pa[it]; } } }
    for (int row = row_lo; row < row_hi; ++row) {
        const int s = row % SB;
        const float hp = (s != 0 && s != 256) ? 0.5f : 0.f, hn = (s != 255 && s != 2303) ? 0.5f : 0.f;
        const int rn = row + 1 < TT ? row + 1 : TT - 1;
#pragma unroll
        for (int it = 0; it < 4; ++it) { const int c0 = (lane + 64 * it) * 8;
            if (it < 3 || l3) pn[it] = *(const u32x4*)(P + (size_t)rn * 2560 + 512 + c0); else pn[it] = u32x4{0u, 0u, 0u, 0u}; }
        *(u32x4*)(YGu + (size_t)row * 512 + lane * 8) = *(const u32x4*)(P + (size_t)row * 2560 + lane * 8);
#pragma unroll
        for (int it = 0; it < 4; ++it) {
            const int c0 = (lane + 64 * it) * 8;
            float x[8], a[8], bq[8], o[8];
            unpk8(px[it], x); unpk8(pa[it], a); unpk8(pn[it], bq);
#pragma unroll
            for (int i = 0; i < 8; ++i) { const float m = (i < 4) ? mu4[it][0][i & 3] : mu4[it][1][i & 3];
                o[i] = x[i] + m * (hp * a[i] + hn * bq[i] - x[i]); }
            if (it == 3) {
                if (lane < 16) {
#pragma unroll
                    for (int i = 0; i < 8; ++i) o[i] = tanh_f(o[i]); }
                else if (lane >= 32) {
#pragma unroll
                    for (int i = 0; i < 8; ++i) o[i] = sigm(o[i]); } }
            if (it == 1) { float ssq = 0.f;
#pragma unroll
                for (int i = 0; i < 8; ++i) { const float t_ = o[i] * ((i < 4) ? kk0[i & 3] : kk1[i & 3]); ssq += t_ * t_; }
                ssq = sum8(ssq);
                if ((lane & 7) == 0) KN[(size_t)row * 8 + (lane >> 3)] = 1.0f / fmaxf(sqrtf(ssq), 1e-12f); }
            if (it < 3) *(u32x4*)(PR + (size_t)row * 1536 + c0) = pk8(o);
            else if (l3) *(u32x4*)(Lb + (size_t)row * 384 + (c0 - 1536)) = pk8(o);
        }
#pragma unroll
        for (int it = 0; it < 4; ++it) { pa[it] = px[it]; px[it] = pn[it]; }
    }
}
__device__ __forceinline__ void rwkv_stage_loop(const Params& p, int jo, int first, int stride, int nitems, unsigned char* sm) {
    unsigned char* const ws = ows(p.ws);
    const int tid = otid();
    if (first >= nitems) return;
    const bf16_t* PR = (const bf16_t*)(ws + OFF_AR + AO_PR); const bf16_t* LO = (const bf16_t*)(ws + OFF_AR + AO_P);
    const float* KN = (const float*)(ws + OFF_KN);
    float* L_lw = (float*)sm; float* L_av = L_lw + 64 * 68; float* L_bv = L_av + 64 * 68; float* L_kd = L_bv + 64 * 68; float* L_rr = L_kd + 64 * 68;
    const int t64 = tid >> 3, c8 = (tid & 7) * 8;
    u32x4 gr, gk, gw, ga; float inn;
#define RS_LOAD(IT_) do { const int u_ = (IT_) / 36, R_ = (IT_) - u_ * 36, dir_ = u_ & 1, hd_ = (u_ >> 1) & 7, b_ = u_ >> 4; \
        const size_t row = (size_t)b_ * SB + scan_row(dir_, 64 * R_ + t64); const int ch_ = hd_ * 64 + c8; \
        gr = *(const u32x4*)(PR + row * 1536 + ch_); gk = *(const u32x4*)(PR + row * 1536 + 512 + ch_); \
        gw = *(const u32x4*)(LO + row * 2560 + dir_ * 512 + ch_); ga = *(const u32x4*)(LO + row * 2560 + 1024 + dir_ * 512 + ch_); inn = KN[row * 8 + hd_]; } while (0)
    f32x4 w0r[2], a0r[2], kkr[2], kar[2]; int cur_u = -1;
#pragma unroll
    for (int i = 0; i < 2; ++i) { w0r[i] = (f32x4){0.f, 0.f, 0.f, 0.f}; a0r[i] = w0r[i]; kkr[i] = w0r[i]; kar[i] = w0r[i]; }
    RS_LOAD(first);
    for (int item = first; item < nitems; item += stride) {
    const int u = item / 36, R = item - u * 36;
    const int dir = u & 1, hd = (u >> 1) & 7;
    {
        const int ch = hd * 64 + c8;
        float r8[8], k8[8], wl8[8], al8[8];
        unpk8(gr, r8); unpk8(gk, k8); unpk8(gw, wl8); unpk8(ga, al8);
        if (u != cur_u) { cur_u = u;
            const float* w0p = p.in[28] + (jo * 2 + dir) * 512 + ch; const float* a0p = p.in[30] + (jo * 2 + dir) * 512 + ch;
            const float* kkp = p.in[33] + jo * 512 + ch; const float* kap = p.in[34] + jo * 512 + ch;
#pragma unroll
            for (int i = 0; i < 2; ++i) { w0r[i] = *(const f32x4*)(w0p + 4 * i); a0r[i] = *(const f32x4*)(a0p + 4 * i); kkr[i] = *(const f32x4*)(kkp + 4 * i); kar[i] = *(const f32x4*)(kap + 4 * i); } }
        float lw[8], av[8], bv[8], kd[8];
#pragma unroll
        for (int i = 0; i < 8; ++i) {
            const float w0v = w0r[i >> 2][i & 3], a0v = a0r[i >> 2][i & 3], kkv = kkr[i >> 2][i & 3], kav = kar[i >> 2][i & 3];
            const float z = -(w0v + wl8[i]);
            const float sp = fmaxf(z, 0.f) + 0.6931471805599453f * __builtin_amdgcn_logf(1.0f + __builtin_amdgcn_exp2f(-1.4426950408889634f * fabsf(z)));
            lw[i] = -__builtin_amdgcn_exp2f(-1.4426950408889634f * (sp + 0.5f)) * 1.4426950408889634f;
            const float a = sigm(a0v + al8[i]);
            const float kn = k8[i] * kkv * inn;
            kd[i] = k8[i] * (1.0f + (a - 1.0f) * kav); av[i] = -kn; bv[i] = kn * a;
        }
        const int o = t64 * 68 + c8;
        *(f32x4*)(L_lw + o) = (f32x4){lw[0], lw[1], lw[2], lw[3]}; *(f32x4*)(L_lw + o + 4) = (f32x4){lw[4], lw[5], lw[6], lw[7]};
        *(f32x4*)(L_av + o) = (f32x4){av[0], av[1], av[2], av[3]}; *(f32x4*)(L_av + o + 4) = (f32x4){av[4], av[5], av[6], av[7]};
        *(f32x4*)(L_bv + o) = (f32x4){bv[0], bv[1], bv[2], bv[3]}; *(f32x4*)(L_bv + o + 4) = (f32x4){bv[4], bv[5], bv[6], bv[7]};
        *(f32x4*)(L_kd + o) = (f32x4){kd[0], kd[1], kd[2], kd[3]}; *(f32x4*)(L_kd + o + 4) = (f32x4){kd[4], kd[5], kd[6], kd[7]};
        *(f32x4*)(L_rr + o) = (f32x4){r8[0], r8[1], r8[2], r8[3]}; *(f32x4*)(L_rr + o + 4) = (f32x4){r8[4], r8[5], r8[6], r8[7]};
    }
    LDS_BARRIER();
    if (item + stride < nitems) { RS_LOAD(item + stride); }
    {
        const int sq = tid >> 7, tl = tid & 127, sj = tl >> 1, th = tl & 1;
        float cw[8], lwk[8]; float run = 0.f;
#pragma unroll
        for (int k = 0; k < 8; ++k) { lwk[k] = L_lw[(sq * 16 + 8 * th + k) * 68 + sj]; run += lwk[k]; cw[k] = run; }
        const float ptot = dppf<0xB1>(run);
        const float off = th ? ptot : 0.f, cw15 = run + ptot;
        u32x2* GE = (u32x2*)(ws + OFF_GE) + ((size_t)(u * 144 + 4 * R + sq) * 64 + sj) * 16 + 8 * th;
#pragma unroll
        for (int k = 0; k < 8; ++k) {
            const int o = (sq * 16 + 8 * th + k) * 68 + sj;
            const float c = off + cw[k];
            const float Ec = __builtin_amdgcn_exp2f(c), Ep = __builtin_amdgcn_exp2f(c - lwk[k]), iE = __builtin_amdgcn_rcpf(Ec);
            u32x2 ov; ov.x = pk2(L_av[o] * Ep, L_rr[o] * Ec); ov.y = pk2(L_bv[o] * iE, L_kd[o] * iE);
            GE[k] = ov;
        }
        ((float*)(ws + OFF_GW))[(size_t)(u * 144 + 4 * R + sq) * 64 + sj] = __builtin_amdgcn_exp2f(cw15);
    }
    LDS_BARRIER();
    }
#undef RS_LOAD
}
__device__ __forceinline__ bf16x8 frag_lo(const f32x4 v) { u32x4 w; w.x = pk2(v[0], v[1]); w.y = pk2(v[2], v[3]); w.z = 0u; w.w = 0u; return __builtin_bit_cast(bf16x8, w); }
__device__ __forceinline__ bf16x8 frag_b64(const bf16_t* pz) { const u32x2 v = *(const u32x2*)pz; u32x4 w; w.x = v.x; w.y = v.y; w.z = 0u; w.w = 0u; return __builtin_bit_cast(bf16x8, w); }
__device__ __forceinline__ u32x2 pk4v(const f32x4 v) { u32x2 r; r.x = pk2(v[0], v[1]); r.y = pk2(v[2], v[3]); return r; }
#define MF16(a, b, c) __builtin_amdgcn_mfma_f32_16x16x32_bf16((a), (b), (c), 0, 0, 0)
constexpr int RW_SCR = 19712, RW_SLOT = 5120, RW_SLOT0 = 4 * RW_SCR;
__device__ __forceinline__ void rwkv_chunk_unit(const Params& p, int jo, int u, unsigned char* sm) {
    unsigned char* const ws = ows(p.ws);
    const int tid = otid(), lane = tid & 63, w = tid >> 6, l15 = lane & 15, kg = lane >> 4;
    const int dir = u & 1, hd = (u >> 1) & 7, b = u >> 4;
    const bf16_t* PR = (const bf16_t*)(ws + OFF_AR + AO_PR); const bf16_t* LO = (const bf16_t*)(ws + OFF_AR + AO_P);
    const float* KN = (const float*)(ws + OFF_KN);
    bf16_t* O = (bf16_t*)(ws + OFF_AR + (dir ? AO_OB : AO_OF));
    const size_t rb = (size_t)b * SB;
    const int sq = tid >> 7, tl = tid & 127, sj = tl >> 1, th = tl & 1, ch = hd * 64 + sj;
    const u32x4* GEb = (const u32x4*)(ws + OFF_GE); const float* GWb = (const float*)(ws + OFF_GW);
    f32x4 S[4];
#pragma unroll
    for (int i = 0; i < 4; ++i) S[i] = (f32x4){0.f, 0.f, 0.f, 0.f};
    u32x4 ge[4], ge2[4]; float e15, e152; unsigned vv[8], vv2[8];
#define RW_LOADX(R_, ge_, e_, vv_) do { const size_t cidx = (size_t)(u * 144 + 4 * (R_) + sq) * 64 + sj; const u32x4* gp = GEb + cidx * 8 + 4 * th; \
        ge_[0] = gp[0]; ge_[1] = gp[1]; ge_[2] = gp[2]; ge_[3] = gp[3]; e_ = GWb[cidx]; \
        _Pragma("unroll") for (int k = 0; k < 8; ++k) { const size_t row = rb + scan_row(dir, (4 * (R_) + sq) * 16 + 8 * th + k); vv_[k] = *(const unsigned*)(PR + row * 1536 + 1024 + (ch & ~1)); } } while (0)
#define RW_LOAD(R_) RW_LOADX(R_, ge2, e152, vv2)
    RW_LOADX(0, ge, e15, vv); RW_LOADX(1, ge2, e152, vv2);
    for (int R = 0; R < 36; ++R) {
        for (int rep1 = 0; rep1 < 1 + DUPB(20); ++rep1) {
            unsigned char* sc = sm + sq * RW_SCR;
            bf16_t* At_ = (bf16_t*)sc; bf16_t* Rt_ = At_ + 16 * 72; bf16_t* Bt_ = Rt_ + 16 * 72; bf16_t* Kt_ = Bt_ + 16 * 72;
            bf16_t* AtT = Kt_ + 16 * 72; bf16_t* BhT = AtT + 64 * 16; bf16_t* KhT = BhT + 64 * 16; bf16_t* Vt_ = KhT + 64 * 16;
            float* WC = (float*)(sc + 18432);
            unsigned at2[4], bh2[4], kh2[4];
#pragma unroll
            for (int k2 = 0; k2 < 4; ++k2) {
                const unsigned x0 = ge[k2].x, y0 = ge[k2].y, x1 = ge[k2].z, y1 = ge[k2].w;
                const int t0 = 8 * th + 2 * k2;
                At_[t0 * 72 + sj] = (bf16_t)(x0 & 0xffff); Rt_[t0 * 72 + sj] = (bf16_t)(x0 >> 16); Bt_[t0 * 72 + sj] = (bf16_t)(y0 & 0xffff); Kt_[t0 * 72 + sj] = (bf16_t)(y0 >> 16);
                At_[(t0 + 1) * 72 + sj] = (bf16_t)(x1 & 0xffff); Rt_[(t0 + 1) * 72 + sj] = (bf16_t)(x1 >> 16); Bt_[(t0 + 1) * 72 + sj] = (bf16_t)(y1 & 0xffff); Kt_[(t0 + 1) * 72 + sj] = (bf16_t)(y1 >> 16);
                at2[k2] = (x0 & 0xffffu) | (x1 << 16);
                bh2[k2] = pk2(bf2f(y0 & 0xffff) * e15, bf2f(y1 & 0xffff) * e15);
                kh2[k2] = pk2(bf2f(y0 >> 16) * e15, bf2f(y1 >> 16) * e15);
            }
            *(u32x4*)(AtT + sj * 16 + 8 * th) = (u32x4){at2[0], at2[1], at2[2], at2[3]};
            *(u32x4*)(BhT + sj * 16 + 8 * th) = (u32x4){bh2[0], bh2[1], bh2[2], bh2[3]};
            *(u32x4*)(KhT + sj * 16 + 8 * th) = (u32x4){kh2[0], kh2[1], kh2[2], kh2[3]};
            { const int vs = (ch & 1) * 16; u32x4 v4; v4.x = ((vv[0] >> vs) & 0xffffu) | ((vv[1] >> vs) << 16); v4.y = ((vv[2] >> vs) & 0xffffu) | ((vv[3] >> vs) << 16); v4.z = ((vv[4] >> vs) & 0xffffu) | ((vv[5] >> vs) << 16); v4.w = ((vv[6] >> vs) & 0xffffu) | ((vv[7] >> vs) << 16);
              *(u32x4*)(Vt_ + sj * 16 + 8 * th) = v4; }
            if (th == 0) WC[sj] = e15;
        }
#pragma unroll
        for (int k = 0; k < 4; ++k) ge[k] = ge2[k];
#pragma unroll
        for (int k = 0; k < 8; ++k) vv[k] = vv2[k];
        e15 = e152;
        if (R + 2 < 36) { RW_LOAD(R + 2); }
        LDS_BARRIER();
        for (int rep2 = 0; rep2 < 1 + DUPB(21); ++rep2) if (w < 4) {
            unsigned char* sc = sm + w * RW_SCR;
            const bf16_t* At_ = (const bf16_t*)sc; const bf16_t* Rt_ = At_ + 16 * 72; const bf16_t* Bt_ = Rt_ + 16 * 72; const bf16_t* Kt_ = Bt_ + 16 * 72;
            const bf16_t* AtT = Kt_ + 16 * 72; const bf16_t* Vt_ = AtT + 3 * 64 * 16;
            float* Lm = (float*)(sc + 17408);
            unsigned char* sl = sm + RW_SLOT0 + w * RW_SLOT;
            u32x2* ATs = (u32x2*)sl; u32x2* GTs = (u32x2*)(sl + 2048); u32x4* MfS = (u32x4*)(sl + 4096);
            const f32x4 z4 = {0.f, 0.f, 0.f, 0.f};
            f32x4 Lab = z4, LakT = z4, Mbr = z4, Mkr = z4;
#pragma unroll
            for (int ks = 0; ks < 2; ++ks) {
                const bf16x8 af = *(const bf16x8*)(At_ + l15 * 72 + 32 * ks + 8 * kg), rf = *(const bf16x8*)(Rt_ + l15 * 72 + 32 * ks + 8 * kg);
                const bf16x8 bf = *(const bf16x8*)(Bt_ + l15 * 72 + 32 * ks + 8 * kg), kf = *(const bf16x8*)(Kt_ + l15 * 72 + 32 * ks + 8 * kg);
                Lab = MF16(bf, af, Lab); LakT = MF16(af, kf, LakT); Mbr = MF16(bf, rf, Mbr); Mkr = MF16(kf, rf, Mkr);
            }
#pragma unroll
            for (int i = 0; i < 4; ++i) { const int rrow = 4 * kg + i;
                Lab[i] = (rrow < l15) ? Lab[i] : 0.f;
                LakT[i] = (l15 < rrow) ? LakT[i] : 0.f;
                Mbr[i] = (rrow <= l15) ? Mbr[i] : 0.f; Mkr[i] = (rrow <= l15) ? Mkr[i] : 0.f;
                Lm[rrow * 16 + l15] = Lab[i]; }
            { u32x4 mw; mw.x = pk2(Mbr[0], Mbr[1]); mw.y = pk2(Mbr[2], Mbr[3]); mw.z = pk2(Mkr[0], Mkr[1]); mw.w = pk2(Mkr[2], Mkr[3]); MfS[lane] = mw; }
            asm volatile("s_waitcnt lgkmcnt(0)" ::: "memory"); __builtin_amdgcn_wave_barrier();
            float T[16];
#pragma unroll
            for (int r = 15; r >= 0; --r) {
                float acc = (r == l15) ? 1.0f : 0.0f;
                const f32x4 L0 = *(const f32x4*)(Lm + r * 16), L1 = *(const f32x4*)(Lm + r * 16 + 4), L2 = *(const f32x4*)(Lm + r * 16 + 8), L3 = *(const f32x4*)(Lm + r * 16 + 12);
#pragma unroll
                for (int m = r + 1; m < 16; ++m) { const float lv = (m < 4) ? L0[m & 3] : (m < 8) ? L1[m & 3] : (m < 12) ? L2[m & 3] : L3[m & 3]; acc += lv * T[m]; }
                T[r] = acc;
            }
            f32x4 Tsel;
#pragma unroll
            for (int i = 0; i < 4; ++i) Tsel[i] = (kg == 0) ? T[i] : (kg == 1) ? T[4 + i] : (kg == 2) ? T[8 + i] : T[12 + i];
            const bf16x8 Tf = frag_lo(Tsel);
            const f32x4 LT = MF16(frag_lo(LakT), Tf, z4);
            const bf16x8 LTf = frag_lo(LT);
#pragma unroll
            for (int t1 = 0; t1 < 4; ++t1) {
                const f32x4 at = MF16(frag_b64(AtT + (16 * t1 + l15) * 16 + 4 * kg), Tf, z4);
                ATs[t1 * 64 + lane] = pk4v(at);
                const f32x4 gt = MF16(LTf, frag_b64(Vt_ + (16 * t1 + l15) * 16 + 4 * kg), z4);
                GTs[t1 * 64 + lane] = pk4v(gt);
            }
        }
        LDS_BARRIER();
        if (w < 4) {
#pragma unroll
            for (int q = 0; q < 4; ++q) {
                const unsigned char* sc = sm + q * RW_SCR;
                const bf16_t* Rt_ = (const bf16_t*)sc + 16 * 72; const bf16_t* BhT = (const bf16_t*)sc + 4 * 16 * 72 + 64 * 16; const bf16_t* KhT = BhT + 64 * 16; const bf16_t* Vt_ = KhT + 64 * 16;
                const float* WC = (const float*)(sc + 18432);
                const unsigned char* sl = sm + RW_SLOT0 + q * RW_SLOT;
                const u32x2* ATs = (const u32x2*)sl; const u32x2* GTs = (const u32x2*)(sl + 2048); const u32x4* MfS = (const u32x4*)(sl + 4096);
                bf16x8 Sf[2];
#pragma unroll
                for (int pi = 0; pi < 2; ++pi) { u32x4 sw; sw.x = pk2(S[2 * pi][0], S[2 * pi][1]); sw.y = pk2(S[2 * pi][2], S[2 * pi][3]); sw.z = pk2(S[2 * pi + 1][0], S[2 * pi + 1][1]); sw.w = pk2(S[2 * pi + 1][2], S[2 * pi + 1][3]);
                    Sf[pi] = __builtin_bit_cast(bf16x8, sw); }
                f32x4 ut = unpk4v(GTs[w * 64 + lane]);
#pragma unroll
                for (int pi = 0; pi < 2; ++pi) { const u32x2 a0 = ATs[(2 * pi) * 64 + lane], a1 = ATs[(2 * pi + 1) * 64 + lane]; u32x4 aw; aw.x = a0.x; aw.y = a0.y; aw.z = a1.x; aw.w = a1.y;
                    ut = MF16(__builtin_bit_cast(bf16x8, aw), Sf[pi], ut); }
                const u32x2 v2 = *(const u32x2*)(Vt_ + (16 * w + l15) * 16 + 4 * kg);
                u32x4 uvw; uvw.x = pk2(ut[0], ut[1]); uvw.y = pk2(ut[2], ut[3]); uvw.z = v2.x; uvw.w = v2.y;
                const bf16x8 UVf = __builtin_bit_cast(bf16x8, uvw);
                f32x4 oa = MF16(__builtin_bit_cast(bf16x8, MfS[lane]), UVf, ((f32x4){0.f, 0.f, 0.f, 0.f}));
#pragma unroll
                for (int pi = 0; pi < 2; ++pi) { const u32x2 r0 = *(const u32x2*)(Rt_ + l15 * 72 + 32 * pi + 4 * kg), r1 = *(const u32x2*)(Rt_ + l15 * 72 + 32 * pi + 16 + 4 * kg);
                    u32x4 rw; rw.x = r0.x; rw.y = r0.y; rw.z = r1.x; rw.w = r1.y;
                    oa = MF16(__builtin_bit_cast(bf16x8, rw), Sf[pi], oa); }
#pragma unroll
                for (int i = 0; i < 4; ++i) { const size_t row = rb + scan_row(dir, (4 * R + q) * 16 + 4 * kg + i); O[row * 512 + hd * 64 + 16 * w + l15] = (bf16_t)(pk2(oa[i], 0.f) & 0xffff); }
#pragma unroll
                for (int t2 = 0; t2 < 4; ++t2) {
                    const u32x2 b2 = *(const u32x2*)(BhT + (16 * t2 + l15) * 16 + 4 * kg), k2 = *(const u32x2*)(KhT + (16 * t2 + l15) * 16 + 4 * kg);
                    u32x4 bw; bw.x = b2.x; bw.y = b2.y; bw.z = k2.x; bw.w = k2.y;
                    const f32x4 dv = *(const f32x4*)(WC + 16 * t2 + 4 * kg);
                    S[t2] = MF16(__builtin_bit_cast(bf16x8, bw), UVf, S[t2] * dv);
                }
            }
        }
        LDS_BARRIER();
    }
#undef RW_LOAD
#undef RW_LOADX
}
__device__ __forceinline__ void odd_finish_rows(const Params& p, int jo, bool skip_ctx) {
    unsigned char* const ws = ows(p.ws);
    const int tid_ = otid(); const int lane = tid_ & 63, w = tid_ >> 6;
    const bf16_t* YF = (const bf16_t*)(ws + OFF_S5F); const bf16_t* YB = (const bf16_t*)(ws + OFF_S5B);
    bf16_t* YG = (bf16_t*)(ws + OFF_AR + AO_YG);
    const bf16_t* OF = (const bf16_t*)(ws + OFF_AR + AO_OF); const bf16_t* OB = (const bf16_t*)(ws + OFF_AR + AO_OB);
    const bf16_t* PR = (const bf16_t*)(ws + OFF_AR + AO_PR); const bf16_t* LO = (const bf16_t*)(ws + OFF_AR + AO_P);
    bf16_t* Y = (bf16_t*)(ws + OFF_AR + AO_Y);
    const int c0 = lane * 8;
    const int nwv = gridDim.x * 8, rpw = (TT + nwv - 1) / nwv, row_lo = (blockIdx.x * 8 + w) * rpw, row_hi = (row_lo + rpw < TT) ? row_lo + rpw : TT;
    const f32x4 ds0 = *(const f32x4*)(p.in[25] + jo * 512 + c0), ds1 = *(const f32x4*)(p.in[25] + jo * 512 + c0 + 4);
    const f32x4 rk0 = *(const f32x4*)(p.in[35] + jo * 512 + c0), rk1 = *(const f32x4*)(p.in[35] + jo * 512 + c0 + 4);
    const f32x4 lg0 = *(const f32x4*)(p.in[36] + jo * 512 + c0), lg1 = *(const f32x4*)(p.in[36] + jo * 512 + c0 + 4);
    const f32x4 lb0 = *(const f32x4*)(p.in[37] + jo * 512 + c0), lb1 = *(const f32x4*)(p.in[37] + jo * 512 + c0 + 4);
    for (int row = row_lo; row < row_hi; ++row) {
        if (skip_ctx && (row % SB) < 256) continue;
        {
            float fa[8], fb[8], uu[8], o[8];
            unpk8(*(const u32x4*)(YF + (size_t)row * 512 + c0), fa); unpk8(*(const u32x4*)(YB + (size_t)row * 512 + c0), fb);
            unpk8(*(const u32x4*)(YG + (size_t)row * 512 + c0), uu);
#pragma unroll
            for (int i = 0; i < 4; ++i) { o[i] = fa[i] + fb[i] + ds0[i] * uu[i]; o[4 + i] = fa[4 + i] + fb[4 + i] + ds1[i] * uu[4 + i]; }
#pragma unroll
            for (int i = 0; i < 8; ++i) { const float x = o[i]; o[i] = 0.5f * x * (1.0f + tanh_f(0.7978845608028654f * (x + 0.044715f * x * x * x))); }
            *(u32x4*)(YG + (size_t)row * 512 + c0) = pk8(o);
        }
        {
            float o[8], r[8], k[8], v[8], g[8];
            { float fa[8], fb[8]; unpk8(*(const u32x4*)(OF + (size_t)row * 512 + c0), fa); unpk8(*(const u32x4*)(OB + (size_t)row * 512 + c0), fb);
#pragma unroll
              for (int i = 0; i < 8; ++i) o[i] = fa[i] + fb[i]; }
            unpk8(*(const u32x4*)(PR + (size_t)row * 1536 + c0), r); unpk8(*(const u32x4*)(PR + (size_t)row * 1536 + 512 + c0), k); unpk8(*(const u32x4*)(PR + (size_t)row * 1536 + 1024 + c0), v);
            unpk8(*(const u32x4*)(LO + (size_t)row * 2560 + 2048 + c0), g);
            float sm_ = 0.f, bo = 0.f;
#pragma unroll
            for (int i = 0; i < 8; ++i) { sm_ += o[i]; bo += r[i] * k[i] * ((i < 4) ? rk0[i & 3] : rk1[i & 3]); }
            const float mean = sum8(sm_) * (1.0f / 64.0f); bo = sum8(bo);
            float sq = 0.f;
#pragma unroll
            for (int i = 0; i < 8; ++i) { const float d = o[i] - mean; sq += d * d; }
            const float rstd = rsqrtf(sum8(sq) * (1.0f / 64.0f) + 64e-5f);
            float y[8];
#pragma unroll
            for (int i = 0; i < 8; ++i) y[i] = ((o[i] - mean) * rstd * ((i < 4) ? lg0[i & 3] : lg1[i & 3]) + ((i < 4) ? lb0[i & 3] : lb1[i & 3]) + bo * v[i]) * g[i];
            *(u32x4*)(Y + (size_t)row * 1024 + 512 + c0) = pk8(y);
        }
    }
}

#define PHB unsigned char* const ws = ows(p.ws); bf16_t* const H = (bf16_t*)(ws + OFF_H); _Float16* const X = (_Float16*)(ws + OFF_X); const float* const mod = (const float*)(ws + OFF_MOD); bf16_t* const PbE = (bf16_t*)(ws + OFF_AR + AE_P); bf16_t* const YbE = (bf16_t*)(ws + OFF_AR + AE_Y); bf16_t* const PbO = (bf16_t*)(ws + OFF_AR + AO_P); bf16_t* const YbO = (bf16_t*)(ws + OFF_AR + AO_Y); const unsigned* const cnt0 = (const unsigned*)(ws + OFF_CNT); (void)H; (void)X; (void)mod; (void)PbE; (void)YbE; (void)PbO; (void)YbO; (void)cnt0;
#define LAYER_PAIR_BODY(lp) {  \
         \
        { \
            const int layer = 2 * lp, j = lp; \
            if (RUN) { PHB    \
                pg8::Gemm g{H, (const bf16_t*)(ws + OFF_WINE + j * SZ_WINE), 1024, 0}; pg8::StaticOrder S; S.init(TT, 3328, G, cb, 1024); \
                { LAS float* lbl = (LAS float*)(lds + LDS_MAIN + 64); lbl[threadIdx.x] = ((const float*)(ws + OFF_LB))[j * 512 + threadIdx.x]; __syncthreads(); } \
                pg8::EpiEvenIn E{PbE, (const LAS float*)(lds + LDS_MAIN + 64)}; REP(8) pg8::gemm_phase(lds, g, S, E); SYNC; } ++ph; \
            if (RUN) { PHB    \
                if (cb < 128) { hgrn_chunk_unit(p, j, cb, smem); __syncthreads(); } \
                else { for (int it = cb - 128; it < 576; it += G - 128) attn_unit(p, j, it, smem); } \
                if (DUPB(1)) { __syncthreads(); if (cb < 128) { hgrn_chunk_unit(p, j, cb, smem); __syncthreads(); } } \
                if (DUPB(2)) { __syncthreads(); if (cb >= 128) { for (int it = cb - 128; it < 576; it += G - 128) attn_unit(p, j, it, smem); } } SYNC; } ++ph; \
            if (RUN) { PHB    \
                const int nextra = (layer == 2) ? p.ntc : 0; \
                hgrn_finish_rows(p, j); \
                if (DUPB(13)) { hgrn_finish_rows(p, j); } \
                if (nextra > 0) { __syncthreads(); tr_loop(p, cb, G, nextra, p.njm, p.nj1, smem); } \
                SYNC; } ++ph; \
            if (RUN) { PHB    \
                pg8::Gemm g{YbE, (const bf16_t*)(ws + OFF_WOUTE + j * SZ_WSQ), 1024, 0}; pg8::CtxSplitOrder S; S.init(G, cb, 1024, SPLIT_S); \
                pg8::EpiResid E{(bf16_t*)(ws + OFF_AR + AE_P), mod + (size_t)layer * 9 * 6144 + 2048, (bf16_t*)(ws + OFF_AR + AE_P) + (size_t)TT * 1024}; if (DUPB(18)) pg8::gemm_phase(lds, g, S, E); pg8::gemm_phase(lds, g, S, E); SYNC; } ++ph; \
            if (RUN) { PHB if (DUPB(17)) phase_ln<0, false, true>(p, layer, OFF_AR + AE_P, SPLIT_S, smem); phase_ln<0, false>(p, layer, OFF_AR + AE_P, SPLIT_S, smem); SYNC; } ++ph; \
            if (RUN) { PHB    \
                pg8::Gemm g{H, (const bf16_t*)(ws + OFF_WFFN1 + j * SZ_WFFN1), 1024, 0}; pg8::StaticOrder S; S.init(TT, 5632, G, cb, 1024); \
                pg8::EpiSwiGLU E{PbE, 2816}; REP(5) pg8::gemm_phase(lds, g, S, E); SYNC; } ++ph; \
            if (RUN) { PHB    \
                pg8::Gemm g{PbE, (const bf16_t*)(ws + OFF_WFFN2 + j * SZ_WFFN2), 2816, 0}; pg8::CtxSplitOrder S; S.init(G, cb, 2816, SPLIT_S); \
                pg8::EpiResid E{(bf16_t*)(ws + OFF_AR + AE_OF), mod + (size_t)layer * 9 * 6144 + 5120, (bf16_t*)(ws + OFF_AR + AE_OF) + (size_t)TT * 1024}; if (DUPB(18)) pg8::gemm_phase(lds, g, S, E); pg8::gemm_phase(lds, g, S, E); SYNC; } ++ph; \
            if (RUN) { PHB if (DUPB(17)) phase_ln<1, false, true>(p, layer, OFF_AR + AE_OF, SPLIT_S, smem); phase_ln<1, false>(p, layer, OFF_AR + AE_OF, SPLIT_S, smem); SYNC; } ++ph; \
        } \
         \
        { \
            const int layer = 2 * lp + 1, jo = lp; \
            if (RUN) { PHB    \
                pg8::Gemm g{H, (const bf16_t*)(ws + OFF_WINO + jo * SZ_WINO), 1024, 0}; pg8::StaticOrder S; S.init(TT, 2560, G, cb, 1024); \
                pg8::EpiBf16 E{PbO, 2560, nullptr}; if (DUPB(19)) pg8::gemm_phase(lds, g, S, E); pg8::gemm_phase(lds, g, S, E); SYNC; } ++ph; \
            if (RUN) { PHB    \
                rwkv_prep_rows(p, jo); \
                if (DUPB(14)) { rwkv_prep_rows(p, jo); } \
                SYNC; } ++ph; \
            if (RUN) { PHB    \
                pg8::Gemm g{(const bf16_t*)(ws + OFF_AR + AO_L), (const bf16_t*)(ws + OFF_WLORA + jo * SZ_WLORA), 384, 0}; pg8::LoraOrder S; S.init(TT, 2560, G, cb, 384); \
                pg8::EpiBf16 E{PbO, 2560, nullptr}; if (DUPB(19)) pg8::gemm_phase(lds, g, S, E); pg8::gemm_phase(lds, g, S, E); \
                SYNC; } ++ph; \
            if (RUN) { PHB   \
                { const int per = (4608 + G - 1) / G, i0 = cb * per, i1 = (i0 + per < 4608) ? i0 + per : 4608; rwkv_stage_loop(p, jo, i0, 1, i1, smem); } \
                SYNC; } ++ph; \
            if (RUN) { PHB    \
                if (cb < 128) { rwkv_chunk_unit(p, jo, cb, smem); if (DUPB(4)) { __syncthreads(); rwkv_chunk_unit(p, jo, cb, smem); } } \
                else { if (wv < 4) { s5_scan_task(p, jo, (cb - 128) * 4 + wv, smem + wv * 20480); } \
                       if (layer == 1 && p.ntm > 0) { __syncthreads(); tr_loop(p, cb - 128, G - 128, p.ntm, p.nj0, p.njm, smem); } \
                       if (layer == 3 && p.nt1 > p.ntc) { __syncthreads(); tr_loop(p, p.ntc + (cb - 128), G - 128, p.nt1, p.njm, p.nj1, smem); } } \
                SYNC; } ++ph; \
            if (RUN) { PHB odd_finish_rows(p, jo, layer == 3); SYNC; } ++ph; \
            if (RUN) { PHB    \
                pg8::Gemm g{(const bf16_t*)(ws + OFF_AR + AO_YG), (const bf16_t*)(ws + OFF_WGLU + jo * SZ_WGLU), 512, 0}; pg8::StaticOrder S; S.init(TT, 512, G, cb, 512); \
                pg8::EpiGLU E{(const bf16_t*)(ws + OFF_AR + AO_YG), YbO}; if (DUPB(19)) pg8::gemm_phase(lds, g, S, E); pg8::gemm_phase(lds, g, S, E); \
                SYNC; } ++ph; \
            if (RUN) { PHB    \
                pg8::Gemm g{YbO, (const bf16_t*)(ws + OFF_WOUTO + jo * SZ_WSQ), 1024, 0}; pg8::CtxSplitOrder S; S.init(G, cb, 1024, layer == 3 ? 0 : SPLIT_S); \
                pg8::EpiResid E{(bf16_t*)(ws + OFF_GE), mod + (size_t)layer * 9 * 6144 + 2048, (bf16_t*)(ws + OFF_GE) + (size_t)TT * 1024}; if (DUPB(18)) pg8::gemm_phase(lds, g, S, E); pg8::gemm_phase(lds, g, S, E); SYNC; } ++ph; \
            if (RUN) { PHB if (DUPB(17)) phase_ln<0, true, true>(p, layer, OFF_GE, SPLIT_S, smem); phase_ln<0, true>(p, layer, OFF_GE, SPLIT_S, smem); SYNC; } ++ph; \
            if (RUN) { PHB    \
                pg8::Gemm g{H, (const bf16_t*)(ws + OFF_WMOE1), 1024, SZ_WFFN1}; pg8::MoeOrder S; S.init((cnt0 + jo * 512), 22, G, cb, 1024); \
                LAS int* ridx = (LAS int*)(lds + LDS_MAIN + 64 + 2048); \
                { const unsigned* inv = (const unsigned*)(ws + OFF_INV); pg8::Unit u; \
                  for (int i = 0; i < 16 && S.next(i, u); ++i) { if (threadIdx.x < 256) { int pst = 0; _Pragma("unroll") for (int k = 0; k < 7; ++k) pst = (u.e > k) ? S.pend[k] : pst; \
                      const int r = (u.pm - pst) * 256 + (int)threadIdx.x; ridx[i * 256 + threadIdx.x] = (r < (int)(cnt0 + jo * 512)[u.e * 64]) ? (int)inv[(size_t)u.e * TT + r] : 0; } } \
                  __syncthreads(); } \
                pg8::EpiSwiGLU E{(bf16_t*)(ws + OFF_AR + AM_H), 2816}; pg8::gemm_phase<pg8::EpiSwiGLU, pg8::MoeOrder, true>(lds, g, S, E, ridx); SYNC; } ++ph; \
            if (RUN) { PHB    \
                pg8::Gemm g{(const bf16_t*)(ws + OFF_AR + AM_H), (const bf16_t*)(ws + OFF_WMOE2), 2816, SZ_WFFN2}; pg8::MoeOrder S; S.init((cnt0 + jo * 512), 4, G, cb, 2816, true); \
                pg8::EpiBf16 E{(bf16_t*)(ws + OFF_AR + AM_A), 1024, (bf16_t*)(ws + OFF_GE)}; REP(7) pg8::gemm_phase(lds, g, S, E); SYNC; } ++ph; \
            if (RUN) { PHB if (DUPB(17)) phase_ln<2, false, true>(p, layer, 0, 0, smem); phase_ln<2, false>(p, layer, 0, 0, smem); SYNC; } ++ph; \
        } \
     }
constexpr int LDS_MAIN = 131072;
constexpr int LDS_BYTES = LDS_MAIN + 64 + 2048 + 16384;
__global__ void __launch_bounds__(512, 2) mega(const Params p) {
    extern __shared__ __attribute__((aligned(16))) unsigned char smem[];
    LAS unsigned char* lds = (LAS unsigned char*)smem;
    volatile LAS unsigned* xbw = (volatile LAS unsigned*)(lds + LDS_MAIN);
    if (threadIdx.x == 0) { xbw[0] = 0u; xbw[1] = 0u; xbw[2] = 0u; xbw[3] = 0u; }
    __syncthreads();
    const bool multi = (p.hi - p.lo) > 1;
    XcdBarrier bar; bar.bar = (unsigned*)(p.ws + OFF_BAR); bar.x = 0; bar.st = xbw;
    if (multi) bar = xcd_barrier_post((unsigned*)(p.ws + OFF_BAR), xbw);
    const int G = gridDim.x, cb = blockIdx.x, wv = threadIdx.x >> 6;
    int ph = 0;
#define RUN (ph >= p.lo && ph < p.hi)
#define SYNC do { if (multi && ph + 1 < p.hi) { xcd_barrier(bar); if (DUPB(12)) xcd_barrier(bar); } else __syncthreads(); } while (0)

    if (RUN) { REP(0) { phase_prologue_a(p, smem); __syncthreads(); } SYNC; } ++ph;
    if (RUN) { phase_prologue_b(p); SYNC; } ++ph;

    LAYER_PAIR_BODY(0)
    LAYER_PAIR_BODY(1)
#undef RUN
#undef SYNC
}

static void add_job(Params& P, int& nj, int& nt, const float* src, bf16_t* dst, int K, int N, int ldd, int mode, int aux) {
    Job& j = P.jobs[nj++]; j.src = src; j.dst = dst; j.K = K; j.N = N; j.ldd = ldd; j.mode = mode; j.tile0 = nt; j.aux = aux; nt += (K / 128) * (N / 128);
}
extern "C" void kernel_launch(void* const* d_in, const int* in_sizes, int n_in, void* d_out, int out_size, void* d_ws, size_t ws_size, hipStream_t stream) {
    static int ready = 0;
    if (ready == 0) {
        if (n_in != 43 || ws_size < WS_END) { fprintf(stderr, "kernel_launch: need 43 inputs and %zu bytes of workspace, got %d / %zu\n", (size_t)WS_END, n_in, ws_size); ready = -1; return; }
        if (hipFuncSetAttribute((const void*)mega, hipFuncAttributeMaxDynamicSharedMemorySize, LDS_BYTES) != hipSuccess) { fprintf(stderr, "kernel_launch: hipFuncSetAttribute failed\n"); ready = -1; return; }
        ready = 1;
    }
    if (ready < 0) return;
    unsigned char* ws = (unsigned char*)d_ws;
    (void)hipMemsetAsync(ws, 0, ZERO_BYTES, stream);
    Params P; memset(&P, 0, sizeof(P));
    for (int i = 0; i < 43; ++i) P.in[i] = (const float*)d_in[i];
    P.out = (float*)d_out; P.ws = ws;
    int nj = 0, nt = 0;
    for (int j = 0; j < 2; ++j) {
        if (j == 1) { P.nj0 = nj; P.nt0 = nt; nt = 0; }
        add_job(P, nj, nt, P.in[8] + (size_t)j * 1024 * 3328, (bf16_t*)(ws + OFF_WINE + j * SZ_WINE), 1024, 3328, 1024, 0, 0);
        add_job(P, nj, nt, P.in[9] + (size_t)j * 1024 * 1024, (bf16_t*)(ws + OFF_WOUTE + j * SZ_WSQ), 1024, 1024, 1024, 0, 0);
        add_job(P, nj, nt, P.in[13] + (size_t)j * 1024 * 2816, (bf16_t*)(ws + OFF_WFFN1 + j * SZ_WFFN1), 1024, 2816, 1024, 1, 0);
        add_job(P, nj, nt, P.in[14] + (size_t)j * 1024 * 2816, (bf16_t*)(ws + OFF_WFFN1 + j * SZ_WFFN1), 1024, 2816, 1024, 2, 0);
        add_job(P, nj, nt, P.in[15] + (size_t)j * 2816 * 1024, (bf16_t*)(ws + OFF_WFFN2 + j * SZ_WFFN2), 2816, 1024, 2816, 0, 0);
        add_job(P, nj, nt, P.in[16] + (size_t)j * 1024 * 2432, (bf16_t*)(ws + OFF_WINO + j * SZ_WINO), 1024, 2432, 1024, 0, 0);
        add_job(P, nj, nt, nullptr, (bf16_t*)(ws + OFF_WINO + j * SZ_WINO) + (size_t)2432 * 1024, 1024, 128, 1024, 3, 0);
        add_job(P, nj, nt, P.in[17] + (size_t)j * 1024 * 1024, (bf16_t*)(ws + OFF_WOUTO + j * SZ_WSQ), 1024, 1024, 1024, 0, 0);
        add_job(P, nj, nt, nullptr, (bf16_t*)(ws + OFF_WLORA + j * SZ_WLORA), 384, 2560, 384, 4, j);
        add_job(P, nj, nt, P.in[26] + (size_t)j * 512 * 512, (bf16_t*)(ws + OFF_WGLU + j * SZ_WGLU), 512, 512, 512, 0, 0);
        if (j == 1) { P.njm = nj; P.ntm = nt; nt = 0; }
        { const int L = j;
        for (int e = 0; e < 8; ++e) {
            const size_t eo = (size_t)(L * 8 + e) * 1024 * 2816;
            add_job(P, nj, nt, P.in[40] + eo, (bf16_t*)(ws + OFF_WMOE1 + e * SZ_WFFN1), 1024, 2816, 1024, 1, 0);
            add_job(P, nj, nt, P.in[41] + eo, (bf16_t*)(ws + OFF_WMOE1 + e * SZ_WFFN1), 1024, 2816, 1024, 2, 0);
            add_job(P, nj, nt, P.in[42] + eo, (bf16_t*)(ws + OFF_WMOE2 + e * SZ_WFFN2), 2816, 1024, 2816, 0, 0);
        }
        }
    }
    P.nj1 = nj; P.nt1 = nt; P.ntc = nt / 2;
#if MK_SINGLE
    P.lo = 0; P.hi = NPH;
    hipLaunchKernelGGL(mega, dim3(256), dim3(512), LDS_BYTES, stream, P);
#else
    for (int ph = 0; ph < NPH; ++ph) { P.lo = ph; P.hi = ph + 1; hipLaunchKernelGGL(mega, dim3(256), dim3(512), LDS_BYTES, stream, P); }
#endif
}
```

```cpp
#include <hip/hip_runtime.h>
#include <stdint.h>
#include <stdio.h>
#include <string.h>

#ifndef PROBE_DUP
#define PROBE_DUP 0
#endif
#define REP(k) for (int rep_ = 0; rep_ < 1 + ((PROBE_DUP >> (k)) & 1); ++rep_)
#define DUPB(k) ((PROBE_DUP >> (k)) & 1)
#ifndef MK_SINGLE
#define MK_SINGLE 1
#endif

#define LAS __attribute__((address_space(3)))
typedef unsigned short bf16_t;
typedef short bf16x8 __attribute__((ext_vector_type(8)));
typedef short s16x4 __attribute__((ext_vector_type(4)));
typedef float f32x2 __attribute__((ext_vector_type(2)));
typedef float f32x4 __attribute__((ext_vector_type(4)));
typedef float f32x16 __attribute__((ext_vector_type(16)));
typedef unsigned u32x2 __attribute__((ext_vector_type(2)));
typedef unsigned u32x4 __attribute__((ext_vector_type(4)));
typedef __bf16 bfv2 __attribute__((ext_vector_type(2)));

constexpr int TT = 18432;
constexpr int SB = 2304;
constexpr int DM = 1024;
constexpr int NPH = 42;
constexpr float ALPHA = 1.6817928305074290f;
constexpr int SPLIT_S = 2;

constexpr size_t OFF_BAR = 0;
constexpr size_t OFF_CNT = 16384;
constexpr size_t ZERO_BYTES = 32768;
constexpr size_t OFF_MOD = 32768;
constexpr size_t OFF_COS = OFF_MOD + 884736;
constexpr size_t OFF_SIN = OFF_COS + 262144;
constexpr size_t OFF_LB = OFF_SIN + 262144;
constexpr size_t OFF_AB = OFF_LB + 4096;
constexpr size_t OFF_BBR = OFF_AB + 65536;
constexpr size_t OFF_BBI = OFF_BBR + 524288;
constexpr size_t OFF_ROUTE = OFF_BBI + 524288;
constexpr size_t OFF_WINE = OFF_ROUTE + 589824;
constexpr size_t SZ_WINE = (size_t)3328 * 1024 * 2;
constexpr size_t OFF_WOUTE = OFF_WINE + 2 * SZ_WINE;
constexpr size_t SZ_WSQ = (size_t)1024 * 1024 * 2;
constexpr size_t OFF_WFFN1 = OFF_WOUTE + 2 * SZ_WSQ;
constexpr size_t SZ_WFFN1 = (size_t)5632 * 1024 * 2;
constexpr size_t OFF_WFFN2 = OFF_WFFN1 + 2 * SZ_WFFN1;
constexpr size_t SZ_WFFN2 = (size_t)1024 * 2816 * 2;
constexpr size_t OFF_WINO = OFF_WFFN2 + 2 * SZ_WFFN2;
constexpr size_t SZ_WINO = (size_t)2560 * 1024 * 2;
constexpr size_t OFF_WOUTO = OFF_WINO + 2 * SZ_WINO;
constexpr size_t OFF_WLORA = OFF_WOUTO + 2 * SZ_WSQ;
constexpr size_t SZ_WLORA = (size_t)2560 * 384 * 2;
constexpr size_t OFF_WGLU = OFF_WLORA + 2 * SZ_WLORA;
constexpr size_t SZ_WGLU = (size_t)512 * 512 * 2;
constexpr size_t OFF_WMOE1 = OFF_WGLU + 2 * SZ_WGLU;
constexpr size_t OFF_WMOE2 = OFF_WMOE1 + 8 * SZ_WFFN1;
constexpr size_t OFF_X = OFF_WMOE2 + 8 * SZ_WFFN2;
constexpr size_t OFF_H = OFF_X + (size_t)TT * 1024 * 4;
constexpr size_t OFF_AR = OFF_H + (size_t)TT * 1024 * 2;
constexpr size_t AE_P = 0, AE_OF = 122683392, AE_OB = AE_OF + 37748736, AE_Y = AE_OB + 37748736;
constexpr size_t AO_P = 0, AO_OF = 94371840, AO_OB = AO_OF + 37748736, AO_PR = AO_OB + 37748736, AO_L = AO_PR + 56623104, AO_YG = AO_L + 14155776, AO_Y = AO_YG + 18874368;
constexpr size_t AM_A = 0, AM_H = 79691776;
constexpr size_t AR_SIZE = 298844160;
constexpr size_t OFF_KN = OFF_AR + AR_SIZE;
constexpr size_t OFF_GE = OFF_KN + 589824;
constexpr size_t OFF_GW = OFF_GE + (size_t)18432 * 8192;
constexpr size_t OFF_S5F = OFF_GW + (size_t)18432 * 256;
constexpr size_t OFF_S5B = OFF_S5F + (size_t)TT * 512 * 4;
constexpr size_t OFF_INV = OFF_S5B + (size_t)TT * 512 * 4;
constexpr size_t WS_END = OFF_INV + (size_t)8 * TT * 4;

struct Job { const float* src; bf16_t* dst; int K, N, ldd, mode, tile0, aux; };
constexpr int MAXJOBS = 72;
struct Params {
    const float* in[43];
    float* out;
    unsigned char* ws;
    int lo, hi;
    int nj0, njm, nj1;
    int nt0, ntm, nt1;
    int ntc;
    Job jobs[MAXJOBS];
};

__device__ __forceinline__ float bf2f(unsigned v) { return __uint_as_float(v << 16); }
__device__ __forceinline__ unsigned pk2(float lo, float hi) { f32x2 v = {lo, hi}; bfv2 b = __builtin_convertvector(v, bfv2); return __builtin_bit_cast(unsigned, b); }
__device__ __forceinline__ void unpk8(const u32x4 v, float* f) {
    f[0] = __uint_as_float(v.x << 16); f[1] = __uint_as_float(v.x & 0xffff0000u);
    f[2] = __uint_as_float(v.y << 16); f[3] = __uint_as_float(v.y & 0xffff0000u);
    f[4] = __uint_as_float(v.z << 16); f[5] = __uint_as_float(v.z & 0xffff0000u);
    f[6] = __uint_as_float(v.w << 16); f[7] = __uint_as_float(v.w & 0xffff0000u);
}
__device__ __forceinline__ void unpk4(const u32x2 v, float* f) {
    f[0] = __uint_as_float(v.x << 16); f[1] = __uint_as_float(v.x & 0xffff0000u);
    f[2] = __uint_as_float(v.y << 16); f[3] = __uint_as_float(v.y & 0xffff0000u);
}
__device__ __forceinline__ f32x4 unpk4v(const u32x2 v) { f32x4 r; r[0] = __uint_as_float(v.x << 16); r[1] = __uint_as_float(v.x & 0xffff0000u); r[2] = __uint_as_float(v.y << 16); r[3] = __uint_as_float(v.y & 0xffff0000u); return r; }
typedef _Float16 hf4 __attribute__((ext_vector_type(4)));
__device__ __forceinline__ u32x2 f2h4(const f32x4 v) { const hf4 h = __builtin_convertvector(v, hf4); return __builtin_bit_cast(u32x2, h); }
__device__ __forceinline__ f32x4 h2f4(const u32x2 u) { const hf4 h = __builtin_bit_cast(hf4, u); return __builtin_convertvector(h, f32x4); }
__device__ __forceinline__ u32x4 pk8(const float* f) { u32x4 r; r.x = pk2(f[0], f[1]); r.y = pk2(f[2], f[3]); r.z = pk2(f[4], f[5]); r.w = pk2(f[6], f[7]); return r; }
template <int CTRL> __device__ __forceinline__ float dppf(float v) { return __builtin_bit_cast(float, __builtin_amdgcn_update_dpp(0, __builtin_bit_cast(int, v), CTRL, 0xF, 0xF, true)); }
__device__ __forceinline__ float sum8(float v) { v += dppf<0xB1>(v); v += dppf<0x4E>(v); v += dppf<0x141>(v); return v; }
__device__ __forceinline__ float sum16(float v) { v = sum8(v); v += dppf<0x140>(v); return v; }
__device__ __forceinline__ float xsum16(float x) { const unsigned xb = __builtin_bit_cast(unsigned, x); auto r = __builtin_amdgcn_permlane16_swap(xb, xb, false, false);
    return __builtin_bit_cast(float, (unsigned)r[0]) + __builtin_bit_cast(float, (unsigned)r[1]); }
__device__ __forceinline__ float xsum32(float x) { const unsigned xb = __builtin_bit_cast(unsigned, x); auto r = __builtin_amdgcn_permlane32_swap(xb, xb, false, false);
    return __builtin_bit_cast(float, (unsigned)r[0]) + __builtin_bit_cast(float, (unsigned)r[1]); }
__device__ __forceinline__ float sum64(float v) { v = sum16(v); v = xsum16(v); v = xsum32(v); return v; }
__device__ __forceinline__ float sigm(float x) { return __builtin_amdgcn_rcpf(1.0f + __builtin_amdgcn_exp2f(-1.4426950408889634f * x)); }
__device__ __forceinline__ float siluf(float x) { return x * __builtin_amdgcn_rcpf(1.0f + __builtin_amdgcn_exp2f(-1.4426950408889634f * x)); }
__device__ __forceinline__ float tanh_f(float x) { const float e = __builtin_amdgcn_exp2f(-2.8853900817779268f * fabsf(x)); const float t = (1.0f - e) * __builtin_amdgcn_rcpf(1.0f + e); return x < 0.f ? -t : t; }
__device__ __forceinline__ void my_sincos(float x, float& s, float& c) {
    const float q = rintf(x * 0.636619772f);
    float r = fmaf(-q, 1.57079637f, x); r = fmaf(-q, -4.37113883e-8f, r);
    const float r2 = r * r;
    const float sp = r + r * r2 * (-1.6666654611e-1f + r2 * (8.3321608736e-3f + r2 * (-1.9515295891e-4f)));
    const float cp = 1.0f - 0.5f * r2 + r2 * r2 * (4.166664568298827e-2f + r2 * (-1.388731625493765e-3f + r2 * 2.443315711809948e-5f));
    const int qi = ((int)q) & 3;
    s = (qi == 0) ? sp : (qi == 1) ? cp : (qi == 2) ? -sp : -cp;
    c = (qi == 0) ? cp : (qi == 1) ? -sp : (qi == 2) ? -cp : sp;
}
__device__ __forceinline__ unsigned char* ows(unsigned char* q) { const unsigned long long t0 = (unsigned long long)q; unsigned lo = __builtin_amdgcn_readfirstlane((unsigned)t0), hi = __builtin_amdgcn_readfirstlane((unsigned)(t0 >> 32)); asm volatile("" : "+s"(lo), "+s"(hi)); const unsigned long long t = ((unsigned long long)hi << 32) | lo; return (unsigned char*)(__attribute__((address_space(1))) unsigned char*)t; }
#define LDS_BARRIER() do { asm volatile("s_waitcnt lgkmcnt(0)" ::: "memory"); __builtin_amdgcn_s_barrier(); asm volatile("" ::: "memory"); } while (0)
__device__ __forceinline__ int otid() { int t = threadIdx.x; asm volatile("" : "+v"(t)); return t; }
__device__ __forceinline__ int mod_index(int row) { const int b = row / SB, s = row - b * SB; return s < 256 ? 8 : b; }

#define XB_TMO      128
#define XB_XCNT(j)  (256  + 64 * (j))
#define XB_XSUB(j)  (1280 + 64 * (j))
#define XB_XGEN(j)  (2304 + 64 * (j))
#define XB_TOP      3328
#define XB_TOPGEN   3392
#define XCD_BAR_WORDS 3456
#define XB_SPIN_CAP (1u << 18)
__device__ __forceinline__ unsigned xb_ld(unsigned* p)              { return __hip_atomic_load(p, __ATOMIC_RELAXED, __HIP_MEMORY_SCOPE_AGENT); }
__device__ __forceinline__ unsigned xb_add(unsigned* p, unsigned v) { return __hip_atomic_fetch_add(p, v, __ATOMIC_RELAXED, __HIP_MEMORY_SCOPE_AGENT); }
__device__ __forceinline__ unsigned xb_xcc_id() { return (unsigned)__builtin_amdgcn_s_getreg((3 << 11) | 20) & 0xFu; }
#define XB_SPIN(cond, bar) do { unsigned _sp = 0; while (cond) { __builtin_amdgcn_s_sleep(1); \
    if ((++_sp & 255u) == 0u) { if (xb_ld(&(bar)[XB_TMO])) break; if (_sp > XB_SPIN_CAP) { atomicAdd(&(bar)[XB_TMO], 1u); break; } } } } while (0)
struct XcdBarrier { unsigned* bar; unsigned x; volatile LAS unsigned* st; };
__device__ __forceinline__ XcdBarrier xcd_barrier_post(unsigned* bar, volatile LAS unsigned* st) {
    XcdBarrier b; b.bar = bar; b.x = xb_xcc_id(); b.st = st;
    if (threadIdx.x == 0) (void)xb_add(&bar[XB_XCNT(b.x)], 1u);
    return b;
}
__device__ __forceinline__ void xcd_barrier_complete(unsigned* bar, unsigned x, unsigned& nloc, unsigned& nx) {
    const unsigned G = gridDim.x * gridDim.y * gridDim.z;
    unsigned sum, cnt, mine, sp = 0u;
    for (;;) {
        sum = 0u; cnt = 0u; mine = 0u;
#pragma unroll
        for (unsigned j = 0; j < 16; ++j) { const unsigned c = xb_ld(&bar[XB_XCNT(j)]); sum += c; cnt += (c > 0u) ? 1u : 0u; mine = (j == x) ? c : mine; }
        if (sum == G) break;
        __builtin_amdgcn_s_sleep(1);
        if ((++sp & 255u) == 0u) { if (xb_ld(&bar[XB_TMO])) break; if (sp > XB_SPIN_CAP) { atomicAdd(&bar[XB_TMO], 1u); break; } }
    }
    nloc = mine > 0u ? mine : 1u; nx = cnt > 0u ? cnt : 1u;
}
__device__ __forceinline__ void xcd_barrier(const XcdBarrier& b) {
    asm volatile("s_waitcnt vmcnt(0)" ::: "memory");
    __syncthreads();
    if (threadIdx.x == 0) {
        unsigned* bar = b.bar;
        __builtin_amdgcn_s_waitcnt(0);
        unsigned nloc = b.st[0], nx = b.st[1];
        if (nloc == 0u) { xcd_barrier_complete(bar, b.x, nloc, nx); b.st[0] = nloc; b.st[1] = nx; }
        const unsigned old = xb_add(&bar[XB_XSUB(b.x)], 1u);
        const unsigned gen = old / nloc;
        if (old + 1u == (gen + 1u) * nloc) {
            __builtin_amdgcn_fence(__ATOMIC_RELEASE, "agent");
            asm volatile("s_waitcnt vmcnt(0)" ::: "memory");
            const unsigned og = xb_add(&bar[XB_TOP], 1u);
            const unsigned tg = og / nx;
            if (og + 1u == (tg + 1u) * nx) xb_add(&bar[XB_TOPGEN], 1u);
            else XB_SPIN(xb_ld(&bar[XB_TOPGEN]) == tg, bar);
            __builtin_amdgcn_fence(__ATOMIC_ACQUIRE, "agent");
            xb_add(&bar[XB_XGEN(b.x)], 1u);
            asm volatile("s_waitcnt vmcnt(0)" ::: "memory");
        } else {
            XB_SPIN(xb_ld(&bar[XB_TOPGEN]) == gen, bar);
            __builtin_amdgcn_fence(__ATOMIC_ACQUIRE, "agent");
            asm volatile("s_waitcnt vmcnt(0)" ::: "memory");
        }
    }
    __syncthreads();
}

namespace pg8 {
constexpr int BM = 256, BK = 64, HALF = 128, HTB = HALF * BK * 2, STAGE_BYTES = 8 * HTB, NXCD = 8, WGM = 8;
__device__ __forceinline__ int lds_byte(int r, int c) { const int st = (r >> 4) * 2 + (c >> 5), rr = r & 15, cc = c & 31, ob = rr * 64 + cc * 2; return st * 1024 + (ob ^ (((ob >> 9) & 1) << 5)); }
__device__ __forceinline__ void stage_rc(int b, int& R, int& C) { const int st = b / 1024, sb = b % 1024, swz = sb ^ (((sb >> 9) & 1) << 5); R = (st >> 1) * 16 + swz / 64; C = (st & 1) * 32 + (swz % 64) / 2; }
__device__ __forceinline__ int perm32(int rho) { const int n = rho >> 4, i = rho & 15; return 8 * (i >> 2) + 4 * n + (i & 3); }
struct Unit { int pm, pn, e, kt0, nkt, ks; };
struct Gemm { const bf16_t* A; const bf16_t* Bt; int K; size_t bstride; };
struct StaticOrder {
    int nM, nN, nwg, G, c, nkt;
    __device__ __forceinline__ void init(int M, int N, int G_, int c_, int K_) { nM = M / BM; nN = N / BM; nwg = nM * nN; G = G_; c = c_; nkt = K_ / BK; }
    __device__ __forceinline__ bool next(int i, Unit& u) const {
        const long L = (long)i * G + c; if (L >= nwg) return false;
        int wgid = (int)L; { const int q = nwg / NXCD, r = nwg % NXCD, xcd = wgid % NXCD, off = wgid / NXCD; wgid = (xcd < r ? xcd * (q + 1) : r * (q + 1) + (xcd - r) * q) + off; }
        const int nig = WGM * nN, gid = wgid / nig, fm = gid * WGM, gsz = (nM - fm) < WGM ? (nM - fm) : WGM;
        u.pm = fm + ((wgid % nig) % gsz); u.pn = (wgid % nig) / gsz; u.e = 0; u.kt0 = 0; u.nkt = nkt; u.ks = -1; return true;
    }
};
struct LoraOrder {
    StaticOrder so;
    __device__ __forceinline__ void init(int M, int N, int G_, int c_, int K_) { so.init(M, N, G_, c_, K_); }
    __device__ __forceinline__ bool next(int i, Unit& u) const {
        if (!so.next(i, u)) return false;
        u.kt0 = (u.pn >> 2) * 2; u.nkt = 2; return true;
    }
};
struct MoeOrder {
    int nN, G, c, npan, nkt, nfullU; int pend[8];
    __device__ __forceinline__ void init(const unsigned* cnt, int nN_, int G_, int c_, int K_, bool split = false) {
        nN = nN_; G = G_; c = c_; nkt = K_ / BK; int acc = 0;
#pragma unroll
        for (int e = 0; e < 8; ++e) { acc += ((int)cnt[e * 64] + 255) >> 8; pend[e] = acc; }
        npan = acc; nfullU = split ? ((npan * nN) / G) * G : 0x40000000;
    }
    __device__ __forceinline__ bool next(int i, Unit& u) const {
        const int q0 = i * G + (c & 7) * (G >> 3) + (c >> 3);
        const bool sub = q0 >= nfullU;
        const int q = sub ? nfullU + ((q0 - nfullU) >> 1) : q0, ksub = (q0 - nfullU) & 1;
        const int per = 4 * nN, nfull = npan >> 2, g4 = q / per;
        int pan, pn; bool ok = true;
        if (g4 < nfull) { const int r = q - g4 * per; pn = r >> 2; pan = g4 * 4 + (r & 3); }
        else { const int q2 = q - nfull * per, gp = npan - 4 * nfull; const int gpd = gp > 0 ? gp : 1; ok = q2 < gp * nN; pn = q2 / gpd; pan = 4 * nfull + (q2 - pn * gpd); }
        int e = 0;
#pragma unroll
        for (int k = 0; k < 7; ++k) e += (pan >= pend[k]) ? 1 : 0;
        u.pm = pan; u.pn = pn; u.e = e; u.kt0 = sub ? ksub * (nkt >> 1) : 0; u.nkt = sub ? (nkt >> 1) : nkt; u.ks = sub ? ksub : -1;
        return ok;
    }
};
struct CtxSplitOrder {
    StaticOrder lat; int G, c, nkt, S;
    __device__ __forceinline__ void init(int G_, int c_, int K_, int S_) { lat.init(64 * BM, 1024, G_, c_, K_); G = G_; c = c_; nkt = K_ / BK; S = S_; }
    __device__ __forceinline__ bool next(int i, Unit& u) const {
        const int L = i * G + c;
        const bool islat = L < 256;
        Unit r; const bool okl = lat.next(islat ? i : 0, r);
        r.pm = (r.pm >> 3) * 9 + 1 + (r.pm & 7);
        const int L2 = islat ? 0 : L - 256, Sd = S > 0 ? S : 1, uid = L2 / Sd, ks = L2 - uid * Sd, sub = nkt / Sd;
        u.pm = islat ? r.pm : (uid >> 2) * 9; u.pn = islat ? r.pn : (uid & 3); u.e = 0;
        u.kt0 = islat ? 0 : ks * sub; u.nkt = islat ? nkt : sub; u.ks = islat ? -1 : ks;
        return islat ? okl : (L2 < 32 * S);
    }
};
template <class Epi, class Sched, bool GA = false>
__device__ __forceinline__ void gemm_phase(LAS unsigned char* lds, const Gemm g, const Sched& S, const Epi& E, const LAS int* ridx = nullptr) {
    const int tid = otid(), wid = __builtin_amdgcn_readfirstlane(tid >> 6), lane = tid & 63, wr = wid >> 2, wc = wid & 3, fr = lane & 15, fq = lane >> 4;
    const int K = g.K;
    unsigned voffA[2], voffB[2]; int RA[2]; unsigned CA2[2];
#pragma unroll
    for (int i = 0; i < 2; ++i) { int R, C; stage_rc(tid * 16 + i * 8192, R, C); const int Rb = Epi::PERM ? ((R & ~31) + perm32(R & 31)) : R;
        voffA[i] = (unsigned)(R * K + C) * 2u; voffB[i] = (unsigned)(Rb * K + C) * 2u; RA[i] = R; CA2[i] = (unsigned)C * 2u; }
    unsigned vA[2][2], nvA[2][2], v2[2][2];
#define PG8_GIDX(dst, ui_) do { _Pragma("unroll") for (int _h = 0; _h < 2; ++_h) _Pragma("unroll") for (int _i = 0; _i < 2; ++_i) \
        dst[_h][_i] = (unsigned)ridx[(ui_) * 256 + _h * HALF + RA[_i]] * (unsigned)(K * 2) + CA2[_i]; } while (0)
#define PG8_STGA(bufoff, abase, h, vsel) do { if (GA) PG8_STAGE(bufoff, abase, vsel[h]); else PG8_STAGE(bufoff, (abase) + (h) * hstep, voffA); } while (0)
    const size_t kstep = (size_t)(BK * 2);
    const size_t hstep = (size_t)HALF * K * 2;
    const size_t tstep = 2 * hstep;
    const unsigned ldsw = (unsigned)wid * 1024u;
    const int aoff = lds_byte(wr * 64 + fr, fq * 8), boff = lds_byte(wc * 32 + fr, fq * 8);
#define PG8_SA(b, h) (((b) * 2 + (h)) * HTB)
#define PG8_SB(b, h) ((4 + (b) * 2 + (h)) * HTB)
#define PG8_STAGE(bufoff, gbase, voff) do { _Pragma("unroll") for (int _i = 0; _i < 2; ++_i) \
        __builtin_amdgcn_global_load_lds((const unsigned*)((const char*)(gbase) + (voff)[_i]), (LAS unsigned*)(lds + (bufoff) + ldsw + _i * 8192), 16, 0, 0); } while (0)
#define PG8_LDA(dst, b, h) do { _Pragma("unroll") for (int m = 0; m < 4; ++m) _Pragma("unroll") for (int k = 0; k < 2; ++k) dst[m][k] = *(const LAS bf16x8*)(lds + PG8_SA(b, h) + aoff + m * 2048 + k * 1024); } while (0)
#define PG8_LDB(dst, b, h) do { _Pragma("unroll") for (int n = 0; n < 2; ++n) _Pragma("unroll") for (int k = 0; k < 2; ++k) dst[n][k] = *(const LAS bf16x8*)(lds + PG8_SB(b, h) + boff + n * 2048 + k * 1024); } while (0)
#define PG8_MMA(ai, bj, At, Bt) do { __builtin_amdgcn_s_setprio(1); _Pragma("unroll") for (int m = 0; m < 4; ++m) _Pragma("unroll") for (int n = 0; n < 2; ++n) _Pragma("unroll") for (int k = 0; k < 2; ++k) \
        acc[ai][bj][m][n] = __builtin_amdgcn_mfma_f32_16x16x32_bf16(Bt[n][k], At[m][k], acc[ai][bj][m][n], 0, 0, 0); __builtin_amdgcn_s_setprio(0); } while (0)
#define PG8_WAIT_V(n) asm volatile("s_waitcnt vmcnt(" #n ")" ::: "memory")
#define PG8_WAIT_L(n) asm volatile("s_waitcnt lgkmcnt(" #n ")" ::: "memory")
#define PG8_BAR __builtin_amdgcn_s_barrier()
#define PG8_SCHED __builtin_amdgcn_sched_barrier(0)
    Unit cur, nxt; int ui = 0;
    if (!S.next(0, cur)) return;
    f32x4 acc[2][2][4][2];
#pragma unroll
    for (int a = 0; a < 2; ++a)
#pragma unroll
        for (int b = 0; b < 2; ++b)
#pragma unroll
            for (int m = 0; m < 4; ++m)
#pragma unroll
                for (int n = 0; n < 2; ++n) acc[a][b][m][n] = (f32x4){0.f, 0.f, 0.f, 0.f};
    bf16x8 At[4][2], B0[2][2], B1[2][2];
    const char* cA = (const char*)g.A + (GA ? (size_t)0 : (size_t)cur.pm * tstep) + (size_t)cur.kt0 * kstep; const char* cB = (const char*)g.Bt + (size_t)cur.e * g.bstride + (size_t)cur.pn * tstep + (size_t)cur.kt0 * kstep;
    if (GA) PG8_GIDX(vA, 0);
    PG8_STAGE(PG8_SB(0, 0), cB, voffB); PG8_STGA(PG8_SA(0, 0), cA, 0, vA); PG8_STAGE(PG8_SB(0, 1), cB + hstep, voffB); PG8_STGA(PG8_SA(0, 1), cA, 1, vA);
    if (wr == 1) PG8_BAR;
    PG8_WAIT_V(4); PG8_BAR;
    PG8_STAGE(PG8_SB(1, 0), cB + kstep, voffB); PG8_STGA(PG8_SA(1, 0), cA + kstep, 0, vA); PG8_STAGE(PG8_SB(1, 1), cB + hstep + kstep, voffB);
    PG8_WAIT_V(6); PG8_BAR;
    for (;;) {
        const bool has_next = S.next(ui + 1, nxt);
        const char* nA = has_next ? (const char*)g.A + (GA ? (size_t)0 : (size_t)nxt.pm * tstep) + (size_t)nxt.kt0 * kstep : cA; const char* nB = has_next ? (const char*)g.Bt + (size_t)nxt.e * g.bstride + (size_t)nxt.pn * tstep + (size_t)nxt.kt0 * kstep : cB;
        const int nt = cur.nkt;
        if (GA) { if (has_next) PG8_GIDX(nvA, ui + 1); else {
#pragma unroll
            for (int _h = 0; _h < 2; ++_h) { nvA[_h][0] = vA[_h][0]; nvA[_h][1] = vA[_h][1]; } } }
        for (int t = 0; t < nt; t += 2) {
            const bool last = (t == nt - 2);
            if (GA) {
#pragma unroll
                for (int _h = 0; _h < 2; ++_h) { v2[_h][0] = last ? nvA[_h][0] : vA[_h][0]; v2[_h][1] = last ? nvA[_h][1] : vA[_h][1]; } }
            const char* a1 = cA + (size_t)(t + 1) * kstep;
            const char* a2 = last ? nA : cA + (size_t)(t + 2) * kstep; const char* b2 = last ? nB : cB + (size_t)(t + 2) * kstep;
            const char* a3 = a2 + kstep; const char* b3 = b2 + kstep;
            PG8_LDB(B0, 0, 0); PG8_SCHED; PG8_LDA(At, 0, 0); PG8_STGA(PG8_SA(1, 1), a1, 1, vA);
            PG8_WAIT_L(8); PG8_BAR; PG8_WAIT_L(0); PG8_MMA(0, 0, At, B0); PG8_BAR; PG8_SCHED;
            PG8_LDB(B1, 0, 1); PG8_STAGE(PG8_SB(0, 0), b2, voffB);
            PG8_BAR; PG8_WAIT_L(0); PG8_MMA(0, 1, At, B1); PG8_BAR;
            PG8_LDA(At, 0, 1); PG8_STGA(PG8_SA(0, 0), a2, 0, v2);
            PG8_BAR; PG8_WAIT_L(0); PG8_MMA(1, 0, At, B0); PG8_BAR; PG8_SCHED;
            PG8_STAGE(PG8_SB(0, 1), b2 + hstep, voffB);
            PG8_WAIT_V(6); PG8_BAR; PG8_MMA(1, 1, At, B1); PG8_BAR;
            PG8_LDB(B0, 1, 0); PG8_SCHED; PG8_LDA(At, 1, 0); PG8_STGA(PG8_SA(0, 1), a2, 1, v2);
            PG8_WAIT_L(8); PG8_BAR; PG8_WAIT_L(0); PG8_MMA(0, 0, At, B0); PG8_BAR; PG8_SCHED;
            PG8_LDB(B1, 1, 1); PG8_STAGE(PG8_SB(1, 0), b3, voffB);
            PG8_BAR; PG8_WAIT_L(0); PG8_MMA(0, 1, At, B1); PG8_BAR;
            PG8_LDA(At, 1, 1); PG8_STGA(PG8_SA(1, 0), a3, 0, v2);
            PG8_BAR; PG8_WAIT_L(0); PG8_MMA(1, 0, At, B0); PG8_BAR; PG8_SCHED;
            PG8_STAGE(PG8_SB(1, 1), b3 + hstep, voffB);
            PG8_WAIT_V(6); PG8_BAR; PG8_MMA(1, 1, At, B1); PG8_BAR;
        }
        E(acc, cur, wr, wc, fr, fq);
        if (!has_next) break;
#pragma unroll
        for (int a = 0; a < 2; ++a)
#pragma unroll
            for (int b = 0; b < 2; ++b)
#pragma unroll
                for (int m = 0; m < 4; ++m)
#pragma unroll
                    for (int n = 0; n < 2; ++n) acc[a][b][m][n] = (f32x4){0.f, 0.f, 0.f, 0.f};
        cur = nxt; cA = nA; cB = nB; ++ui;
        if (GA) {
#pragma unroll
            for (int _h = 0; _h < 2; ++_h) { vA[_h][0] = nvA[_h][0]; vA[_h][1] = nvA[_h][1]; } }
    }
    PG8_WAIT_V(0);
    if (wr == 0) PG8_BAR;
    PG8_BAR;
#undef PG8_SA
#undef PG8_SB
#undef PG8_STAGE
#undef PG8_STGA
#undef PG8_GIDX
#undef PG8_LDA
#undef PG8_LDB
#undef PG8_MMA
#undef PG8_WAIT_V
#undef PG8_WAIT_L
#undef PG8_BAR
#undef PG8_SCHED
}

struct EpiBf16 {
    static constexpr bool PERM = true;
    bf16_t* O; int ldc; bf16_t* O2;
    __device__ __forceinline__ void operator()(const f32x4 (&acc)[2][2][4][2], const Unit& u, int wr, int wc, int fr, int fq) const {
        const int row0 = u.pm * BM + wr * 64 + fr, col0 = u.pn * BM + wc * 32 + 8 * fq;
        bf16_t* Ob = (u.ks == 1) ? O2 : O;
#pragma unroll
        for (int ai = 0; ai < 2; ++ai)
#pragma unroll
            for (int m = 0; m < 4; ++m) { bf16_t* rowp = Ob + (size_t)(row0 + ai * HALF + m * 16) * ldc + col0;
#pragma unroll
                for (int bj = 0; bj < 2; ++bj) { const f32x4 v0 = acc[ai][bj][m][0], v1 = acc[ai][bj][m][1];
                    u32x4 w; w.x = pk2(v0[0], v0[1]); w.y = pk2(v0[2], v0[3]); w.z = pk2(v1[0], v1[1]); w.w = pk2(v1[2], v1[3]);
                    *(u32x4*)(rowp + bj * HALF) = w; } }
    }
};
struct EpiEvenIn {
    static constexpr bool PERM = true;
    bf16_t* O; const LAS float* lb;
    __device__ __forceinline__ void operator()(const f32x4 (&acc)[2][2][4][2], const Unit& u, int wr, int wc, int fr, int fq) const {
        const int row0 = u.pm * BM + wr * 64 + fr, col0 = u.pn * BM + wc * 32 + 8 * fq;
        const int kind = (u.pn < 2) ? 1 : (u.pn < 6) ? 2 : (u.pn == 8 || u.pn == 9) ? 3 : 0;
        float lbv[2][8];
        if (kind == 2) {
#pragma unroll
            for (int bj = 0; bj < 2; ++bj)
#pragma unroll
                for (int j = 0; j < 8; ++j) lbv[bj][j] = lb[(col0 + bj * HALF + j) & 511];
        }
#pragma unroll
        for (int ai = 0; ai < 2; ++ai)
#pragma unroll
            for (int m = 0; m < 4; ++m) { bf16_t* rowp = O + (size_t)(row0 + ai * HALF + m * 16) * 3328 + col0;
#pragma unroll
                for (int bj = 0; bj < 2; ++bj) { float v[8];
#pragma unroll
                    for (int j = 0; j < 4; ++j) { v[j] = acc[ai][bj][m][0][j]; v[4 + j] = acc[ai][bj][m][1][j]; }
                    if (kind == 1) {
#pragma unroll
                        for (int j = 0; j < 8; ++j) v[j] = siluf(v[j]) * 0.08838834764831845f; }
                    else if (kind == 2) {
#pragma unroll
                        for (int j = 0; j < 8; ++j) v[j] = __builtin_amdgcn_logf(lbv[bj][j] + (1.0f - lbv[bj][j]) * sigm(v[j])); }
                    else if (kind == 3) {
#pragma unroll
                        for (int j = 0; j < 8; ++j) v[j] = siluf(v[j]); }
                    *(u32x4*)(rowp + bj * HALF) = pk8(v); } }
    }
};
struct EpiResid {
    static constexpr bool PERM = true;
    bf16_t* D0; const float* gate; bf16_t* D1;
    __device__ __forceinline__ void operator()(const f32x4 (&acc)[2][2][4][2], const Unit& u, int wr, int wc, int fr, int fq) const {
        const int row0 = u.pm * BM + wr * 64 + fr, col0 = u.pn * BM + wc * 32 + 8 * fq;
        const int b = u.pm / 9, isctx = (u.pm - b * 9 == 0), mi = isctx ? 8 : b;
        const float* gp = gate + (size_t)mi * 6144 + col0;
        f32x4 gv[2][2];
#pragma unroll
        for (int bj = 0; bj < 2; ++bj)
#pragma unroll
            for (int n = 0; n < 2; ++n) gv[bj][n] = *(const f32x4*)(gp + bj * HALF + 4 * n);
        bf16_t* Db = (u.ks == 1) ? D1 : D0;
#pragma unroll
        for (int ai = 0; ai < 2; ++ai)
#pragma unroll
            for (int m = 0; m < 4; ++m) { bf16_t* rowp = Db + (size_t)(row0 + ai * HALF + m * 16) * 1024 + col0;
#pragma unroll
                for (int bj = 0; bj < 2; ++bj) { const f32x4 v0 = acc[ai][bj][m][0] * gv[bj][0], v1 = acc[ai][bj][m][1] * gv[bj][1];
                    u32x4 w; w.x = pk2(v0[0], v0[1]); w.y = pk2(v0[2], v0[3]); w.z = pk2(v1[0], v1[1]); w.w = pk2(v1[2], v1[3]);
                    *(u32x4*)(rowp + bj * HALF) = w; } }
    }
};
struct EpiSwiGLU {
    static constexpr bool PERM = true;
    bf16_t* O; int ldc;
    __device__ __forceinline__ void operator()(const f32x4 (&acc)[2][2][4][2], const Unit& u, int wr, int wc, int fr, int fq) const {
        const int row0 = u.pm * BM + wr * 64 + fr, col0 = u.pn * HALF + wc * 32 + 8 * fq;
#pragma unroll
        for (int ai = 0; ai < 2; ++ai)
#pragma unroll
            for (int m = 0; m < 4; ++m) { bf16_t* rowp = O + (size_t)(row0 + ai * HALF + m * 16) * ldc + col0;
                float o[8];
#pragma unroll
                for (int n = 0; n < 2; ++n)
#pragma unroll
                    for (int j = 0; j < 4; j += 2) {
                        const f32x2 g2 = {acc[ai][0][m][n][j], acc[ai][0][m][n][j + 1]}, u2 = {acc[ai][1][m][n][j], acc[ai][1][m][n][j + 1]};
                        const f32x2 t = g2 * (-1.4426950408889634f);
                        f32x2 e; e.x = __builtin_amdgcn_exp2f(t.x); e.y = __builtin_amdgcn_exp2f(t.y);
                        const f32x2 d = e + 1.0f;
                        f32x2 r; r.x = __builtin_amdgcn_rcpf(d.x); r.y = __builtin_amdgcn_rcpf(d.y);
                        const f32x2 y = (g2 * u2) * r;
                        o[n * 4 + j] = y.x; o[n * 4 + j + 1] = y.y; }
                *(u32x4*)rowp = pk8(o); }
    }
};
struct EpiGLU {
    static constexpr bool PERM = true;
    const bf16_t* YG; bf16_t* Y;
    __device__ __forceinline__ void operator()(const f32x4 (&acc)[2][2][4][2], const Unit& u, int wr, int wc, int fr, int fq) const {
        const int row0 = u.pm * BM + wr * 64 + fr, col0 = u.pn * BM + wc * 32 + 8 * fq;
#pragma unroll
        for (int ai = 0; ai < 2; ++ai)
#pragma unroll
            for (int m = 0; m < 4; ++m) { const size_t row = (size_t)(row0 + ai * HALF + m * 16);
#pragma unroll
                for (int bj = 0; bj < 2; ++bj) { const int col = col0 + bj * HALF;
                    float y[8], o[8]; unpk8(*(const u32x4*)(YG + row * 512 + col), y);
#pragma unroll
                    for (int n = 0; n < 2; ++n)
#pragma unroll
                        for (int j = 0; j < 4; ++j) o[n * 4 + j] = y[n * 4 + j] * sigm(acc[ai][bj][m][n][j]);
                    *(u32x4*)(Y + row * 1024 + col) = pk8(o); } }
    }
};
}

__device__ __forceinline__ void ada_item(const Params& p, int item, unsigned char* sm) {
    unsigned char* const ws = ows(p.ws);
    const int tid = otid();
    const int l = item / 48, n0 = (item % 48) * 128;
    float* sc = (float*)sm;
    float* red = (float*)(sm + 49152);
    for (int i = tid; i < 9 * 1024; i += 512) { const int m = i >> 10, k = i & 1023; const float v = (m < 8) ? p.in[1][m * 1024 + k] : p.in[3][k]; sc[k * 12 + m] = siluf(v); }
    __syncthreads();
    const int col = tid & 127, kg = tid >> 7;
    float a0 = 0, a1 = 0, a2 = 0, a3 = 0, a4 = 0, a5 = 0, a6 = 0, a7 = 0, a8 = 0;
    const float* w = p.in[4] + (size_t)l * 1024 * 6144 + n0 + col;
#pragma unroll 8
    for (int k = kg * 256; k < kg * 256 + 256; ++k) {
        const float wv = w[(size_t)k * 6144];
        const f32x4 s0 = *(const f32x4*)&sc[k * 12], s1 = *(const f32x4*)&sc[k * 12 + 4]; const float s8 = sc[k * 12 + 8];
        a0 += s0[0] * wv; a1 += s0[1] * wv; a2 += s0[2] * wv; a3 += s0[3] * wv; a4 += s1[0] * wv; a5 += s1[1] * wv; a6 += s1[2] * wv; a7 += s1[3] * wv; a8 += s8 * wv;
    }
    float* rp = red + (kg * 9) * 128 + col;
    rp[0] = a0; rp[128] = a1; rp[256] = a2; rp[384] = a3; rp[512] = a4; rp[640] = a5; rp[768] = a6; rp[896] = a7; rp[1024] = a8;
    __syncthreads();
    float* mod = (float*)(ws + OFF_MOD);
    for (int i = tid; i < 9 * 128; i += 512) { const int m = i >> 7, cc = i & 127;
        const float s = red[(0 * 9 + m) * 128 + cc] + red[(1 * 9 + m) * 128 + cc] + red[(2 * 9 + m) * 128 + cc] + red[(3 * 9 + m) * 128 + cc];
        mod[(size_t)(l * 9 + m) * 6144 + n0 + cc] = s + p.in[5][l * 6144 + n0 + cc]; }
}
__device__ __forceinline__ void rope_item(const Params& p) {
    unsigned char* const ws = ows(p.ws);
    float* COS = (float*)(ws + OFF_COS); float* SIN = (float*)(ws + OFF_SIN);
    for (int i = threadIdx.x; i < 2048 * 32; i += 512) { const int pos = i >> 5, f = i & 31, fi = f & 15;
        const float inv = exp2f(-(float)fi * (13.287712379549449f / 16.0f));
        const float ang = (float)(f < 16 ? (pos >> 6) : (pos & 63)) * inv;
        float s, c; my_sincos(ang, s, c); COS[i] = c; SIN[i] = s; }
}
__device__ __forceinline__ void s5disc_item(const Params& p) {
    unsigned char* const ws = ows(p.ws);
    float* AB = (float*)(ws + OFF_AB); float* BBR = (float*)(ws + OFF_BBR); float* BBI = (float*)(ws + OFF_BBI); float* LB = (float*)(ws + OFF_LB);
    for (int idx = threadIdx.x; idx < 8192; idx += 512) {
        const int pp = idx & 63, g = (idx >> 6) & 31, jd = idx >> 11, jo = jd >> 1;
        const float lr = fminf(p.in[18][idx], -1e-4f), li = p.in[19][idx];
        const float dt = expf(p.in[20][jd * 32 + g]);
        const float mag = expf(lr * dt); float s, c; my_sincos(li * dt, s, c);
        const float abr = mag * c, abi = mag * s, den = lr * lr + li * li, nr = abr - 1.0f;
        const float cor = (nr * lr + abi * li) / den, coi = (abi * lr - nr * li) / den;
        AB[idx * 2] = abr; AB[idx * 2 + 1] = abi;
        const float* br = p.in[21] + (size_t)((jo * 32 + g) * 64 + pp) * 16; const float* bi = p.in[22] + (size_t)((jo * 32 + g) * 64 + pp) * 16;
        for (int h = 0; h < 16; ++h) { BBR[idx * 16 + h] = cor * br[h] - coi * bi[h]; BBI[idx * 16 + h] = cor * bi[h] + coi * br[h]; }
    }
    for (int c = threadIdx.x; c < 512; c += 512) { const float e0 = expf(p.in[10][c]), e1 = expf(p.in[10][512 + c]); LB[c] = 0.f; LB[512 + c] = e1 / (e0 + e1); }
}
struct TrTile { bf16_t* dp; int mode; };
__device__ __forceinline__ void tr_load(const Params& p, int tile, int& j, int jhi, f32x4 (&v)[8], int& k0, int& n0, Job& jb, int tid) {
    while (j + 1 < jhi && tile >= p.jobs[j + 1].tile0) ++j;
    jb = p.jobs[j]; const int t = tile - jb.tile0;
    const int nkt = jb.K >> 7, kt = t % nkt, ntl = t / nkt; k0 = kt * 128; n0 = ntl * 128;
    if (jb.mode == 3) {
#pragma unroll
        for (int i = 0; i < 8; ++i) v[i] = (f32x4){0.f, 0.f, 0.f, 0.f};
    } else if (jb.mode == 4) {
        const int blk = n0 >> 9, jo = jb.aux, sn0 = n0 & 511;
        const float* src = (blk < 4) ? (blk < 2 ? p.in[29] : p.in[31]) + (size_t)(jo * 2 + (blk & 1)) * 64 * 512 : p.in[32] + (size_t)jo * 128 * 512;
        const int klo = (blk < 4) ? 64 * blk : 256, khi = (blk < 4) ? 64 * blk + 64 : 384;
#pragma unroll
        for (int i = 0; i < 8; ++i) { const int idx = tid + 512 * i, kk = k0 + (idx >> 5), n4 = (idx & 31) * 4;
            v[i] = (kk >= klo && kk < khi) ? *(const f32x4*)(src + (size_t)(kk - klo) * 512 + sn0 + n4) : (f32x4){0.f, 0.f, 0.f, 0.f}; }
    } else {
#pragma unroll
        for (int i = 0; i < 8; ++i) { const int idx = tid + 512 * i, kk = idx >> 5, n4 = (idx & 31) * 4;
            v[i] = *(const f32x4*)(jb.src + (size_t)(k0 + kk) * jb.N + n0 + n4); }
    }
}
__device__ __forceinline__ void tr_loop(const Params& p, int first, int stride, int ntiles, int jlo, int jhi, unsigned char* sm) {
    const int tid = otid();
    bf16_t* Lb = (bf16_t*)sm;
    if (first >= ntiles) return;
    int j = jlo, k0, n0; Job jb; f32x4 v[8];
    tr_load(p, first, j, jhi, v, k0, n0, jb, tid);
    for (int tile = first; tile < ntiles; tile += stride) {
#pragma unroll
        for (int i = 0; i < 8; ++i) { const int idx = tid + 512 * i, kk = idx >> 5, n4 = (idx & 31) * 4;
            u32x2 w2; w2.x = pk2(v[i][0], v[i][1]); w2.y = pk2(v[i][2], v[i][3]); *(u32x2*)(Lb + kk * 132 + n4) = w2; }
        const int nn = tid >> 2, kq = tid & 3, ng = n0 + nn;
        int drow = ng;
        if (jb.mode == 1) drow = (ng >> 7) * 256 + (ng & 127);
        else if (jb.mode == 2) drow = (ng >> 7) * 256 + 128 + (ng & 127);
        bf16_t* dp = jb.dst + (size_t)drow * jb.ldd + k0;
        __syncthreads();
        if (tile + stride < ntiles) tr_load(p, tile + stride, j, jhi, v, k0, n0, jb, tid);
#pragma unroll
        for (int g = 0; g < 4; ++g) { const int k8 = g * 32 + kq * 8;
            u32x4 o;
            o.x = (unsigned)Lb[(k8 + 0) * 132 + nn] | ((unsigned)Lb[(k8 + 1) * 132 + nn] << 16); o.y = (unsigned)Lb[(k8 + 2) * 132 + nn] | ((unsigned)Lb[(k8 + 3) * 132 + nn] << 16);
            o.z = (unsigned)Lb[(k8 + 4) * 132 + nn] | ((unsigned)Lb[(k8 + 5) * 132 + nn] << 16); o.w = (unsigned)Lb[(k8 + 6) * 132 + nn] | ((unsigned)Lb[(k8 + 7) * 132 + nn] << 16);
            *(u32x4*)(dp + k8) = o; }
        __syncthreads();
    }
}
__device__ __forceinline__ void phase_prologue_a(const Params& p, unsigned char* sm) {
    const int cb = blockIdx.x, G = gridDim.x;
    for (int item = cb; item < 194; item += G) {
        if (item < 192) ada_item(p, item, sm);
        else if (item == 192) rope_item(p);
        else s5disc_item(p);
        __syncthreads();
    }
    tr_loop(p, (cb + 62) % G, G, p.nt0, 0, p.nj0, sm);
    if (DUPB(10)) { __syncthreads(); tr_loop(p, (cb + 62) % G, G, p.nt0, 0, p.nj0, sm); }
    if (DUPB(11)) { __syncthreads(); for (int item = cb; item < 192; item += G) { ada_item(p, item, sm); __syncthreads(); } }
}
__device__ __forceinline__ void phase_prologue_b(const Params& p) {
    unsigned char* const ws = ows(p.ws);
    const int tid_ = otid(); const int lane = tid_ & 63, w = tid_ >> 6;
    _Float16* X = (_Float16*)(ws + OFF_X); bf16_t* H = (bf16_t*)(ws + OFF_H); const float* mod = (const float*)(ws + OFF_MOD);
    f32x4 shr[4], scr[4]; int cur_mi = -1;
#pragma unroll
    for (int i = 0; i < 4; ++i) { shr[i] = (f32x4){0.f, 0.f, 0.f, 0.f}; scr[i] = shr[i]; }
    const int nwv = gridDim.x * 8, rpw = (TT + nwv - 1) / nwv, row_lo = (blockIdx.x * 8 + w) * rpw, row_hi = row_lo + rpw < TT ? row_lo + rpw : TT;
    for (int row = row_lo; row < row_hi; ++row) {
        const int b = row / SB, s = row - b * SB; const int mi = s < 256 ? 8 : b;
        const float* src = s < 256 ? p.in[2] + ((size_t)b * 256 + s) * 1024 : p.in[0] + ((size_t)b * 2048 + (s - 256)) * 1024;
        if (mi != cur_mi) { cur_mi = mi; const float* mp = mod + (size_t)mi * 6144;
#pragma unroll
            for (int i = 0; i < 4; ++i) { shr[i] = *(const f32x4*)(mp + 4 * lane + 256 * i); scr[i] = *(const f32x4*)(mp + 1024 + 4 * lane + 256 * i); } }
#pragma unroll
        for (int i = 0; i < 4; ++i) { const int c = 4 * lane + 256 * i; const f32x4 v = *(const f32x4*)(src + c);
            *(u32x2*)(X + (size_t)row * 1024 + c) = f2h4(v * ALPHA);
            const f32x4 sh = shr[i], sc = scr[i];
            u32x2 o; o.x = pk2(v[0] * (1.f + sc[0]) + sh[0], v[1] * (1.f + sc[1]) + sh[1]); o.y = pk2(v[2] * (1.f + sc[2]) + sh[2], v[3] * (1.f + sc[3]) + sh[3]);
            *(u32x2*)(H + (size_t)row * 1024 + c) = o; }
    }
}

template <int MODE, bool ROUTE, bool DRY = false>
__device__ __forceinline__ void phase_ln(const Params& p, int layer, size_t part_off, int nsplit, unsigned char* sm) {
    unsigned char* const ws = ows(p.ws);
    const int tid_ = otid(); const int lane = tid_ & 63, w = tid_ >> 6;
    _Float16* X = (_Float16*)(ws + OFF_X); bf16_t* H = (bf16_t*)(ws + OFF_H); const float* mod = (const float*)(ws + OFF_MOD);
    const int which = MODE == 0 ? 0 : 1;
    const float* lg = p.in[6] + (size_t)(layer * 2 + which) * 1024; const float* lbp = p.in[7] + (size_t)(layer * 2 + which) * 1024;
    const bool last = (layer == 3);
    const int jo = layer >> 1;
    unsigned* route = (unsigned*)(ws + OFF_ROUTE);
    unsigned* cnt = (unsigned*)(ws + OFF_CNT) + jo * 512;
    int offs[8];
    int split_row = 0x7fffffff;
    if (MODE == 2) { int acc = 0;
#pragma unroll
        for (int e = 0; e < 8; ++e) { offs[e] = acc; acc += (((int)cnt[e * 64] + 255) >> 8) << 8; }
        const int npan = acc >> 8, G_ = gridDim.x; split_row = ((((npan * 4) / G_) * G_) >> 2) << 8; }
    f32x4 rwr[4][4][2];
    if (ROUTE) { const float* rwg = p.in[38] + (size_t)jo * 8192;
#pragma unroll
        for (int i = 0; i < 4; ++i)
#pragma unroll
            for (int q = 0; q < 4; ++q) { const float* rp = rwg + (size_t)(4 * lane + 256 * i + q) * 8; rwr[i][q][0] = *(const f32x4*)rp; rwr[i][q][1] = *(const f32x4*)(rp + 4); } }
    f32x4 g4r[4], b4r[4], shr[4], scr[4];
#pragma unroll
    for (int i = 0; i < 4; ++i) { g4r[i] = *(const f32x4*)(lg + 4 * lane + 256 * i); b4r[i] = *(const f32x4*)(lbp + 4 * lane + 256 * i); shr[i] = (f32x4){0.f, 0.f, 0.f, 0.f}; scr[i] = shr[i]; }
    int cur_mi = -1, cur_gi = -1; f32x4 gtr[4];
#pragma unroll
    for (int i = 0; i < 4; ++i) gtr[i] = (f32x4){0.f, 0.f, 0.f, 0.f};
    const int nwv = gridDim.x * 8, rpw = (TT + nwv - 1) / nwv, row_lo = (blockIdx.x * 8 + w) * rpw, row_hi = row_lo + rpw < TT ? row_lo + rpw : TT;
    for (int row = row_lo; row < row_hi; ++row) {
        const int b = row / SB, s = row - b * SB; const int mi = s < 256 ? 8 : b;
        if (last && s < 256 && (MODE != 0 || ROUTE)) {
            if (ROUTE && lane == 0 && !DRY) route[(size_t)row * 8] = 0xffffffffu;
            continue;
        }
        f32x4 v[4];
        _Float16* xr = X + (size_t)row * 1024;
        _Float16* xw = DRY ? (_Float16*)(ws + OFF_S5F) + (size_t)row * 1024 : xr; bf16_t* hw = DRY ? (bf16_t*)(ws + OFF_S5B) + (size_t)row * 1024 : H + (size_t)row * 1024;
#pragma unroll
        for (int i = 0; i < 4; ++i) v[i] = h2f4(*(const u32x2*)(xr + 4 * lane + 256 * i));
        if (MODE != 2) {
            const bf16_t* d0 = (const bf16_t*)(ws + part_off) + (size_t)row * 1024 + 4 * lane;
            const bool two = (s < 256 && nsplit > 0);
#pragma unroll
            for (int i = 0; i < 4; ++i) { v[i] += unpk4v(*(const u32x2*)(d0 + 256 * i)); if (two) v[i] += unpk4v(*(const u32x2*)(d0 + (size_t)TT * 1024 + 256 * i)); }
        }
        if (MODE == 2) {
            const unsigned* rt = route + (size_t)row * 8;
            const int e1 = (int)rt[0], e2 = (int)rt[1]; const int r1 = (int)rt[2], r2 = (int)rt[3]; const float p1 = __uint_as_float(rt[4]), p2 = __uint_as_float(rt[5]);
            int o1 = 0, o2 = 0;
#pragma unroll
            for (int e = 0; e < 8; ++e) { o1 = (e == e1) ? offs[e] : o1; o2 = (e == e2) ? offs[e] : o2; }
            const bf16_t* F = (const bf16_t*)(ws + OFF_AR + AM_A);
            const bf16_t* f1 = F + (size_t)(o1 + r1) * 1024; const bf16_t* f2 = F + (size_t)(o2 + r2) * 1024;
            const bf16_t* F2 = (const bf16_t*)(ws + OFF_GE);
            const bool s1 = (o1 + r1) >= split_row, s2 = (o2 + r2) >= split_row;
            if (mi != cur_gi) { cur_gi = mi; const float* gt = mod + (size_t)(layer * 9 + mi) * 6144 + 5120;
#pragma unroll
                for (int i = 0; i < 4; ++i) gtr[i] = *(const f32x4*)(gt + 4 * lane + 256 * i); }
#pragma unroll
            for (int i = 0; i < 4; ++i) { const int c = 4 * lane + 256 * i; float a[4], bb[4]; unpk4(*(const u32x2*)(f1 + c), a); unpk4(*(const u32x2*)(f2 + c), bb);
                if (s1) { float t_[4]; unpk4(*(const u32x2*)(F2 + (size_t)(o1 + r1) * 1024 + c), t_); a[0] += t_[0]; a[1] += t_[1]; a[2] += t_[2]; a[3] += t_[3]; }
                if (s2) { float t_[4]; unpk4(*(const u32x2*)(F2 + (size_t)(o2 + r2) * 1024 + c), t_); bb[0] += t_[0]; bb[1] += t_[1]; bb[2] += t_[2]; bb[3] += t_[3]; }
                const f32x4 g4 = gtr[i];
#pragma unroll
                for (int q = 0; q < 4; ++q) v[i][q] = v[i][q] + g4[q] * (p1 * a[q] + p2 * bb[q]); }
        }
        float sm_ = 0.f;
#pragma unroll
        for (int i = 0; i < 4; ++i) sm_ += (v[i][0] + v[i][1]) + (v[i][2] + v[i][3]);
        const float mean = sum64(sm_) * (1.0f / 1024.0f);
        float sq = 0.f;
#pragma unroll
        for (int i = 0; i < 4; ++i) { const f32x4 d = v[i] - mean; sq += (d[0] * d[0] + d[1] * d[1]) + (d[2] * d[2] + d[3] * d[3]); }
        const float rstd = rsqrtf(sum64(sq) * (1.0f / 1024.0f) + 1e-5f);
        if (mi != cur_mi) { cur_mi = mi;
            const float* mp = (MODE == 0) ? mod + (size_t)(layer * 9 + mi) * 6144 + 3072 : mod + (size_t)((last ? 0 : layer + 1) * 9 + mi) * 6144;
#pragma unroll
            for (int i = 0; i < 4; ++i) { shr[i] = *(const f32x4*)(mp + 4 * lane + 256 * i); scr[i] = *(const f32x4*)(mp + 1024 + 4 * lane + 256 * i); } }
        float lg8[8];
#pragma unroll
        for (int e = 0; e < 8; ++e) lg8[e] = 0.f;
#pragma unroll
        for (int i = 0; i < 4; ++i) { const int c = 4 * lane + 256 * i;
            const f32x4 y = (v[i] - mean) * rstd * g4r[i] + b4r[i];
            if (MODE != 0 && last) { if (!DRY) *(f32x4*)(p.out + ((size_t)b * 2048 + (s - 256)) * 1024 + c) = y; else *(u32x2*)(xw + c) = f2h4(y); }
            else {
                *(u32x2*)(xw + c) = f2h4(y * ALPHA);
                const f32x4 h = y * (1.0f + scr[i]) + shr[i];
                u32x2 o; o.x = pk2(h[0], h[1]); o.y = pk2(h[2], h[3]);
                *(u32x2*)(hw + c) = o;
                if (ROUTE) {
#pragma unroll
                    for (int e = 0; e < 8; ++e) lg8[e] += (h[0] * rwr[i][0][e >> 2][e & 3] + h[1] * rwr[i][1][e >> 2][e & 3]) + (h[2] * rwr[i][2][e >> 2][e & 3] + h[3] * rwr[i][3][e >> 2][e & 3]); }
            }
        }
        if (ROUTE) {
#pragma unroll
            for (int e = 0; e < 8; ++e) lg8[e] = sum64(lg8[e]) + p.in[39][jo * 8 + e];
            int e1 = 0; float v1 = lg8[0];
#pragma unroll
            for (int e = 1; e < 8; ++e) if (lg8[e] > v1) { v1 = lg8[e]; e1 = e; }
            int e2 = -1; float v2 = -3.0e38f;
#pragma unroll
            for (int e = 0; e < 8; ++e) if (e != e1 && lg8[e] > v2) { v2 = lg8[e]; e2 = e; }
            if (lane == 0 && !DRY) {
                const float p1 = 1.0f / (1.0f + __expf(v2 - v1)), p2 = 1.0f - p1;
                const unsigned r1 = atomicAdd(&cnt[e1 * 64], 1u), r2 = atomicAdd(&cnt[e2 * 64], 1u);
                unsigned* rt = route + (size_t)row * 8;
                rt[0] = (unsigned)e1; rt[1] = (unsigned)e2; rt[2] = r1; rt[3] = r2; rt[4] = __float_as_uint(p1); rt[5] = __float_as_uint(p2);
                unsigned* inv = (unsigned*)(ws + OFF_INV); inv[(size_t)e1 * TT + r1] = (unsigned)row; inv[(size_t)e2 * TT + r2] = (unsigned)row;
            }
        }
    }
}
__device__ __forceinline__ int scan_row(int dir, int n) { return dir == 0 ? n : (n < 256 ? 255 - n : 2559 - n); }
__device__ __forceinline__ void hgrn_chunk_unit(const Params& p, int j, int u, unsigned char* sm) {
    unsigned char* const ws = ows(p.ws);
    const int tid = otid(), lane = tid & 63, w = tid >> 6, l15 = lane & 15, kg = lane >> 4;
    const int chf = u & 1, dir = (u >> 1) & 1, h = (u >> 2) & 3, b = u >> 4;
    const int ct = 4 * chf + (w & 3);
    const bf16_t* P = (const bf16_t*)(ws + OFF_AR + AE_P);
    bf16_t* O = (bf16_t*)(ws + OFF_AR + (dir ? AE_OB : AE_OF));
    const size_t rb = (size_t)b * SB;
    const int pd = tid >> 2, tq = tid & 3;
    const int ppos = (pd & ~31) + 8 * ((pd & 15) >> 2) + 4 * ((pd >> 4) & 1) + (pd & 3);
    const int rstep = dir ? -1 : 1;
    constexpr int RAW0 = 2 * 21504, RAWSZ = 3 * 16 * 136 * 2;
    const int t4 = tid & 255, lt = t4 >> 4, lc = t4 & 15;
    u32x4 gq, gf, gv;
#define HG_LOAD(c) do { const size_t row = rb + scan_row(dir, (c) * 16 + lt); const bf16_t* pr = P + row * 3328 + h * 128 + 8 * lc; \
        gq = *(const u32x4*)pr; gf = *(const u32x4*)(pr + 512 + dir * 512); gv = *(const u32x4*)(pr + 1536); } while (0)
#define HG_RAWW(bi) do { bf16_t* rw = (bf16_t*)(sm + RAW0 + (bi) * RAWSZ) + lt * 136 + 8 * lc; \
        *(u32x4*)rw = gq; *(u32x4*)(rw + 16 * 136) = gf; *(u32x4*)(rw + 32 * 136) = gv; } while (0)
    unsigned short rq[4], rf[4], rv[4];
#define HG_RAWR(bi) do { const bf16_t* rr_ = (const bf16_t*)(sm + RAW0 + (bi) * RAWSZ) + (4 * tq) * 136 + pd; \
        _Pragma("unroll") for (int k = 0; k < 4; ++k) { rq[k] = rr_[k * 136]; rf[k] = rr_[(16 + k) * 136]; rv[k] = rr_[(32 + k) * 136]; } } while (0)
#define HG_PREP(bufi) do { \
        bf16_t* Qd = (bf16_t*)(sm + (bufi) * 21504); bf16_t* Kd = Qd + 16 * 136; bf16_t* KeT = Kd + 16 * 136; bf16_t* Vt = KeT + 128 * 24; float* dec = (float*)(Vt + 128 * 24); \
        float qv[4], kk[4], cl[4]; float run = 0.f; \
        _Pragma("unroll") for (int k = 0; k < 4; ++k) { const float lg = bf2f(rf[k]); \
            qv[k] = bf2f(rq[k]); kk[k] = 1.0f - __builtin_amdgcn_exp2f(lg); run += lg; cl[k] = run; } \
        float x1 = dppf<0x93>(run); x1 = (tq >= 1) ? x1 : 0.f;            \
        float s2 = run + x1; float x2 = dppf<0x4E>(s2); x2 = (tq >= 2) ? x2 : 0.f; \
        const float incl = s2 + x2; const float off = incl - run; \
        const float btot = dppf<0xFF>(incl);                                  \
        const float etot = __builtin_amdgcn_exp2f(btot); \
        float ke[4]; \
        _Pragma("unroll") for (int k = 0; k < 4; ++k) { const float bl = off + cl[k]; const float E = __builtin_amdgcn_exp2f(bl); const float iE = __builtin_amdgcn_rcpf(E); \
            const float qd = qv[k] * E, kd = kk[k] * iE; ke[k] = kd * etot; \
            Qd[(4 * tq + k) * 136 + ppos] = (bf16_t)(pk2(qd, 0.f) & 0xffff); Kd[(4 * tq + k) * 136 + ppos] = (bf16_t)(pk2(kd, 0.f) & 0xffff); } \
        { u32x2 w2; w2.x = pk2(ke[0], ke[1]); w2.y = pk2(ke[2], ke[3]); *(u32x2*)(KeT + pd * 24 + 4 * tq) = w2; \
          u32x2 v2; v2.x = (unsigned)rv[0] | ((unsigned)rv[1] << 16); v2.y = (unsigned)rv[2] | ((unsigned)rv[3] << 16); *(u32x2*)(Vt + pd * 24 + 4 * tq) = v2; } \
        if (tq == 0) dec[pd] = etot; } while (0)
    f32x4 S[8];
#pragma unroll
    for (int i = 0; i < 8; ++i) S[i] = (f32x4){0.f, 0.f, 0.f, 0.f};
    if (w >= 4) { HG_LOAD(0); HG_RAWW(0); HG_LOAD(1); }
    LDS_BARRIER();
    HG_RAWR(0); HG_PREP(0);
    if (w >= 4) { HG_RAWW(1); HG_LOAD(2); }
    LDS_BARRIER();
    for (int c = 0; c < 144; ++c) {
        if (c + 1 < 144) { HG_RAWR((c + 1) & 1); HG_PREP((c + 1) & 1); }
        if (w >= 4) { if (c + 2 < 144) { HG_RAWW(c & 1); } if (c + 3 < 144) { HG_LOAD(c + 3); } }
        if (w < 4) {
            const bf16_t* Qd = (const bf16_t*)(sm + (c & 1) * 21504); const bf16_t* Kd = Qd + 16 * 136; const bf16_t* KeT = Kd + 16 * 136; const bf16_t* Vt = KeT + 128 * 24; const float* dec = (const float*)(Vt + 128 * 24);
            f32x4 AT = {0.f, 0.f, 0.f, 0.f};
            bf16x8 qf[4];
#pragma unroll
            for (int ks = 0; ks < 4; ++ks) { const bf16x8 kf = *(const bf16x8*)(Kd + l15 * 136 + 32 * ks + 8 * kg); qf[ks] = *(const bf16x8*)(Qd + l15 * 136 + 32 * ks + 8 * kg);
                AT = __builtin_amdgcn_mfma_f32_16x16x32_bf16(kf, qf[ks], AT, 0, 0, 0); }
            u32x4 aw;
            aw.x = pk2((4 * kg + 0 <= l15) ? AT[0] : 0.f, (4 * kg + 1 <= l15) ? AT[1] : 0.f); aw.y = pk2((4 * kg + 2 <= l15) ? AT[2] : 0.f, (4 * kg + 3 <= l15) ? AT[3] : 0.f); aw.z = 0u; aw.w = 0u;
            const bf16x8 afrag = __builtin_bit_cast(bf16x8, aw);
            u32x4 vw; { const u32x2 v2 = *(const u32x2*)(Vt + (16 * ct + l15) * 24 + 4 * kg); vw.x = v2.x; vw.y = v2.y; vw.z = 0u; vw.w = 0u; }
            const bf16x8 vfrag = __builtin_bit_cast(bf16x8, vw);
            f32x4 Oa = {0.f, 0.f, 0.f, 0.f};
            Oa = __builtin_amdgcn_mfma_f32_16x16x32_bf16(afrag, vfrag, Oa, 0, 0, 0);
#pragma unroll
            for (int pi = 0; pi < 4; ++pi) {
                u32x4 sw; sw.x = pk2(S[2 * pi][0], S[2 * pi][1]); sw.y = pk2(S[2 * pi][2], S[2 * pi][3]); sw.z = pk2(S[2 * pi + 1][0], S[2 * pi + 1][1]); sw.w = pk2(S[2 * pi + 1][2], S[2 * pi + 1][3]);
                Oa = __builtin_amdgcn_mfma_f32_16x16x32_bf16(qf[pi], __builtin_bit_cast(bf16x8, sw), Oa, 0, 0, 0);
            }
            { bf16_t* op = O + (rb + scan_row(dir, c * 16 + 4 * kg)) * 512 + h * 128 + 16 * ct + l15;
#pragma unroll
              for (int i = 0; i < 4; ++i) op[(ptrdiff_t)(rstep * i) * 512] = (bf16_t)(pk2(Oa[i], 0.f) & 0xffff); }
#pragma unroll
            for (int dt = 0; dt < 8; ++dt) {
                const f32x4 dv = *(const f32x4*)(dec + 16 * dt + 4 * kg);
                u32x4 kw; { const u32x2 k2 = *(const u32x2*)(KeT + (16 * dt + l15) * 24 + 4 * kg); kw.x = k2.x; kw.y = k2.y; kw.z = 0u; kw.w = 0u; }
                S[dt] = __builtin_amdgcn_mfma_f32_16x16x32_bf16(__builtin_bit_cast(bf16x8, kw), vfrag, S[dt] * dv, 0, 0, 0);
            }
        }
        LDS_BARRIER();
    }
#undef HG_LOAD
#undef HG_RAWW
#undef HG_RAWR
#undef HG_PREP
}
__device__ __forceinline__ void hgrn_finish_rows(const Params& p, int j) {
    unsigned char* const ws = ows(p.ws);
    const int tid_ = otid(); const int lane = tid_ & 63, w = tid_ >> 6;
    const bf16_t* P = (const bf16_t*)(ws + OFF_AR + AE_P);
    const bf16_t* OF = (const bf16_t*)(ws + OFF_AR + AE_OF); const bf16_t* OB = (const bf16_t*)(ws + OFF_AR + AE_OB);
    bf16_t* Y = (bf16_t*)(ws + OFF_AR + AE_Y);
    const int c0 = lane * 8;
    const int nwv = gridDim.x * 8, rpw = (TT + nwv - 1) / nwv, row_lo = (blockIdx.x * 8 + w) * rpw, row_hi = (row_lo + rpw < TT) ? row_lo + rpw : TT;
    const f32x4 ng0 = *(const f32x4*)(p.in[11] + j * 512 + c0), ng1 = *(const f32x4*)(p.in[11] + j * 512 + c0 + 4);
    for (int row = row_lo; row < row_hi; ++row) {
        float o[8], g[8];
        { float fa[8], fb[8]; unpk8(*(const u32x4*)(OF + (size_t)row * 512 + c0), fa); unpk8(*(const u32x4*)(OB + (size_t)row * 512 + c0), fb);
#pragma unroll
          for (int i = 0; i < 8; ++i) o[i] = fa[i] + fb[i]; }
        unpk8(*(const u32x4*)(P + (size_t)row * 3328 + 2048 + c0), g);
        float ssq = 0.f;
#pragma unroll
        for (int i = 0; i < 8; ++i) ssq += o[i] * o[i];
        ssq = sum16(ssq);
        const float r = rsqrtf(ssq * (1.0f / 128.0f) + 1e-6f);
        float y[8];
#pragma unroll
        for (int i = 0; i < 4; ++i) { y[i] = o[i] * r * ng0[i] * g[i]; y[4 + i] = o[4 + i] * r * ng1[i] * g[4 + i]; }
        *(u32x4*)(Y + (size_t)row * 1024 + c0) = pk8(y);
    }
}

__device__ __forceinline__ void attn_unit(const Params& p, int j, int u, unsigned char* sm) {
    unsigned char* const ws = ows(p.ws);
    const int tid = otid(), lane = tid & 63, w = tid >> 6;
    const int b = u / 72, rem = u - b * 72, g = rem / 36, qb = rem - g * 36;
    const int r4 = w & 3, sub = w >> 2, hh = g * 4 + r4, l31 = lane & 31, hf = lane >> 5;
    bf16_t* Ks = (bf16_t*)sm; bf16_t* Vt = Ks + 64 * 72;
    const bf16_t* P = (const bf16_t*)(ws + OFF_AR + AE_P); bf16_t* Y = (bf16_t*)(ws + OFF_AR + AE_Y);
    const float* COS = (const float*)(ws + OFF_COS); const float* SIN = (const float*)(ws + OFF_SIN);
    const bool isl = qb < 32;
    const int q0 = isl ? qb * 64 : (qb - 32) * 64;
    const size_t rb = (size_t)b * SB;
    const int qpos = q0 + sub * 32 + l31;
    const size_t qrow = rb + (isl ? 256 : 0) + qpos;
    bf16x8 qf[4];
    {
        const bf16_t* qp = P + qrow * 3328 + 2560 + hh * 64;
        float x1a[8], x1b[8], x2a[8], x2b[8];
        unpk8(*(const u32x4*)(qp + 8 * hf), x1a); unpk8(*(const u32x4*)(qp + 16 + 8 * hf), x1b);
        unpk8(*(const u32x4*)(qp + 32 + 8 * hf), x2a); unpk8(*(const u32x4*)(qp + 48 + 8 * hf), x2b);
        const float sc = 0.125f * 1.4426950408889634f;
        float o0[8], o1[8], o2[8], o3[8];
        if (isl) {
            const float* cp = COS + qpos * 32 + 8 * hf; const float* sp = SIN + qpos * 32 + 8 * hf;
#pragma unroll
            for (int i = 0; i < 8; ++i) { const float ca = cp[i], sa = sp[i], cb = cp[16 + i], sb = sp[16 + i];
                o0[i] = (x1a[i] * ca - x2a[i] * sa) * sc; o2[i] = (x1a[i] * sa + x2a[i] * ca) * sc;
                o1[i] = (x1b[i] * cb - x2b[i] * sb) * sc; o3[i] = (x1b[i] * sb + x2b[i] * cb) * sc; }
        } else {
#pragma unroll
            for (int i = 0; i < 8; ++i) { o0[i] = x1a[i] * sc; o1[i] = x1b[i] * sc; o2[i] = x2a[i] * sc; o3[i] = x2b[i] * sc; }
        }
        qf[0] = __builtin_bit_cast(bf16x8, pk8(o0)); qf[1] = __builtin_bit_cast(bf16x8, pk8(o1)); qf[2] = __builtin_bit_cast(bf16x8, pk8(o2)); qf[3] = __builtin_bit_cast(bf16x8, pk8(o3));
    }
    float m = p.in[12][j * 8 + hh] * 1.4426950408889634f;
    float lsum = hf == 0 ? 1.0f : 0.0f;
    f32x16 O0, O1;
#pragma unroll
    for (int i = 0; i < 16; ++i) { O0[i] = 0.f; O1[i] = 0.f; }
    const int nch = isl ? 9 : 4;
    for (int ci = 0; ci < nch; ++ci) {
        const bool win = isl && ci < 5;
        int w0 = 0; size_t krow0;
        if (win) { w0 = q0 - 128 + 64 * ci; if (w0 < 0 || w0 >= 2048) continue; krow0 = rb + 256 + w0; }
        else { const int cc = isl ? ci - 5 : ci; krow0 = rb + cc * 64; }
        __syncthreads();
        if (tid < 256) {
            const int key = tid >> 2, dq = tid & 3;
            const bf16_t* src = P + (krow0 + key) * 3328 + 2560 + 512 + g * 64;
            u32x4 r1 = *(const u32x4*)(src + dq * 8), r2 = *(const u32x4*)(src + 32 + dq * 8);
            if (win) {
                float x1[8], x2[8], y1[8], y2[8]; unpk8(r1, x1); unpk8(r2, x2);
                const float* cp = COS + (w0 + key) * 32 + dq * 8; const float* sp = SIN + (w0 + key) * 32 + dq * 8;
#pragma unroll
                for (int i = 0; i < 8; ++i) { const float c_ = cp[i], s_ = sp[i]; y1[i] = x1[i] * c_ - x2[i] * s_; y2[i] = x1[i] * s_ + x2[i] * c_; }
                r1 = pk8(y1); r2 = pk8(y2);
            }
            *(u32x4*)(Ks + key * 72 + dq * 8) = r1; *(u32x4*)(Ks + key * 72 + 32 + dq * 8) = r2;
        } else {
            const int t2 = tid - 256, key = t2 >> 2, dq = t2 & 3;
            const bf16_t* src = P + (krow0 + key) * 3328 + 2560 + 640 + g * 64 + dq * 16;
            const u32x4 r1 = *(const u32x4*)src, r2 = *(const u32x4*)(src + 8);
            bf16_t* vp = Vt + (dq * 16) * 72 + key;
            vp[0 * 72] = (bf16_t)(r1.x & 0xffff); vp[1 * 72] = (bf16_t)(r1.x >> 16); vp[2 * 72] = (bf16_t)(r1.y & 0xffff); vp[3 * 72] = (bf16_t)(r1.y >> 16);
            vp[4 * 72] = (bf16_t)(r1.z & 0xffff); vp[5 * 72] = (bf16_t)(r1.z >> 16); vp[6 * 72] = (bf16_t)(r1.w & 0xffff); vp[7 * 72] = (bf16_t)(r1.w >> 16);
            vp[8 * 72] = (bf16_t)(r2.x & 0xffff); vp[9 * 72] = (bf16_t)(r2.x >> 16); vp[10 * 72] = (bf16_t)(r2.y & 0xffff); vp[11 * 72] = (bf16_t)(r2.y >> 16);
            vp[12 * 72] = (bf16_t)(r2.z & 0xffff); vp[13 * 72] = (bf16_t)(r2.z >> 16); vp[14 * 72] = (bf16_t)(r2.w & 0xffff); vp[15 * 72] = (bf16_t)(r2.w >> 16);
        }
        __syncthreads();
        f32x16 s0, s1;
#pragma unroll
        for (int i = 0; i < 16; ++i) { s0[i] = 0.f; s1[i] = 0.f; }
#pragma unroll
        for (int s = 0; s < 4; ++s) {
            const bf16x8 a0 = *(const bf16x8*)(Ks + l31 * 72 + 16 * s + 8 * hf), a1 = *(const bf16x8*)(Ks + (32 + l31) * 72 + 16 * s + 8 * hf);
            s0 = __builtin_amdgcn_mfma_f32_32x32x16_bf16(a0, qf[s], s0, 0, 0, 0);
            s1 = __builtin_amdgcn_mfma_f32_32x32x16_bf16(a1, qf[s], s1, 0, 0, 0);
        }
        if (win) {
#pragma unroll
            for (int i = 0; i < 16; ++i) { const int key = 8 * (i >> 2) + 4 * hf + (i & 3); const int d0 = qpos - (w0 + key), d1 = d0 - 32;
                if (d0 > 128 || d0 < -128) s0[i] = -INFINITY;
                if (d1 > 128 || d1 < -128) s1[i] = -INFINITY; }
        }
        float mt = s0[0];
#pragma unroll
        for (int i = 1; i < 16; ++i) mt = fmaxf(mt, s0[i]);
#pragma unroll
        for (int i = 0; i < 16; ++i) mt = fmaxf(mt, s1[i]);
        mt = fmaxf(mt, __shfl_xor(mt, 32));
        const float mnew = fmaxf(m, mt), alpha = __builtin_amdgcn_exp2f(m - mnew);
        m = mnew;
        float rs = 0.f;
#pragma unroll
        for (int i = 0; i < 16; ++i) { s0[i] = __builtin_amdgcn_exp2f(s0[i] - mnew); s1[i] = __builtin_amdgcn_exp2f(s1[i] - mnew); rs += s0[i] + s1[i]; }
        lsum = lsum * alpha + rs;
#pragma unroll
        for (int i = 0; i < 16; ++i) { O0[i] *= alpha; O1[i] *= alpha; }
#pragma unroll
        for (int kt = 0; kt < 2; ++kt)
#pragma unroll
            for (int s2 = 0; s2 < 2; ++s2) {
                u32x4 pw;
                if (kt == 0) { pw.x = pk2(s0[8 * s2], s0[8 * s2 + 1]); pw.y = pk2(s0[8 * s2 + 2], s0[8 * s2 + 3]); pw.z = pk2(s0[8 * s2 + 4], s0[8 * s2 + 5]); pw.w = pk2(s0[8 * s2 + 6], s0[8 * s2 + 7]); }
                else { pw.x = pk2(s1[8 * s2], s1[8 * s2 + 1]); pw.y = pk2(s1[8 * s2 + 2], s1[8 * s2 + 3]); pw.z = pk2(s1[8 * s2 + 4], s1[8 * s2 + 5]); pw.w = pk2(s1[8 * s2 + 6], s1[8 * s2 + 7]); }
                const bf16x8 pf = __builtin_bit_cast(bf16x8, pw);
#pragma unroll
                for (int mt2 = 0; mt2 < 2; ++mt2) {
                    const bf16_t* vp = Vt + (mt2 * 32 + l31) * 72 + kt * 32 + 16 * s2 + 4 * hf;
                    const u32x2 lo = *(const u32x2*)vp, hi = *(const u32x2*)(vp + 8);
                    u32x4 vv; vv.x = lo.x; vv.y = lo.y; vv.z = hi.x; vv.w = hi.y;
                    const bf16x8 vf = __builtin_bit_cast(bf16x8, vv);
                    if (mt2 == 0) O0 = __builtin_amdgcn_mfma_f32_32x32x16_bf16(vf, pf, O0, 0, 0, 0);
                    else O1 = __builtin_amdgcn_mfma_f32_32x32x16_bf16(vf, pf, O1, 0, 0, 0);
                }
            }
    }
    const float ltot = lsum + __shfl_xor(lsum, 32);
    const float inv = 1.0f / ltot;
    bf16_t* yp = Y + qrow * 1024 + 512 + hh * 64;
#pragma unroll
    for (int ib = 0; ib < 4; ++ib) {
        u32x2 o; o.x = pk2(O0[4 * ib] * inv, O0[4 * ib + 1] * inv); o.y = pk2(O0[4 * ib + 2] * inv, O0[4 * ib + 3] * inv);
        *(u32x2*)(yp + 8 * ib + 4 * hf) = o;
        u32x2 o2; o2.x = pk2(O1[4 * ib] * inv, O1[4 * ib + 1] * inv); o2.y = pk2(O1[4 * ib + 2] * inv, O1[4 * ib + 3] * inv);
        *(u32x2*)(yp + 32 + 8 * ib + 4 * hf) = o2;
    }
    __syncthreads();
}

__device__ __forceinline__ float partner32(float x) {
    const unsigned xb = __builtin_bit_cast(unsigned, x);
    auto r = __builtin_amdgcn_permlane32_swap(xb, xb, false, false);
    const unsigned pb = (r[0] == xb) ? r[1] : r[0];
    return __builtin_bit_cast(float, pb);
}
__device__ __forceinline__ void s5_scan_task(const Params& p, int jo, int task, unsigned char* smw) {
    unsigned char* const ws = ows(p.ws);
    const int lane = otid() & 63, l31 = lane & 31, hf = lane >> 5, l15 = lane & 15, kg = lane >> 4;
    const int dir = task & 1, g = (task >> 1) & 31, b = task >> 6;
    bf16_t* Xs = (bf16_t*)smw;
    const bf16_t* P = (const bf16_t*)(ws + OFF_AR + AO_YG);
    bf16_t* Yd = (bf16_t*)(ws + (dir ? OFF_S5B : OFF_S5F));
    const size_t rb = (size_t)b * SB;
    const int idx0 = ((jo * 2 + dir) * 32 + g) * 64 + l31, idx1 = idx0 + 32;
    const float* AB = (const float*)(ws + OFF_AB);
    const float ar0 = AB[idx0 * 2], ai0 = AB[idx0 * 2 + 1], ar1 = AB[idx1 * 2], ai1 = AB[idx1 * 2 + 1];
    bf16x8 bbf[4];
    { const float* BR = (const float*)(ws + OFF_BBR); const float* BI = (const float*)(ws + OFF_BBI);
      float t8[8];
#pragma unroll
      for (int j = 0; j < 8; ++j) t8[j] = BR[(size_t)idx0 * 16 + 8 * hf + j];
      bbf[0] = __builtin_bit_cast(bf16x8, pk8(t8));
#pragma unroll
      for (int j = 0; j < 8; ++j) t8[j] = BR[(size_t)idx1 * 16 + 8 * hf + j];
      bbf[1] = __builtin_bit_cast(bf16x8, pk8(t8));
#pragma unroll
      for (int j = 0; j < 8; ++j) t8[j] = BI[(size_t)idx0 * 16 + 8 * hf + j];
      bbf[2] = __builtin_bit_cast(bf16x8, pk8(t8));
#pragma unroll
      for (int j = 0; j < 8; ++j) t8[j] = BI[(size_t)idx1 * 16 + 8 * hf + j];
      bbf[3] = __builtin_bit_cast(bf16x8, pk8(t8)); }
    bf16x8 cmf[4], dskf;
    { const float* c1 = p.in[23] + (size_t)((jo * 32 + g) * 16 + l15) * 64; const float* c2 = p.in[24] + (size_t)((jo * 32 + g) * 16 + l15) * 64;
#pragma unroll
      for (int ks = 0; ks < 4; ++ks) { float t8[8];
#pragma unroll
          for (int j = 0; j < 8; ++j) { const int n = 8 * ks + 2 * kg + (j >> 2), q = j & 3; const int pp = n + 32 * (q & 1); t8[j] = (q < 2) ? c1[pp] : -c2[pp]; }
          cmf[ks] = __builtin_bit_cast(bf16x8, pk8(t8)); }
      float t8[8]; const float dv = p.in[25][jo * 512 + g * 16 + l15];
#pragma unroll
      for (int j = 0; j < 8; ++j) t8[j] = (kg < 2 && 8 * kg + j == l15) ? dv : 0.f;
      dskf = __builtin_bit_cast(bf16x8, pk8(t8)); }
    float xr0 = 0.f, xi0 = 0.f, xr1 = 0.f, xi1 = 0.f;
    u32x4 ua = *(const u32x4*)(P + (rb + scan_row(dir, l31)) * 512 + g * 16 + 8 * hf);
    for (int c = 0; c < 72; ++c) {
        f32x16 D0, D1, D2, D3;
#pragma unroll
        for (int i = 0; i < 16; ++i) { D0[i] = 0.f; D1[i] = 0.f; D2[i] = 0.f; D3[i] = 0.f; }
        { const bf16x8 uf = __builtin_bit_cast(bf16x8, ua);
          D0 = __builtin_amdgcn_mfma_f32_32x32x16_bf16(uf, bbf[0], D0, 0, 0, 0); D1 = __builtin_amdgcn_mfma_f32_32x32x16_bf16(uf, bbf[1], D1, 0, 0, 0);
          D2 = __builtin_amdgcn_mfma_f32_32x32x16_bf16(uf, bbf[2], D2, 0, 0, 0); D3 = __builtin_amdgcn_mfma_f32_32x32x16_bf16(uf, bbf[3], D3, 0, 0, 0); }
        if (c + 1 < 72) ua = *(const u32x4*)(P + (rb + scan_row(dir, (c + 1) * 32 + l31)) * 512 + g * 16 + 8 * hf);
#pragma unroll
        for (int m = 0; m < 4; ++m) {
            float A_[4][4], B_[4][4];
#pragma unroll
            for (int k = 0; k < 4; ++k) { const int i = 4 * m + k;
                const float n0r = ar0 * xr0 - ai0 * xi0 + D0[i], n0i = ar0 * xi0 + ai0 * xr0 + D2[i];
                const float n1r = ar1 * xr1 - ai1 * xi1 + D1[i], n1i = ar1 * xi1 + ai1 * xr1 + D3[i];
                xr0 = n0r; xi0 = n0i; xr1 = n1r; xi1 = n1i; A_[k][0] = xr0; A_[k][1] = xr1; A_[k][2] = xi0; A_[k][3] = xi1; }
            { const float q0 = partner32(xr0), q1 = partner32(xi0), q2 = partner32(xr1), q3 = partner32(xi1);
              xr0 = hf ? q0 : xr0; xi0 = hf ? q1 : xi0; xr1 = hf ? q2 : xr1; xi1 = hf ? q3 : xi1; }
#pragma unroll
            for (int k = 0; k < 4; ++k) { const int i = 4 * m + k;
                const float n0r = ar0 * xr0 - ai0 * xi0 + D0[i], n0i = ar0 * xi0 + ai0 * xr0 + D2[i];
                const float n1r = ar1 * xr1 - ai1 * xi1 + D1[i], n1i = ar1 * xi1 + ai1 * xr1 + D3[i];
                xr0 = n0r; xi0 = n0i; xr1 = n1r; xi1 = n1i; B_[k][0] = xr0; B_[k][1] = xr1; B_[k][2] = xi0; B_[k][3] = xi1; }
            { const float q0 = partner32(xr0), q1 = partner32(xi0), q2 = partner32(xr1), q3 = partner32(xi1);
              xr0 = hf ? xr0 : q0; xi0 = hf ? xi0 : q1; xr1 = hf ? xr1 : q2; xi1 = hf ? xi1 : q3; }
#pragma unroll
            for (int k = 0; k < 4; ++k) { const int t = 8 * m + 4 * hf + k;
                u32x2 w2; w2.x = pk2(hf ? B_[k][0] : A_[k][0], hf ? B_[k][1] : A_[k][1]); w2.y = pk2(hf ? B_[k][2] : A_[k][2], hf ? B_[k][3] : A_[k][3]);
                *(u32x2*)(Xs + t * 136 + 4 * l31) = w2; }
        }
        asm volatile("s_waitcnt lgkmcnt(0)" ::: "memory"); __builtin_amdgcn_wave_barrier();
#pragma unroll
        for (int tt = 0; tt < 2; ++tt) {
            f32x4 acc = {0.f, 0.f, 0.f, 0.f};
#pragma unroll
            for (int ks = 0; ks < 4; ++ks) { const bf16x8 a = *(const bf16x8*)(Xs + (16 * tt + l15) * 136 + 32 * ks + 8 * kg);
                acc = __builtin_amdgcn_mfma_f32_16x16x32_bf16(a, cmf[ks], acc, 0, 0, 0); }
#pragma unroll
            for (int i = 0; i < 4; ++i) { const size_t row = rb + scan_row(dir, c * 32 + 16 * tt + 4 * kg + i); Yd[row * 512 + g * 16 + l15] = (bf16_t)(pk2(acc[i], 0.f) & 0xffff); }
        }
        asm volatile("s_waitcnt lgkmcnt(0)" ::: "memory"); __builtin_amdgcn_wave_barrier();
    }
}
__device__ __forceinline__ void rwkv_prep_rows(const Params& p, int jo) {
    unsigned char* const ws = ows(p.ws);
    const int tid_ = otid(); const int lane = tid_ & 63, w = tid_ >> 6;
    const bf16_t* P = (const bf16_t*)(ws + OFF_AR + AO_P);
    bf16_t* PR = (bf16_t*)(ws + OFF_AR + AO_PR); bf16_t* Lb = (bf16_t*)(ws + OFF_AR + AO_L);
    bf16_t* YGu = (bf16_t*)(ws + OFF_AR + AO_YG);
    float* KN = (float*)(ws + OFF_KN);
    const int nwv = gridDim.x * 8, rpw = (TT + nwv - 1) / nwv, row_lo = (blockIdx.x * 8 + w) * rpw, row_hi = (row_lo + rpw < TT) ? row_lo + rpw : TT;
    if (row_lo >= row_hi) return;
    const bool l3 = lane < 48;
    f32x4 mu4[4][2];
#pragma unroll
    for (int it = 0; it < 4; ++it) { const int c0 = (lane + 64 * it) * 8;
        if (it < 3 || l3) { mu4[it][0] = *(const f32x4*)(p.in[27] + jo * 1920 + c0); mu4[it][1] = *(const f32x4*)(p.in[27] + jo * 1920 + c0 + 4); }
        else { mu4[it][0] = f32x4{0.f, 0.f, 0.f, 0.f}; mu4[it][1] = mu4[it][0]; } }
    const f32x4 kk0 = *(const f32x4*)(p.in[33] + jo * 512 + lane * 8), kk1 = *(const f32x4*)(p.in[33] + jo * 512 + lane * 8 + 4);
    u32x4 pa[4], px[4], pn[4];
    { const int rp = row_lo > 0 ? row_lo - 1 : 0;
#pragma unroll
      for (int it = 0; it < 4; ++it) { const int c0 = (lane + 64 * it) * 8;
        if (it < 3 || l3) { pa[it] = *(const u32x4*)(P + (size_t)rp * 2560 + 512 + c0); px[it] = *(const u32x4*)(P + (size_t)row_lo * 2560 + 512 + c0); }
        else { pa[it] = u32x4{0u, 0u, 0u, 0u}; px[it] = pa[it]; } } }
    for (int row = row_lo; row < row_hi; ++row) {
        const int s = row % SB;
        const float hp = (s != 0 && s != 256) ? 0.5f : 0.f, hn = (s != 255 && s != 2303) ? 0.5f : 0.f;
        const int rn = row + 1 < TT ? row + 1 : TT - 1;
#pragma unroll
        for (int it = 0; it < 4; ++it) { const int c0 = (lane + 64 * it) * 8;
            if (it < 3 || l3) pn[it] = *(const u32x4*)(P + (size_t)rn * 2560 + 512 + c0); else pn[it] = u32x4{0u, 0u, 0u, 0u}; }
        *(u32x4*)(YGu + (size_t)row * 512 + lane * 8) = *(const u32x4*)(P + (size_t)row * 2560 + lane * 8);
#pragma unroll
        for (int it = 0; it < 4; ++it) {
            const int c0 = (lane + 64 * it) * 8;
            float x[8], a[8], bq[8], o[8];
            unpk8(px[it], x); unpk8(pa[it], a); unpk8(pn[it], bq);
#pragma unroll
            for (int i = 0; i < 8; ++i) { const float m = (i < 4) ? mu4[it][0][i & 3] : mu4[it][1][i & 3];
                o[i] = x[i] + m * (hp * a[i] + hn * bq[i] - x[i]); }
            if (it == 3) {
                if (lane < 16) {
#pragma unroll
                    for (int i = 0; i < 8; ++i) o[i] = tanh_f(o[i]); }
                else if (lane >= 32) {
#pragma unroll
                    for (int i = 0; i < 8; ++i) o[i] = sigm(o[i]); } }
            if (it == 1) { float ssq = 0.f;
#pragma unroll
                for (int i = 0; i < 8; ++i) { const float t_ = o[i] * ((i < 4) ? kk0[i & 3] : kk1[i & 3]); ssq += t_ * t_; }
                ssq = sum8(ssq);
                if ((lane & 7) == 0) KN[(size_t)row * 8 + (lane >> 3)] = 1.0f / fmaxf(sqrtf(ssq), 1e-12f); }
            if (it < 3) *(u32x4*)(PR + (size_t)row * 1536 + c0) = pk8(o);
            else if (l3) *(u32x4*)(Lb + (size_t)row * 384 + (c0 - 1536)) = pk8(o);
        }
#pragma unroll
        for (int it = 0; it < 4; ++it) { pa[it] = px[it]; px[it] = pn[it]; }
    }
}
__device__ __forceinline__ void rwkv_stage_loop(const Params& p, int jo, int first, int stride, int nitems, unsigned char* sm) {
    unsigned char* const ws = ows(p.ws);
    const int tid = otid();
    if (first >= nitems) return;
    const bf16_t* PR = (const bf16_t*)(ws + OFF_AR + AO_PR); const bf16_t* LO = (const bf16_t*)(ws + OFF_AR + AO_P);
    const float* KN = (const float*)(ws + OFF_KN);
    float* L_lw = (float*)sm; float* L_av = L_lw + 64 * 68; float* L_bv = L_av + 64 * 68; float* L_kd = L_bv + 64 * 68; float* L_rr = L_kd + 64 * 68;
    const int t64 = tid >> 3, c8 = (tid & 7) * 8;
    u32x4 gr, gk, gw, ga; float inn;
#define RS_LOAD(IT_) do { const int u_ = (IT_) / 36, R_ = (IT_) - u_ * 36, dir_ = u_ & 1, hd_ = (u_ >> 1) & 7, b_ = u_ >> 4; \
        const size_t row = (size_t)b_ * SB + scan_row(dir_, 64 * R_ + t64); const int ch_ = hd_ * 64 + c8; \
        gr = *(const u32x4*)(PR + row * 1536 + ch_); gk = *(const u32x4*)(PR + row * 1536 + 512 + ch_); \
        gw = *(const u32x4*)(LO + row * 2560 + dir_ * 512 + ch_); ga = *(const u32x4*)(LO + row * 2560 + 1024 + dir_ * 512 + ch_); inn = KN[row * 8 + hd_]; } while (0)
    f32x4 w0r[2], a0r[2], kkr[2], kar[2]; int cur_u = -1;
#pragma unroll
    for (int i = 0; i < 2; ++i) { w0r[i] = (f32x4){0.f, 0.f, 0.f, 0.f}; a0r[i] = w0r[i]; kkr[i] = w0r[i]; kar[i] = w0r[i]; }
    RS_LOAD(first);
    for (int item = first; item < nitems; item += stride) {
    const int u = item / 36, R = item - u * 36;
    const int dir = u & 1, hd = (u >> 1) & 7;
    {
        const int ch = hd * 64 + c8;
        float r8[8], k8[8], wl8[8], al8[8];
        unpk8(gr, r8); unpk8(gk, k8); unpk8(gw, wl8); unpk8(ga, al8);
        if (u != cur_u) { cur_u = u;
            const float* w0p = p.in[28] + (jo * 2 + dir) * 512 + ch; const float* a0p = p.in[30] + (jo * 2 + dir) * 512 + ch;
            const float* kkp = p.in[33] + jo * 512 + ch; const float* kap = p.in[34] + jo * 512 + ch;
#pragma unroll
            for (int i = 0; i < 2; ++i) { w0r[i] = *(const f32x4*)(w0p + 4 * i); a0r[i] = *(const f32x4*)(a0p + 4 * i); kkr[i] = *(const f32x4*)(kkp + 4 * i); kar[i] = *(const f32x4*)(kap + 4 * i); } }
        float lw[8], av[8], bv[8], kd[8];
#pragma unroll
        for (int i = 0; i < 8; ++i) {
            const float w0v = w0r[i >> 2][i & 3], a0v = a0r[i >> 2][i & 3], kkv = kkr[i >> 2][i & 3], kav = kar[i >> 2][i & 3];
            const float z = -(w0v + wl8[i]);
            const float sp = fmaxf(z, 0.f) + 0.6931471805599453f * __builtin_amdgcn_logf(1.0f + __builtin_amdgcn_exp2f(-1.4426950408889634f * fabsf(z)));
            lw[i] = -__builtin_amdgcn_exp2f(-1.4426950408889634f * (sp + 0.5f)) * 1.4426950408889634f;
            const float a = sigm(a0v + al8[i]);
            const float kn = k8[i] * kkv * inn;
            kd[i] = k8[i] * (1.0f + (a - 1.0f) * kav); av[i] = -kn; bv[i] = kn * a;
        }
        const int o = t64 * 68 + c8;
        *(f32x4*)(L_lw + o) = (f32x4){lw[0], lw[1], lw[2], lw[3]}; *(f32x4*)(L_lw + o + 4) = (f32x4){lw[4], lw[5], lw[6], lw[7]};
        *(f32x4*)(L_av + o) = (f32x4){av[0], av[1], av[2], av[3]}; *(f32x4*)(L_av + o + 4) = (f32x4){av[4], av[5], av[6], av[7]};
        *(f32x4*)(L_bv + o) = (f32x4){bv[0], bv[1], bv[2], bv[3]}; *(f32x4*)(L_bv + o + 4) = (f32x4){bv[4], bv[5], bv[6], bv[7]};
        *(f32x4*)(L_kd + o) = (f32x4){kd[0], kd[1], kd[2], kd[3]}; *(f32x4*)(L_kd + o + 4) = (f32x4){kd[4], kd[5], kd[6], kd[7]};
        *(f32x4*)(L_rr + o) = (f32x4){r8[0], r8[1], r8[2], r8[3]}; *(f32x4*)(L_rr + o + 4) = (f32x4){r8[4], r8[5], r8[6], r8[7]};
    }
    LDS_BARRIER();
    if (item + stride < nitems) { RS_LOAD(item + stride); }
    {
        const int sq = tid >> 7, tl = tid & 127, sj = tl >> 1, th = tl & 1;
        float cw[8], lwk[8]; float run = 0.f;
#pragma unroll
        for (int k = 0; k < 8; ++k) { lwk[k] = L_lw[(sq * 16 + 8 * th + k) * 68 + sj]; run += lwk[k]; cw[k] = run; }
        const float ptot = dppf<0xB1>(run);
        const float off = th ? ptot : 0.f, cw15 = run + ptot;
        u32x2* GE = (u32x2*)(ws + OFF_GE) + ((size_t)(u * 144 + 4 * R + sq) * 64 + sj) * 16 + 8 * th;
#pragma unroll
        for (int k = 0; k < 8; ++k) {
            const int o = (sq * 16 + 8 * th + k) * 68 + sj;
            const float c = off + cw[k];
            const float Ec = __builtin_amdgcn_exp2f(c), Ep = __builtin_amdgcn_exp2f(c - lwk[k]), iE = __builtin_amdgcn_rcpf(Ec);
            u32x2 ov; ov.x = pk2(L_av[o] * Ep, L_rr[o] * Ec); ov.y = pk2(L_bv[o] * iE, L_kd[o] * iE);
            GE[k] = ov;
        }
        ((float*)(ws + OFF_GW))[(size_t)(u * 144 + 4 * R + sq) * 64 + sj] = __builtin_amdgcn_exp2f(cw15);
    }
    LDS_BARRIER();
    }
#undef RS_LOAD
}
__device__ __forceinline__ bf16x8 frag_lo(const f32x4 v) { u32x4 w; w.x = pk2(v[0], v[1]); w.y = pk2(v[2], v[3]); w.z = 0u; w.w = 0u; return __builtin_bit_cast(bf16x8, w); }
__device__ __forceinline__ bf16x8 frag_b64(const bf16_t* pz) { const u32x2 v = *(const u32x2*)pz; u32x4 w; w.x = v.x; w.y = v.y; w.z = 0u; w.w = 0u; return __builtin_bit_cast(bf16x8, w); }
__device__ __forceinline__ u32x2 pk4v(const f32x4 v) { u32x2 r; r.x = pk2(v[0], v[1]); r.y = pk2(v[2], v[3]); return r; }
#define MF16(a, b, c) __builtin_amdgcn_mfma_f32_16x16x32_bf16((a), (b), (c), 0, 0, 0)
constexpr int RW_SCR = 19712, RW_SLOT = 5120, RW_SLOT0 = 4 * RW_SCR;
__device__ __forceinline__ void rwkv_chunk_unit(const Params& p, int jo, int u, unsigned char* sm) {
    unsigned char* const ws = ows(p.ws);
    const int tid = otid(), lane = tid & 63, w = tid >> 6, l15 = lane & 15, kg = lane >> 4;
    const int dir = u & 1, hd = (u >> 1) & 7, b = u >> 4;
    const bf16_t* PR = (const bf16_t*)(ws + OFF_AR + AO_PR); const bf16_t* LO = (const bf16_t*)(ws + OFF_AR + AO_P);
    const float* KN = (const float*)(ws + OFF_KN);
    bf16_t* O = (bf16_t*)(ws + OFF_AR + (dir ? AO_OB : AO_OF));
    const size_t rb = (size_t)b * SB;
    const int sq = tid >> 7, tl = tid & 127, sj = tl >> 1, th = tl & 1, ch = hd * 64 + sj;
    const u32x4* GEb = (const u32x4*)(ws + OFF_GE); const float* GWb = (const float*)(ws + OFF_GW);
    f32x4 S[4];
#pragma unroll
    for (int i = 0; i < 4; ++i) S[i] = (f32x4){0.f, 0.f, 0.f, 0.f};
    u32x4 ge[4], ge2[4]; float e15, e152; unsigned vv[8], vv2[8];
#define RW_LOADX(R_, ge_, e_, vv_) do { const size_t cidx = (size_t)(u * 144 + 4 * (R_) + sq) * 64 + sj; const u32x4* gp = GEb + cidx * 8 + 4 * th; \
        ge_[0] = gp[0]; ge_[1] = gp[1]; ge_[2] = gp[2]; ge_[3] = gp[3]; e_ = GWb[cidx]; \
        _Pragma("unroll") for (int k = 0; k < 8; ++k) { const size_t row = rb + scan_row(dir, (4 * (R_) + sq) * 16 + 8 * th + k); vv_[k] = *(const unsigned*)(PR + row * 1536 + 1024 + (ch & ~1)); } } while (0)
#define RW_LOAD(R_) RW_LOADX(R_, ge2, e152, vv2)
    RW_LOADX(0, ge, e15, vv); RW_LOADX(1, ge2, e152, vv2);
    for (int R = 0; R < 36; ++R) {
        for (int rep1 = 0; rep1 < 1 + DUPB(20); ++rep1) {
            unsigned char* sc = sm + sq * RW_SCR;
            bf16_t* At_ = (bf16_t*)sc; bf16_t* Rt_ = At_ + 16 * 72; bf16_t* Bt_ = Rt_ + 16 * 72; bf16_t* Kt_ = Bt_ + 16 * 72;
            bf16_t* AtT = Kt_ + 16 * 72; bf16_t* BhT = AtT + 64 * 16; bf16_t* KhT = BhT + 64 * 16; bf16_t* Vt_ = KhT + 64 * 16;
            float* WC = (float*)(sc + 18432);
            unsigned at2[4], bh2[4], kh2[4];
#pragma unroll
            for (int k2 = 0; k2 < 4; ++k2) {
                const unsigned x0 = ge[k2].x, y0 = ge[k2].y, x1 = ge[k2].z, y1 = ge[k2].w;
                const int t0 = 8 * th + 2 * k2;
                At_[t0 * 72 + sj] = (bf16_t)(x0 & 0xffff); Rt_[t0 * 72 + sj] = (bf16_t)(x0 >> 16); Bt_[t0 * 72 + sj] = (bf16_t)(y0 & 0xffff); Kt_[t0 * 72 + sj] = (bf16_t)(y0 >> 16);
                At_[(t0 + 1) * 72 + sj] = (bf16_t)(x1 & 0xffff); Rt_[(t0 + 1) * 72 + sj] = (bf16_t)(x1 >> 16); Bt_[(t0 + 1) * 72 + sj] = (bf16_t)(y1 & 0xffff); Kt_[(t0 + 1) * 72 + sj] = (bf16_t)(y1 >> 16);
                at2[k2] = (x0 & 0xffffu) | (x1 << 16);
                bh2[k2] = pk2(bf2f(y0 & 0xffff) * e15, bf2f(y1 & 0xffff) * e15);
                kh2[k2] = pk2(bf2f(y0 >> 16) * e15, bf2f(y1 >> 16) * e15);
            }
            *(u32x4*)(AtT + sj * 16 + 8 * th) = (u32x4){at2[0], at2[1], at2[2], at2[3]};
            *(u32x4*)(BhT + sj * 16 + 8 * th) = (u32x4){bh2[0], bh2[1], bh2[2], bh2[3]};
            *(u32x4*)(KhT + sj * 16 + 8 * th) = (u32x4){kh2[0], kh2[1], kh2[2], kh2[3]};
            { const int vs = (ch & 1) * 16; u32x4 v4; v4.x = ((vv[0] >> vs) & 0xffffu) | ((vv[1] >> vs) << 16); v4.y = ((vv[2] >> vs) & 0xffffu) | ((vv[3] >> vs) << 16); v4.z = ((vv[4] >> vs) & 0xffffu) | ((vv[5] >> vs) << 16); v4.w = ((vv[6] >> vs) & 0xffffu) | ((vv[7] >> vs) << 16);
              *(u32x4*)(Vt_ + sj * 16 + 8 * th) = v4; }
            if (th == 0) WC[sj] = e15;
        }
#pragma unroll
        for (int k = 0; k < 4; ++k) ge[k] = ge2[k];
#pragma unroll
        for (int k = 0; k < 8; ++k) vv[k] = vv2[k];
        e15 = e152;
        if (R + 2 < 36) { RW_LOAD(R + 2); }
        LDS_BARRIER();
        for (int rep2 = 0; rep2 < 1 + DUPB(21); ++rep2) if (w < 4) {
            unsigned char* sc = sm + w * RW_SCR;
            const bf16_t* At_ = (const bf16_t*)sc; const bf16_t* Rt_ = At_ + 16 * 72; const bf16_t* Bt_ = Rt_ + 16 * 72; const bf16_t* Kt_ = Bt_ + 16 * 72;
            const bf16_t* AtT = Kt_ + 16 * 72; const bf16_t* Vt_ = AtT + 3 * 64 * 16;
            float* Lm = (float*)(sc + 17408);
            unsigned char* sl = sm + RW_SLOT0 + w * RW_SLOT;
            u32x2* ATs = (u32x2*)sl; u32x2* GTs = (u32x2*)(sl + 2048); u32x4* MfS = (u32x4*)(sl + 4096);
            const f32x4 z4 = {0.f, 0.f, 0.f, 0.f};
            f32x4 Lab = z4, LakT = z4, Mbr = z4, Mkr = z4;
#pragma unroll
            for (int ks = 0; ks < 2; ++ks) {
                const bf16x8 af = *(const bf16x8*)(At_ + l15 * 72 + 32 * ks + 8 * kg), rf = *(const bf16x8*)(Rt_ + l15 * 72 + 32 * ks + 8 * kg);
                const bf16x8 bf = *(const bf16x8*)(Bt_ + l15 * 72 + 32 * ks + 8 * kg), kf = *(const bf16x8*)(Kt_ + l15 * 72 + 32 * ks + 8 * kg);
                Lab = MF16(bf, af, Lab); LakT = MF16(af, kf, LakT); Mbr = MF16(bf, rf, Mbr); Mkr = MF16(kf, rf, Mkr);
            }
#pragma unroll
            for (int i = 0; i < 4; ++i) { const int rrow = 4 * kg + i;
                Lab[i] = (rrow < l15) ? Lab[i] : 0.f;
                LakT[i] = (l15 < rrow) ? LakT[i] : 0.f;
                Mbr[i] = (rrow <= l15) ? Mbr[i] : 0.f; Mkr[i] = (rrow <= l15) ? Mkr[i] : 0.f;
                Lm[rrow * 16 + l15] = Lab[i]; }
            { u32x4 mw; mw.x = pk2(Mbr[0], Mbr[1]); mw.y = pk2(Mbr[2], Mbr[3]); mw.z = pk2(Mkr[0], Mkr[1]); mw.w = pk2(Mkr[2], Mkr[3]); MfS[lane] = mw; }
            asm volatile("s_waitcnt lgkmcnt(0)" ::: "memory"); __builtin_amdgcn_wave_barrier();
            float T[16];
#pragma unroll
            for (int r = 15; r >= 0; --r) {
                float acc = (r == l15) ? 1.0f : 0.0f;
                const f32x4 L0 = *(const f32x4*)(Lm + r * 16), L1 = *(const f32x4*)(Lm + r * 16 + 4), L2 = *(const f32x4*)(Lm + r * 16 + 8), L3 = *(const f32x4*)(Lm + r * 16 + 12);
#pragma unroll
                for (int m = r + 1; m < 16; ++m) { const float lv = (m < 4) ? L0[m & 3] : (m < 8) ? L1[m & 3] : (m < 12) ? L2[m & 3] : L3[m & 3]; acc += lv * T[m]; }
                T[r] = acc;
            }
            f32x4 Tsel;
#pragma unroll
            for (int i = 0; i < 4; ++i) Tsel[i] = (kg == 0) ? T[i] : (kg == 1) ? T[4 + i] : (kg == 2) ? T[8 + i] : T[12 + i];
            const bf16x8 Tf = frag_lo(Tsel);
            const f32x4 LT = MF16(frag_lo(LakT), Tf, z4);
            const bf16x8 LTf = frag_lo(LT);
#pragma unroll
            for (int t1 = 0; t1 < 4; ++t1) {
                const f32x4 at = MF16(frag_b64(AtT + (16 * t1 + l15) * 16 + 4 * kg), Tf, z4);
                ATs[t1 * 64 + lane] = pk4v(at);
                const f32x4 gt = MF16(LTf, frag_b64(Vt_ + (16 * t1 + l15) * 16 + 4 * kg), z4);
                GTs[t1 * 64 + lane] = pk4v(gt);
            }
        }
        LDS_BARRIER();
        if (w < 4) {
#pragma unroll
            for (int q = 0; q < 4; ++q) {
                const unsigned char* sc = sm + q * RW_SCR;
                const bf16_t* Rt_ = (const bf16_t*)sc + 16 * 72; const bf16_t* BhT = (const bf16_t*)sc + 4 * 16 * 72 + 64 * 16; const bf16_t* KhT = BhT + 64 * 16; const bf16_t* Vt_ = KhT + 64 * 16;
                const float* WC = (const float*)(sc + 18432);
                const unsigned char* sl = sm + RW_SLOT0 + q * RW_SLOT;
                const u32x2* ATs = (const u32x2*)sl; const u32x2* GTs = (const u32x2*)(sl + 2048); const u32x4* MfS = (const u32x4*)(sl + 4096);
                bf16x8 Sf[2];
#pragma unroll
                for (int pi = 0; pi < 2; ++pi) { u32x4 sw; sw.x = pk2(S[2 * pi][0], S[2 * pi][1]); sw.y = pk2(S[2 * pi][2], S[2 * pi][3]); sw.z = pk2(S[2 * pi + 1][0], S[2 * pi + 1][1]); sw.w = pk2(S[2 * pi + 1][2], S[2 * pi + 1][3]);
                    Sf[pi] = __builtin_bit_cast(bf16x8, sw); }
                f32x4 ut = unpk4v(GTs[w * 64 + lane]);
#pragma unroll
                for (int pi = 0; pi < 2; ++pi) { const u32x2 a0 = ATs[(2 * pi) * 64 + lane], a1 = ATs[(2 * pi + 1) * 64 + lane]; u32x4 aw; aw.x = a0.x; aw.y = a0.y; aw.z = a1.x; aw.w = a1.y;
                    ut = MF16(__builtin_bit_cast(bf16x8, aw), Sf[pi], ut); }
                const u32x2 v2 = *(const u32x2*)(Vt_ + (16 * w + l15) * 16 + 4 * kg);
                u32x4 uvw; uvw.x = pk2(ut[0], ut[1]); uvw.y = pk2(ut[2], ut[3]); uvw.z = v2.x; uvw.w = v2.y;
                const bf16x8 UVf = __builtin_bit_cast(bf16x8, uvw);
                f32x4 oa = MF16(__builtin_bit_cast(bf16x8, MfS[lane]), UVf, ((f32x4){0.f, 0.f, 0.f, 0.f}));
#pragma unroll
                for (int pi = 0; pi < 2; ++pi) { const u32x2 r0 = *(const u32x2*)(Rt_ + l15 * 72 + 32 * pi + 4 * kg), r1 = *(const u32x2*)(Rt_ + l15 * 72 + 32 * pi + 16 + 4 * kg);
                    u32x4 rw; rw.x = r0.x; rw.y = r0.y; rw.z = r1.x; rw.w = r1.y;
                    oa = MF16(__builtin_bit_cast(bf16x8, rw), Sf[pi], oa); }
#pragma unroll
                for (int i = 0; i < 4; ++i) { const size_t row = rb + scan_row(dir, (4 * R + q) * 16 + 4 * kg + i); O[row * 512 + hd * 64 + 16 * w + l15] = (bf16_t)(pk2(oa[i], 0.f) & 0xffff); }
#pragma unroll
                for (int t2 = 0; t2 < 4; ++t2) {
                    const u32x2 b2 = *(const u32x2*)(BhT + (16 * t2 + l15) * 16 + 4 * kg), k2 = *(const u32x2*)(KhT + (16 * t2 + l15) * 16 + 4 * kg);
                    u32x4 bw; bw.x = b2.x; bw.y = b2.y; bw.z = k2.x; bw.w = k2.y;
                    const f32x4 dv = *(const f32x4*)(WC + 16 * t2 + 4 * kg);
                    S[t2] = MF16(__builtin_bit_cast(bf16x8, bw), UVf, S[t2] * dv);
                }
            }
        }
        LDS_BARRIER();
    }
#undef RW_LOAD
#undef RW_LOADX
}
__device__ __forceinline__ void odd_finish_rows(const Params& p, int jo, bool skip_ctx) {
    unsigned char* const ws = ows(p.ws);
    const int tid_ = otid(); const int lane = tid_ & 63, w = tid_ >> 6;
    const bf16_t* YF = (const bf16_t*)(ws + OFF_S5F); const bf16_t* YB = (const bf16_t*)(ws + OFF_S5B);
    bf16_t* YG = (bf16_t*)(ws + OFF_AR + AO_YG);
    const bf16_t* OF = (const bf16_t*)(ws + OFF_AR + AO_OF); const bf16_t* OB = (const bf16_t*)(ws + OFF_AR + AO_OB);
    const bf16_t* PR = (const bf16_t*)(ws + OFF_AR + AO_PR); const bf16_t* LO = (const bf16_t*)(ws + OFF_AR + AO_P);
    bf16_t* Y = (bf16_t*)(ws + OFF_AR + AO_Y);
    const int c0 = lane * 8;
    const int nwv = gridDim.x * 8, rpw = (TT + nwv - 1) / nwv, row_lo = (blockIdx.x * 8 + w) * rpw, row_hi = (row_lo + rpw < TT) ? row_lo + rpw : TT;
    const f32x4 ds0 = *(const f32x4*)(p.in[25] + jo * 512 + c0), ds1 = *(const f32x4*)(p.in[25] + jo * 512 + c0 + 4);
    const f32x4 rk0 = *(const f32x4*)(p.in[35] + jo * 512 + c0), rk1 = *(const f32x4*)(p.in[35] + jo * 512 + c0 + 4);
    const f32x4 lg0 = *(const f32x4*)(p.in[36] + jo * 512 + c0), lg1 = *(const f32x4*)(p.in[36] + jo * 512 + c0 + 4);
    const f32x4 lb0 = *(const f32x4*)(p.in[37] + jo * 512 + c0), lb1 = *(const f32x4*)(p.in[37] + jo * 512 + c0 + 4);
    for (int row = row_lo; row < row_hi; ++row) {
        if (skip_ctx && (row % SB) < 256) continue;
        {
            float fa[8], fb[8], uu[8], o[8];
            unpk8(*(const u32x4*)(YF + (size_t)row * 512 + c0), fa); unpk8(*(const u32x4*)(YB + (size_t)row * 512 + c0), fb);
            unpk8(*(const u32x4*)(YG + (size_t)row * 512 + c0), uu);
#pragma unroll
            for (int i = 0; i < 4; ++i) { o[i] = fa[i] + fb[i] + ds0[i] * uu[i]; o[4 + i] = fa[4 + i] + fb[4 + i] + ds1[i] * uu[4 + i]; }
#pragma unroll
            for (int i = 0; i < 8; ++i) { const float x = o[i]; o[i] = 0.5f * x * (1.0f + tanh_f(0.7978845608028654f * (x + 0.044715f * x * x * x))); }
            *(u32x4*)(YG + (size_t)row * 512 + c0) = pk8(o);
        }
        {
            float o[8], r[8], k[8], v[8], g[8];
            { float fa[8], fb[8]; unpk8(*(const u32x4*)(OF + (size_t)row * 512 + c0), fa); unpk8(*(const u32x4*)(OB + (size_t)row * 512 + c0), fb);
#pragma unroll
              for (int i = 0; i < 8; ++i) o[i] = fa[i] + fb[i]; }
            unpk8(*(const u32x4*)(PR + (size_t)row * 1536 + c0), r); unpk8(*(const u32x4*)(PR + (size_t)row * 1536 + 512 + c0), k); unpk8(*(const u32x4*)(PR + (size_t)row * 1536 + 1024 + c0), v);
            unpk8(*(const u32x4*)(LO + (size_t)row * 2560 + 2048 + c0), g);
            float sm_ = 0.f, bo = 0.f;
#pragma unroll
            for (int i = 0; i < 8; ++i) { sm_ += o[i]; bo += r[i] * k[i] * ((i < 4) ? rk0[i & 3] : rk1[i & 3]); }
            const float mean = sum8(sm_) * (1.0f / 64.0f); bo = sum8(bo);
            float sq = 0.f;
#pragma unroll
            for (int i = 0; i < 8; ++i) { const float d = o[i] - mean; sq += d * d; }
            const float rstd = rsqrtf(sum8(sq) * (1.0f / 64.0f) + 64e-5f);
            float y[8];
#pragma unroll
            for (int i = 0; i < 8; ++i) y[i] = ((o[i] - mean) * rstd * ((i < 4) ? lg0[i & 3] : lg1[i & 3]) + ((i < 4) ? lb0[i & 3] : lb1[i & 3]) + bo * v[i]) * g[i];
            *(u32x4*)(Y + (size_t)row * 1024 + 512 + c0) = pk8(y);
        }
    }
}

#define PHB unsigned char* const ws = ows(p.ws); bf16_t* const H = (bf16_t*)(ws + OFF_H); _Float16* const X = (_Float16*)(ws + OFF_X); const float* const mod = (const float*)(ws + OFF_MOD); bf16_t* const PbE = (bf16_t*)(ws + OFF_AR + AE_P); bf16_t* const YbE = (bf16_t*)(ws + OFF_AR + AE_Y); bf16_t* const PbO = (bf16_t*)(ws + OFF_AR + AO_P); bf16_t* const YbO = (bf16_t*)(ws + OFF_AR + AO_Y); const unsigned* const cnt0 = (const unsigned*)(ws + OFF_CNT); (void)H; (void)X; (void)mod; (void)PbE; (void)YbE; (void)PbO; (void)YbO; (void)cnt0;
#define LAYER_PAIR_BODY(lp) {  \
         \
        { \
            const int layer = 2 * lp, j = lp; \
            if (RUN) { PHB    \
                pg8::Gemm g{H, (const bf16_t*)(ws + OFF_WINE + j * SZ_WINE), 1024, 0}; pg8::StaticOrder S; S.init(TT, 3328, G, cb, 1024); \
                { LAS float* lbl = (LAS float*)(lds + LDS_MAIN + 64); lbl[threadIdx.x] = ((const float*)(ws + OFF_LB))[j * 512 + threadIdx.x]; __syncthreads(); } \
                pg8::EpiEvenIn E{PbE, (const LAS float*)(lds + LDS_MAIN + 64)}; REP(8) pg8::gemm_phase(lds, g, S, E); SYNC; } ++ph; \
            if (RUN) { PHB    \
                if (cb < 128) { hgrn_chunk_unit(p, j, cb, smem); __syncthreads(); } \
                else { for (int it = cb - 128; it < 576; it += G - 128) attn_unit(p, j, it, smem); } \
                if (DUPB(1)) { __syncthreads(); if (cb < 128) { hgrn_chunk_unit(p, j, cb, smem); __syncthreads(); } } \
                if (DUPB(2)) { __syncthreads(); if (cb >= 128) { for (int it = cb - 128; it < 576; it += G - 128) attn_unit(p, j, it, smem); } } SYNC; } ++ph; \
            if (RUN) { PHB    \
                const int nextra = (layer == 2) ? p.ntc : 0; \
                hgrn_finish_rows(p, j); \
                if (DUPB(13)) { hgrn_finish_rows(p, j); } \
                if (nextra > 0) { __syncthreads(); tr_loop(p, cb, G, nextra, p.njm, p.nj1, smem); } \
                SYNC; } ++ph; \
            if (RUN) { PHB    \
                pg8::Gemm g{YbE, (const bf16_t*)(ws + OFF_WOUTE + j * SZ_WSQ), 1024, 0}; pg8::CtxSplitOrder S; S.init(G, cb, 1024, SPLIT_S); \
                pg8::EpiResid E{(bf16_t*)(ws + OFF_AR + AE_P), mod + (size_t)layer * 9 * 6144 + 2048, (bf16_t*)(ws + OFF_AR + AE_P) + (size_t)TT * 1024}; if (DUPB(18)) pg8::gemm_phase(lds, g, S, E); pg8::gemm_phase(lds, g, S, E); SYNC; } ++ph; \
            if (RUN) { PHB if (DUPB(17)) phase_ln<0, false, true>(p, layer, OFF_AR + AE_P, SPLIT_S, smem); phase_ln<0, false>(p, layer, OFF_AR + AE_P, SPLIT_S, smem); SYNC; } ++ph; \
            if (RUN) { PHB    \
                pg8::Gemm g{H, (const bf16_t*)(ws + OFF_WFFN1 + j * SZ_WFFN1), 1024, 0}; pg8::StaticOrder S; S.init(TT, 5632, G, cb, 1024); \
                pg8::EpiSwiGLU E{PbE, 2816}; REP(5) pg8::gemm_phase(lds, g, S, E); SYNC; } ++ph; \
            if (RUN) { PHB    \
                pg8::Gemm g{PbE, (const bf16_t*)(ws + OFF_WFFN2 + j * SZ_WFFN2), 2816, 0}; pg8::CtxSplitOrder S; S.init(G, cb, 2816, SPLIT_S); \
                pg8::EpiResid E{(bf16_t*)(ws + OFF_AR + AE_OF), mod + (size_t)layer * 9 * 6144 + 5120, (bf16_t*)(ws + OFF_AR + AE_OF) + (size_t)TT * 1024}; if (DUPB(18)) pg8::gemm_phase(lds, g, S, E); pg8::gemm_phase(lds, g, S, E); SYNC; } ++ph; \
            if (RUN) { PHB if (DUPB(17)) phase_ln<1, false, true>(p, layer, OFF_AR + AE_OF, SPLIT_S, smem); phase_ln<1, false>(p, layer, OFF_AR + AE_OF, SPLIT_S, smem); SYNC; } ++ph; \
        } \
         \
        { \
            const int layer = 2 * lp + 1, jo = lp; \
            if (RUN) { PHB    \
                pg8::Gemm g{H, (const bf16_t*)(ws + OFF_WINO + jo * SZ_WINO), 1024, 0}; pg8::StaticOrder S; S.init(TT, 2560, G, cb, 1024); \
                pg8::EpiBf16 E{PbO, 2560, nullptr}; if (DUPB(19)) pg8::gemm_phase(lds, g, S, E); pg8::gemm_phase(lds, g, S, E); SYNC; } ++ph; \
            if (RUN) { PHB    \
                rwkv_prep_rows(p, jo); \
                if (DUPB(14)) { rwkv_prep_rows(p, jo); } \
                SYNC; } ++ph; \
            if (RUN) { PHB    \
                pg8::Gemm g{(const bf16_t*)(ws + OFF_AR + AO_L), (const bf16_t*)(ws + OFF_WLORA + jo * SZ_WLORA), 384, 0}; pg8::LoraOrder S; S.init(TT, 2560, G, cb, 384); \
                pg8::EpiBf16 E{PbO, 2560, nullptr}; if (DUPB(19)) pg8::gemm_phase(lds, g, S, E); pg8::gemm_phase(lds, g, S, E); \
                SYNC; } ++ph; \
            if (RUN) { PHB   \
                { const int per = (4608 + G - 1) / G, i0 = cb * per, i1 = (i0 + per < 4608) ? i0 + per : 4608; rwkv_stage_loop(p, jo, i0, 1, i1, smem); } \
                SYNC; } ++ph; \
            if (RUN) { PHB    \
                if (cb < 128) { rwkv_chunk_unit(p, jo, cb, smem); if (DUPB(4)) { __syncthreads(); rwkv_chunk_unit(p, jo, cb, smem); } } \
                else { if (wv < 4) { s5_scan_task(p, jo, (cb - 128) * 4 + wv, smem + wv * 20480); } \
                       if (layer == 1 && p.ntm > 0) { __syncthreads(); tr_loop(p, cb - 128, G - 128, p.ntm, p.nj0, p.njm, smem); } \
                       if (layer == 3 && p.nt1 > p.ntc) { __syncthreads(); tr_loop(p, p.ntc + (cb - 128), G - 128, p.nt1, p.njm, p.nj1, smem); } } \
                SYNC; } ++ph; \
            if (RUN) { PHB odd_finish_rows(p, jo, layer == 3); SYNC; } ++ph; \
            if (RUN) { PHB    \
                pg8::Gemm g{(const bf16_t*)(ws + OFF_AR + AO_YG), (const bf16_t*)(ws + OFF_WGLU + jo * SZ_WGLU), 512, 0}; pg8::StaticOrder S; S.init(TT, 512, G, cb, 512); \
                pg8::EpiGLU E{(const bf16_t*)(ws + OFF_AR + AO_YG), YbO}; if (DUPB(19)) pg8::gemm_phase(lds, g, S, E); pg8::gemm_phase(lds, g, S, E); \
                SYNC; } ++ph; \
            if (RUN) { PHB    \
                pg8::Gemm g{YbO, (const bf16_t*)(ws + OFF_WOUTO + jo * SZ_WSQ), 1024, 0}; pg8::CtxSplitOrder S; S.init(G, cb, 1024, layer == 3 ? 0 : SPLIT_S); \
                pg8::EpiResid E{(bf16_t*)(ws + OFF_GE), mod + (size_t)layer * 9 * 6144 + 2048, (bf16_t*)(ws + OFF_GE) + (size_t)TT * 1024}; if (DUPB(18)) pg8::gemm_phase(lds, g, S, E); pg8::gemm_phase(lds, g, S, E); SYNC; } ++ph; \
            if (RUN) { PHB if (DUPB(17)) phase_ln<0, true, true>(p, layer, OFF_GE, SPLIT_S, smem); phase_ln<0, true>(p, layer, OFF_GE, SPLIT_S, smem); SYNC; } ++ph; \
            if (RUN) { PHB    \
                pg8::Gemm g{H, (const bf16_t*)(ws + OFF_WMOE1), 1024, SZ_WFFN1}; pg8::MoeOrder S; S.init((cnt0 + jo * 512), 22, G, cb, 1024); \
                LAS int* ridx = (LAS int*)(lds + LDS_MAIN + 64 + 2048); \
                { const unsigned* inv = (const unsigned*)(ws + OFF_INV); pg8::Unit u; \
                  for (int i = 0; i < 16 && S.next(i, u); ++i) { if (threadIdx.x < 256) { int pst = 0; _Pragma("unroll") for (int k = 0; k < 7; ++k) pst = (u.e > k) ? S.pend[k] : pst; \
                      const int r = (u.pm - pst) * 256 + (int)threadIdx.x; ridx[i * 256 + threadIdx.x] = (r < (int)(cnt0 + jo * 512)[u.e * 64]) ? (int)inv[(size_t)u.e * TT + r] : 0; } } \
                  __syncthreads(); } \
                pg8::EpiSwiGLU E{(bf16_t*)(ws + OFF_AR + AM_H), 2816}; pg8::gemm_phase<pg8::EpiSwiGLU, pg8::MoeOrder, true>(lds, g, S, E, ridx); SYNC; } ++ph; \
            if (RUN) { PHB    \
                pg8::Gemm g{(const bf16_t*)(ws + OFF_AR + AM_H), (const bf16_t*)(ws + OFF_WMOE2), 2816, SZ_WFFN2}; pg8::MoeOrder S; S.init((cnt0 + jo * 512), 4, G, cb, 2816, true); \
                pg8::EpiBf16 E{(bf16_t*)(ws + OFF_AR + AM_A), 1024, (bf16_t*)(ws + OFF_GE)}; REP(7) pg8::gemm_phase(lds, g, S, E); SYNC; } ++ph; \
            if (RUN) { PHB if (DUPB(17)) phase_ln<2, false, true>(p, layer, 0, 0, smem); phase_ln<2, false>(p, layer, 0, 0, smem); SYNC; } ++ph; \
        } \
     }
constexpr int LDS_MAIN = 131072;
constexpr int LDS_BYTES = LDS_MAIN + 64 + 2048 + 16384;
__global__ void __launch_bounds__(512, 2) mega(const Params p) {
    extern __shared__ __attribute__((aligned(16))) unsigned char smem[];
    LAS unsigned char* lds = (LAS unsigned char*)smem;
    volatile LAS unsigned* xbw = (volatile LAS unsigned*)(lds + LDS_MAIN);
    if (threadIdx.x == 0) { xbw[0] = 0u; xbw[1] = 0u; xbw[2] = 0u; xbw[3] = 0u; }
    __syncthreads();
    const bool multi = (p.hi - p.lo) > 1;
    XcdBarrier bar; bar.bar = (unsigned*)(p.ws + OFF_BAR); bar.x = 0; bar.st = xbw;
    if (multi) bar = xcd_barrier_post((unsigned*)(p.ws + OFF_BAR), xbw);
    const int G = gridDim.x, cb = blockIdx.x, wv = threadIdx.x >> 6;
    int ph = 0;
#define RUN (ph >= p.lo && ph < p.hi)
#define SYNC do { if (multi && ph + 1 < p.hi) { xcd_barrier(bar); if (DUPB(12)) xcd_barrier(bar); } else __syncthreads(); } while (0)

    if (RUN) { REP(0) { phase_prologue_a(p, smem); __syncthreads(); } SYNC; } ++ph;
    if (RUN) { phase_prologue_b(p); SYNC; } ++ph;

    LAYER_PAIR_BODY(0)
    LAYER_PAIR_BODY(1)
#undef RUN
#undef SYNC
}

static void add_job(Params& P, int& nj, int& nt, const float* src, bf16_t* dst, int K, int N, int ldd, int mode, int aux) {
    Job& j = P.jobs[nj++]; j.src = src; j.dst = dst; j.K = K; j.N = N; j.ldd = ldd; j.mode = mode; j.tile0 = nt; j.aux = aux; nt += (K / 128) * (N / 128);
}
extern "C" void kernel_launch(void* const* d_in, const int* in_sizes, int n_in, void* d_out, int out_size, void* d_ws, size_t ws_size, hipStream_t stream) {
    static int ready = 0;
    if (ready == 0) {
        if (n_in != 43 || ws_size < WS_END) { fprintf(stderr, "kernel_launch: need 43 inputs and %zu bytes of workspace, got %d / %zu\n", (size_t)WS_END, n_in, ws_size); ready = -1; return; }
        if (hipFuncSetAttribute((const void*)mega, hipFuncAttributeMaxDynamicSharedMemorySize, LDS_BYTES) != hipSuccess) { fprintf(stderr, "kernel_launch: hipFuncSetAttribute failed\n"); ready = -1; return; }
        ready = 1;
    }
    if (ready < 0) return;
    unsigned char* ws = (unsigned char*)d_ws;
    (void)hipMemsetAsync(ws, 0, ZERO_BYTES, stream);
    Params P; memset(&P, 0, sizeof(P));
    for (int i = 0; i < 43; ++i) P.in[i] = (const float*)d_in[i];
    P.out = (float*)d_out; P.ws = ws;
    int nj = 0, nt = 0;
    for (int j = 0; j < 2; ++j) {
        if (j == 1) { P.nj0 = nj; P.nt0 = nt; nt = 0; }
        add_job(P, nj, nt, P.in[8] + (size_t)j * 1024 * 3328, (bf16_t*)(ws + OFF_WINE + j * SZ_WINE), 1024, 3328, 1024, 0, 0);
        add_job(P, nj, nt, P.in[9] + (size_t)j * 1024 * 1024, (bf16_t*)(ws + OFF_WOUTE + j * SZ_WSQ), 1024, 1024, 1024, 0, 0);
        add_job(P, nj, nt, P.in[13] + (size_t)j * 1024 * 2816, (bf16_t*)(ws + OFF_WFFN1 + j * SZ_WFFN1), 1024, 2816, 1024, 1, 0);
        add_job(P, nj, nt, P.in[14] + (size_t)j * 1024 * 2816, (bf16_t*)(ws + OFF_WFFN1 + j * SZ_WFFN1), 1024, 2816, 1024, 2, 0);
        add_job(P, nj, nt, P.in[15] + (size_t)j * 2816 * 1024, (bf16_t*)(ws + OFF_WFFN2 + j * SZ_WFFN2), 2816, 1024, 2816, 0, 0);
        add_job(P, nj, nt, P.in[16] + (size_t)j * 1024 * 2432, (bf16_t*)(ws + OFF_WINO + j * SZ_WINO), 1024, 2432, 1024, 0, 0);
        add_job(P, nj, nt, nullptr, (bf16_t*)(ws + OFF_WINO + j * SZ_WINO) + (size_t)2432 * 1024, 1024, 128, 1024, 3, 0);
        add_job(P, nj, nt, P.in[17] + (size_t)j * 1024 * 1024, (bf16_t*)(ws + OFF_WOUTO + j * SZ_WSQ), 1024, 1024, 1024, 0, 0);
        add_job(P, nj, nt, nullptr, (bf16_t*)(ws + OFF_WLORA + j * SZ_WLORA), 384, 2560, 384, 4, j);
        add_job(P, nj, nt, P.in[26] + (size_t)j * 512 * 512, (bf16_t*)(ws + OFF_WGLU + j * SZ_WGLU), 512, 512, 512, 0, 0);
        if (j == 1) { P.njm = nj; P.ntm = nt; nt = 0; }
        { const int L = j;
        for (int e = 0; e < 8; ++e) {
            const size_t eo = (size_t)(L * 8 + e) * 1024 * 2816;
            add_job(P, nj, nt, P.in[40] + eo, (bf16_t*)(ws + OFF_WMOE1 + e * SZ_WFFN1), 1024, 2816, 1024, 1, 0);
            add_job(P, nj, nt, P.in[41] + eo, (bf16_t*)(ws + OFF_WMOE1 + e * SZ_WFFN1), 1024, 2816, 1024, 2, 0);
            add_job(P, nj, nt, P.in[42] + eo, (bf16_t*)(ws + OFF_WMOE2 + e * SZ_WFFN2), 2816, 1024, 2816, 0, 0);
        }
        }
    }
    P.nj1 = nj; P.nt1 = nt; P.ntc = nt / 2;
#if MK_SINGLE
    P.lo = 0; P.hi = NPH;
    hipLaunchKernelGGL(mega, dim3(256), dim3(512), LDS_BYTES, stream, P);
#else
    for (int ph = 0; ph < NPH; ++ph) { P.lo = ph; P.hi = ph + 1; hipLaunchKernelGGL(mega, dim3(256), dim3(512), LDS_BYTES, stream, P); }
#endif
}
```

```cpp
#include <hip/hip_runtime.h>
#include <stdint.h>
#include <stdio.h>
#include <string.h>

#ifndef PROBE_DUP
#define PROBE_DUP 0
#endif
#define REP(k) for (int rep_ = 0; rep_ < 1 + ((PROBE_DUP >> (k)) & 1); ++rep_)
#define DUPB(k) ((PROBE_DUP >> (k)) & 1)
#ifndef MK_SINGLE
#define MK_SINGLE 1
#endif

#define LAS __attribute__((address_space(3)))
typedef unsigned short bf16_t;
typedef short bf16x8 __attribute__((ext_vector_type(8)));
typedef short s16x4 __attribute__((ext_vector_type(4)));
typedef float f32x2 __attribute__((ext_vector_type(2)));
typedef float f32x4 __attribute__((ext_vector_type(4)));
typedef float f32x16 __attribute__((ext_vector_type(16)));
typedef unsigned u32x2 __attribute__((ext_vector_type(2)));
typedef unsigned u32x4 __attribute__((ext_vector_type(4)));
typedef __bf16 bfv2 __attribute__((ext_vector_type(2)));

constexpr int TT = 18432;
constexpr int SB = 2304;
constexpr int DM = 1024;
constexpr int NPH = 42;
constexpr float ALPHA = 1.6817928305074290f;
constexpr int SPLIT_S = 2;

constexpr size_t OFF_BAR = 0;
constexpr size_t OFF_CNT = 16384;
constexpr size_t ZERO_BYTES = 32768;
constexpr size_t OFF_MOD = 32768;
constexpr size_t OFF_COS = OFF_MOD + 884736;
constexpr size_t OFF_SIN = OFF_COS + 262144;
constexpr size_t OFF_LB = OFF_SIN + 262144;
constexpr size_t OFF_AB = OFF_LB + 4096;
constexpr size_t OFF_BBR = OFF_AB + 65536;
constexpr size_t OFF_BBI = OFF_BBR + 524288;
constexpr size_t OFF_ROUTE = OFF_BBI + 524288;
constexpr size_t OFF_WINE = OFF_ROUTE + 589824;
constexpr size_t SZ_WINE = (size_t)3328 * 1024 * 2;
constexpr size_t OFF_WOUTE = OFF_WINE + 2 * SZ_WINE;
constexpr size_t SZ_WSQ = (size_t)1024 * 1024 * 2;
constexpr size_t OFF_WFFN1 = OFF_WOUTE + 2 * SZ_WSQ;
constexpr size_t SZ_WFFN1 = (size_t)5632 * 1024 * 2;
constexpr size_t OFF_WFFN2 = OFF_WFFN1 + 2 * SZ_WFFN1;
constexpr size_t SZ_WFFN2 = (size_t)1024 * 2816 * 2;
constexpr size_t OFF_WINO = OFF_WFFN2 + 2 * SZ_WFFN2;
constexpr size_t SZ_WINO = (size_t)2560 * 1024 * 2;
constexpr size_t OFF_WOUTO = OFF_WINO + 2 * SZ_WINO;
constexpr size_t OFF_WLORA = OFF_WOUTO + 2 * SZ_WSQ;
constexpr size_t SZ_WLORA = (size_t)2560 * 384 * 2;
constexpr size_t OFF_WGLU = OFF_WLORA + 2 * SZ_WLORA;
constexpr size_t SZ_WGLU = (size_t)512 * 512 * 2;
constexpr size_t OFF_WMOE1 = OFF_WGLU + 2 * SZ_WGLU;
constexpr size_t OFF_WMOE2 = OFF_WMOE1 + 8 * SZ_WFFN1;
constexpr size_t OFF_X = OFF_WMOE2 + 8 * SZ_WFFN2;
constexpr size_t OFF_H = OFF_X + (size_t)TT * 1024 * 4;
constexpr size_t OFF_AR = OFF_H + (size_t)TT * 1024 * 2;
constexpr size_t AE_P = 0, AE_OF = 122683392, AE_OB = AE_OF + 37748736, AE_Y = AE_OB + 37748736;
constexpr size_t AO_P = 0, AO_OF = 94371840, AO_OB = AO_OF + 37748736, AO_PR = AO_OB + 37748736, AO_L = AO_PR + 56623104, AO_YG = AO_L + 14155776, AO_Y = AO_YG + 18874368;
constexpr size_t AM_A = 0, AM_H = 79691776;
constexpr size_t AR_SIZE = 298844160;
constexpr size_t OFF_KN = OFF_AR + AR_SIZE;
constexpr size_t OFF_GE = OFF_KN + 589824;
constexpr size_t OFF_GW = OFF_GE + (size_t)18432 * 8192;
constexpr size_t OFF_S5F = OFF_GW + (size_t)18432 * 256;
constexpr size_t OFF_S5B = OFF_S5F + (size_t)TT * 512 * 4;
constexpr size_t OFF_INV = OFF_S5B + (size_t)TT * 512 * 4;
constexpr size_t WS_END = OFF_INV + (size_t)8 * TT * 4;

struct Job { const float* src; bf16_t* dst; int K, N, ldd, mode, tile0, aux; };
constexpr int MAXJOBS = 72;
struct Params {
    const float* in[43];
    float* out;
    unsigned char* ws;
    int lo, hi;
    int nj0, njm, nj1;
    int nt0, ntm, nt1;
    int ntc;
    Job jobs[MAXJOBS];
};

__device__ __forceinline__ float bf2f(unsigned v) { return __uint_as_float(v << 16); }
__device__ __forceinline__ unsigned pk2(float lo, float hi) { f32x2 v = {lo, hi}; bfv2 b = __builtin_convertvector(v, bfv2); return __builtin_bit_cast(unsigned, b); }
__device__ __forceinline__ void unpk8(const u32x4 v, float* f) {
    f[0] = __uint_as_float(v.x << 16); f[1] = __uint_as_float(v.x & 0xffff0000u);
    f[2] = __uint_as_float(v.y << 16); f[3] = __uint_as_float(v.y & 0xffff0000u);
    f[4] = __uint_as_float(v.z << 16); f[5] = __uint_as_float(v.z & 0xffff0000u);
    f[6] = __uint_as_float(v.w << 16); f[7] = __uint_as_float(v.w & 0xffff0000u);
}
__device__ __forceinline__ void unpk4(const u32x2 v, float* f) {
    f[0] = __uint_as_float(v.x << 16); f[1] = __uint_as_float(v.x & 0xffff0000u);
    f[2] = __uint_as_float(v.y << 16); f[3] = __uint_as_float(v.y & 0xffff0000u);
}
__device__ __forceinline__ f32x4 unpk4v(const u32x2 v) { f32x4 r; r[0] = __uint_as_float(v.x << 16); r[1] = __uint_as_float(v.x & 0xffff0000u); r[2] = __uint_as_float(v.y << 16); r[3] = __uint_as_float(v.y & 0xffff0000u); return r; }
typedef _Float16 hf4 __attribute__((ext_vector_type(4)));
__device__ __forceinline__ u32x2 f2h4(const f32x4 v) { const hf4 h = __builtin_convertvector(v, hf4); return __builtin_bit_cast(u32x2, h); }
__device__ __forceinline__ f32x4 h2f4(const u32x2 u) { const hf4 h = __builtin_bit_cast(hf4, u); return __builtin_convertvector(h, f32x4); }
__device__ __forceinline__ u32x4 pk8(const float* f) { u32x4 r; r.x = pk2(f[0], f[1]); r.y = pk2(f[2], f[3]); r.z = pk2(f[4], f[5]); r.w = pk2(f[6], f[7]); return r; }
template <int CTRL> __device__ __forceinline__ float dppf(float v) { return __builtin_bit_cast(float, __builtin_amdgcn_update_dpp(0, __builtin_bit_cast(int, v), CTRL, 0xF, 0xF, true)); }
__device__ __forceinline__ float sum8(float v) { v += dppf<0xB1>(v); v += dppf<0x4E>(v); v += dppf<0x141>(v); return v; }
__device__ __forceinline__ float sum16(float v) { v = sum8(v); v += dppf<0x140>(v); return v; }
__device__ __forceinline__ float xsum16(float x) { const unsigned xb = __builtin_bit_cast(unsigned, x); auto r = __builtin_amdgcn_permlane16_swap(xb, xb, false, false);
    return __builtin_bit_cast(float, (unsigned)r[0]) + __builtin_bit_cast(float, (unsigned)r[1]); }
__device__ __forceinline__ float xsum32(float x) { const unsigned xb = __builtin_bit_cast(unsigned, x); auto r = __builtin_amdgcn_permlane32_swap(xb, xb, false, false);
    return __builtin_bit_cast(float, (unsigned)r[0]) + __builtin_bit_cast(float, (unsigned)r[1]); }
__device__ __forceinline__ float sum64(float v) { v = sum16(v); v = xsum16(v); v = xsum32(v); return v; }
__device__ __forceinline__ float sigm(float x) { return __builtin_amdgcn_rcpf(1.0f + __builtin_amdgcn_exp2f(-1.4426950408889634f * x)); }
__device__ __forceinline__ float siluf(float x) { return x * __builtin_amdgcn_rcpf(1.0f + __builtin_amdgcn_exp2f(-1.4426950408889634f * x)); }
__device__ __forceinline__ float tanh_f(float x) { const float e = __builtin_amdgcn_exp2f(-2.8853900817779268f * fabsf(x)); const float t = (1.0f - e) * __builtin_amdgcn_rcpf(1.0f + e); return x < 0.f ? -t : t; }
__device__ __forceinline__ void my_sincos(float x, float& s, float& c) {
    const float q = rintf(x * 0.636619772f);
    float r = fmaf(-q, 1.57079637f, x); r = fmaf(-q, -4.37113883e-8f, r);
    const float r2 = r * r;
    const float sp = r + r * r2 * (-1.6666654611e-1f + r2 * (8.3321608736e-3f + r2 * (-1.9515295891e-4f)));
    const float cp = 1.0f - 0.5f * r2 + r2 * r2 * (4.166664568298827e-2f + r2 * (-1.388731625493765e-3f + r2 * 2.443315711809948e-5f));
    const int qi = ((int)q) & 3;
    s = (qi == 0) ? sp : (qi == 1) ? cp : (qi == 2) ? -sp : -cp;
    c = (qi == 0) ? cp : (qi == 1) ? -sp : (qi == 2) ? -cp : sp;
}
__device__ __forceinline__ unsigned char* ows(unsigned char* q) { const unsigned long long t0 = (unsigned long long)q; unsigned lo = __builtin_amdgcn_readfirstlane((unsigned)t0), hi = __builtin_amdgcn_readfirstlane((unsigned)(t0 >> 32)); asm volatile("" : "+s"(lo), "+s"(hi)); const unsigned long long t = ((unsigned long long)hi << 32) | lo; return (unsigned char*)(__attribute__((address_space(1))) unsigned char*)t; }
#define LDS_BARRIER() do { asm volatile("s_waitcnt lgkmcnt(0)" ::: "memory"); __builtin_amdgcn_s_barrier(); asm volatile("" ::: "memory"); } while (0)
__device__ __forceinline__ int otid() { int t = threadIdx.x; asm volatile("" : "+v"(t)); return t; }
__device__ __forceinline__ int mod_index(int row) { const int b = row / SB, s = row - b * SB; return s < 256 ? 8 : b; }

#define XB_TMO      128
#define XB_XCNT(j)  (256  + 64 * (j))
#define XB_XSUB(j)  (1280 + 64 * (j))
#define XB_XGEN(j)  (2304 + 64 * (j))
#define XB_TOP      3328
#define XB_TOPGEN   3392
#define XCD_BAR_WORDS 3456
#define XB_SPIN_CAP (1u << 18)
__device__ __forceinline__ unsigned xb_ld(unsigned* p)              { return __hip_atomic_load(p, __ATOMIC_RELAXED, __HIP_MEMORY_SCOPE_AGENT); }
__device__ __forceinline__ unsigned xb_add(unsigned* p, unsigned v) { return __hip_atomic_fetch_add(p, v, __ATOMIC_RELAXED, __HIP_MEMORY_SCOPE_AGENT); }
__device__ __forceinline__ unsigned xb_xcc_id() { return (unsigned)__builtin_amdgcn_s_getreg((3 << 11) | 20) & 0xFu; }
#define XB_SPIN(cond, bar) do { unsigned _sp = 0; while (cond) { __builtin_amdgcn_s_sleep(1); \
    if ((++_sp & 255u) == 0u) { if (xb_ld(&(bar)[XB_TMO])) break; if (_sp > XB_SPIN_CAP) { atomicAdd(&(bar)[XB_TMO], 1u); break; } } } } while (0)
struct XcdBarrier { unsigned* bar; unsigned x; volatile LAS unsigned* st; };
__device__ __forceinline__ XcdBarrier xcd_barrier_post(unsigned* bar, volatile LAS unsigned* st) {
    XcdBarrier b; b.bar = bar; b.x = xb_xcc_id(); b.st = st;
    if (threadIdx.x == 0) (void)xb_add(&bar[XB_XCNT(b.x)], 1u);
    return b;
}
__device__ __forceinline__ void xcd_barrier_complete(unsigned* bar, unsigned x, unsigned& nloc, unsigned& nx) {
    const unsigned G = gridDim.x * gridDim.y * gridDim.z;
    unsigned sum, cnt, mine, sp = 0u;
    for (;;) {
        sum = 0u; cnt = 0u; mine = 0u;
#pragma unroll
        for (unsigned j = 0; j < 16; ++j) { const unsigned c = xb_ld(&bar[XB_XCNT(j)]); sum += c; cnt += (c > 0u) ? 1u : 0u; mine = (j == x) ? c : mine; }
        if (sum == G) break;
        __builtin_amdgcn_s_sleep(1);
        if ((++sp & 255u) == 0u) { if (xb_ld(&bar[XB_TMO])) break; if (sp > XB_SPIN_CAP) { atomicAdd(&bar[XB_TMO], 1u); break; } }
    }
    nloc = mine > 0u ? mine : 1u; nx = cnt > 0u ? cnt : 1u;
}
__device__ __forceinline__ void xcd_barrier(const XcdBarrier& b) {
    asm volatile("s_waitcnt vmcnt(0)" ::: "memory");
    __syncthreads();
    if (threadIdx.x == 0) {
        unsigned* bar = b.bar;
        __builtin_amdgcn_s_waitcnt(0);
        unsigned nloc = b.st[0], nx = b.st[1];
        if (nloc == 0u) { xcd_barrier_complete(bar, b.x, nloc, nx); b.st[0] = nloc; b.st[1] = nx; }
        const unsigned old = xb_add(&bar[XB_XSUB(b.x)], 1u);
        const unsigned gen = old / nloc;
        if (old + 1u == (gen + 1u) * nloc) {
            __builtin_amdgcn_fence(__ATOMIC_RELEASE, "agent");
            asm volatile("s_waitcnt vmcnt(0)" ::: "memory");
            const unsigned og = xb_add(&bar[XB_TOP], 1u);
            const unsigned tg = og / nx;
            if (og + 1u == (tg + 1u) * nx) xb_add(&bar[XB_TOPGEN], 1u);
            else XB_SPIN(xb_ld(&bar[XB_TOPGEN]) == tg, bar);
            __builtin_amdgcn_fence(__ATOMIC_ACQUIRE, "agent");
            asm volatile("s_waitcnt vmcnt(0)" ::: "memory");
        } else {
            XB_SPIN(xb_ld(&bar[XB_TOPGEN]) == gen, bar);
            __builtin_amdgcn_fence(__ATOMIC_ACQUIRE, "agent");
            asm volatile("s_waitcnt vmcnt(0)" ::: "memory");
        }
    }
    __syncthreads();
}

namespace pg8 {
constexpr int BM = 256, BK = 64, HALF = 128, HTB = HALF * BK * 2, STAGE_BYTES = 8 * HTB, NXCD = 8, WGM = 8;
__device__ __forceinline__ int lds_byte(int r, int c) { const int st = (r >> 4) * 2 + (c >> 5), rr = r & 15, cc = c & 31, ob = rr * 64 + cc * 2; return st * 1024 + (ob ^ (((ob >> 9) & 1) << 5)); }
__device__ __forceinline__ void stage_rc(int b, int& R, int& C) { const int st = b / 1024, sb = b % 1024, swz = sb ^ (((sb >> 9) & 1) << 5); R = (st >> 1) * 16 + swz / 64; C = (st & 1) * 32 + (swz % 64) / 2; }
__device__ __forceinline__ int perm32(int rho) { const int n = rho >> 4, i = rho & 15; return 8 * (i >> 2) + 4 * n + (i & 3); }
struct Unit { int pm, pn, e, kt0, nkt, ks; };
struct Gemm { const bf16_t* A; const bf16_t* Bt; int K; size_t bstride; };
struct StaticOrder {
    int nM, nN, nwg, G, c, nkt;
    __device__ __forceinline__ void init(int M, int N, int G_, int c_, int K_) { nM = M / BM; nN = N / BM; nwg = nM * nN; G = G_; c = c_; nkt = K_ / BK; }
    __device__ __forceinline__ bool next(int i, Unit& u) const {
        const long L = (long)i * G + c; if (L >= nwg) return false;
        int wgid = (int)L; { const int q = nwg / NXCD, r = nwg % NXCD, xcd = wgid % NXCD, off = wgid / NXCD; wgid = (xcd < r ? xcd * (q + 1) : r * (q + 1) + (xcd - r) * q) + off; }
        const int nig = WGM * nN, gid = wgid / nig, fm = gid * WGM, gsz = (nM - fm) < WGM ? (nM - fm) : WGM;
        u.pm = fm + ((wgid % nig) % gsz); u.pn = (wgid % nig) / gsz; u.e = 0; u.kt0 = 0; u.nkt = nkt; u.ks = -1; return true;
    }
};
struct LoraOrder {
    StaticOrder so;
    __device__ __forceinline__ void init(int M, int N, int G_, int c_, int K_) { so.init(M, N, G_, c_, K_); }
    __device__ __forceinline__ bool next(int i, Unit& u) const {
        if (!so.next(i, u)) return false;
        u.kt0 = (u.pn >> 2) * 2; u.nkt = 2; return true;
    }
};
struct MoeOrder {
    int nN, G, c, npan, nkt, nfullU; int pend[8];
    __device__ __forceinline__ void init(const unsigned* cnt, int nN_, int G_, int c_, int K_, bool split = false) {
        nN = nN_; G = G_; c = c_; nkt = K_ / BK; int acc = 0;
#pragma unroll
        for (int e = 0; e < 8; ++e) { acc += ((int)cnt[e * 64] + 255) >> 8; pend[e] = acc; }
        npan = acc; nfullU = split ? ((npan * nN) / G) * G : 0x40000000;
    }
    __device__ __forceinline__ bool next(int i, Unit& u) const {
        const int q0 = i * G + (c & 7) * (G >> 3) + (c >> 3);
        const bool sub = q0 >= nfullU;
        const int q = sub ? nfullU + ((q0 - nfullU) >> 1) : q0, ksub = (q0 - nfullU) & 1;
        const int per = 4 * nN, nfull = npan >> 2, g4 = q / per;
        int pan, pn; bool ok = true;
        if (g4 < nfull) { const int r = q - g4 * per; pn = r >> 2; pan = g4 * 4 + (r & 3); }
        else { const int q2 = q - nfull * per, gp = npan - 4 * nfull; const int gpd = gp > 0 ? gp : 1; ok = q2 < gp * nN; pn = q2 / gpd; pan = 4 * nfull + (q2 - pn * gpd); }
        int e = 0;
#pragma unroll
        for (int k = 0; k < 7; ++k) e += (pan >= pend[k]) ? 1 : 0;
        u.pm = pan; u.pn = pn; u.e = e; u.kt0 = sub ? ksub * (nkt >> 1) : 0; u.nkt = sub ? (nkt >> 1) : nkt; u.ks = sub ? ksub : -1;
        return ok;
    }
};
struct CtxSplitOrder {
    StaticOrder lat; int G, c, nkt, S;
    __device__ __forceinline__ void init(int G_, int c_, int K_, int S_) { lat.init(64 * BM, 1024, G_, c_, K_); G = G_; c = c_; nkt = K_ / BK; S = S_; }
    __device__ __forceinline__ bool next(int i, Unit& u) const {
        const int L = i * G + c;
        const bool islat = L < 256;
        Unit r; const bool okl = lat.next(islat ? i : 0, r);
        r.pm = (r.pm >> 3) * 9 + 1 + (r.pm & 7);
        const int L2 = islat ? 0 : L - 256, Sd = S > 0 ? S : 1, uid = L2 / Sd, ks = L2 - uid * Sd, sub = nkt / Sd;
        u.pm = islat ? r.pm : (uid >> 2) * 9; u.pn = islat ? r.pn : (uid & 3); u.e = 0;
        u.kt0 = islat ? 0 : ks * sub; u.nkt = islat ? nkt : sub; u.ks = islat ? -1 : ks;
        return islat ? okl : (L2 < 32 * S);
    }
};
template <class Epi, class Sched, bool GA = false>
__device__ __forceinline__ void gemm_phase(LAS unsigned char* lds, const Gemm g, const Sched& S, const Epi& E, const LAS int* ridx = nullptr) {
    const int tid = otid(), wid = __builtin_amdgcn_readfirstlane(tid >> 6), lane = tid & 63, wr = wid >> 2, wc = wid & 3, fr = lane & 15, fq = lane >> 4;
    const int K = g.K;
    unsigned voffA[2], voffB[2]; int RA[2]; unsigned CA2[2];
#pragma unroll
    for (int i = 0; i < 2; ++i) { int R, C; stage_rc(tid * 16 + i * 8192, R, C); const int Rb = Epi::PERM ? ((R & ~31) + perm32(R & 31)) : R;
        voffA[i] = (unsigned)(R * K + C) * 2u; voffB[i] = (unsigned)(Rb * K + C) * 2u; RA[i] = R; CA2[i] = (unsigned)C * 2u; }
    unsigned vA[2][2], nvA[2][2], v2[2][2];
#define PG8_GIDX(dst, ui_) do { _Pragma("unroll") for (int _h = 0; _h < 2; ++_h) _Pragma("unroll") for (int _i = 0; _i < 2; ++_i) \
        dst[_h][_i] = (unsigned)ridx[(ui_) * 256 + _h * HALF + RA[_i]] * (unsigned)(K * 2) + CA2[_i]; } while (0)
#define PG8_STGA(bufoff, abase, h, vsel) do { if (GA) PG8_STAGE(bufoff, abase, vsel[h]); else PG8_STAGE(bufoff, (abase) + (h) * hstep, voffA); } while (0)
    const size_t kstep = (size_t)(BK * 2);
    const size_t hstep = (size_t)HALF * K * 2;
    const size_t tstep = 2 * hstep;
    const unsigned ldsw = (unsigned)wid * 1024u;
    const int aoff = lds_byte(wr * 64 + fr, fq * 8), boff = lds_byte(wc * 32 + fr, fq * 8);
#define PG8_SA(b, h) (((b) * 2 + (h)) * HTB)
#define PG8_SB(b, h) ((4 + (b) * 2 + (h)) * HTB)
#define PG8_STAGE(bufoff, gbase, voff) do { _Pragma("unroll") for (int _i = 0; _i < 2; ++_i) \
        __builtin_amdgcn_global_load_lds((const unsigned*)((const char*)(gbase) + (voff)[_i]), (LAS unsigned*)(lds + (bufoff) + ldsw + _i * 8192), 16, 0, 0); } while (0)
#define PG8_LDA(dst, b, h) do { _Pragma("unroll") for (int m = 0; m < 4; ++m) _Pragma("unroll") for (int k = 0; k < 2; ++k) dst[m][k] = *(const LAS bf16x8*)(lds + PG8_SA(b, h) + aoff + m * 2048 + k * 1024); } while (0)
#define PG8_LDB(dst, b, h) do { _Pragma("unroll") for (int n = 0; n < 2; ++n) _Pragma("unroll") for (int k = 0; k < 2; ++k) dst[n][k] = *(const LAS bf16x8*)(lds + PG8_SB(b, h) + boff + n * 2048 + k * 1024); } while (0)
#define PG8_MMA(ai, bj, At, Bt) do { __builtin_amdgcn_s_setprio(1); _Pragma("unroll") for (int m = 0; m < 4; ++m) _Pragma("unroll") for (int n = 0; n < 2; ++n) _Pragma("unroll") for (int k = 0; k < 2; ++k) \
        acc[ai][bj][m][n] = __builtin_amdgcn_mfma_f32_16x16x32_bf16(Bt[n][k], At[m][k], acc[ai][bj][m][n], 0, 0, 0); __builtin_amdgcn_s_setprio(0); } while (0)
#define PG8_WAIT_V(n) asm volatile("s_waitcnt vmcnt(" #n ")" ::: "memory")
#define PG8_WAIT_L(n) asm volatile("s_waitcnt lgkmcnt(" #n ")" ::: "memory")
#define PG8_BAR __builtin_amdgcn_s_barrier()
#define PG8_SCHED __builtin_amdgcn_sched_barrier(0)
    Unit cur, nxt; int ui = 0;
    if (!S.next(0, cur)) return;
    f32x4 acc[2][2][4][2];
#pragma unroll
    for (int a = 0; a < 2; ++a)
#pragma unroll
        for (int b = 0; b < 2; ++b)
#pragma unroll
            for (int m = 0; m < 4; ++m)
#pragma unroll
                for (int n = 0; n < 2; ++n) acc[a][b][m][n] = (f32x4){0.f, 0.f, 0.f, 0.f};
    bf16x8 At[4][2], B0[2][2], B1[2][2];
    const char* cA = (const char*)g.A + (GA ? (size_t)0 : (size_t)cur.pm * tstep) + (size_t)cur.kt0 * kstep; const char* cB = (const char*)g.Bt + (size_t)cur.e * g.bstride + (size_t)cur.pn * tstep + (size_t)cur.kt0 * kstep;
    if (GA) PG8_GIDX(vA, 0);
    PG8_STAGE(PG8_SB(0, 0), cB, voffB); PG8_STGA(PG8_SA(0, 0), cA, 0, vA); PG8_STAGE(PG8_SB(0, 1), cB + hstep, voffB); PG8_STGA(PG8_SA(0, 1), cA, 1, vA);
    if (wr == 1) PG8_BAR;
    PG8_WAIT_V(4); PG8_BAR;
    PG8_STAGE(PG8_SB(1, 0), cB + kstep, voffB); PG8_STGA(PG8_SA(1, 0), cA + kstep, 0, vA); PG8_STAGE(PG8_SB(1, 1), cB + hstep + kstep, voffB);
    PG8_WAIT_V(6); PG8_BAR;
    for (;;) {
        const bool has_next = S.next(ui + 1, nxt);
        const char* nA = has_next ? (const char*)g.A + (GA ? (size_t)0 : (size_t)nxt.pm * tstep) + (size_t)nxt.kt0 * kstep : cA; const char* nB = has_next ? (const char*)g.Bt + (size_t)nxt.e * g.bstride + (size_t)nxt.pn * tstep + (size_t)nxt.kt0 * kstep : cB;
        const int nt = cur.nkt;
        if (GA) { if (has_next) PG8_GIDX(nvA, ui + 1); else {
#pragma unroll
            for (int _h = 0; _h < 2; ++_h) { nvA[_h][0] = vA[_h][0]; nvA[_h][1] = vA[_h][1]; } } }
        for (int t = 0; t < nt; t += 2) {
            const bool last = (t == nt - 2);
            if (GA) {
#pragma unroll
                for (int _h = 0; _h < 2; ++_h) { v2[_h][0] = last ? nvA[_h][0] : vA[_h][0]; v2[_h][1] = last ? nvA[_h][1] : vA[_h][1]; } }
            const char* a1 = cA + (size_t)(t + 1) * kstep;
            const char* a2 = last ? nA : cA + (size_t)(t + 2) * kstep; const char* b2 = last ? nB : cB + (size_t)(t + 2) * kstep;
            const char* a3 = a2 + kstep; const char* b3 = b2 + kstep;
            PG8_LDB(B0, 0, 0); PG8_SCHED; PG8_LDA(At, 0, 0); PG8_STGA(PG8_SA(1, 1), a1, 1, vA);
            PG8_WAIT_L(8); PG8_BAR; PG8_WAIT_L(0); PG8_MMA(0, 0, At, B0); PG8_BAR; PG8_SCHED;
            PG8_LDB(B1, 0, 1); PG8_STAGE(PG8_SB(0, 0), b2, voffB);
            PG8_BAR; PG8_WAIT_L(0); PG8_MMA(0, 1, At, B1); PG8_BAR;
            PG8_LDA(At, 0, 1); PG8_STGA(PG8_SA(0, 0), a2, 0, v2);
            PG8_BAR; PG8_WAIT_L(0); PG8_MMA(1, 0, At, B0); PG8_BAR; PG8_SCHED;
            PG8_STAGE(PG8_SB(0, 1), b2 + hstep, voffB);
            PG8_WAIT_V(6); PG8_BAR; PG8_MMA(1, 1, At, B1); PG8_BAR;
            PG8_LDB(B0, 1, 0); PG8_SCHED; PG8_LDA(At, 1, 0); PG8_STGA(PG8_SA(0, 1), a2, 1, v2);
            PG8_WAIT_L(8); PG8_BAR; PG8_WAIT_L(0); PG8_MMA(0, 0, At, B0); PG8_BAR; PG8_SCHED;
            PG8_LDB(B1, 1, 1); PG8_STAGE(PG8_SB(1, 0), b3, voffB);
            PG8_BAR; PG8_WAIT_L(0); PG8_MMA(0, 1, At, B1); PG8_BAR;
            PG8_LDA(At, 1, 1); PG8_STGA(PG8_SA(1, 0), a3, 0, v2);
            PG8_BAR; PG8_WAIT_L(0); PG8_MMA(1, 0, At, B0); PG8_BAR; PG8_SCHED;
            PG8_STAGE(PG8_SB(1, 1), b3 + hstep, voffB);
            PG8_WAIT_V(6); PG8_BAR; PG8_MMA(1, 1, At, B1); PG8_BAR;
        }
        E(acc, cur, wr, wc, fr, fq);
        if (!has_next) break;
#pragma unroll
        for (int a = 0; a < 2; ++a)
#pragma unroll
            for (int b = 0; b < 2; ++b)
#pragma unroll
                for (int m = 0; m < 4; ++m)
#pragma unroll
                    for (int n = 0; n < 2; ++n) acc[a][b][m][n] = (f32x4){0.f, 0.f, 0.f, 0.f};
        cur = nxt; cA = nA; cB = nB; ++ui;
        if (GA) {
#pragma unroll
            for (int _h = 0; _h < 2; ++_h) { vA[_h][0] = nvA[_h][0]; vA[_h][1] = nvA[_h][1]; } }
    }
    PG8_WAIT_V(0);
    if (wr == 0) PG8_BAR;
    PG8_BAR;
#undef PG8_SA
#undef PG8_SB
#undef PG8_STAGE
#undef PG8_STGA
#undef PG8_GIDX
#undef PG8_LDA
#undef PG8_LDB
#undef PG8_MMA
#undef PG8_WAIT_V
#undef PG8_WAIT_L
#undef PG8_BAR
#undef PG8_SCHED
}

struct EpiBf16 {
    static constexpr bool PERM = true;
    bf16_t* O; int ldc; bf16_t* O2;
    __device__ __forceinline__ void operator()(const f32x4 (&acc)[2][2][4][2], const Unit& u, int wr, int wc, int fr, int fq) const {
        const int row0 = u.pm * BM + wr * 64 + fr, col0 = u.pn * BM + wc * 32 + 8 * fq;
        bf16_t* Ob = (u.ks == 1) ? O2 : O;
#pragma unroll
        for (int ai = 0; ai < 2; ++ai)
#pragma unroll
            for (int m = 0; m < 4; ++m) { bf16_t* rowp = Ob + (size_t)(row0 + ai * HALF + m * 16) * ldc + col0;
#pragma unroll
                for (int bj = 0; bj < 2; ++bj) { const f32x4 v0 = acc[ai][bj][m][0], v1 = acc[ai][bj][m][1];
                    u32x4 w; w.x = pk2(v0[0], v0[1]); w.y = pk2(v0[2], v0[3]); w.z = pk2(v1[0], v1[1]); w.w = pk2(v1[2], v1[3]);
                    *(u32x4*)(rowp + bj * HALF) = w; } }
    }
};
struct EpiEvenIn {
    static constexpr bool PERM = true;
    bf16_t* O; const LAS float* lb;
    __device__ __forceinline__ void operator()(const f32x4 (&acc)[2][2][4][2], const Unit& u, int wr, int wc, int fr, int fq) const {
        const int row0 = u.pm * BM + wr * 64 + fr, col0 = u.pn * BM + wc * 32 + 8 * fq;
        const int kind = (u.pn < 2) ? 1 : (u.pn < 6) ? 2 : (u.pn == 8 || u.pn == 9) ? 3 : 0;
        float lbv[2][8];
        if (kind == 2) {
#pragma unroll
            for (int bj = 0; bj < 2; ++bj)
#pragma unroll
                for (int j = 0; j < 8; ++j) lbv[bj][j] = lb[(col0 + bj * HALF + j) & 511];
        }
#pragma unroll
        for (int ai = 0; ai < 2; ++ai)
#pragma unroll
            for (int m = 0; m < 4; ++m) { bf16_t* rowp = O + (size_t)(row0 + ai * HALF + m * 16) * 3328 + col0;
#pragma unroll
                for (int bj = 0; bj < 2; ++bj) { float v[8];
#pragma unroll
                    for (int j = 0; j < 4; ++j) { v[j] = acc[ai][bj][m][0][j]; v[4 + j] = acc[ai][bj][m][1][j]; }
                    if (kind == 1) {
#pragma unroll
                        for (int j = 0; j < 8; ++j) v[j] = siluf(v[j]) * 0.08838834764831845f; }
                    else if (kind == 2) {
#pragma unroll
                        for (int j = 0; j < 8; ++j) v[j] = __builtin_amdgcn_logf(lbv[bj][j] + (1.0f - lbv[bj][j]) * sigm(v[j])); }
                    else if (kind == 3) {
#pragma unroll
                        for (int j = 0; j < 8; ++j) v[j] = siluf(v[j]); }
                    *(u32x4*)(rowp + bj * HALF) = pk8(v); } }
    }
};
struct EpiResid {
    static constexpr bool PERM = true;
    bf16_t* D0; const float* gate; bf16_t* D1;
    __device__ __forceinline__ void operator()(const f32x4 (&acc)[2][2][4][2], const Unit& u, int wr, int wc, int fr, int fq) const {
        const int row0 = u.pm * BM + wr * 64 + fr, col0 = u.pn * BM + wc * 32 + 8 * fq;
        const int b = u.pm / 9, isctx = (u.pm - b * 9 == 0), mi = isctx ? 8 : b;
        const float* gp = gate + (size_t)mi * 6144 + col0;
        f32x4 gv[2][2];
#pragma unroll
        for (int bj = 0; bj < 2; ++bj)
#pragma unroll
            for (int n = 0; n < 2; ++n) gv[bj][n] = *(const f32x4*)(gp + bj * HALF + 4 * n);
        bf16_t* Db = (u.ks == 1) ? D1 : D0;
#pragma unroll
        for (int ai = 0; ai < 2; ++ai)
#pragma unroll
            for (int m = 0; m < 4; ++m) { bf16_t* rowp = Db + (size_t)(row0 + ai * HALF + m * 16) * 1024 + col0;
#pragma unroll
                for (int bj = 0; bj < 2; ++bj) { const f32x4 v0 = acc[ai][bj][m][0] * gv[bj][0], v1 = acc[ai][bj][m][1] * gv[bj][1];
                    u32x4 w; w.x = pk2(v0[0], v0[1]); w.y = pk2(v0[2], v0[3]); w.z = pk2(v1[0], v1[1]); w.w = pk2(v1[2], v1[3]);
                    *(u32x4*)(rowp + bj * HALF) = w; } }
    }
};
struct EpiSwiGLU {
    static constexpr bool PERM = true;
    bf16_t* O; int ldc;
    __device__ __forceinline__ void operator()(const f32x4 (&acc)[2][2][4][2], const Unit& u, int wr, int wc, int fr, int fq) const {
        const int row0 = u.pm * BM + wr * 64 + fr, col0 = u.pn * HALF + wc * 32 + 8 * fq;
#pragma unroll
        for (int ai = 0; ai < 2; ++ai)
#pragma unroll
            for (int m = 0; m < 4; ++m) { bf16_t* rowp = O + (size_t)(row0 + ai * HALF + m * 16) * ldc + col0;
                float o[8];
#pragma unroll
                for (int n = 0; n < 2; ++n)
#pragma unroll
                    for (int j = 0; j < 4; j += 2) {
                        const f32x2 g2 = {acc[ai][0][m][n][j], acc[ai][0][m][n][j + 1]}, u2 = {acc[ai][1][m][n][j], acc[ai][1][m][n][j + 1]};
                        const f32x2 t = g2 * (-1.4426950408889634f);
                        f32x2 e; e.x = __builtin_amdgcn_exp2f(t.x); e.y = __builtin_amdgcn_exp2f(t.y);
                        const f32x2 d = e + 1.0f;
                        f32x2 r; r.x = __builtin_amdgcn_rcpf(d.x); r.y = __builtin_amdgcn_rcpf(d.y);
                        const f32x2 y = (g2 * u2) * r;
                        o[n * 4 + j] = y.x; o[n * 4 + j + 1] = y.y; }
                *(u32x4*)rowp = pk8(o); }
    }
};
struct EpiGLU {
    static constexpr bool PERM = true;
    const bf16_t* YG; bf16_t* Y;
    __device__ __forceinline__ void operator()(const f32x4 (&acc)[2][2][4][2], const Unit& u, int wr, int wc, int fr, int fq) const {
        const int row0 = u.pm * BM + wr * 64 + fr, col0 = u.pn * BM + wc * 32 + 8 * fq;
#pragma unroll
        for (int ai = 0; ai < 2; ++ai)
#pragma unroll
            for (int m = 0; m < 4; ++m) { const size_t row = (size_t)(row0 + ai * HALF + m * 16);
#pragma unroll
                for (int bj = 0; bj < 2; ++bj) { const int col = col0 + bj * HALF;
                    float y[8], o[8]; unpk8(*(const u32x4*)(YG + row * 512 + col), y);
#pragma unroll
                    for (int n = 0; n < 2; ++n)
#pragma unroll
                        for (int j = 0; j < 4; ++j) o[n * 4 + j] = y[n * 4 + j] * sigm(acc[ai][bj][m][n][j]);
                    *(u32x4*)(Y + row * 1024 + col) = pk8(o); } }
    }
};
}

__device__ __forceinline__ void ada_item(const Params& p, int item, unsigned char* sm) {
    unsigned char* const ws = ows(p.ws);
    const int tid = otid();
    const int l = item / 48, n0 = (item % 48) * 128;
    float* sc = (float*)sm;
    float* red = (float*)(sm + 49152);
    for (int i = tid; i < 9 * 1024; i += 512) { const int m = i >> 10, k = i & 1023; const float v = (m < 8) ? p.in[1][m * 1024 + k] : p.in[3][k]; sc[k * 12 + m] = siluf(v); }
    __syncthreads();
    const int col = tid & 127, kg = tid >> 7;
    float a0 = 0, a1 = 0, a2 = 0, a3 = 0, a4 = 0, a5 = 0, a6 = 0, a7 = 0, a8 = 0;
    const float* w = p.in[4] + (size_t)l * 1024 * 6144 + n0 + col;
#pragma unroll 8
    for (int k = kg * 256; k < kg * 256 + 256; ++k) {
        const float wv = w[(size_t)k * 6144];
        const f32x4 s0 = *(const f32x4*)&sc[k * 12], s1 = *(const f32x4*)&sc[k * 12 + 4]; const float s8 = sc[k * 12 + 8];
        a0 += s0[0] * wv; a1 += s0[1] * wv; a2 += s0[2] * wv; a3 += s0[3] * wv; a4 += s1[0] * wv; a5 += s1[1] * wv; a6 += s1[2] * wv; a7 += s1[3] * wv; a8 += s8 * wv;
    }
    float* rp = red + (kg * 9) * 128 + col;
    rp[0] = a0; rp[128] = a1; rp[256] = a2; rp[384] = a3; rp[512] = a4; rp[640] = a5; rp[768] = a6; rp[896] = a7; rp[1024] = a8;
    __syncthreads();
    float* mod = (float*)(ws + OFF_MOD);
    for (int i = tid; i < 9 * 128; i += 512) { const int m = i >> 7, cc = i & 127;
        const float s = red[(0 * 9 + m) * 128 + cc] + red[(1 * 9 + m) * 128 + cc] + red[(2 * 9 + m) * 128 + cc] + red[(3 * 9 + m) * 128 + cc];
        mod[(size_t)(l * 9 + m) * 6144 + n0 + cc] = s + p.in[5][l * 6144 + n0 + cc]; }
}
__device__ __forceinline__ void rope_item(const Params& p) {
    unsigned char* const ws = ows(p.ws);
    float* COS = (float*)(ws + OFF_COS); float* SIN = (float*)(ws + OFF_SIN);
    for (int i = threadIdx.x; i < 2048 * 32; i += 512) { const int pos = i >> 5, f = i & 31, fi = f & 15;
        const float inv = exp2f(-(float)fi * (13.287712379549449f / 16.0f));
        const float ang = (float)(f < 16 ? (pos >> 6) : (pos & 63)) * inv;
        float s, c; my_sincos(ang, s, c); COS[i] = c; SIN[i] = s; }
}
__device__ __forceinline__ void s5disc_item(const Params& p) {
    unsigned char* const ws = ows(p.ws);
    float* AB = (float*)(ws + OFF_AB); float* BBR = (float*)(ws + OFF_BBR); float* BBI = (float*)(ws + OFF_BBI); float* LB = (float*)(ws + OFF_LB);
    for (int idx = threadIdx.x; idx < 8192; idx += 512) {
        const int pp = idx & 63, g = (idx >> 6) & 31, jd = idx >> 11, jo = jd >> 1;
        const float lr = fminf(p.in[18][idx], -1e-4f), li = p.in[19][idx];
        const float dt = expf(p.in[20][jd * 32 + g]);
        const float mag = expf(lr * dt); float s, c; my_sincos(li * dt, s, c);
        const float abr = mag * c, abi = mag * s, den = lr * lr + li * li, nr = abr - 1.0f;
        const float cor = (nr * lr + abi * li) / den, coi = (abi * lr - nr * li) / den;
        AB[idx * 2] = abr; AB[idx * 2 + 1] = abi;
        const float* br = p.in[21] + (size_t)((jo * 32 + g) * 64 + pp) * 16; const float* bi = p.in[22] + (size_t)((jo * 32 + g) * 64 + pp) * 16;
        for (int h = 0; h < 16; ++h) { BBR[idx * 16 + h] = cor * br[h] - coi * bi[h]; BBI[idx * 16 + h] = cor * bi[h] + coi * br[h]; }
    }
    for (int c = threadIdx.x; c < 512; c += 512) { const float e0 = expf(p.in[10][c]), e1 = expf(p.in[10][512 + c]); LB[c] = 0.f; LB[512 + c] = e1 / (e0 + e1); }
}
struct TrTile { bf16_t* dp; int mode; };
__device__ __forceinline__ void tr_load(const Params& p, int tile, int& j, int jhi, f32x4 (&v)[8], int& k0, int& n0, Job& jb, int tid) {
    while (j + 1 < jhi && tile >= p.jobs[j + 1].tile0) ++j;
    jb = p.jobs[j]; const int t = tile - jb.tile0;
    const int nkt = jb.K >> 7, kt = t % nkt, ntl = t / nkt; k0 = kt * 128; n0 = ntl * 128;
    if (jb.mode == 3) {
#pragma unroll
        for (int i = 0; i < 8; ++i) v[i] = (f32x4){0.f, 0.f, 0.f, 0.f};
    } else if (jb.mode == 4) {
        const int blk = n0 >> 9, jo = jb.aux, sn0 = n0 & 511;
        const float* src = (blk < 4) ? (blk < 2 ? p.in[29] : p.in[31]) + (size_t)(jo * 2 + (blk & 1)) * 64 * 512 : p.in[32] + (size_t)jo * 128 * 512;
        const int klo = (blk < 4) ? 64 * blk : 256, khi = (blk < 4) ? 64 * blk + 64 : 384;
#pragma unroll
        for (int i = 0; i < 8; ++i) { const int idx = tid + 512 * i, kk = k0 + (idx >> 5), n4 = (idx & 31) * 4;
            v[i] = (kk >= klo && kk < khi) ? *(const f32x4*)(src + (size_t)(kk - klo) * 512 + sn0 + n4) : (f32x4){0.f, 0.f, 0.f, 0.f}; }
    } else {
#pragma unroll
        for (int i = 0; i < 8; ++i) { const int idx = tid + 512 * i, kk = idx >> 5, n4 = (idx & 31) * 4;
            v[i] = *(const f32x4*)(jb.src + (size_t)(k0 + kk) * jb.N + n0 + n4); }
    }
}
__device__ __forceinline__ void tr_loop(const Params& p, int first, int stride, int ntiles, int jlo, int jhi, unsigned char* sm) {
    const int tid = otid();
    bf16_t* Lb = (bf16_t*)sm;
    if (first >= ntiles) return;
    int j = jlo, k0, n0; Job jb; f32x4 v[8];
    tr_load(p, first, j, jhi, v, k0, n0, jb, tid);
    for (int tile = first; tile < ntiles; tile += stride) {
#pragma unroll
        for (int i = 0; i < 8; ++i) { const int idx = tid + 512 * i, kk = idx >> 5, n4 = (idx & 31) * 4;
            u32x2 w2; w2.x = pk2(v[i][0], v[i][1]); w2.y = pk2(v[i][2], v[i][3]); *(u32x2*)(Lb + kk * 132 + n4) = w2; }
        const int nn = tid >> 2, kq = tid & 3, ng = n0 + nn;
        int drow = ng;
        if (jb.mode == 1) drow = (ng >> 7) * 256 + (ng & 127);
        else if (jb.mode == 2) drow = (ng >> 7) * 256 + 128 + (ng & 127);
        bf16_t* dp = jb.dst + (size_t)drow * jb.ldd + k0;
        __syncthreads();
        if (tile + stride < ntiles) tr_load(p, tile + stride, j, jhi, v, k0, n0, jb, tid);
#pragma unroll
        for (int g = 0; g < 4; ++g) { const int k8 = g * 32 + kq * 8;
            u32x4 o;
            o.x = (unsigned)Lb[(k8 + 0) * 132 + nn] | ((unsigned)Lb[(k8 + 1) * 132 + nn] << 16); o.y = (unsigned)Lb[(k8 + 2) * 132 + nn] | ((unsigned)Lb[(k8 + 3) * 132 + nn] << 16);
            o.z = (unsigned)Lb[(k8 + 4) * 132 + nn] | ((unsigned)Lb[(k8 + 5) * 132 + nn] << 16); o.w = (unsigned)Lb[(k8 + 6) * 132 + nn] | ((unsigned)Lb[(k8 + 7) * 132 + nn] << 16);
            *(u32x4*)(dp + k8) = o; }
        __syncthreads();
    }
}
__device__ __forceinline__ void phase_prologue_a(const Params& p, unsigned char* sm) {
    const int cb = blockIdx.x, G = gridDim.x;
    for (int item = cb; item < 194; item += G) {
        if (item < 192) ada_item(p, item, sm);
        else if (item == 192) rope_item(p);
        else s5disc_item(p);
        __syncthreads();
    }
    tr_loop(p, (cb + 62) % G, G, p.nt0, 0, p.nj0, sm);
    if (DUPB(10)) { __syncthreads(); tr_loop(p, (cb + 62) % G, G, p.nt0, 0, p.nj0, sm); }
    if (DUPB(11)) { __syncthreads(); for (int item = cb; item < 192; item += G) { ada_item(p, item, sm); __syncthreads(); } }
}
__device__ __forceinline__ void phase_prologue_b(const Params& p) {
    unsigned char* const ws = ows(p.ws);
    const int tid_ = otid(); const int lane = tid_ & 63, w = tid_ >> 6;
    _Float16* X = (_Float16*)(ws + OFF_X); bf16_t* H = (bf16_t*)(ws + OFF_H); const float* mod = (const float*)(ws + OFF_MOD);
    f32x4 shr[4], scr[4]; int cur_mi = -1;
#pragma unroll
    for (int i = 0; i < 4; ++i) { shr[i] = (f32x4){0.f, 0.f, 0.f, 0.f}; scr[i] = shr[i]; }
    const int nwv = gridDim.x * 8, rpw = (TT + nwv - 1) / nwv, row_lo = (blockIdx.x * 8 + w) * rpw, row_hi = row_lo + rpw < TT ? row_lo + rpw : TT;
    for (int row = row_lo; row < row_hi; ++row) {
        const int b = row / SB, s = row - b * SB; const int mi = s < 256 ? 8 : b;
        const float* src = s < 256 ? p.in[2] + ((size_t)b * 256 + s) * 1024 : p.in[0] + ((size_t)b * 2048 + (s - 256)) * 1024;
        if (mi != cur_mi) { cur_mi = mi; const float* mp = mod + (size_t)mi * 6144;
#pragma unroll
            for (int i = 0; i < 4; ++i) { shr[i] = *(const f32x4*)(mp + 4 * lane + 256 * i); scr[i] = *(const f32x4*)(mp + 1024 + 4 * lane + 256 * i); } }
#pragma unroll
        for (int i = 0; i < 4; ++i) { const int c = 4 * lane + 256 * i; const f32x4 v = *(const f32x4*)(src + c);
            *(u32x2*)(X + (size_t)row * 1024 + c) = f2h4(v * ALPHA);
            const f32x4 sh = shr[i], sc = scr[i];
            u32x2 o; o.x = pk2(v[0] * (1.f + sc[0]) + sh[0], v[1] * (1.f + sc[1]) + sh[1]); o.y = pk2(v[2] * (1.f + sc[2]) + sh[2], v[3] * (1.f + sc[3]) + sh[3]);
            *(u32x2*)(H + (size_t)row * 1024 + c) = o; }
    }
}

template <int MODE, bool ROUTE, bool DRY = false>
__device__ __forceinline__ void phase_ln(const Params& p, int layer, size_t part_off, int nsplit, unsigned char* sm) {
    unsigned char* const ws = ows(p.ws);
    const int tid_ = otid(); const int lane = tid_ & 63, w = tid_ >> 6;
    _Float16* X = (_Float16*)(ws + OFF_X); bf16_t* H = (bf16_t*)(ws + OFF_H); const float* mod = (const float*)(ws + OFF_MOD);
    const int which = MODE == 0 ? 0 : 1;
    const float* lg = p.in[6] + (size_t)(layer * 2 + which) * 1024; const float* lbp = p.in[7] + (size_t)(layer * 2 + which) * 1024;
    const bool last = (layer == 3);
    const int jo = layer >> 1;
    unsigned* route = (unsigned*)(ws + OFF_ROUTE);
    unsigned* cnt = (unsigned*)(ws + OFF_CNT) + jo * 512;
    int offs[8];
    int split_row = 0x7fffffff;
    if (MODE == 2) { int acc = 0;
#pragma unroll
        for (int e = 0; e < 8; ++e) { offs[e] = acc; acc += (((int)cnt[e * 64] + 255) >> 8) << 8; }
        const int npan = acc >> 8, G_ = gridDim.x; split_row = ((((npan * 4) / G_) * G_) >> 2) << 8; }
    f32x4 rwr[4][4][2];
    if (ROUTE) { const float* rwg = p.in[38] + (size_t)jo * 8192;
#pragma unroll
        for (int i = 0; i < 4; ++i)
#pragma unroll
            for (int q = 0; q < 4; ++q) { const float* rp = rwg + (size_t)(4 * lane + 256 * i + q) * 8; rwr[i][q][0] = *(const f32x4*)rp; rwr[i][q][1] = *(const f32x4*)(rp + 4); } }
    f32x4 g4r[4], b4r[4], shr[4], scr[4];
#pragma unroll
    for (int i = 0; i < 4; ++i) { g4r[i] = *(const f32x4*)(lg + 4 * lane + 256 * i); b4r[i] = *(const f32x4*)(lbp + 4 * lane + 256 * i); shr[i] = (f32x4){0.f, 0.f, 0.f, 0.f}; scr[i] = shr[i]; }
    int cur_mi = -1, cur_gi = -1; f32x4 gtr[4];
#pragma unroll
    for (int i = 0; i < 4; ++i) gtr[i] = (f32x4){0.f, 0.f, 0.f, 0.f};
    const int nwv = gridDim.x * 8, rpw = (TT + nwv - 1) / nwv, row_lo = (blockIdx.x * 8 + w) * rpw, row_hi = row_lo + rpw < TT ? row_lo + rpw : TT;
    for (int row = row_lo; row < row_hi; ++row) {
        const int b = row / SB, s = row - b * SB; const int mi = s < 256 ? 8 : b;
        if (last && s < 256 && (MODE != 0 || ROUTE)) {
            if (ROUTE && lane == 0 && !DRY) route[(size_t)row * 8] = 0xffffffffu;
            continue;
        }
        f32x4 v[4];
        _Float16* xr = X + (size_t)row * 1024;
        _Float16* xw = DRY ? (_Float16*)(ws + OFF_S5F) + (size_t)row * 1024 : xr; bf16_t* hw = DRY ? (bf16_t*)(ws + OFF_S5B) + (size_t)row * 1024 : H + (size_t)row * 1024;
#pragma unroll
        for (int i = 0; i < 4; ++i) v[i] = h2f4(*(const u32x2*)(xr + 4 * lane + 256 * i));
        if (MODE != 2) {
            const bf16_t* d0 = (const bf16_t*)(ws + part_off) + (size_t)row * 1024 + 4 * lane;
            const bool two = (s < 256 && nsplit > 0);
#pragma unroll
            for (int i = 0; i < 4; ++i) { v[i] += unpk4v(*(const u32x2*)(d0 + 256 * i)); if (two) v[i] += unpk4v(*(const u32x2*)(d0 + (size_t)TT * 1024 + 256 * i)); }
        }
        if (MODE == 2) {
            const unsigned* rt = route + (size_t)row * 8;
            const int e1 = (int)rt[0], e2 = (int)rt[1]; const int r1 = (int)rt[2], r2 = (int)rt[3]; const float p1 = __uint_as_float(rt[4]), p2 = __uint_as_float(rt[5]);
            int o1 = 0, o2 = 0;
#pragma unroll
            for (int e = 0; e < 8; ++e) { o1 = (e == e1) ? offs[e] : o1; o2 = (e == e2) ? offs[e] : o2; }
            const bf16_t* F = (const bf16_t*)(ws + OFF_AR + AM_A);
            const bf16_t* f1 = F + (size_t)(o1 + r1) * 1024; const bf16_t* f2 = F + (size_t)(o2 + r2) * 1024;
            const bf16_t* F2 = (const bf16_t*)(ws + OFF_GE);
            const bool s1 = (o1 + r1) >= split_row, s2 = (o2 + r2) >= split_row;
            if (mi != cur_gi) { cur_gi = mi; const float* gt = mod + (size_t)(layer * 9 + mi) * 6144 + 5120;
#pragma unroll
                for (int i = 0; i < 4; ++i) gtr[i] = *(const f32x4*)(gt + 4 * lane + 256 * i); }
#pragma unroll
            for (int i = 0; i < 4; ++i) { const int c = 4 * lane + 256 * i; float a[4], bb[4]; unpk4(*(const u32x2*)(f1 + c), a); unpk4(*(const u32x2*)(f2 + c), bb);
                if (s1) { float t_[4]; unpk4(*(const u32x2*)(F2 + (size_t)(o1 + r1) * 1024 + c), t_); a[0] += t_[0]; a[1] += t_[1]; a[2] += t_[2]; a[3] += t_[3]; }
                if (s2) { float t_[4]; unpk4(*(const u32x2*)(F2 + (size_t)(o2 + r2) * 1024 + c), t_); bb[0] += t_[0]; bb[1] += t_[1]; bb[2] += t_[2]; bb[3] += t_[3]; }
                const f32x4 g4 = gtr[i];
#pragma unroll
                for (int q = 0; q < 4; ++q) v[i][q] = v[i][q] + g4[q] * (p1 * a[q] + p2 * bb[q]); }
        }
        float sm_ = 0.f;
#pragma unroll
        for (int i = 0; i < 4; ++i) sm_ += (v[i][0] + v[i][1]) + (v[i][2] + v[i][3]);
        const float mean = sum64(sm_) * (1.0f / 1024.0f);
        float sq = 0.f;
#pragma unroll
        for (int i = 0; i < 4; ++i) { const f32x4 d = v[i] - mean; sq += (d[0] * d[0] + d[1] * d[1]) + (d[2] * d[2] + d[3] * d[3]); }
        const float rstd = rsqrtf(sum64(sq) * (1.0f / 1024.0f) + 1e-5f);
        if (mi != cur_mi) { cur_mi = mi;
            const float* mp = (MODE == 0) ? mod + (size_t)(layer * 9 + mi) * 6144 + 3072 : mod + (size_t)((last ? 0 : layer + 1) * 9 + mi) * 6144;
#pragma unroll
            for (int i = 0; i < 4; ++i) { shr[i] = *(const f32x4*)(mp + 4 * lane + 256 * i); scr[i] = *(const f32x4*)(mp + 1024 + 4 * lane + 256 * i); } }
        float lg8[8];
#pragma unroll
        for (int e = 0; e < 8; ++e) lg8[e] = 0.f;
#pragma unroll
        for (int i = 0; i < 4; ++i) { const int c = 4 * lane + 256 * i;
            const f32x4 y = (v[i] - mean) * rstd * g4r[i] + b4r[i];
            if (MODE != 0 && last) { if (!DRY) *(f32x4*)(p.out + ((size_t)b * 2048 + (s - 256)) * 1024 + c) = y; else *(u32x2*)(xw + c) = f2h4(y); }
            else {
                *(u32x2*)(xw + c) = f2h4(y * ALPHA);
                const f32x4 h = y * (1.0f + scr[i]) + shr[i];
                u32x2 o; o.x = pk2(h[0], h[1]); o.y = pk2(h[2], h[3]);
                *(u32x2*)(hw + c) = o;
                if (ROUTE) {
#pragma unroll
                    for (int e = 0; e < 8; ++e) lg8[e] += (h[0] * rwr[i][0][e >> 2][e & 3] + h[1] * rwr[i][1][e >> 2][e & 3]) + (h[2] * rwr[i][2][e >> 2][e & 3] + h[3] * rwr[i][3][e >> 2][e & 3]); }
            }
        }
        if (ROUTE) {
#pragma unroll
            for (int e = 0; e < 8; ++e) lg8[e] = sum64(lg8[e]) + p.in[39][jo * 8 + e];
            int e1 = 0; float v1 = lg8[0];
#pragma unroll
            for (int e = 1; e < 8; ++e) if (lg8[e] > v1) { v1 = lg8[e]; e1 = e; }
            int e2 = -1; float v2 = -3.0e38f;
#pragma unroll
            for (int e = 0; e < 8; ++e) if (e != e1 && lg8[e] > v2) { v2 = lg8[e]; e2 = e; }
            if (lane == 0 && !DRY) {
                const float p1 = 1.0f / (1.0f + __expf(v2 - v1)), p2 = 1.0f - p1;
                const unsigned r1 = atomicAdd(&cnt[e1 * 64], 1u), r2 = atomicAdd(&cnt[e2 * 64], 1u);
                unsigned* rt = route + (size_t)row * 8;
                rt[0] = (unsigned)e1; rt[1] = (unsigned)e2; rt[2] = r1; rt[3] = r2; rt[4] = __float_as_uint(p1); rt[5] = __float_as_uint(p2);
                unsigned* inv = (unsigned*)(ws + OFF_INV); inv[(size_t)e1 * TT + r1] = (unsigned)row; inv[(size_t)e2 * TT + r2] = (unsigned)row;
            }
        }
    }
}
__device__ __forceinline__ int scan_row(int dir, int n) { return dir == 0 ? n : (n < 256 ? 255 - n : 2559 - n); }
__device__ __forceinline__ void hgrn_chunk_unit(const Params& p, int j, int u, unsigned char* sm) {
    unsigned char* const ws = ows(p.ws);
    const int tid = otid(), lane = tid & 63, w = tid >> 6, l15 = lane & 15, kg = lane >> 4;
    const int chf = u & 1, dir = (u >> 1) & 1, h = (u >> 2) & 3, b = u >> 4;
    const int ct = 4 * chf + (w & 3);
    const bf16_t* P = (const bf16_t*)(ws + OFF_AR + AE_P);
    bf16_t* O = (bf16_t*)(ws + OFF_AR + (dir ? AE_OB : AE_OF));
    const size_t rb = (size_t)b * SB;
    const int pd = tid >> 2, tq = tid & 3;
    const int ppos = (pd & ~31) + 8 * ((pd & 15) >> 2) + 4 * ((pd >> 4) & 1) + (pd & 3);
    const int rstep = dir ? -1 : 1;
    constexpr int RAW0 = 2 * 21504, RAWSZ = 3 * 16 * 136 * 2;
    const int t4 = tid & 255, lt = t4 >> 4, lc = t4 & 15;
    u32x4 gq, gf, gv;
#define HG_LOAD(c) do { const size_t row = rb + scan_row(dir, (c) * 16 + lt); const bf16_t* pr = P + row * 3328 + h * 128 + 8 * lc; \
        gq = *(const u32x4*)pr; gf = *(const u32x4*)(pr + 512 + dir * 512); gv = *(const u32x4*)(pr + 1536); } while (0)
#define HG_RAWW(bi) do { bf16_t* rw = (bf16_t*)(sm + RAW0 + (bi) * RAWSZ) + lt * 136 + 8 * lc; \
        *(u32x4*)rw = gq; *(u32x4*)(rw + 16 * 136) = gf; *(u32x4*)(rw + 32 * 136) = gv; } while (0)
    unsigned short rq[4], rf[4], rv[4];
#define HG_RAWR(bi) do { const bf16_t* rr_ = (const bf16_t*)(sm + RAW0 + (bi) * RAWSZ) + (4 * tq) * 136 + pd; \
        _Pragma("unroll") for (int k = 0; k < 4; ++k) { rq[k] = rr_[k * 136]; rf[k] = rr_[(16 + k) * 136]; rv[k] = rr_[(32 + k) * 136]; } } while (0)
#define HG_PREP(bufi) do { \
        bf16_t* Qd = (bf16_t*)(sm + (bufi) * 21504); bf16_t* Kd = Qd + 16 * 136; bf16_t* KeT = Kd + 16 * 136; bf16_t* Vt = KeT + 128 * 24; float* dec = (float*)(Vt + 128 * 24); \
        float qv[4], kk[4], cl[4]; float run = 0.f; \
        _Pragma("unroll") for (int k = 0; k < 4; ++k) { const float lg = bf2f(rf[k]); \
            qv[k] = bf2f(rq[k]); kk[k] = 1.0f - __builtin_amdgcn_exp2f(lg); run += lg; cl[k] = run; } \
        float x1 = dppf<0x93>(run); x1 = (tq >= 1) ? x1 : 0.f;            \
        float s2 = run + x1; float x2 = dppf<0x4E>(s2); x2 = (tq >= 2) ? x2 : 0.f; \
        const float incl = s2 + x2; const float off = incl - run; \
        const float btot = dppf<0xFF>(incl);                                  \
        const float etot = __builtin_amdgcn_exp2f(btot); \
        float ke[4]; \
        _Pragma("unroll") for (int k = 0; k < 4; ++k) { const float bl = off + cl[k]; const float E = __builtin_amdgcn_exp2f(bl); const float iE = __builtin_amdgcn_rcpf(E); \
            const float qd = qv[k] * E, kd = kk[k] * iE; ke[k] = kd * etot; \
            Qd[(4 * tq + k) * 136 + ppos] = (bf16_t)(pk2(qd, 0.f) & 0xffff); Kd[(4 * tq + k) * 136 + ppos] = (bf16_t)(pk2(kd, 0.f) & 0xffff); } \
        { u32x2 w2; w2.x = pk2(ke[0], ke[1]); w2.y = pk2(ke[2], ke[3]); *(u32x2*)(KeT + pd * 24 + 4 * tq) = w2; \
          u32x2 v2; v2.x = (unsigned)rv[0] | ((unsigned)rv[1] << 16); v2.y = (unsigned)rv[2] | ((unsigned)rv[3] << 16); *(u32x2*)(Vt + pd * 24 + 4 * tq) = v2; } \
        if (tq == 0) dec[pd] = etot; } while (0)
    f32x4 S[8];
#pragma unroll
    for (int i = 0; i < 8; ++i) S[i] = (f32x4){0.f, 0.f, 0.f, 0.f};
    if (w >= 4) { HG_LOAD(0); HG_RAWW(0); HG_LOAD(1); }
    LDS_BARRIER();
    HG_RAWR(0); HG_PREP(0);
    if (w >= 4) { HG_RAWW(1); HG_LOAD(2); }
    LDS_BARRIER();
    for (int c = 0; c < 144; ++c) {
        if (c + 1 < 144) { HG_RAWR((c + 1) & 1); HG_PREP((c + 1) & 1); }
        if (w >= 4) { if (c + 2 < 144) { HG_RAWW(c & 1); } if (c + 3 < 144) { HG_LOAD(c + 3); } }
        if (w < 4) {
            const bf16_t* Qd = (const bf16_t*)(sm + (c & 1) * 21504); const bf16_t* Kd = Qd + 16 * 136; const bf16_t* KeT = Kd + 16 * 136; const bf16_t* Vt = KeT + 128 * 24; const float* dec = (const float*)(Vt + 128 * 24);
            f32x4 AT = {0.f, 0.f, 0.f, 0.f};
            bf16x8 qf[4];
#pragma unroll
            for (int ks = 0; ks < 4; ++ks) { const bf16x8 kf = *(const bf16x8*)(Kd + l15 * 136 + 32 * ks + 8 * kg); qf[ks] = *(const bf16x8*)(Qd + l15 * 136 + 32 * ks + 8 * kg);
                AT = __builtin_amdgcn_mfma_f32_16x16x32_bf16(kf, qf[ks], AT, 0, 0, 0); }
            u32x4 aw;
            aw.x = pk2((4 * kg + 0 <= l15) ? AT[0] : 0.f, (4 * kg + 1 <= l15) ? AT[1] : 0.f); aw.y = pk2((4 * kg + 2 <= l15) ? AT[2] : 0.f, (4 * kg + 3 <= l15) ? AT[3] : 0.f); aw.z = 0u; aw.w = 0u;
            const bf16x8 afrag = __builtin_bit_cast(bf16x8, aw);
            u32x4 vw; { const u32x2 v2 = *(const u32x2*)(Vt + (16 * ct + l15) * 24 + 4 * kg); vw.x = v2.x; vw.y = v2.y; vw.z = 0u; vw.w = 0u; }
            const bf16x8 vfrag = __builtin_bit_cast(bf16x8, vw);
            f32x4 Oa = {0.f, 0.f, 0.f, 0.f};
            Oa = __builtin_amdgcn_mfma_f32_16x16x32_bf16(afrag, vfrag, Oa, 0, 0, 0);
#pragma unroll
            for (int pi = 0; pi < 4; ++pi) {
                u32x4 sw; sw.x = pk2(S[2 * pi][0], S[2 * pi][1]); sw.y = pk2(S[2 * pi][2], S[2 * pi][3]); sw.z = pk2(S[2 * pi + 1][0], S[2 * pi + 1][1]); sw.w = pk2(S[2 * pi + 1][2], S[2 * pi + 1][3]);
                Oa = __builtin_amdgcn_mfma_f32_16x16x32_bf16(qf[pi], __builtin_bit_cast(bf16x8, sw), Oa, 0, 0, 0);
            }
            { bf16_t* op = O + (rb + scan_row(dir, c * 16 + 4 * kg)) * 512 + h * 128 + 16 * ct + l15;
#pragma unroll
              for (int i = 0; i < 4; ++i) op[(ptrdiff_t)(rstep * i) * 512] = (bf16_t)(pk2(Oa[i], 0.f) & 0xffff); }
#pragma unroll
            for (int dt = 0; dt < 8; ++dt) {
                const f32x4 dv = *(const f32x4*)(dec + 16 * dt + 4 * kg);
                u32x4 kw; { const u32x2 k2 = *(const u32x2*)(KeT + (16 * dt + l15) * 24 + 4 * kg); kw.x = k2.x; kw.y = k2.y; kw.z = 0u; kw.w = 0u; }
                S[dt] = __builtin_amdgcn_mfma_f32_16x16x32_bf16(__builtin_bit_cast(bf16x8, kw), vfrag, S[dt] * dv, 0, 0, 0);
            }
        }
        LDS_BARRIER();
    }
#undef HG_LOAD
#undef HG_RAWW
#undef HG_RAWR
#undef HG_PREP
}
__device__ __forceinline__ void hgrn_finish_rows(const Params& p, int j) {
    unsigned char* const ws = ows(p.ws);
    const int tid_ = otid(); const int lane = tid_ & 63, w = tid_ >> 6;
    const bf16_t* P = (const bf16_t*)(ws + OFF_AR + AE_P);
    const bf16_t* OF = (const bf16_t*)(ws + OFF_AR + AE_OF); const bf16_t* OB = (const bf16_t*)(ws + OFF_AR + AE_OB);
    bf16_t* Y = (bf16_t*)(ws + OFF_AR + AE_Y);
    const int c0 = lane * 8;
    const int nwv = gridDim.x * 8, rpw = (TT + nwv - 1) / nwv, row_lo = (blockIdx.x * 8 + w) * rpw, row_hi = (row_lo + rpw < TT) ? row_lo + rpw : TT;
    const f32x4 ng0 = *(const f32x4*)(p.in[11] + j * 512 + c0), ng1 = *(const f32x4*)(p.in[11] + j * 512 + c0 + 4);
    for (int row = row_lo; row < row_hi; ++row) {
        float o[8], g[8];
        { float fa[8], fb[8]; unpk8(*(const u32x4*)(OF + (size_t)row * 512 + c0), fa); unpk8(*(const u32x4*)(OB + (size_t)row * 512 + c0), fb);
#pragma unroll
          for (int i = 0; i < 8; ++i) o[i] = fa[i] + fb[i]; }
        unpk8(*(const u32x4*)(P + (size_t)row * 3328 + 2048 + c0), g);
        float ssq = 0.f;
#pragma unroll
        for (int i = 0; i < 8; ++i) ssq += o[i] * o[i];
        ssq = sum16(ssq);
        const float r = rsqrtf(ssq * (1.0f / 128.0f) + 1e-6f);
        float y[8];
#pragma unroll
        for (int i = 0; i < 4; ++i) { y[i] = o[i] * r * ng0[i] * g[i]; y[4 + i] = o[4 + i] * r * ng1[i] * g[4 + i]; }
        *(u32x4*)(Y + (size_t)row * 1024 + c0) = pk8(y);
    }
}

__device__ __forceinline__ void attn_unit(const Params& p, int j, int u, unsigned char* sm) {
    unsigned char* const ws = ows(p.ws);
    const int tid = otid(), lane = tid & 63, w = tid >> 6;
    const int b = u / 72, rem = u - b * 72, g = rem / 36, qb = rem - g * 36;
    const int r4 = w & 3, sub = w >> 2, hh = g * 4 + r4, l31 = lane & 31, hf = lane >> 5;
    bf16_t* Ks = (bf16_t*)sm; bf16_t* Vt = Ks + 64 * 72;
    const bf16_t* P = (const bf16_t*)(ws + OFF_AR + AE_P); bf16_t* Y = (bf16_t*)(ws + OFF_AR + AE_Y);
    const float* COS = (const float*)(ws + OFF_COS); const float* SIN = (const float*)(ws + OFF_SIN);
    const bool isl = qb < 32;
    const int q0 = isl ? qb * 64 : (qb - 32) * 64;
    const size_t rb = (size_t)b * SB;
    const int qpos = q0 + sub * 32 + l31;
    const size_t qrow = rb + (isl ? 256 : 0) + qpos;
    bf16x8 qf[4];
    {
        const bf16_t* qp = P + qrow * 3328 + 2560 + hh * 64;
        float x1a[8], x1b[8], x2a[8], x2b[8];
        unpk8(*(const u32x4*)(qp + 8 * hf), x1a); unpk8(*(const u32x4*)(qp + 16 + 8 * hf), x1b);
        unpk8(*(const u32x4*)(qp + 32 + 8 * hf), x2a); unpk8(*(const u32x4*)(qp + 48 + 8 * hf), x2b);
        const float sc = 0.125f * 1.4426950408889634f;
        float o0[8], o1[8], o2[8], o3[8];
        if (isl) {
            const float* cp = COS + qpos * 32 + 8 * hf; const float* sp = SIN + qpos * 32 + 8 * hf;
#pragma unroll
            for (int i = 0; i < 8; ++i) { const float ca = cp[i], sa = sp[i], cb = cp[16 + i], sb = sp[16 + i];
                o0[i] = (x1a[i] * ca - x2a[i] * sa) * sc; o2[i] = (x1a[i] * sa + x2a[i] * ca) * sc;
                o1[i] = (x1b[i] * cb - x2b[i] * sb) * sc; o3[i] = (x1b[i] * sb + x2b[i] * cb) * sc; }
        } else {
#pragma unroll
            for (int i = 0; i < 8; ++i) { o0[i] = x1a[i] * sc; o1[i] = x1b[i] * sc; o2[i] = x2a[i] * sc; o3[i] = x2b[i] * sc; }
        }
        qf[0] = __builtin_bit_cast(bf16x8, pk8(o0)); qf[1] = __builtin_bit_cast(bf16x8, pk8(o1)); qf[2] = __builtin_bit_cast(bf16x8, pk8(o2)); qf[3] = __builtin_bit_cast(bf16x8, pk8(o3));
    }
    float m = p.in[12][j * 8 + hh] * 1.4426950408889634f;
    float lsum = hf == 0 ? 1.0f : 0.0f;
    f32x16 O0, O1;
#pragma unroll
    for (int i = 0; i < 16; ++i) { O0[i] = 0.f; O1[i] = 0.f; }
    const int nch = isl ? 9 : 4;
    for (int ci = 0; ci < nch; ++ci) {
        const bool win = isl && ci < 5;
        int w0 = 0; size_t krow0;
        if (win) { w0 = q0 - 128 + 64 * ci; if (w0 < 0 || w0 >= 2048) continue; krow0 = rb + 256 + w0; }
        else { const int cc = isl ? ci - 5 : ci; krow0 = rb + cc * 64; }
        __syncthreads();
        if (tid < 256) {
            const int key = tid >> 2, dq = tid & 3;
            const bf16_t* src = P + (krow0 + key) * 3328 + 2560 + 512 + g * 64;
            u32x4 r1 = *(const u32x4*)(src + dq * 8), r2 = *(const u32x4*)(src + 32 + dq * 8);
            if (win) {
                float x1[8], x2[8], y1[8], y2[8]; unpk8(r1, x1); unpk8(r2, x2);
                const float* cp = COS + (w0 + key) * 32 + dq * 8; const float* sp = SIN + (w0 + key) * 32 + dq * 8;
#pragma unroll
                for (int i = 0; i < 8; ++i) { const float c_ = cp[i], s_ = sp[i]; y1[i] = x1[i] * c_ - x2[i] * s_; y2[i] = x1[i] * s_ + x2[i] * c_; }
                r1 = pk8(y1); r2 = pk8(y2);
            }
            *(u32x4*)(Ks + key * 72 + dq * 8) = r1; *(u32x4*)(Ks + key * 72 + 32 + dq * 8) = r2;
        } else {
            const int t2 = tid - 256, key = t2 >> 2, dq = t2 & 3;
            const bf16_t* src = P + (krow0 + key) * 3328 + 2560 + 640 + g * 64 + dq * 16;
            const u32x4 r1 = *(const u32x4*)src, r2 = *(const u32x4*)(src + 8);
            bf16_t* vp = Vt + (dq * 16) * 72 + key;
            vp[0 * 72] = (bf16_t)(r1.x & 0xffff); vp[1 * 72] = (bf16_t)(r1.x >> 16); vp[2 * 72] = (bf16_t)(r1.y & 0xffff); vp[3 * 72] = (bf16_t)(r1.y >> 16);
            vp[4 * 72] = (bf16_t)(r1.z & 0xffff); vp[5 * 72] = (bf16_t)(r1.z >> 16); vp[6 * 72] = (bf16_t)(r1.w & 0xffff); vp[7 * 72] = (bf16_t)(r1.w >> 16);
            vp[8 * 72] = (bf16_t)(r2.x & 0xffff); vp[9 * 72] = (bf16_t)(r2.x >> 16); vp[10 * 72] = (bf16_t)(r2.y & 0xffff); vp[11 * 72] = (bf16_t)(r2.y >> 16);
            vp[12 * 72] = (bf16_t)(r2.z & 0xffff); vp[13 * 72] = (bf16_t)(r2.z >> 16); vp[14 * 72] = (bf16_t)(r2.w & 0xffff); vp[15 * 72] = (bf16_t)(r2.w >> 16);
        }
        __syncthreads();
        f32x16 s0, s1;
#pragma unroll
        for (int i = 0; i < 16; ++i) { s0[i] = 0.f; s1[i] = 0.f; }
#pragma unroll
        for (int s = 0; s < 4; ++s) {
            const bf16x8 a0 = *(const bf16x8*)(Ks + l31 * 72 + 16 * s + 8 * hf), a1 = *(const bf16x8*)(Ks + (32 + l31) * 72 + 16 * s + 8 * hf);
            s0 = __builtin_amdgcn_mfma_f32_32x32x16_bf16(a0, qf[s], s0, 0, 0, 0);
            s1 = __builtin_amdgcn_mfma_f32_32x32x16_bf16(a1, qf[s], s1, 0, 0, 0);
        }
        if (win) {
#pragma unroll
            for (int i = 0; i < 16; ++i) { const int key = 8 * (i >> 2) + 4 * hf + (i & 3); const int d0 = qpos - (w0 + key), d1 = d0 - 32;
                if (d0 > 128 || d0 < -128) s0[i] = -INFINITY;
                if (d1 > 128 || d1 < -128) s1[i] = -INFINITY; }
        }
        float mt = s0[0];
#pragma unroll
        for (int i = 1; i < 16; ++i) mt = fmaxf(mt, s0[i]);
#pragma unroll
        for (int i = 0; i < 16; ++i) mt = fmaxf(mt, s1[i]);
        mt = fmaxf(mt, __shfl_xor(mt, 32));
        const float mnew = fmaxf(m, mt), alpha = __builtin_amdgcn_exp2f(m - mnew);
        m = mnew;
        float rs = 0.f;
#pragma unroll
        for (int i = 0; i < 16; ++i) { s0[i] = __builtin_amdgcn_exp2f(s0[i] - mnew); s1[i] = __builtin_amdgcn_exp2f(s1[i] - mnew); rs += s0[i] + s1[i]; }
        lsum = lsum * alpha + rs;
#pragma unroll
        for (int i = 0; i < 16; ++i) { O0[i] *= alpha; O1[i] *= alpha; }
#pragma unroll
        for (int kt = 0; kt < 2; ++kt)
#pragma unroll
            for (int s2 = 0; s2 < 2; ++s2) {
                u32x4 pw;
                if (kt == 0) { pw.x = pk2(s0[8 * s2], s0[8 * s2 + 1]); pw.y = pk2(s0[8 * s2 + 2], s0[8 * s2 + 3]); pw.z = pk2(s0[8 * s2 + 4], s0[8 * s2 + 5]); pw.w = pk2(s0[8 * s2 + 6], s0[8 * s2 + 7]); }
                else { pw.x = pk2(s1[8 * s2], s1[8 * s2 + 1]); pw.y = pk2(s1[8 * s2 + 2], s1[8 * s2 + 3]); pw.z = pk2(s1[8 * s2 + 4], s1[8 * s2 + 5]); pw.w = pk2(s1[8 * s2 + 6], s1[8 * s2 + 7]); }
                const bf16x8 pf = __builtin_bit_cast(bf16x8, pw);
#pragma unroll
                for (int mt2 = 0; mt2 < 2; ++mt2) {
                    const bf16_t* vp = Vt + (mt2 * 32 + l31) * 72 + kt * 32 + 16 * s2 + 4 * hf;
                    const u32x2 lo = *(const u32x2*)vp, hi = *(const u32x2*)(vp + 8);
                    u32x4 vv; vv.x = lo.x; vv.y = lo.y; vv.z = hi.x; vv.w = hi.y;
                    const bf16x8 vf = __builtin_bit_cast(bf16x8, vv);
                    if (mt2 == 0) O0 = __builtin_amdgcn_mfma_f32_32x32x16_bf16(vf, pf, O0, 0, 0, 0);
                    else O1 = __builtin_amdgcn_mfma_f32_32x32x16_bf16(vf, pf, O1, 0, 0, 0);
                }
            }
    }
    const float ltot = lsum + __shfl_xor(lsum, 32);
    const float inv = 1.0f / ltot;
    bf16_t* yp = Y + qrow * 1024 + 512 + hh * 64;
#pragma unroll
    for (int ib = 0; ib < 4; ++ib) {
        u32x2 o; o.x = pk2(O0[4 * ib] * inv, O0[4 * ib + 1] * inv); o.y = pk2(O0[4 * ib + 2] * inv, O0[4 * ib + 3] * inv);
        *(u32x2*)(yp + 8 * ib + 4 * hf) = o;
        u32x2 o2; o2.x = pk2(O1[4 * ib] * inv, O1[4 * ib + 1] * inv); o2.y = pk2(O1[4 * ib + 2] * inv, O1[4 * ib + 3] * inv);
        *(u32x2*)(yp + 32 + 8 * ib + 4 * hf) = o2;
    }
    __syncthreads();
}

__device__ __forceinline__ float partner32(float x) {
    const unsigned xb = __builtin_bit_cast(unsigned, x);
    auto r = __builtin_amdgcn_permlane32_swap(xb, xb, false, false);
    const unsigned pb = (r[0] == xb) ? r[1] : r[0];
    return __builtin_bit_cast(float, pb);
}
__device__ __forceinline__ void s5_scan_task(const Params& p, int jo, int task, unsigned char* smw) {
    unsigned char* const ws = ows(p.ws);
    const int lane = otid() & 63, l31 = lane & 31, hf = lane >> 5, l15 = lane & 15, kg = lane >> 4;
    const int dir = task & 1, g = (task >> 1) & 31, b = task >> 6;
    bf16_t* Xs = (bf16_t*)smw;
    const bf16_t* P = (const bf16_t*)(ws + OFF_AR + AO_YG);
    bf16_t* Yd = (bf16_t*)(ws + (dir ? OFF_S5B : OFF_S5F));
    const size_t rb = (size_t)b * SB;
    const int idx0 = ((jo * 2 + dir) * 32 + g) * 64 + l31, idx1 = idx0 + 32;
    const float* AB = (const float*)(ws + OFF_AB);
    const float ar0 = AB[idx0 * 2], ai0 = AB[idx0 * 2 + 1], ar1 = AB[idx1 * 2], ai1 = AB[idx1 * 2 + 1];
    bf16x8 bbf[4];
    { const float* BR = (const float*)(ws + OFF_BBR); const float* BI = (const float*)(ws + OFF_BBI);
      float t8[8];
#pragma unroll
      for (int j = 0; j < 8; ++j) t8[j] = BR[(size_t)idx0 * 16 + 8 * hf + j];
      bbf[0] = __builtin_bit_cast(bf16x8, pk8(t8));
#pragma unroll
      for (int j = 0; j < 8; ++j) t8[j] = BR[(size_t)idx1 * 16 + 8 * hf + j];
      bbf[1] = __builtin_bit_cast(bf16x8, pk8(t8));
#pragma unroll
      for (int j = 0; j < 8; ++j) t8[j] = BI[(size_t)idx0 * 16 + 8 * hf + j];
      bbf[2] = __builtin_bit_cast(bf16x8, pk8(t8));
#pragma unroll
      for (int j = 0; j < 8; ++j) t8[j] = BI[(size_t)idx1 * 16 + 8 * hf + j];
      bbf[3] = __builtin_bit_cast(bf16x8, pk8(t8)); }
    bf16x8 cmf[4], dskf;
    { const float* c1 = p.in[23] + (size_t)((jo * 32 + g) * 16 + l15) * 64; const float* c2 = p.in[24] + (size_t)((jo * 32 + g) * 16 + l15) * 64;
#pragma unroll
      for (int ks = 0; ks < 4; ++ks) { float t8[8];
#pragma unroll
          for (int j = 0; j < 8; ++j) { const int n = 8 * ks + 2 * kg + (j >> 2), q = j & 3; const int pp = n + 32 * (q & 1); t8[j] = (q < 2) ? c1[pp] : -c2[pp]; }
          cmf[ks] = __builtin_bit_cast(bf16x8, pk8(t8)); }
      float t8[8]; const float dv = p.in[25][jo * 512 + g * 16 + l15];
#pragma unroll
      for (int j = 0; j < 8; ++j) t8[j] = (kg < 2 && 8 * kg + j == l15) ? dv : 0.f;
      dskf = __builtin_bit_cast(bf16x8, pk8(t8)); }
    float xr0 = 0.f, xi0 = 0.f, xr1 = 0.f, xi1 = 0.f;
    u32x4 ua = *(const u32x4*)(P + (rb + scan_row(dir, l31)) * 512 + g * 16 + 8 * hf);
    for (int c = 0; c < 72; ++c) {
        f32x16 D0, D1, D2, D3;
#pragma unroll
        for (int i = 0; i < 16; ++i) { D0[i] = 0.f; D1[i] = 0.f; D2[i] = 0.f; D3[i] = 0.f; }
        { const bf16x8 uf = __builtin_bit_cast(bf16x8, ua);
          D0 = __builtin_amdgcn_mfma_f32_32x32x16_bf16(uf, bbf[0], D0, 0, 0, 0); D1 = __builtin_amdgcn_mfma_f32_32x32x16_bf16(uf, bbf[1], D1, 0, 0, 0);
          D2 = __builtin_amdgcn_mfma_f32_32x32x16_bf16(uf, bbf[2], D2, 0, 0, 0); D3 = __builtin_amdgcn_mfma_f32_32x32x16_bf16(uf, bbf[3], D3, 0, 0, 0); }
        if (c + 1 < 72) ua = *(const u32x4*)(P + (rb + scan_row(dir, (c + 1) * 32 + l31)) * 512 + g * 16 + 8 * hf);
#pragma unroll
        for (int m = 0; m < 4; ++m) {
            float A_[4][4], B_[4][4];
#pragma unroll
            for (int k = 0; k < 4; ++k) { const int i = 4 * m + k;
                const float n0r = ar0 * xr0 - ai0 * xi0 + D0[i], n0i = ar0 * xi0 + ai0 * xr0 + D2[i];
                const float n1r = ar1 * xr1 - ai1 * xi1 + D1[i], n1i = ar1 * xi1 + ai1 * xr1 + D3[i];
                xr0 = n0r; xi0 = n0i; xr1 = n1r; xi1 = n1i; A_[k][0] = xr0; A_[k][1] = xr1; A_[k][2] = xi0; A_[k][3] = xi1; }
            { const float q0 = partner32(xr0), q1 = partner32(xi0), q2 = partner32(xr1), q3 = partner32(xi1);
              xr0 = hf ? q0 : xr0; xi0 = hf ? q1 : xi0; xr1 = hf ? q2 : xr1; xi1 = hf ? q3 : xi1; }
#pragma unroll
            for (int k = 0; k < 4; ++k) { const int i = 4 * m + k;
                const float n0r = ar0 * xr0 - ai0 * xi0 + D0[i], n0i = ar0 * xi0 + ai0 * xr0 + D2[i];
                const float n1r = ar1 * xr1 - ai1 * xi1 + D1[i], n1i = ar1 * xi1 + ai1 * xr1 + D3[i];
                xr0 = n0r; xi0 = n0i; xr1 = n1r; xi1 = n1i; B_[k][0] = xr0; B_[k][1] = xr1; B_[k][2] = xi0; B_[k][3] = xi1; }
            { const float q0 = partner32(xr0), q1 = partner32(xi0), q2 = partner32(xr1), q3 = partner32(xi1);
              xr0 = hf ? xr0 : q0; xi0 = hf ? xi0 : q1; xr1 = hf ? xr1 : q2; xi1 = hf ? xi1 : q3; }
#pragma unroll
            for (int k = 0; k < 4; ++k) { const int t = 8 * m + 4 * hf + k;
                u32x2 w2; w2.x = pk2(hf ? B_[k][0] : A_[k][0], hf ? B_[k][1] : A_[k][1]); w2.y = pk2(hf ? B_[k][2] : A_[k][2], hf ? B_[k][3] : A_[k][3]);
                *(u32x2*)(Xs + t * 136 + 4 * l31) = w2; }
        }
        asm volatile("s_waitcnt lgkmcnt(0)" ::: "memory"); __builtin_amdgcn_wave_barrier();
#pragma unroll
        for (int tt = 0; tt < 2; ++tt) {
            f32x4 acc = {0.f, 0.f, 0.f, 0.f};
#pragma unroll
            for (int ks = 0; ks < 4; ++ks) { const bf16x8 a = *(const bf16x8*)(Xs + (16 * tt + l15) * 136 + 32 * ks + 8 * kg);
                acc = __builtin_amdgcn_mfma_f32_16x16x32_bf16(a, cmf[ks], acc, 0, 0, 0); }
#pragma unroll
            for (int i = 0; i < 4; ++i) { const size_t row = rb + scan_row(dir, c * 32 + 16 * tt + 4 * kg + i); Yd[row * 512 + g * 16 + l15] = (bf16_t)(pk2(acc[i], 0.f) & 0xffff); }
        }
        asm volatile("s_waitcnt lgkmcnt(0)" ::: "memory"); __builtin_amdgcn_wave_barrier();
    }
}
__device__ __forceinline__ void rwkv_prep_rows(const Params& p, int jo) {
    unsigned char* const ws = ows(p.ws);
    const int tid_ = otid(); const int lane = tid_ & 63, w = tid_ >> 6;
    const bf16_t* P = (const bf16_t*)(ws + OFF_AR + AO_P);
    bf16_t* PR = (bf16_t*)(ws + OFF_AR + AO_PR); bf16_t* Lb = (bf16_t*)(ws + OFF_AR + AO_L);
    bf16_t* YGu = (bf16_t*)(ws + OFF_AR + AO_YG);
    float* KN = (float*)(ws + OFF_KN);
    const int nwv = gridDim.x * 8, rpw = (TT + nwv - 1) / nwv, row_lo = (blockIdx.x * 8 + w) * rpw, row_hi = (row_lo + rpw < TT) ? row_lo + rpw : TT;
    if (row_lo >= row_hi) return;
    const bool l3 = lane < 48;
    f32x4 mu4[4][2];
#pragma unroll
    for (int it = 0; it < 4; ++it) { const int c0 = (lane + 64 * it) * 8;
        if (it < 3 || l3) { mu4[it][0] = *(const f32x4*)(p.in[27] + jo * 1920 + c0); mu4[it][1] = *(const f32x4*)(p.in[27] + jo * 1920 + c0 + 4); }
        else { mu4[it][0] = f32x4{0.f, 0.f, 0.f, 0.f}; mu4[it][1] = mu4[it][0]; } }
    const f32x4 kk0 = *(const f32x4*)(p.in[33] + jo * 512 + lane * 8), kk1 = *(const f32x4*)(p.in[33] + jo * 512 + lane * 8 + 4);
    u32x4 pa[4], px[4], pn[4];
    { const int rp = row_lo > 0 ? row_lo - 1 : 0;
#pragma unroll
      for (int it = 0; it < 4; ++it) { const int c0 = (lane + 64 * it) * 8;
        if (it < 3 || l3) { pa[it] = *(const u32x4*)(P + (size_t)rp * 2560 + 512 + c0); px[it] = *(const u32x4*)(P + (size_t)row_lo * 2560 + 512 + c0); }
        else { pa[it] = u32x4{0u, 0u, 0u, 0u}; px[it] = pa[it]; } } }
    for (int row = row_lo; row < row_hi; ++row) {
        const int s = row % SB;
        const float hp = (s != 0 && s != 256) ? 0.5f : 0.f, hn = (s != 255 && s != 2303) ? 0.5f : 0.f;
        const int rn = row + 1 < TT ? row + 1 : TT - 1;
#pragma unroll
        for (int it = 0; it < 4; ++it) { const int c0 = (lane + 64 * it) * 8;
            if (it < 3 || l3) pn[it] = *(const u32x4*)(P + (size_t)rn * 2560 + 512 + c0); else pn[it] = u32x4{0u, 0u, 0u, 0u}; }
        *(u32x4*)(YGu + (size_t)row * 512 + lane * 8) = *(const u32x4*)(P + (size_t)row * 2560 + lane * 8);
#pragma unroll
        for (int it = 0; it < 4; ++it) {
            const int c0 = (lane + 64 * it) * 8;
            float x[8], a[8], bq[8], o[8];
            unpk8(px[it], x); unpk8(pa[it], a); unpk8(pn[it], bq);
#pragma unroll
            for (int i = 0; i < 8; ++i) { const float m = (i < 4) ? mu4[it][0][i & 3] : mu4[it][1][i & 3];
                o[i] = x[i] + m * (hp * a[i] + hn * bq[i] - x[i]); }
            if (it == 3) {
                if (lane < 16) {
#pragma unroll
                    for (int i = 0; i < 8; ++i) o[i] = tanh_f(o[i]); }
                else if (lane >= 32) {
#pragma unroll
                    for (int i = 0; i < 8; ++i) o[i] = sigm(o[i]); } }
            if (it == 1) { float ssq = 0.f;
#pragma unroll
                for (int i = 0; i < 8; ++i) { const float t_ = o[i] * ((i < 4) ? kk0[i & 3] : kk1[i & 3]); ssq += t_ * t_; }
                ssq = sum8(ssq);
                if ((lane & 7) == 0) KN[(size_t)row * 8 + (lane >> 3)] = 1.0f / fmaxf(sqrtf(ssq), 1e-12f); }
            if (it < 3) *(u32x4*)(PR + (size_t)row * 1536 + c0) = pk8(o);
            else if (l3) *(u32x4*)(Lb + (size_t)row * 384 + (c0 - 1536)) = pk8(o);
        }
#pragma unroll
        for (int it = 0; it < 4; ++it) { pa[it] = px[it]; px[it] = pn[it]; }
    }
}
__device__ __forceinline__ void rwkv_stage_loop(const Params& p, int jo, int first, int stride, int nitems, unsigned char* sm) {
    unsigned char* const ws = ows(p.ws);
    const int tid = otid();
    if (first >= nitems) return;
    const bf16_t* PR = (const bf16_t*)(ws + OFF_AR + AO_PR); const bf16_t* LO = (const bf16_t*)(ws + OFF_AR + AO_P);
    const float* KN = (const float*)(ws + OFF_KN);
    float* L_lw = (float*)sm; float* L_av = L_lw + 64 * 68; float* L_bv = L_av + 64 * 68; float* L_kd = L_bv + 64 * 68; float* L_rr = L_kd + 64 * 68;
    const int t64 = tid >> 3, c8 = (tid & 7) * 8;
    u32x4 gr, gk, gw, ga; float inn;
#define RS_LOAD(IT_) do { const int u_ = (IT_) / 36, R_ = (IT_) - u_ * 36, dir_ = u_ & 1, hd_ = (u_ >> 1) & 7, b_ = u_ >> 4; \
        const size_t row = (size_t)b_ * SB + scan_row(dir_, 64 * R_ + t64); const int ch_ = hd_ * 64 + c8; \
        gr = *(const u32x4*)(PR + row * 1536 + ch_); gk = *(const u32x4*)(PR + row * 1536 + 512 + ch_); \
        gw = *(const u32x4*)(LO + row * 2560 + dir_ * 512 + ch_); ga = *(const u32x4*)(LO + row * 2560 + 1024 + dir_ * 512 + ch_); inn = KN[row * 8 + hd_]; } while (0)
    f32x4 w0r[2], a0r[2], kkr[2], kar[2]; int cur_u = -1;
#pragma unroll
    for (int i = 0; i < 2; ++i) { w0r[i] = (f32x4){0.f, 0.f, 0.f, 0.f}; a0r[i] = w0r[i]; kkr[i] = w0r[i]; kar[i] = w0r[i]; }
    RS_LOAD(first);
    for (int item = first; item < nitems; item += stride) {
    const int u = item / 36, R = item - u * 36;
    const int dir = u & 1, hd = (u >> 1) & 7;
    {
        const int ch = hd * 64 + c8;
        float r8[8], k8[8], wl8[8], al8[8];
        unpk8(gr, r8); unpk8(gk, k8); unpk8(gw, wl8); unpk8(ga, al8);
        if (u != cur_u) { cur_u = u;
            const float* w0p = p.in[28] + (jo * 2 + dir) * 512 + ch; const float* a0p = p.in[30] + (jo * 2 + dir) * 512 + ch;
            const float* kkp = p.in[33] + jo * 512 + ch; const float* kap = p.in[34] + jo * 512 + ch;
#pragma unroll
            for (int i = 0; i < 2; ++i) { w0r[i] = *(const f32x4*)(w0p + 4 * i); a0r[i] = *(const f32x4*)(a0p + 4 * i); kkr[i] = *(const f32x4*)(kkp + 4 * i); kar[i] = *(const f32x4*)(kap + 4 * i); } }
        float lw[8], av[8], bv[8], kd[8];
#pragma unroll
        for (int i = 0; i < 8; ++i) {
            const float w0v = w0r[i >> 2][i & 3], a0v = a0r[i >> 2][i & 3], kkv = kkr[i >> 2][i & 3], kav = kar[i >> 2][i & 3];
            const float z = -(w0v + wl8[i]);
            const float sp = fmaxf(z, 0.f) + 0.6931471805599453f * __builtin_amdgcn_logf(1.0f + __builtin_amdgcn_exp2f(-1.4426950408889634f * fabsf(z)));
            lw[i] = -__builtin_amdgcn_exp2f(-1.4426950408889634f * (sp + 0.5f)) * 1.4426950408889634f;
            const float a = sigm(a0v + al8[i]);
            const float kn = k8[i] * kkv * inn;
            kd[i] = k8[i] * (1.0f + (a - 1.0f) * kav); av[i] = -kn; bv[i] = kn * a;
        }
        const int o = t64 * 68 + c8;
        *(f32x4*)(L_lw + o) = (f32x4){lw[0], lw[1], lw[2], lw[3]}; *(f32x4*)(L_lw + o + 4) = (f32x4){lw[4], lw[5], lw[6], lw[7]};
        *(f32x4*)(L_av + o) = (f32x4){av[0], av[1], av[2], av[3]}; *(f32x4*)(L_av + o + 4) = (f32x4){av[4], av[5], av[6], av[7]};
        *(f32x4*)(L_bv + o) = (f32x4){bv[0], bv[1], bv[2], bv[3]}; *(f32x4*)(L_bv + o + 4) = (f32x4){bv[4], bv[5], bv[6], bv[7]};
        *(f32x4*)(L_kd + o) = (f32x4){kd[0], kd[1], kd[2], kd[3]}; *(f32x4*)(L_kd + o + 4) = (f32x4){kd[4], kd[5], kd[6], kd[7]};
        *(f32x4*)(L_rr + o) = (f32x4){r8[0], r8[1], r8[2], r8[3]}; *(f32x4*)(L_rr + o + 4) = (f32x4){r8[4], r8[5], r8[6], r8[7]};
    }
    LDS_BARRIER();
    if (item + stride < nitems) { RS_LOAD(item + stride); }
    {
        const int sq = tid >> 7, tl = tid & 127, sj = tl >> 1, th = tl & 1;
        float cw[8], lwk[8]; float run = 0.f;
#pragma unroll
        for (int k = 0; k < 8; ++k) { lwk[k] = L_lw[(sq * 16 + 8 * th + k) * 68 + sj]; run += lwk[k]; cw[k] = run; }
        const float ptot = dppf<0xB1>(run);
        const float off = th ? ptot : 0.f, cw15 = run + ptot;
        u32x2* GE = (u32x2*)(ws + OFF_GE) + ((size_t)(u * 144 + 4 * R + sq) * 64 + sj) * 16 + 8 * th;
#pragma unroll
        for (int k = 0; k < 8; ++k) {
            const int o = (sq * 16 + 8 * th + k) * 68 + sj;
            const float c = off + cw[k];
            const float Ec = __builtin_amdgcn_exp2f(c), Ep = __builtin_amdgcn_exp2f(c - lwk[k]), iE = __builtin_amdgcn_rcpf(Ec);
            u32x2 ov; ov.x = pk2(L_av[o] * Ep, L_rr[o] * Ec); ov.y = pk2(L_bv[o] * iE, L_kd[o] * iE);
            GE[k] = ov;
        }
        ((float*)(ws + OFF_GW))[(size_t)(u * 144 + 4 * R + sq) * 64 + sj] = __builtin_amdgcn_exp2f(cw15);
    }
    LDS_BARRIER();
    }
#undef RS_LOAD
}
__device__ __forceinline__ bf16x8 frag_lo(const f32x4 v) { u32x4 w; w.x = pk2(v[0], v[1]); w.y = pk2(v[2], v[3]); w.z = 0u; w.w = 0u; return __builtin_bit_cast(bf16x8, w); }
__device__ __forceinline__ bf16x8 frag_b64(const bf16_t* pz) { const u32x2 v = *(const u32x2*)pz; u32x4 w; w.x = v.x; w.y = v.y; w.z = 0u; w.w = 0u; return __builtin_bit_cast(bf16x8, w); }
__device__ __forceinline__ u32x2 pk4v(const f32x4 v) { u32x2 r; r.x = pk2(v[0], v[1]); r.y = pk2(v[2], v[3]); return r; }
#define MF16(a, b, c) __builtin_amdgcn_mfma_f32_16x16x32_bf16((a), (b), (c), 0, 0, 0)
constexpr int RW_SCR = 19712, RW_SLOT = 5120, RW_SLOT0 = 4 * RW_SCR;
__device__ __forceinline__ void rwkv_chunk_unit(const Params& p, int jo, int u, unsigned char* sm) {
    unsigned char* const ws = ows(p.ws);
    const int tid = otid(), lane = tid & 63, w = tid >> 6, l15 = lane & 15, kg = lane >> 4;
    const int dir = u & 1, hd = (u >> 1) & 7, b = u >> 4;
    const bf16_t* PR = (const bf16_t*)(ws + OFF_AR + AO_PR); const bf16_t* LO = (const bf16_t*)(ws + OFF_AR + AO_P);
    const float* KN = (const float*)(ws + OFF_KN);
    bf16_t* O = (bf16_t*)(ws + OFF_AR + (dir ? AO_OB : AO_OF));
    const size_t rb = (size_t)b * SB;
    const int sq = tid >> 7, tl = tid & 127, sj = tl >> 1, th = tl & 1, ch = hd * 64 + sj;
    const u32x4* GEb = (const u32x4*)(ws + OFF_GE); const float* GWb = (const float*)(ws + OFF_GW);
    f32x4 S[4];
#pragma unroll
    for (int i = 0; i < 4; ++i) S[i] = (f32x4){0.f, 0.f, 0.f, 0.f};
    u32x4 ge[4], ge2[4]; float e15, e152; unsigned vv[8], vv2[8];
#define RW_LOADX(R_, ge_, e_, vv_) do { const size_t cidx = (size_t)(u * 144 + 4 * (R_) + sq) * 64 + sj; const u32x4* gp = GEb + cidx * 8 + 4 * th; \
        ge_[0] = gp[0]; ge_[1] = gp[1]; ge_[2] = gp[2]; ge_[3] = gp[3]; e_ = GWb[cidx]; \
        _Pragma("unroll") for (int k = 0; k < 8; ++k) { const size_t row = rb + scan_row(dir, (4 * (R_) + sq) * 16 + 8 * th + k); vv_[k] = *(const unsigned*)(PR + row * 1536 + 1024 + (ch & ~1)); } } while (0)
#define RW_LOAD(R_) RW_LOADX(R_, ge2, e152, vv2)
    RW_LOADX(0, ge, e15, vv); RW_LOADX(1, ge2, e152, vv2);
    for (int R = 0; R < 36; ++R) {
        for (int rep1 = 0; rep1 < 1 + DUPB(20); ++rep1) {
            unsigned char* sc = sm + sq * RW_SCR;
            bf16_t* At_ = (bf16_t*)sc; bf16_t* Rt_ = At_ + 16 * 72; bf16_t* Bt_ = Rt_ + 16 * 72; bf16_t* Kt_ = Bt_ + 16 * 72;
            bf16_t* AtT = Kt_ + 16 * 72; bf16_t* BhT = AtT + 64 * 16; bf16_t* KhT = BhT + 64 * 16; bf16_t* Vt_ = KhT + 64 * 16;
            float* WC = (float*)(sc + 18432);
            unsigned at2[4], bh2[4], kh2[4];
#pragma unroll
            for (int k2 = 0; k2 < 4; ++k2) {
                const unsigned x0 = ge[k2].x, y0 = ge[k2].y, x1 = ge[k2].z, y1 = ge[k2].w;
                const int t0 = 8 * th + 2 * k2;
                At_[t0 * 72 + sj] = (bf16_t)(x0 & 0xffff); Rt_[t0 * 72 + sj] = (bf16_t)(x0 >> 16); Bt_[t0 * 72 + sj] = (bf16_t)(y0 & 0xffff); Kt_[t0 * 72 + sj] = (bf16_t)(y0 >> 16);
                At_[(t0 + 1) * 72 + sj] = (bf16_t)(x1 & 0xffff); Rt_[(t0 + 1) * 72 + sj] = (bf16_t)(x1 >> 16); Bt_[(t0 + 1) * 72 + sj] = (bf16_t)(y1 & 0xffff); Kt_[(t0 + 1) * 72 + sj] = (bf16_t)(y1 >> 16);
                at2[k2] = (x0 & 0xffffu) | (x1 << 16);
                bh2[k2] = pk2(bf2f(y0 & 0xffff) * e15, bf2f(y1 & 0xffff) * e15);
                kh2[k2] = pk2(bf2f(y0 >> 16) * e15, bf2f(y1 >> 16) * e15);
            }
            *(u32x4*)(AtT + sj * 16 + 8 * th) = (u32x4){at2[0], at2[1], at2[2], at2[3]};
            *(u32x4*)(BhT + sj * 16 + 8 * th) = (u32x4){bh2[0], bh2[1], bh2[2], bh2[3]};
            *(u32x4*)(KhT + sj * 16 + 8 * th) = (u32x4){kh2[0], kh2[1], kh2[2], kh2[3]};
            { const int vs = (ch & 1) * 16; u32x4 v4; v4.x = ((vv[0] >> vs) & 0xffffu) | ((vv[1] >> vs) << 16); v4.y = ((vv[2] >> vs) & 0xffffu) | ((vv[3] >> vs) << 16); v4.z = ((vv[4] >> vs) & 0xffffu) | ((vv[5] >> vs) << 16); v4.w = ((vv[6] >> vs) & 0xffffu) | ((vv[7] >> vs) << 16);
              *(u32x4*)(Vt_ + sj * 16 + 8 * th) = v4; }
            if (th == 0) WC[sj] = e15;
        }
#pragma unroll
        for (int k = 0; k < 4; ++k) ge[k] = ge2[k];
#pragma unroll
        for (int k = 0; k < 8; ++k) vv[k] = vv2[k];
        e15 = e152;
        if (R + 2 < 36) { RW_LOAD(R + 2); }
        LDS_BARRIER();
        for (int rep2 = 0; rep2 < 1 + DUPB(21); ++rep2) if (w < 4) {
            unsigned char* sc = sm + w * RW_SCR;
            const bf16_t* At_ = (const bf16_t*)sc; const bf16_t* Rt_ = At_ + 16 * 72; const bf16_t* Bt_ = Rt_ + 16 * 72; const bf16_t* Kt_ = Bt_ + 16 * 72;
            const bf16_t* AtT = Kt_ + 16 * 72; const bf16_t* Vt_ = AtT + 3 * 64 * 16;
            float* Lm = (float*)(sc + 17408);
            unsigned char* sl = sm + RW_SLOT0 + w * RW_SLOT;
            u32x2* ATs = (u32x2*)sl; u32x2* GTs = (u32x2*)(sl + 2048); u32x4* MfS = (u32x4*)(sl + 4096);
            const f32x4 z4 = {0.f, 0.f, 0.f, 0.f};
            f32x4 Lab = z4, LakT = z4, Mbr = z4, Mkr = z4;
#pragma unroll
            for (int ks = 0; ks < 2; ++ks) {
                const bf16x8 af = *(const bf16x8*)(At_ + l15 * 72 + 32 * ks + 8 * kg), rf = *(const bf16x8*)(Rt_ + l15 * 72 + 32 * ks + 8 * kg);
                const bf16x8 bf = *(const bf16x8*)(Bt_ + l15 * 72 + 32 * ks + 8 * kg), kf = *(const bf16x8*)(Kt_ + l15 * 72 + 32 * ks + 8 * kg);
                Lab = MF16(bf, af, Lab); LakT = MF16(af, kf, LakT); Mbr = MF16(bf, rf, Mbr); Mkr = MF16(kf, rf, Mkr);
            }
#pragma unroll
            for (int i = 0; i < 4; ++i) { const int rrow = 4 * kg + i;
                Lab[i] = (rrow < l15) ? Lab[i] : 0.f;
                LakT[i] = (l15 < rrow) ? LakT[i] : 0.f;
                Mbr[i] = (rrow <= l15) ? Mbr[i] : 0.f; Mkr[i] = (rrow <= l15) ? Mkr[i] : 0.f;
                Lm[rrow * 16 + l15] = Lab[i]; }
            { u32x4 mw; mw.x = pk2(Mbr[0], Mbr[1]); mw.y = pk2(Mbr[2], Mbr[3]); mw.z = pk2(Mkr[0], Mkr[1]); mw.w = pk2(Mkr[2], Mkr[3]); MfS[lane] = mw; }
            asm volatile("s_waitcnt lgkmcnt(0)" ::: "memory"); __builtin_amdgcn_wave_barrier();
            float T[16];
#pragma unroll
            for (int r = 15; r >= 0; --r) {
                float acc = (r == l15) ? 1.0f : 0.0f;
                const f32x4 L0 = *(const f32x4*)(Lm + r * 16), L1 = *(const f32x4*)(Lm + r * 16 + 4), L2 = *(const f32x4*)(Lm + r * 16 + 8), L3 = *(const f32x4*)(Lm + r * 16 + 12);
#pragma unroll
                for (int m = r + 1; m < 16; ++m) { const float lv = (m < 4) ? L0[m & 3] : (m < 8) ? L1[m & 3] : (m < 12) ? L2[m & 3] : L3[m & 3]; acc += lv * T[m]; }
                T[r] = acc;
            }
            f32x4 Tsel;
#pragma unroll
            for (int i = 0; i < 4; ++i) Tsel[i] = (kg == 0) ? T[i] : (kg == 1) ? T[4 + i] : (kg == 2) ? T[8 + i] : T[12 + i];
            const bf16x8 Tf = frag_lo(Tsel);
            const f32x4 LT = MF16(frag_lo(LakT), Tf, z4);
            const bf16x8 LTf = frag_lo(LT);
#pragma unroll
            for (int t1 = 0; t1 < 4; ++t1) {
                const f32x4 at = MF16(frag_b64(AtT + (16 * t1 + l15) * 16 + 4 * kg), Tf, z4);
                ATs[t1 * 64 + lane] = pk4v(at);
                const f32x4 gt = MF16(LTf, frag_b64(Vt_ + (16 * t1 + l15) * 16 + 4 * kg), z4);
                GTs[t1 * 64 + lane] = pk4v(gt);
            }
        }
        LDS_BARRIER();
        if (w < 4) {
#pragma unroll
            for (int q = 0; q < 4; ++q) {
                const unsigned char* sc = sm + q * RW_SCR;
                const bf16_t* Rt_ = (const bf16_t*)sc + 16 * 72; const bf16_t* BhT = (const bf16_t*)sc + 4 * 16 * 72 + 64 * 16; const bf16_t* KhT = BhT + 64 * 16; const bf16_t* Vt_ = KhT + 64 * 16;
                const float* WC = (const float*)(sc + 18432);
                const unsigned char* sl = sm + RW_SLOT0 + q * RW_SLOT;
                const u32x2* ATs = (const u32x2*)sl; const u32x2* GTs = (const u32x2*)(sl + 2048); const u32x4* MfS = (const u32x4*)(sl + 4096);
                bf16x8 Sf[2];
#pragma unroll
                for (int pi = 0; pi < 2; ++pi) { u32x4 sw; sw.x = pk2(S[2 * pi][0], S[2 * pi][1]); sw.y = pk2(S[2 * pi][2], S[2 * pi][3]); sw.z = pk2(S[2 * pi + 1][0], S[2 * pi + 1][1]); sw.w = pk2(S[2 * pi + 1][2], S[2 * pi + 1][3]);
                    Sf[pi] = __builtin_bit_cast(bf16x8, sw); }
                f32x4 ut = unpk4v(GTs[w * 64 + lane]);
#pragma unroll
                for (int pi = 0; pi < 2; ++pi) { const u32x2 a0 = ATs[(2 * pi) * 64 + lane], a1 = ATs[(2 * pi + 1) * 64 + lane]; u32x4 aw; aw.x = a0.x; aw.y = a0.y; aw.z = a1.x; aw.w = a1.y;
                    ut = MF16(__builtin_bit_cast(bf16x8, aw), Sf[pi], ut); }
                const u32x2 v2 = *(const u32x2*)(Vt_ + (16 * w + l15) * 16 + 4 * kg);
                u32x4 uvw; uvw.x = pk2(ut[0], ut[1]); uvw.y = pk2(ut[2], ut[3]); uvw.z = v2.x; uvw.w = v2.y;
                const bf16x8 UVf = __builtin_bit_cast(bf16x8, uvw);
                f32x4 oa = MF16(__builtin_bit_cast(bf16x8, MfS[lane]), UVf, ((f32x4){0.f, 0.f, 0.f, 0.f}));
#pragma unroll
                for (int pi = 0; pi < 2; ++pi) { const u32x2 r0 = *(const u32x2*)(Rt_ + l15 * 72 + 32 * pi + 4 * kg), r1 = *(const u32x2*)(Rt_ + l15 * 72 + 32 * pi + 16 + 4 * kg);
                    u32x4 rw; rw.x = r0.x; rw.y = r0.y; rw.z = r1.x; rw.w = r1.y;
                    oa = MF16(__builtin_bit_cast(bf16x8, rw), Sf[pi], oa); }
#pragma unroll
                for (int i = 0; i < 4; ++i) { const size_t row = rb + scan_row(dir, (4 * R + q) * 16 + 4 * kg + i); O[row * 512 + hd * 64 + 16 * w + l15] = (bf16_t)(pk2(oa[i], 0.f) & 0xffff); }
#pragma unroll
                for (int t2 = 0; t2 < 4; ++t2) {
                    const u32x2 b2 = *(const u32x2*)(BhT + (16 * t2 + l15) * 16 + 4 * kg), k2 = *(const u32x2*)(KhT + (16 * t2 + l15) * 16 + 4 * kg);
                    u32x4 bw; bw.x = b2.x; bw.y = b2.y; bw.z = k2.x; bw.w = k2.y;
                    const f32x4 dv = *(const f32x4*)(WC + 16 * t2 + 4 * kg);
                    S[t2] = MF16(__builtin_bit_cast(bf16x8, bw), UVf, S[t2] * dv);
                }
            }
        }
        LDS_BARRIER();
    }
#undef RW_LOAD
#undef RW_LOADX
}
__device__ __forceinline__ void odd_finish_rows(const Params& p, int jo, bool skip_ctx) {
    unsigned char* const ws = ows(p.ws);
    const int tid_ = otid(); const int lane = tid_ & 63, w = tid_ >> 6;
    const bf16_t* YF = (const bf16_t*)(ws + OFF_S5F); const bf16_t* YB = (const bf16_t*)(ws + OFF_S5B);
    bf16_t* YG = (bf16_t*)(ws + OFF_AR + AO_YG);
    const bf16_t* OF = (const bf16_t*)(ws + OFF_AR + AO_OF); const bf16_t* OB = (const bf16_t*)(ws + OFF_AR + AO_OB);
    const bf16_t* PR = (const bf16_t*)(ws + OFF_AR + AO_PR); const bf16_t* LO = (const bf16_t*)(ws + OFF_AR + AO_P);
    bf16_t* Y = (bf16_t*)(ws + OFF_AR + AO_Y);
    const int c0 = lane * 8;
    const int nwv = gridDim.x * 8, rpw = (TT + nwv - 1) / nwv, row_lo = (blockIdx.x * 8 + w) * rpw, row_hi = (row_lo + rpw < TT) ? row_lo + rpw : TT;
    const f32x4 ds0 = *(const f32x4*)(p.in[25] + jo * 512 + c0), ds1 = *(const f32x4*)(p.in[25] + jo * 512 + c0 + 4);
    const f32x4 rk0 = *(const f32x4*)(p.in[35] + jo * 512 + c0), rk1 = *(const f32x4*)(p.in[35] + jo * 512 + c0 + 4);
    const f32x4 lg0 = *(const f32x4*)(p.in[36] + jo * 512 + c0), lg1 = *(const f32x4*)(p.in[36] + jo * 512 + c0 + 4);
    const f32x4 lb0 = *(const f32x4*)(p.in[37] + jo * 512 + c0), lb1 = *(const f32x4*)(p.in[37] + jo * 512 + c0 + 4);
    for (int row = row_lo; row < row_hi; ++row) {
        if (skip_ctx && (row % SB) < 256) continue;
        {
            float fa[8], fb[8], uu[8], o[8];
            unpk8(*(const u32x4*)(YF + (size_t)row * 512 + c0), fa); unpk8(*(const u32x4*)(YB + (size_t)row * 512 + c0), fb);
            unpk8(*(const u32x4*)(YG + (size_t)row * 512 + c0), uu);
#pragma unroll
            for (int i = 0; i < 4; ++i) { o[i] = fa[i] + fb[i] + ds0[i] * uu[i]; o[4 + i] = fa[4 + i] + fb[4 + i] + ds1[i] * uu[4 + i]; }
#pragma unroll
            for (int i = 0; i < 8; ++i) { const float x = o[i]; o[i] = 0.5f * x * (1.0f + tanh_f(0.7978845608028654f * (x + 0.044715f * x * x * x))); }
            *(u32x4*)(YG + (size_t)row * 512 + c0) = pk8(o);
        }
        {
            float o[8], r[8], k[8], v[8], g[8];
            { float fa[8], fb[8]; unpk8(*(const u32x4*)(OF + (size_t)row * 512 + c0), fa); unpk8(*(const u32x4*)(OB + (size_t)row * 512 + c0), fb);
#pragma unroll
              for (int i = 0; i < 8; ++i) o[i] = fa[i] + fb[i]; }
            unpk8(*(const u32x4*)(PR + (size_t)row * 1536 + c0), r); unpk8(*(const u32x4*)(PR + (size_t)row * 1536 + 512 + c0), k); unpk8(*(const u32x4*)(PR + (size_t)row * 1536 + 1024 + c0), v);
            unpk8(*(const u32x4*)(LO + (size_t)row * 2560 + 2048 + c0), g);
            float sm_ = 0.f, bo = 0.f;
#pragma unroll
            for (int i = 0; i < 8; ++i) { sm_ += o[i]; bo += r[i] * k[i] * ((i < 4) ? rk0[i & 3] : rk1[i & 3]); }
            const float mean = sum8(sm_) * (1.0f / 64.0f); bo = sum8(bo);
            float sq = 0.f;
#pragma unroll
            for (int i = 0; i < 8; ++i) { const float d = o[i] - mean; sq += d * d; }
            const float rstd = rsqrtf(sum8(sq) * (1.0f / 64.0f) + 64e-5f);
            float y[8];
#pragma unroll
            for (int i = 0; i < 8; ++i) y[i] = ((o[i] - mean) * rstd * ((i < 4) ? lg0[i & 3] : lg1[i & 3]) + ((i < 4) ? lb0[i & 3] : lb1[i & 3]) + bo * v[i]) * g[i];
            *(u32x4*)(Y + (size_t)row * 1024 + 512 + c0) = pk8(y);
        }
    }
}

#define PHB unsigned char* const ws = ows(p.ws); bf16_t* const H = (bf16_t*)(ws + OFF_H); _Float16* const X = (_Float16*)(ws + OFF_X); const float* const mod = (const float*)(ws + OFF_MOD); bf16_t* const PbE = (bf16_t*)(ws + OFF_AR + AE_P); bf16_t* const YbE = (bf16_t*)(ws + OFF_AR + AE_Y); bf16_t* const PbO = (bf16_t*)(ws + OFF_AR + AO_P); bf16_t* const YbO = (bf16_t*)(ws + OFF_AR + AO_Y); const unsigned* const cnt0 = (const unsigned*)(ws + OFF_CNT); (void)H; (void)X; (void)mod; (void)PbE; (void)YbE; (void)PbO; (void)YbO; (void)cnt0;
#define LAYER_PAIR_BODY(lp) {  \
         \
        { \
            const int layer = 2 * lp, j = lp; \
            if (RUN) { PHB    \
                pg8::Gemm g{H, (const bf16_t*)(ws + OFF_WINE + j * SZ_WINE), 1024, 0}; pg8::StaticOrder S; S.init(TT, 3328, G, cb, 1024); \
                { LAS float* lbl = (LAS float*)(lds + LDS_MAIN + 64); lbl[threadIdx.x] = ((const float*)(ws + OFF_LB))[j * 512 + threadIdx.x]; __syncthreads(); } \
                pg8::EpiEvenIn E{PbE, (const LAS float*)(lds + LDS_MAIN + 64)}; REP(8) pg8::gemm_phase(lds, g, S, E); SYNC; } ++ph; \
            if (RUN) { PHB    \
                if (cb < 128) { hgrn_chunk_unit(p, j, cb, smem); __syncthreads(); } \
                else { for (int it = cb - 128; it < 576; it += G - 128) attn_unit(p, j, it, smem); } \
                if (DUPB(1)) { __syncthreads(); if (cb < 128) { hgrn_chunk_unit(p, j, cb, smem); __syncthreads(); } } \
                if (DUPB(2)) { __syncthreads(); if (cb >= 128) { for (int it = cb - 128; it < 576; it += G - 128) attn_unit(p, j, it, smem); } } SYNC; } ++ph; \
            if (RUN) { PHB    \
                const int nextra = (layer == 2) ? p.ntc : 0; \
                hgrn_finish_rows(p, j); \
                if (DUPB(13)) { hgrn_finish_rows(p, j); } \
                if (nextra > 0) { __syncthreads(); tr_loop(p, cb, G, nextra, p.njm, p.nj1, smem); } \
                SYNC; } ++ph; \
            if (RUN) { PHB    \
                pg8::Gemm g{YbE, (const bf16_t*)(ws + OFF_WOUTE + j * SZ_WSQ), 1024, 0}; pg8::CtxSplitOrder S; S.init(G, cb, 1024, SPLIT_S); \
                pg8::EpiResid E{(bf16_t*)(ws + OFF_AR + AE_P), mod + (size_t)layer * 9 * 6144 + 2048, (bf16_t*)(ws + OFF_AR + AE_P) + (size_t)TT * 1024}; if (DUPB(18)) pg8::gemm_phase(lds, g, S, E); pg8::gemm_phase(lds, g, S, E); SYNC; } ++ph; \
            if (RUN) { PHB if (DUPB(17)) phase_ln<0, false, true>(p, layer, OFF_AR + AE_P, SPLIT_S, smem); phase_ln<0, false>(p, layer, OFF_AR + AE_P, SPLIT_S, smem); SYNC; } ++ph; \
            if (RUN) { PHB    \
                pg8::Gemm g{H, (const bf16_t*)(ws + OFF_WFFN1 + j * SZ_WFFN1), 1024, 0}; pg8::StaticOrder S; S.init(TT, 5632, G, cb, 1024); \
                pg8::EpiSwiGLU E{PbE, 2816}; REP(5) pg8::gemm_phase(lds, g, S, E); SYNC; } ++ph; \
            if (RUN) { PHB    \
                pg8::Gemm g{PbE, (const bf16_t*)(ws + OFF_WFFN2 + j * SZ_WFFN2), 2816, 0}; pg8::CtxSplitOrder S; S.init(G, cb, 2816, SPLIT_S); \
                pg8::EpiResid E{(bf16_t*)(ws + OFF_AR + AE_OF), mod + (size_t)layer * 9 * 6144 + 5120, (bf16_t*)(ws + OFF_AR + AE_OF) + (size_t)TT * 1024}; if (DUPB(18)) pg8::gemm_phase(lds, g, S, E); pg8::gemm_phase(lds, g, S, E); SYNC; } ++ph; \
            if (RUN) { PHB if (DUPB(17)) phase_ln<1, false, true>(p, layer, OFF_AR + AE_OF, SPLIT_S, smem); phase_ln<1, false>(p, layer, OFF_AR + AE_OF, SPLIT_S, smem); SYNC; } ++ph; \
        } \
         \
        { \
            const int layer = 2 * lp + 1, jo = lp; \
            if (RUN) { PHB    \
                pg8::Gemm g{H, (const bf16_t*)(ws + OFF_WINO + jo * SZ_WINO), 1024, 0}; pg8::StaticOrder S; S.init(TT, 2560, G, cb, 1024); \
                pg8::EpiBf16 E{PbO, 2560, nullptr}; if (DUPB(19)) pg8::gemm_phase(lds, g, S, E); pg8::gemm_phase(lds, g, S, E); SYNC; } ++ph; \
            if (RUN) { PHB    \
                rwkv_prep_rows(p, jo); \
                if (DUPB(14)) { rwkv_prep_rows(p, jo); } \
                SYNC; } ++ph; \
            if (RUN) { PHB    \
                pg8::Gemm g{(const bf16_t*)(ws + OFF_AR + AO_L), (const bf16_t*)(ws + OFF_WLORA + jo * SZ_WLORA), 384, 0}; pg8::LoraOrder S; S.init(TT, 2560, G, cb, 384); \
                pg8::EpiBf16 E{PbO, 2560, nullptr}; if (DUPB(19)) pg8::gemm_phase(lds, g, S, E); pg8::gemm_phase(lds, g, S, E); \
                SYNC; } ++ph; \
            if (RUN) { PHB   \
                { const int per = (4608 + G - 1) / G, i0 = cb * per, i1 = (i0 + per < 4608) ? i0 + per : 4608; rwkv_stage_loop(p, jo, i0, 1, i1, smem); } \
                SYNC; } ++ph; \
            if (RUN) { PHB    \
                if (cb < 128) { rwkv_chunk_unit(p, jo, cb, smem); if (DUPB(4)) { __syncthreads(); rwkv_chunk_unit(p, jo, cb, smem); } } \
                else { if (wv < 4) { s5_scan_task(p, jo, (cb - 128) * 4 + wv, smem + wv * 20480); } \
                       if (layer == 1 && p.ntm > 0) { __syncthreads(); tr_loop(p, cb - 128, G - 128, p.ntm, p.nj0, p.njm, smem); } \
                       if (layer == 3 && p.nt1 > p.ntc) { __syncthreads(); tr_loop(p, p.ntc + (cb - 128), G - 128, p.nt1, p.njm, p.nj1, smem); } } \
                SYNC; } ++ph; \
            if (RUN) { PHB odd_finish_rows(p, jo, layer == 3); SYNC; } ++ph; \
            if (RUN) { PHB    \
                pg8::Gemm g{(const bf16_t*)(ws + OFF_AR + AO_YG), (const bf16_t*)(ws + OFF_WGLU + jo * SZ_WGLU), 512, 0}; pg8::StaticOrder S; S.init(TT, 512, G, cb, 512); \
                pg8::EpiGLU E{(const bf16_t*)(ws + OFF_AR + AO_YG), YbO}; if (DUPB(19)) pg8::gemm_phase(lds, g, S, E); pg8::gemm_phase(lds, g, S, E); \
                SYNC; } ++ph; \
            if (RUN) { PHB    \
                pg8::Gemm g{YbO, (const bf16_t*)(ws + OFF_WOUTO + jo * SZ_WSQ), 1024, 0}; pg8::CtxSplitOrder S; S.init(G, cb, 1024, layer == 3 ? 0 : SPLIT_S); \
                pg8::EpiResid E{(bf16_t*)(ws + OFF_GE), mod + (size_t)layer * 9 * 6144 + 2048, (bf16_t*)(ws + OFF_GE) + (size_t)TT * 1024}; if (DUPB(18)) pg8::gemm_phase(lds, g, S, E); pg8::gemm_phase(lds, g, S, E); SYNC; } ++ph; \
            if (RUN) { PHB if (DUPB(17)) phase_ln<0, true, true>(p, layer, OFF_GE, SPLIT_S, smem); phase_ln<0, true>(p, layer, OFF_GE, SPLIT_S, smem); SYNC; } ++ph; \
            if (RUN) { PHB    \
                pg8::Gemm g{H, (const bf16_t*)(ws + OFF_WMOE1), 1024, SZ_WFFN1}; pg8::MoeOrder S; S.init((cnt0 + jo * 512), 22, G, cb, 1024); \
                LAS int* ridx = (LAS int*)(lds + LDS_MAIN + 64 + 2048); \
                { const unsigned* inv = (const unsigned*)(ws + OFF_INV); pg8::Unit u; \
                  for (int i = 0; i < 16 && S.next(i, u); ++i) { if (threadIdx.x < 256) { int pst = 0; _Pragma("unroll") for (int k = 0; k < 7; ++k) pst = (u.e > k) ? S.pend[k] : pst; \
                      const int r = (u.pm - pst) * 256 + (int)threadIdx.x; ridx[i * 256 + threadIdx.x] = (r < (int)(cnt0 + jo * 512)[u.e * 64]) ? (int)inv[(size_t)u.e * TT + r] : 0; } } \
                  __syncthreads(); } \
                pg8::EpiSwiGLU E{(bf16_t*)(ws + OFF_AR + AM_H), 2816}; pg8::gemm_phase<pg8::EpiSwiGLU, pg8::MoeOrder, true>(lds, g, S, E, ridx); SYNC; } ++ph; \
            if (RUN) { PHB    \
                pg8::Gemm g{(const bf16_t*)(ws + OFF_AR + AM_H), (const bf16_t*)(ws + OFF_WMOE2), 2816, SZ_WFFN2}; pg8::MoeOrder S; S.init((cnt0 + jo * 512), 4, G, cb, 2816, true); \
                pg8::EpiBf16 E{(bf16_t*)(ws + OFF_AR + AM_A), 1024, (bf16_t*)(ws + OFF_GE)}; REP(7) pg8::gemm_phase(lds, g, S, E); SYNC; } ++ph; \
            if (RUN) { PHB if (DUPB(17)) phase_ln<2, false, true>(p, layer, 0, 0, smem); phase_ln<2, false>(p, layer, 0, 0, smem); SYNC; } ++ph; \
        } \
     }
constexpr int LDS_MAIN = 131072;
constexpr int LDS_BYTES = LDS_MAIN + 64 + 2048 + 16384;
__global__ void __launch_bounds__(512, 2) mega(const Params p) {
    extern __shared__ __attribute__((aligned(16))) unsigned char smem[];
    LAS unsigned char* lds = (LAS unsigned char*)smem;
    volatile LAS unsigned* xbw = (volatile LAS unsigned*)(lds + LDS_MAIN);
    if (threadIdx.x == 0) { xbw[0] = 0u; xbw[1] = 0u; xbw[2] = 0u; xbw[3] = 0u; }
    __syncthreads();
    const bool multi = (p.hi - p.lo) > 1;
    XcdBarrier bar; bar.bar = (unsigned*)(p.ws + OFF_BAR); bar.x = 0; bar.st = xbw;
    if (multi) bar = xcd_barrier_post((unsigned*)(p.ws + OFF_BAR), xbw);
    const int G = gridDim.x, cb = blockIdx.x, wv = threadIdx.x >> 6;
    int ph = 0;
#define RUN (ph >= p.lo && ph < p.hi)
#define SYNC do { if (multi && ph + 1 < p.hi) { xcd_barrier(bar); if (DUPB(12)) xcd_barrier(bar); } else __syncthreads(); } while (0)

    if (RUN) { REP(0) { phase_prologue_a(p, smem); __syncthreads(); } SYNC; } ++ph;
    if (RUN) { phase_prologue_b(p); SYNC; } ++ph;

    LAYER_PAIR_BODY(0)
    LAYER_PAIR_BODY(1)
#undef RUN
#undef SYNC
}

static void add_job(Params& P, int& nj, int& nt, const float* src, bf16_t* dst, int K, int N, int ldd, int mode, int aux) {
    Job& j = P.jobs[nj++]; j.src = src; j.dst = dst; j.K = K; j.N = N; j.ldd = ldd; j.mode = mode; j.tile0 = nt; j.aux = aux; nt += (K / 128) * (N / 128);
}
extern "C" void kernel_launch(void* const* d_in, const int* in_sizes, int n_in, void* d_out, int out_size, void* d_ws, size_t ws_size, hipStream_t stream) {
    static int ready = 0;
    if (ready == 0) {
        if (n_in != 43 || ws_size < WS_END) { fprintf(stderr, "kernel_launch: need 43 inputs and %zu bytes of workspace, got %d / %zu\n", (size_t)WS_END, n_in, ws_size); ready = -1; return; }
        if (hipFuncSetAttribute((const void*)mega, hipFuncAttributeMaxDynamicSharedMemorySize, LDS_BYTES) != hipSuccess) { fprintf(stderr, "kernel_launch: hipFuncSetAttribute failed\n"); ready = -1; return; }
        ready = 1;
    }
    if (ready < 0) return;
    unsigned char* ws = (unsigned char*)d_ws;
    (void)hipMemsetAsync(ws, 0, ZERO_BYTES, stream);
    Params P; memset(&P, 0, sizeof(P));
    for (int i = 0; i < 43; ++i) P.in[i] = (const float*)d_in[i];
    P.out = (float*)d_out; P.ws = ws;
    int nj = 0, nt = 0;
    for (int j = 0; j < 2; ++j) {
        if (j == 1) { P.nj0 = nj; P.nt0 = nt; nt = 0; }
        add_job(P, nj, nt, P.in[8] + (size_t)j * 1024 * 3328, (bf16_t*)(ws + OFF_WINE + j * SZ_WINE), 1024, 3328, 1024, 0, 0);
        add_job(P, nj, nt, P.in[9] + (size_t)j * 1024 * 1024, (bf16_t*)(ws + OFF_WOUTE + j * SZ_WSQ), 1024, 1024, 1024, 0, 0);
        add_job(P, nj, nt, P.in[13] + (size_t)j * 1024 * 2816, (bf16_t*)(ws + OFF_WFFN1 + j * SZ_WFFN1), 1024, 2816, 1024, 1, 0);
        add_job(P, nj, nt, P.in[14] + (size_t)j * 1024 * 2816, (bf16_t*)(ws + OFF_WFFN1 + j * SZ_WFFN1), 1024, 2816, 1024, 2, 0);
        add_job(P, nj, nt, P.in[15] + (size_t)j * 2816 * 1024, (bf16_t*)(ws + OFF_WFFN2 + j * SZ_WFFN2), 2816, 1024, 2816, 0, 0);
        add_job(P, nj, nt, P.in[16] + (size_t)j * 1024 * 2432, (bf16_t*)(ws + OFF_WINO + j * SZ_WINO), 1024, 2432, 1024, 0, 0);
        add_job(P, nj, nt, nullptr, (bf16_t*)(ws + OFF_WINO + j * SZ_WINO) + (size_t)2432 * 1024, 1024, 128, 1024, 3, 0);
        add_job(P, nj, nt, P.in[17] + (size_t)j * 1024 * 1024, (bf16_t*)(ws + OFF_WOUTO + j * SZ_WSQ), 1024, 1024, 1024, 0, 0);
        add_job(P, nj, nt, nullptr, (bf16_t*)(ws + OFF_WLORA + j * SZ_WLORA), 384, 2560, 384, 4, j);
        add_job(P, nj, nt, P.in[26] + (size_t)j * 512 * 512, (bf16_t*)(ws + OFF_WGLU + j * SZ_WGLU), 512, 512, 512, 0, 0);
        if (j == 1) { P.njm = nj; P.ntm = nt; nt = 0; }
        { const int L = j;
        for (int e = 0; e < 8; ++e) {
            const size_t eo = (size_t)(L * 8 + e) * 1024 * 2816;
            add_job(P, nj, nt, P.in[40] + eo, (bf16_t*)(ws + OFF_WMOE1 + e * SZ_WFFN1), 1024, 2816, 1024, 1, 0);
            add_job(P, nj, nt, P.in[41] + eo, (bf16_t*)(ws + OFF_WMOE1 + e * SZ_WFFN1), 1024, 2816, 1024, 2, 0);
            add_job(P, nj, nt, P.in[42] + eo, (bf16_t*)(ws + OFF_WMOE2 + e * SZ_WFFN2), 2816, 1024, 2816, 0, 0);
        }
        }
    }
    P.nj1 = nj; P.nt1 = nt; P.ntc = nt / 2;
#if MK_SINGLE
    P.lo = 0; P.hi = NPH;
    hipLaunchKernelGGL(mega, dim3(256), dim3(512), LDS_BYTES, stream, P);
#else
    for (int ph = 0; ph < NPH; ++ph) { P.lo = ph; P.hi = ph + 1; hipLaunchKernelGGL(mega, dim3(256), dim3(512), LDS_BYTES, stream, P); }
#endif
}
```

```cpp
#include <hip/hip_runtime.h>
#include <stdint.h>
#include <stdio.h>
#include <string.h>

#ifndef PROBE_DUP
#define PROBE_DUP 0
#endif
#define REP(k) for (int rep_ = 0; rep_ < 1 + ((PROBE_DUP >> (k)) & 1); ++rep_)
#define DUPB(k) ((PROBE_DUP >> (k)) & 1)
#ifndef MK_SINGLE
#define MK_SINGLE 1
#endif

#define LAS __attribute__((address_space(3)))
typedef unsigned short bf16_t;
typedef short bf16x8 __attribute__((ext_vector_type(8)));
typedef short s16x4 __attribute__((ext_vector_type(4)));
typedef float f32x2 __attribute__((ext_vector_type(2)));
typedef float f32x4 __attribute__((ext_vector_type(4)));
typedef float f32x16 __attribute__((ext_vector_type(16)));
typedef unsigned u32x2 __attribute__((ext_vector_type(2)));
typedef unsigned u32x4 __attribute__((ext_vector_type(4)));
typedef __bf16 bfv2 __attribute__((ext_vector_type(2)));

constexpr int TT = 18432;
constexpr int SB = 2304;
constexpr int DM = 1024;
constexpr int NPH = 42;
constexpr float ALPHA = 1.6817928305074290f;
constexpr int SPLIT_S = 2;

constexpr size_t OFF_BAR = 0;
constexpr size_t OFF_CNT = 16384;
constexpr size_t ZERO_BYTES = 32768;
constexpr size_t OFF_MOD = 32768;
constexpr size_t OFF_COS = OFF_MOD + 884736;
constexpr size_t OFF_SIN = OFF_COS + 262144;
constexpr size_t OFF_LB = OFF_SIN + 262144;
constexpr size_t OFF_AB = OFF_LB + 4096;
constexpr size_t OFF_BBR = OFF_AB + 65536;
constexpr size_t OFF_BBI = OFF_BBR + 524288;
constexpr size_t OFF_ROUTE = OFF_BBI + 524288;
constexpr size_t OFF_WINE = OFF_ROUTE + 589824;
constexpr size_t SZ_WINE = (size_t)3328 * 1024 * 2;
constexpr size_t OFF_WOUTE = OFF_WINE + 2 * SZ_WINE;
constexpr size_t SZ_WSQ = (size_t)1024 * 1024 * 2;
constexpr size_t OFF_WFFN1 = OFF_WOUTE + 2 * SZ_WSQ;
constexpr size_t SZ_WFFN1 = (size_t)5632 * 1024 * 2;
constexpr size_t OFF_WFFN2 = OFF_WFFN1 + 2 * SZ_WFFN1;
constexpr size_t SZ_WFFN2 = (size_t)1024 * 2816 * 2;
constexpr size_t OFF_WINO = OFF_WFFN2 + 2 * SZ_WFFN2;
constexpr size_t SZ_WINO = (size_t)2560 * 1024 * 2;
constexpr size_t OFF_WOUTO = OFF_WINO + 2 * SZ_WINO;
constexpr size_t OFF_WLORA = OFF_WOUTO + 2 * SZ_WSQ;
constexpr size_t SZ_WLORA = (size_t)2560 * 384 * 2;
constexpr size_t OFF_WGLU = OFF_WLORA + 2 * SZ_WLORA;
constexpr size_t SZ_WGLU = (size_t)512 * 512 * 2;
constexpr size_t OFF_WMOE1 = OFF_WGLU + 2 * SZ_WGLU;
constexpr size_t OFF_WMOE2 = OFF_WMOE1 + 8 * SZ_WFFN1;
constexpr size_t OFF_X = OFF_WMOE2 + 8 * SZ_WFFN2;
constexpr size_t OFF_H = OFF_X + (size_t)TT * 1024 * 4;
constexpr size_t OFF_AR = OFF_H + (size_t)TT * 1024 * 2;
constexpr size_t AE_P = 0, AE_OF = 122683392, AE_OB = AE_OF + 37748736, AE_Y = AE_OB + 37748736;
constexpr size_t AO_P = 0, AO_OF = 94371840, AO_OB = AO_OF + 37748736, AO_PR = AO_OB + 37748736, AO_L = AO_PR + 56623104, AO_YG = AO_L + 14155776, AO_Y = AO_YG + 18874368;
constexpr size_t AM_A = 0, AM_H = 79691776;
constexpr size_t AR_SIZE = 298844160;
constexpr size_t OFF_KN = OFF_AR + AR_SIZE;
constexpr size_t OFF_GE = OFF_KN + 589824;
constexpr size_t OFF_GW = OFF_GE + (size_t)18432 * 8192;
constexpr size_t OFF_S5F = OFF_GW + (size_t)18432 * 256;
constexpr size_t OFF_S5B = OFF_S5F + (size_t)TT * 512 * 4;
constexpr size_t OFF_INV = OFF_S5B + (size_t)TT * 512 * 4;
constexpr size_t WS_END = OFF_INV + (size_t)8 * TT * 4;

struct Job { const float* src; bf16_t* dst; int K, N, ldd, mode, tile0, aux; };
constexpr int MAXJOBS = 72;
struct Params {
    const float* in[43];
    float* out;
    unsigned char* ws;
    int lo, hi;
    int nj0, njm, nj1;
    int nt0, ntm, nt1;
    int ntc;
    Job jobs[MAXJOBS];
};

__device__ __forceinline__ float bf2f(unsigned v) { return __uint_as_float(v << 16); }
__device__ __forceinline__ unsigned pk2(float lo, float hi) { f32x2 v = {lo, hi}; bfv2 b = __builtin_convertvector(v, bfv2); return __builtin_bit_cast(unsigned, b); }
__device__ __forceinline__ void unpk8(const u32x4 v, float* f) {
    f[0] = __uint_as_float(v.x << 16); f[1] = __uint_as_float(v.x & 0xffff0000u);
    f[2] = __uint_as_float(v.y << 16); f[3] = __uint_as_float(v.y & 0xffff0000u);
    f[4] = __uint_as_float(v.z << 16); f[5] = __uint_as_float(v.z & 0xffff0000u);
    f[6] = __uint_as_float(v.w << 16); f[7] = __uint_as_float(v.w & 0xffff0000u);
}
__device__ __forceinline__ void unpk4(const u32x2 v, float* f) {
    f[0] = __uint_as_float(v.x << 16); f[1] = __uint_as_float(v.x & 0xffff0000u);
    f[2] = __uint_as_float(v.y << 16); f[3] = __uint_as_float(v.y & 0xffff0000u);
}
__device__ __forceinline__ f32x4 unpk4v(const u32x2 v) { f32x4 r; r[0] = __uint_as_float(v.x << 16); r[1] = __uint_as_float(v.x & 0xffff0000u); r[2] = __uint_as_float(v.y << 16); r[3] = __uint_as_float(v.y & 0xffff0000u); return r; }
typedef _Float16 hf4 __attribute__((ext_vector_type(4)));
__device__ __forceinline__ u32x2 f2h4(const f32x4 v) { const hf4 h = __builtin_convertvector(v, hf4); return __builtin_bit_cast(u32x2, h); }
__device__ __forceinline__ f32x4 h2f4(const u32x2 u) { const hf4 h = __builtin_bit_cast(hf4, u); return __builtin_convertvector(h, f32x4); }
__device__ __forceinline__ u32x4 pk8(const float* f) { u32x4 r; r.x = pk2(f[0], f[1]); r.y = pk2(f[2], f[3]); r.z = pk2(f[4], f[5]); r.w = pk2(f[6], f[7]); return r; }
template <int CTRL> __device__ __forceinline__ float dppf(float v) { return __builtin_bit_cast(float, __builtin_amdgcn_update_dpp(0, __builtin_bit_cast(int, v), CTRL, 0xF, 0xF, true)); }
__device__ __forceinline__ float sum8(float v) { v += dppf<0xB1>(v); v += dppf<0x4E>(v); v += dppf<0x141>(v); return v; }
__device__ __forceinline__ float sum16(float v) { v = sum8(v); v += dppf<0x140>(v); return v; }
__device__ __forceinline__ float xsum16(float x) { const unsigned xb = __builtin_bit_cast(unsigned, x); auto r = __builtin_amdgcn_permlane16_swap(xb, xb, false, false);
    return __builtin_bit_cast(float, (unsigned)r[0]) + __builtin_bit_cast(float, (unsigned)r[1]); }
__device__ __forceinline__ float xsum32(float x) { const unsigned xb = __builtin_bit_cast(unsigned, x); auto r = __builtin_amdgcn_permlane32_swap(xb, xb, false, false);
    return __builtin_bit_cast(float, (unsigned)r[0]) + __builtin_bit_cast(float, (unsigned)r[1]); }
__device__ __forceinline__ float sum64(float v) { v = sum16(v); v = xsum16(v); v = xsum32(v); return v; }
__device__ __forceinline__ float sigm(float x) { return __builtin_amdgcn_rcpf(1.0f + __builtin_amdgcn_exp2f(-1.4426950408889634f * x)); }
__device__ __forceinline__ float siluf(float x) { return x * __builtin_amdgcn_rcpf(1.0f + __builtin_amdgcn_exp2f(-1.4426950408889634f * x)); }
__device__ __forceinline__ float tanh_f(float x) { const float e = __builtin_amdgcn_exp2f(-2.8853900817779268f * fabsf(x)); const float t = (1.0f - e) * __builtin_amdgcn_rcpf(1.0f + e); return x < 0.f ? -t : t; }
__device__ __forceinline__ void my_sincos(float x, float& s, float& c) {
    const float q = rintf(x * 0.636619772f);
    float r = fmaf(-q, 1.57079637f, x); r = fmaf(-q, -4.37113883e-8f, r);
    const float r2 = r * r;
    const float sp = r + r * r2 * (-1.6666654611e-1f + r2 * (8.3321608736e-3f + r2 * (-1.9515295891e-4f)));
    const float cp = 1.0f - 0.5f * r2 + r2 * r2 * (4.166664568298827e-2f + r2 * (-1.388731625493765e-3f + r2 * 2.443315711809948e-5f));
    const int qi = ((int)q) & 3;
    s = (qi == 0) ? sp : (qi == 1) ? cp : (qi == 2) ? -sp : -cp;
    c = (qi == 0) ? cp : (qi == 1) ? -sp : (qi == 2) ? -cp : sp;
}
__device__ __forceinline__ unsigned char* ows(unsigned char* q) { const unsigned long long t0 = (unsigned long long)q; unsigned lo = __builtin_amdgcn_readfirstlane((unsigned)t0), hi = __builtin_amdgcn_readfirstlane((unsigned)(t0 >> 32)); asm volatile("" : "+s"(lo), "+s"(hi)); const unsigned long long t = ((unsigned long long)hi << 32) | lo; return (unsigned char*)(__attribute__((address_space(1))) unsigned char*)t; }
#define LDS_BARRIER() do { asm volatile("s_waitcnt lgkmcnt(0)" ::: "memory"); __builtin_amdgcn_s_barrier(); asm volatile("" ::: "memory"); } while (0)
__device__ __forceinline__ int otid() { int t = threadIdx.x; asm volatile("" : "+v"(t)); return t; }
__device__ __forceinline__ int mod_index(int row) { const int b = row / SB, s = row - b * SB; return s < 256 ? 8 : b; }

#define XB_TMO      128
#define XB_XCNT(j)  (256  + 64 * (j))
#define XB_XSUB(j)  (1280 + 64 * (j))
#define XB_XGEN(j)  (2304 + 64 * (j))
#define XB_TOP      3328
#define XB_TOPGEN   3392
#define XCD_BAR_WORDS 3456
#define XB_SPIN_CAP (1u << 18)
__device__ __forceinline__ unsigned xb_ld(unsigned* p)              { return __hip_atomic_load(p, __ATOMIC_RELAXED, __HIP_MEMORY_SCOPE_AGENT); }
__device__ __forceinline__ unsigned xb_add(unsigned* p, unsigned v) { return __hip_atomic_fetch_add(p, v, __ATOMIC_RELAXED, __HIP_MEMORY_SCOPE_AGENT); }
__device__ __forceinline__ unsigned xb_xcc_id() { return (unsigned)__builtin_amdgcn_s_getreg((3 << 11) | 20) & 0xFu; }
#define XB_SPIN(cond, bar) do { unsigned _sp = 0; while (cond) { __builtin_amdgcn_s_sleep(1); \
    if ((++_sp & 255u) == 0u) { if (xb_ld(&(bar)[XB_TMO])) break; if (_sp > XB_SPIN_CAP) { atomicAdd(&(bar)[XB_TMO], 1u); break; } } } } while (0)
struct XcdBarrier { unsigned* bar; unsigned x; volatile LAS unsigned* st; };
__device__ __forceinline__ XcdBarrier xcd_barrier_post(unsigned* bar, volatile LAS unsigned* st) {
    XcdBarrier b; b.bar = bar; b.x = xb_xcc_id(); b.st = st;
    if (threadIdx.x == 0) (void)xb_add(&bar[XB_XCNT(b.x)], 1u);
    return b;
}
__device__ __forceinline__ void xcd_barrier_complete(unsigned* bar, unsigned x, unsigned& nloc, unsigned& nx) {
    const unsigned G = gridDim.x * gridDim.y * gridDim.z;
    unsigned sum, cnt, mine, sp = 0u;
    for (;;) {
        sum = 0u; cnt = 0u; mine = 0u;
#pragma unroll
        for (unsigned j = 0; j < 16; ++j) { const unsigned c = xb_ld(&bar[XB_XCNT(j)]); sum += c; cnt += (c > 0u) ? 1u : 0u; mine = (j == x) ? c : mine; }
        if (sum == G) break;
        __builtin_amdgcn_s_sleep(1);
        if ((++sp & 255u) == 0u) { if (xb_ld(&bar[XB_TMO])) break; if (sp > XB_SPIN_CAP) { atomicAdd(&bar[XB_TMO], 1u); break; } }
    }
    nloc = mine > 0u ? mine : 1u; nx = cnt > 0u ? cnt : 1u;
}
__device__ __forceinline__ void xcd_barrier(const XcdBarrier& b) {
    asm volatile("s_waitcnt vmcnt(0)" ::: "memory");
    __syncthreads();
    if (threadIdx.x == 0) {
        unsigned* bar = b.bar;
        __builtin_amdgcn_s_waitcnt(0);
        unsigned nloc = b.st[0], nx = b.st[1];
        if (nloc == 0u) { xcd_barrier_complete(bar, b.x, nloc, nx); b.st[0] = nloc; b.st[1] = nx; }
        const unsigned old = xb_add(&bar[XB_XSUB(b.x)], 1u);
        const unsigned gen = old / nloc;
        if (old + 1u == (gen + 1u) * nloc) {
            __builtin_amdgcn_fence(__ATOMIC_RELEASE, "agent");
            asm volatile("s_waitcnt vmcnt(0)" ::: "memory");
            (void)xb_add(&bar[XB_TOP], 1u);
        }
        XB_SPIN(xb_ld(&bar[XB_TOP]) < (gen + 1u) * nx, bar);
        __builtin_amdgcn_fence(__ATOMIC_ACQUIRE, "agent");
        asm volatile("s_waitcnt vmcnt(0)" ::: "memory");
    }
    __syncthreads();
}

namespace pg8 {
constexpr int BM = 256, BK = 64, HALF = 128, HTB = HALF * BK * 2, STAGE_BYTES = 8 * HTB, NXCD = 8, WGM = 8;
__device__ __forceinline__ int lds_byte(int r, int c) { const int st = (r >> 4) * 2 + (c >> 5), rr = r & 15, cc = c & 31, ob = rr * 64 + cc * 2; return st * 1024 + (ob ^ (((ob >> 9) & 1) << 5)); }
__device__ __forceinline__ void stage_rc(int b, int& R, int& C) { const int st = b / 1024, sb = b % 1024, swz = sb ^ (((sb >> 9) & 1) << 5); R = (st >> 1) * 16 + swz / 64; C = (st & 1) * 32 + (swz % 64) / 2; }
__device__ __forceinline__ int perm32(int rho) { const int n = rho >> 4, i = rho & 15; return 8 * (i >> 2) + 4 * n + (i & 3); }
struct Unit { int pm, pn, e, kt0, nkt, ks; };
struct Gemm { const bf16_t* A; const bf16_t* Bt; int K; size_t bstride; };
struct StaticOrder {
    int nM, nN, nwg, G, c, nkt;
    __device__ __forceinline__ void init(int M, int N, int G_, int c_, int K_) { nM = M / BM; nN = N / BM; nwg = nM * nN; G = G_; c = c_; nkt = K_ / BK; }
    __device__ __forceinline__ bool next(int i, Unit& u) const {
        const long L = (long)i * G + c; if (L >= nwg) return false;
        int wgid = (int)L; { const int q = nwg / NXCD, r = nwg % NXCD, xcd = wgid % NXCD, off = wgid / NXCD; wgid = (xcd < r ? xcd * (q + 1) : r * (q + 1) + (xcd - r) * q) + off; }
        const int nig = WGM * nN, gid = wgid / nig, fm = gid * WGM, gsz = (nM - fm) < WGM ? (nM - fm) : WGM;
        u.pm = fm + ((wgid % nig) % gsz); u.pn = (wgid % nig) / gsz; u.e = 0; u.kt0 = 0; u.nkt = nkt; u.ks = -1; return true;
    }
};
struct LoraOrder {
    StaticOrder so;
    __device__ __forceinline__ void init(int M, int N, int G_, int c_, int K_) { so.init(M, N, G_, c_, K_); }
    __device__ __forceinline__ bool next(int i, Unit& u) const {
        if (!so.next(i, u)) return false;
        u.kt0 = (u.pn >> 2) * 2; u.nkt = 2; return true;
    }
};
struct MoeOrder {
    int nN, G, c, npan, nkt, nfullU; int pend[8];
    __device__ __forceinline__ void init(const unsigned* cnt, int nN_, int G_, int c_, int K_, bool split = false) {
        nN = nN_; G = G_; c = c_; nkt = K_ / BK; int acc = 0;
#pragma unroll
        for (int e = 0; e < 8; ++e) { acc += ((int)cnt[e * 64] + 255) >> 8; pend[e] = acc; }
        npan = acc; nfullU = split ? ((npan * nN) / G) * G : 0x40000000;
    }
    __device__ __forceinline__ bool next(int i, Unit& u) const {
        const int q0 = i * G + (c & 7) * (G >> 3) + (c >> 3);
        const bool sub = q0 >= nfullU;
        const int q = sub ? nfullU + ((q0 - nfullU) >> 1) : q0, ksub = (q0 - nfullU) & 1;
        const int per = 4 * nN, nfull = npan >> 2, g4 = q / per;
        int pan, pn; bool ok = true;
        if (g4 < nfull) { const int r = q - g4 * per; pn = r >> 2; pan = g4 * 4 + (r & 3); }
        else { const int q2 = q - nfull * per, gp = npan - 4 * nfull; const int gpd = gp > 0 ? gp : 1; ok = q2 < gp * nN; pn = q2 / gpd; pan = 4 * nfull + (q2 - pn * gpd); }
        int e = 0;
#pragma unroll
        for (int k = 0; k < 7; ++k) e += (pan >= pend[k]) ? 1 : 0;
        u.pm = pan; u.pn = pn; u.e = e; u.kt0 = sub ? ksub * (nkt >> 1) : 0; u.nkt = sub ? (nkt >> 1) : nkt; u.ks = sub ? ksub : -1;
        return ok;
    }
};
struct CtxSplitOrder {
    StaticOrder lat; int G, c, nkt, S;
    __device__ __forceinline__ void init(int G_, int c_, int K_, int S_) { lat.init(64 * BM, 1024, G_, c_, K_); G = G_; c = c_; nkt = K_ / BK; S = S_; }
    __device__ __forceinline__ bool next(int i, Unit& u) const {
        const int L = i * G + c;
        const bool islat = L < 256;
        Unit r; const bool okl = lat.next(islat ? i : 0, r);
        r.pm = (r.pm >> 3) * 9 + 1 + (r.pm & 7);
        const int L2 = islat ? 0 : L - 256, Sd = S > 0 ? S : 1, uid = L2 / Sd, ks = L2 - uid * Sd, sub = nkt / Sd;
        u.pm = islat ? r.pm : (uid >> 2) * 9; u.pn = islat ? r.pn : (uid & 3); u.e = 0;
        u.kt0 = islat ? 0 : ks * sub; u.nkt = islat ? nkt : sub; u.ks = islat ? -1 : ks;
        return islat ? okl : (L2 < 32 * S);
    }
};
template <class Epi, class Sched, bool GA = false>
__device__ __forceinline__ void gemm_phase(LAS unsigned char* lds, const Gemm g, const Sched& S, const Epi& E, const LAS int* ridx = nullptr) {
    const int tid = otid(), wid = __builtin_amdgcn_readfirstlane(tid >> 6), lane = tid & 63, wr = wid >> 2, wc = wid & 3, fr = lane & 15, fq = lane >> 4;
    const int K = g.K;
    unsigned voffA[2], voffB[2]; int RA[2]; unsigned CA2[2];
#pragma unroll
    for (int i = 0; i < 2; ++i) { int R, C; stage_rc(tid * 16 + i * 8192, R, C); const int Rb = Epi::PERM ? ((R & ~31) + perm32(R & 31)) : R;
        voffA[i] = (unsigned)(R * K + C) * 2u; voffB[i] = (unsigned)(Rb * K + C) * 2u; RA[i] = R; CA2[i] = (unsigned)C * 2u; }
    unsigned vA[2][2], nvA[2][2], v2[2][2];
#define PG8_GIDX(dst, ui_) do { _Pragma("unroll") for (int _h = 0; _h < 2; ++_h) _Pragma("unroll") for (int _i = 0; _i < 2; ++_i) \
        dst[_h][_i] = (unsigned)ridx[(ui_) * 256 + _h * HALF + RA[_i]] * (unsigned)(K * 2) + CA2[_i]; } while (0)
#define PG8_STGA(bufoff, abase, h, vsel) do { if (GA) PG8_STAGE(bufoff, abase, vsel[h]); else PG8_STAGE(bufoff, (abase) + (h) * hstep, voffA); } while (0)
    const size_t kstep = (size_t)(BK * 2);
    const size_t hstep = (size_t)HALF * K * 2;
    const size_t tstep = 2 * hstep;
    const unsigned ldsw = (unsigned)wid * 1024u;
    const int aoff = lds_byte(wr * 64 + fr, fq * 8), boff = lds_byte(wc * 32 + fr, fq * 8);
#define PG8_SA(b, h) (((b) * 2 + (h)) * HTB)
#define PG8_SB(b, h) ((4 + (b) * 2 + (h)) * HTB)
#define PG8_STAGE(bufoff, gbase, voff) do { _Pragma("unroll") for (int _i = 0; _i < 2; ++_i) \
        __builtin_amdgcn_global_load_lds((const unsigned*)((const char*)(gbase) + (voff)[_i]), (LAS unsigned*)(lds + (bufoff) + ldsw + _i * 8192), 16, 0, 0); } while (0)
#define PG8_LDA(dst, b, h) do { _Pragma("unroll") for (int m = 0; m < 4; ++m) _Pragma("unroll") for (int k = 0; k < 2; ++k) dst[m][k] = *(const LAS bf16x8*)(lds + PG8_SA(b, h) + aoff + m * 2048 + k * 1024); } while (0)
#define PG8_LDB(dst, b, h) do { _Pragma("unroll") for (int n = 0; n < 2; ++n) _Pragma("unroll") for (int k = 0; k < 2; ++k) dst[n][k] = *(const LAS bf16x8*)(lds + PG8_SB(b, h) + boff + n * 2048 + k * 1024); } while (0)
#define PG8_MMA(ai, bj, At, Bt) do { __builtin_amdgcn_s_setprio(1); _Pragma("unroll") for (int m = 0; m < 4; ++m) _Pragma("unroll") for (int n = 0; n < 2; ++n) _Pragma("unroll") for (int k = 0; k < 2; ++k) \
        acc[ai][bj][m][n] = __builtin_amdgcn_mfma_f32_16x16x32_bf16(Bt[n][k], At[m][k], acc[ai][bj][m][n], 0, 0, 0); __builtin_amdgcn_s_setprio(0); } while (0)
#define PG8_WAIT_V(n) asm volatile("s_waitcnt vmcnt(" #n ")" ::: "memory")
#define PG8_WAIT_L(n) asm volatile("s_waitcnt lgkmcnt(" #n ")" ::: "memory")
#define PG8_BAR __builtin_amdgcn_s_barrier()
#define PG8_SCHED __builtin_amdgcn_sched_barrier(0)
    Unit cur, nxt; int ui = 0;
    if (!S.next(0, cur)) return;
    f32x4 acc[2][2][4][2];
#pragma unroll
    for (int a = 0; a < 2; ++a)
#pragma unroll
        for (int b = 0; b < 2; ++b)
#pragma unroll
            for (int m = 0; m < 4; ++m)
#pragma unroll
                for (int n = 0; n < 2; ++n) acc[a][b][m][n] = (f32x4){0.f, 0.f, 0.f, 0.f};
    bf16x8 At[4][2], B0[2][2], B1[2][2];
    const char* cA = (const char*)g.A + (GA ? (size_t)0 : (size_t)cur.pm * tstep) + (size_t)cur.kt0 * kstep; const char* cB = (const char*)g.Bt + (size_t)cur.e * g.bstride + (size_t)cur.pn * tstep + (size_t)cur.kt0 * kstep;
    if (GA) PG8_GIDX(vA, 0);
    PG8_STAGE(PG8_SB(0, 0), cB, voffB); PG8_STGA(PG8_SA(0, 0), cA, 0, vA); PG8_STAGE(PG8_SB(0, 1), cB + hstep, voffB); PG8_STGA(PG8_SA(0, 1), cA, 1, vA);
    if (wr == 1) PG8_BAR;
    PG8_WAIT_V(4); PG8_BAR;
    PG8_STAGE(PG8_SB(1, 0), cB + kstep, voffB); PG8_STGA(PG8_SA(1, 0), cA + kstep, 0, vA); PG8_STAGE(PG8_SB(1, 1), cB + hstep + kstep, voffB);
    PG8_WAIT_V(6); PG8_BAR;
    for (;;) {
        const bool has_next = S.next(ui + 1, nxt);
        const char* nA = has_next ? (const char*)g.A + (GA ? (size_t)0 : (size_t)nxt.pm * tstep) + (size_t)nxt.kt0 * kstep : cA; const char* nB = has_next ? (const char*)g.Bt + (size_t)nxt.e * g.bstride + (size_t)nxt.pn * tstep + (size_t)nxt.kt0 * kstep : cB;
        const int nt = cur.nkt;
        if (GA) { if (has_next) PG8_GIDX(nvA, ui + 1); else {
#pragma unroll
            for (int _h = 0; _h < 2; ++_h) { nvA[_h][0] = vA[_h][0]; nvA[_h][1] = vA[_h][1]; } } }
        for (int t = 0; t < nt; t += 2) {
            const bool last = (t == nt - 2);
            if (GA) {
#pragma unroll
                for (int _h = 0; _h < 2; ++_h) { v2[_h][0] = last ? nvA[_h][0] : vA[_h][0]; v2[_h][1] = last ? nvA[_h][1] : vA[_h][1]; } }
            const char* a1 = cA + (size_t)(t + 1) * kstep;
            const char* a2 = last ? nA : cA + (size_t)(t + 2) * kstep; const char* b2 = last ? nB : cB + (size_t)(t + 2) * kstep;
            const char* a3 = a2 + kstep; const char* b3 = b2 + kstep;
            PG8_LDB(B0, 0, 0); PG8_SCHED; PG8_LDA(At, 0, 0); PG8_STGA(PG8_SA(1, 1), a1, 1, vA);
            PG8_WAIT_L(8); PG8_BAR; PG8_WAIT_L(0); PG8_MMA(0, 0, At, B0); PG8_BAR; PG8_SCHED;
            PG8_LDB(B1, 0, 1); PG8_STAGE(PG8_SB(0, 0), b2, voffB);
            PG8_BAR; PG8_WAIT_L(0); PG8_MMA(0, 1, At, B1); PG8_BAR;
            PG8_LDA(At, 0, 1); PG8_STGA(PG8_SA(0, 0), a2, 0, v2);
            PG8_BAR; PG8_WAIT_L(0); PG8_MMA(1, 0, At, B0); PG8_BAR; PG8_SCHED;
            PG8_STAGE(PG8_SB(0, 1), b2 + hstep, voffB);
            PG8_WAIT_V(6); PG8_BAR; PG8_MMA(1, 1, At, B1); PG8_BAR;
            PG8_LDB(B0, 1, 0); PG8_SCHED; PG8_LDA(At, 1, 0); PG8_STGA(PG8_SA(0, 1), a2, 1, v2);
            PG8_WAIT_L(8); PG8_BAR; PG8_WAIT_L(0); PG8_MMA(0, 0, At, B0); PG8_BAR; PG8_SCHED;
            PG8_LDB(B1, 1, 1); PG8_STAGE(PG8_SB(1, 0), b3, voffB);
            PG8_BAR; PG8_WAIT_L(0); PG8_MMA(0, 1, At, B1); PG8_BAR;
            PG8_LDA(At, 1, 1); PG8_STGA(PG8_SA(1, 0), a3, 0, v2);
            PG8_BAR; PG8_WAIT_L(0); PG8_MMA(1, 0, At, B0); PG8_BAR; PG8_SCHED;
            PG8_STAGE(PG8_SB(1, 1), b3 + hstep, voffB);
            PG8_WAIT_V(6); PG8_BAR; PG8_MMA(1, 1, At, B1); PG8_BAR;
        }
        E(acc, cur, wr, wc, fr, fq);
        if (!has_next) break;
#pragma unroll
        for (int a = 0; a < 2; ++a)
#pragma unroll
            for (int b = 0; b < 2; ++b)
#pragma unroll
                for (int m = 0; m < 4; ++m)
#pragma unroll
                    for (int n = 0; n < 2; ++n) acc[a][b][m][n] = (f32x4){0.f, 0.f, 0.f, 0.f};
        cur = nxt; cA = nA; cB = nB; ++ui;
        if (GA) {
#pragma unroll
            for (int _h = 0; _h < 2; ++_h) { vA[_h][0] = nvA[_h][0]; vA[_h][1] = nvA[_h][1]; } }
    }
    PG8_WAIT_V(0);
    if (wr == 0) PG8_BAR;
    PG8_BAR;
#undef PG8_SA
#undef PG8_SB
#undef PG8_STAGE
#undef PG8_STGA
#undef PG8_GIDX
#undef PG8_LDA
#undef PG8_LDB
#undef PG8_MMA
#undef PG8_WAIT_V
#undef PG8_WAIT_L
#undef PG8_BAR
#undef PG8_SCHED
}

struct EpiBf16 {
    static constexpr bool PERM = true;
    bf16_t* O; int ldc; bf16_t* O2;
    __device__ __forceinline__ void operator()(const f32x4 (&acc)[2][2][4][2], const Unit& u, int wr, int wc, int fr, int fq) const {
        const int row0 = u.pm * BM + wr * 64 + fr, col0 = u.pn * BM + wc * 32 + 8 * fq;
        bf16_t* Ob = (u.ks == 1) ? O2 : O;
#pragma unroll
        for (int ai = 0; ai < 2; ++ai)
#pragma unroll
            for (int m = 0; m < 4; ++m) { bf16_t* rowp = Ob + (size_t)(row0 + ai * HALF + m * 16) * ldc + col0;
#pragma unroll
                for (int bj = 0; bj < 2; ++bj) { const f32x4 v0 = acc[ai][bj][m][0], v1 = acc[ai][bj][m][1];
                    u32x4 w; w.x = pk2(v0[0], v0[1]); w.y = pk2(v0[2], v0[3]); w.z = pk2(v1[0], v1[1]); w.w = pk2(v1[2], v1[3]);
                    *(u32x4*)(rowp + bj * HALF) = w; } }
    }
};
struct EpiEvenIn {
    static constexpr bool PERM = true;
    bf16_t* O; const LAS float* lb;
    __device__ __forceinline__ void operator()(const f32x4 (&acc)[2][2][4][2], const Unit& u, int wr, int wc, int fr, int fq) const {
        const int row0 = u.pm * BM + wr * 64 + fr, col0 = u.pn * BM + wc * 32 + 8 * fq;
        const int kind = (u.pn < 2) ? 1 : (u.pn < 6) ? 2 : (u.pn == 8 || u.pn == 9) ? 3 : 0;
        float lbv[2][8];
        if (kind == 2) {
#pragma unroll
            for (int bj = 0; bj < 2; ++bj)
#pragma unroll
                for (int j = 0; j < 8; ++j) lbv[bj][j] = lb[(col0 + bj * HALF + j) & 511];
        }
#pragma unroll
        for (int ai = 0; ai < 2; ++ai)
#pragma unroll
            for (int m = 0; m < 4; ++m) { bf16_t* rowp = O + (size_t)(row0 + ai * HALF + m * 16) * 3328 + col0;
#pragma unroll
                for (int bj = 0; bj < 2; ++bj) { float v[8];
#pragma unroll
                    for (int j = 0; j < 4; ++j) { v[j] = acc[ai][bj][m][0][j]; v[4 + j] = acc[ai][bj][m][1][j]; }
                    if (kind == 1) {
#pragma unroll
                        for (int j = 0; j < 8; ++j) v[j] = siluf(v[j]) * 0.08838834764831845f; }
                    else if (kind == 2) {
#pragma unroll
                        for (int j = 0; j < 8; ++j) v[j] = __builtin_amdgcn_logf(lbv[bj][j] + (1.0f - lbv[bj][j]) * sigm(v[j])); }
                    else if (kind == 3) {
#pragma unroll
                        for (int j = 0; j < 8; ++j) v[j] = siluf(v[j]); }
                    *(u32x4*)(rowp + bj * HALF) = pk8(v); } }
    }
};
struct EpiResid {
    static constexpr bool PERM = true;
    bf16_t* D0; const float* gate; bf16_t* D1;
    __device__ __forceinline__ void operator()(const f32x4 (&acc)[2][2][4][2], const Unit& u, int wr, int wc, int fr, int fq) const {
        const int row0 = u.pm * BM + wr * 64 + fr, col0 = u.pn * BM + wc * 32 + 8 * fq;
        const int b = u.pm / 9, isctx = (u.pm - b * 9 == 0), mi = isctx ? 8 : b;
        const float* gp = gate + (size_t)mi * 6144 + col0;
        f32x4 gv[2][2];
#pragma unroll
        for (int bj = 0; bj < 2; ++bj)
#pragma unroll
            for (int n = 0; n < 2; ++n) gv[bj][n] = *(const f32x4*)(gp + bj * HALF + 4 * n);
        bf16_t* Db = (u.ks == 1) ? D1 : D0;
#pragma unroll
        for (int ai = 0; ai < 2; ++ai)
#pragma unroll
            for (int m = 0; m < 4; ++m) { bf16_t* rowp = Db + (size_t)(row0 + ai * HALF + m * 16) * 1024 + col0;
#pragma unroll
                for (int bj = 0; bj < 2; ++bj) { const f32x4 v0 = acc[ai][bj][m][0] * gv[bj][0], v1 = acc[ai][bj][m][1] * gv[bj][1];
                    u32x4 w; w.x = pk2(v0[0], v0[1]); w.y = pk2(v0[2], v0[3]); w.z = pk2(v1[0], v1[1]); w.w = pk2(v1[2], v1[3]);
                    *(u32x4*)(rowp + bj * HALF) = w; } }
    }
};
struct EpiSwiGLU {
    static constexpr bool PERM = true;
    bf16_t* O; int ldc;
    __device__ __forceinline__ void operator()(const f32x4 (&acc)[2][2][4][2], const Unit& u, int wr, int wc, int fr, int fq) const {
        const int row0 = u.pm * BM + wr * 64 + fr, col0 = u.pn * HALF + wc * 32 + 8 * fq;
#pragma unroll
        for (int ai = 0; ai < 2; ++ai)
#pragma unroll
            for (int m = 0; m < 4; ++m) { bf16_t* rowp = O + (size_t)(row0 + ai * HALF + m * 16) * ldc + col0;
                float o[8];
#pragma unroll
                for (int n = 0; n < 2; ++n)
#pragma unroll
                    for (int j = 0; j < 4; j += 2) {
                        const f32x2 g2 = {acc[ai][0][m][n][j], acc[ai][0][m][n][j + 1]}, u2 = {acc[ai][1][m][n][j], acc[ai][1][m][n][j + 1]};
                        const f32x2 t = g2 * (-1.4426950408889634f);
                        f32x2 e; e.x = __builtin_amdgcn_exp2f(t.x); e.y = __builtin_amdgcn_exp2f(t.y);
                        const f32x2 d = e + 1.0f;
                        f32x2 r; r.x = __builtin_amdgcn_rcpf(d.x); r.y = __builtin_amdgcn_rcpf(d.y);
                        const f32x2 y = (g2 * u2) * r;
                        o[n * 4 + j] = y.x; o[n * 4 + j + 1] = y.y; }
                *(u32x4*)rowp = pk8(o); }
    }
};
struct EpiGLU {
    static constexpr bool PERM = true;
    const bf16_t* YG; bf16_t* Y;
    __device__ __forceinline__ void operator()(const f32x4 (&acc)[2][2][4][2], const Unit& u, int wr, int wc, int fr, int fq) const {
        const int row0 = u.pm * BM + wr * 64 + fr, col0 = u.pn * BM + wc * 32 + 8 * fq;
#pragma unroll
        for (int ai = 0; ai < 2; ++ai)
#pragma unroll
            for (int m = 0; m < 4; ++m) { const size_t row = (size_t)(row0 + ai * HALF + m * 16);
#pragma unroll
                for (int bj = 0; bj < 2; ++bj) { const int col = col0 + bj * HALF;
                    float y[8], o[8]; unpk8(*(const u32x4*)(YG + row * 512 + col), y);
#pragma unroll
                    for (int n = 0; n < 2; ++n)
#pragma unroll
                        for (int j = 0; j < 4; ++j) o[n * 4 + j] = y[n * 4 + j] * sigm(acc[ai][bj][m][n][j]);
                    *(u32x4*)(Y + row * 1024 + col) = pk8(o); } }
    }
};
}

__device__ __forceinline__ void ada_item(const Params& p, int item, unsigned char* sm) {
    unsigned char* const ws = ows(p.ws);
    const int tid = otid();
    const int l = item / 48, n0 = (item % 48) * 128;
    float* sc = (float*)sm;
    float* red = (float*)(sm + 49152);
    for (int i = tid; i < 9 * 1024; i += 512) { const int m = i >> 10, k = i & 1023; const float v = (m < 8) ? p.in[1][m * 1024 + k] : p.in[3][k]; sc[k * 12 + m] = siluf(v); }
    __syncthreads();
    const int col = tid & 127, kg = tid >> 7;
    float a0 = 0, a1 = 0, a2 = 0, a3 = 0, a4 = 0, a5 = 0, a6 = 0, a7 = 0, a8 = 0;
    const float* w = p.in[4] + (size_t)l * 1024 * 6144 + n0 + col;
#pragma unroll 8
    for (int k = kg * 256; k < kg * 256 + 256; ++k) {
        const float wv = w[(size_t)k * 6144];
        const f32x4 s0 = *(const f32x4*)&sc[k * 12], s1 = *(const f32x4*)&sc[k * 12 + 4]; const float s8 = sc[k * 12 + 8];
        a0 += s0[0] * wv; a1 += s0[1] * wv; a2 += s0[2] * wv; a3 += s0[3] * wv; a4 += s1[0] * wv; a5 += s1[1] * wv; a6 += s1[2] * wv; a7 += s1[3] * wv; a8 += s8 * wv;
    }
    float* rp = red + (kg * 9) * 128 + col;
    rp[0] = a0; rp[128] = a1; rp[256] = a2; rp[384] = a3; rp[512] = a4; rp[640] = a5; rp[768] = a6; rp[896] = a7; rp[1024] = a8;
    __syncthreads();
    float* mod = (float*)(ws + OFF_MOD);
    for (int i = tid; i < 9 * 128; i += 512) { const int m = i >> 7, cc = i & 127;
        const float s = red[(0 * 9 + m) * 128 + cc] + red[(1 * 9 + m) * 128 + cc] + red[(2 * 9 + m) * 128 + cc] + red[(3 * 9 + m) * 128 + cc];
        mod[(size_t)(l * 9 + m) * 6144 + n0 + cc] = s + p.in[5][l * 6144 + n0 + cc]; }
}
__device__ __forceinline__ void rope_item(const Params& p) {
    unsigned char* const ws = ows(p.ws);
    float* COS = (float*)(ws + OFF_COS); float* SIN = (float*)(ws + OFF_SIN);
    for (int i = threadIdx.x; i < 2048 * 32; i += 512) { const int pos = i >> 5, f = i & 31, fi = f & 15;
        const float inv = exp2f(-(float)fi * (13.287712379549449f / 16.0f));
        const float ang = (float)(f < 16 ? (pos >> 6) : (pos & 63)) * inv;
        float s, c; my_sincos(ang, s, c); COS[i] = c; SIN[i] = s; }
}
__device__ __forceinline__ void s5disc_item(const Params& p) {
    unsigned char* const ws = ows(p.ws);
    float* AB = (float*)(ws + OFF_AB); float* BBR = (float*)(ws + OFF_BBR); float* BBI = (float*)(ws + OFF_BBI); float* LB = (float*)(ws + OFF_LB);
    for (int idx = threadIdx.x; idx < 8192; idx += 512) {
        const int pp = idx & 63, g = (idx >> 6) & 31, jd = idx >> 11, jo = jd >> 1;
        const float lr = fminf(p.in[18][idx], -1e-4f), li = p.in[19][idx];
        const float dt = expf(p.in[20][jd * 32 + g]);
        const float mag = expf(lr * dt); float s, c; my_sincos(li * dt, s, c);
        const float abr = mag * c, abi = mag * s, den = lr * lr + li * li, nr = abr - 1.0f;
        const float cor = (nr * lr + abi * li) / den, coi = (abi * lr - nr * li) / den;
        AB[idx * 2] = abr; AB[idx * 2 + 1] = abi;
        const float* br = p.in[21] + (size_t)((jo * 32 + g) * 64 + pp) * 16; const float* bi = p.in[22] + (size_t)((jo * 32 + g) * 64 + pp) * 16;
        for (int h = 0; h < 16; ++h) { BBR[idx * 16 + h] = cor * br[h] - coi * bi[h]; BBI[idx * 16 + h] = cor * bi[h] + coi * br[h]; }
    }
    for (int c = threadIdx.x; c < 512; c += 512) { const float e0 = expf(p.in[10][c]), e1 = expf(p.in[10][512 + c]); LB[c] = 0.f; LB[512 + c] = e1 / (e0 + e1); }
}
struct TrTile { bf16_t* dp; int mode; };
__device__ __forceinline__ void tr_load(const Params& p, int tile, int& j, int jhi, f32x4 (&v)[8], int& k0, int& n0, Job& jb, int tid) {
    while (j + 1 < jhi && tile >= p.jobs[j + 1].tile0) ++j;
    jb = p.jobs[j]; const int t = tile - jb.tile0;
    const int nkt = jb.K >> 7, kt = t % nkt, ntl = t / nkt; k0 = kt * 128; n0 = ntl * 128;
    if (jb.mode == 3) {
#pragma unroll
        for (int i = 0; i < 8; ++i) v[i] = (f32x4){0.f, 0.f, 0.f, 0.f};
    } else if (jb.mode == 4) {
        const int blk = n0 >> 9, jo = jb.aux, sn0 = n0 & 511;
        const float* src = (blk < 4) ? (blk < 2 ? p.in[29] : p.in[31]) + (size_t)(jo * 2 + (blk & 1)) * 64 * 512 : p.in[32] + (size_t)jo * 128 * 512;
        const int klo = (blk < 4) ? 64 * blk : 256, khi = (blk < 4) ? 64 * blk + 64 : 384;
#pragma unroll
        for (int i = 0; i < 8; ++i) { const int idx = tid + 512 * i, kk = k0 + (idx >> 5), n4 = (idx & 31) * 4;
            v[i] = (kk >= klo && kk < khi) ? *(const f32x4*)(src + (size_t)(kk - klo) * 512 + sn0 + n4) : (f32x4){0.f, 0.f, 0.f, 0.f}; }
    } else {
#pragma unroll
        for (int i = 0; i < 8; ++i) { const int idx = tid + 512 * i, kk = idx >> 5, n4 = (idx & 31) * 4;
            v[i] = *(const f32x4*)(jb.src + (size_t)(k0 + kk) * jb.N + n0 + n4); }
    }
}
__device__ __forceinline__ void tr_loop(const Params& p, int first, int stride, int ntiles, int jlo, int jhi, unsigned char* sm) {
    const int tid = otid();
    bf16_t* Lb = (bf16_t*)sm;
    if (first >= ntiles) return;
    int j = jlo, k0, n0; Job jb; f32x4 v[8];
    tr_load(p, first, j, jhi, v, k0, n0, jb, tid);
    for (int tile = first; tile < ntiles; tile += stride) {
#pragma unroll
        for (int i = 0; i < 8; ++i) { const int idx = tid + 512 * i, kk = idx >> 5, n4 = (idx & 31) * 4;
            u32x2 w2; w2.x = pk2(v[i][0], v[i][1]); w2.y = pk2(v[i][2], v[i][3]); *(u32x2*)(Lb + kk * 132 + n4) = w2; }
        const int nn = tid >> 2, kq = tid & 3, ng = n0 + nn;
        int drow = ng;
        if (jb.mode == 1) drow = (ng >> 7) * 256 + (ng & 127);
        else if (jb.mode == 2) drow = (ng >> 7) * 256 + 128 + (ng & 127);
        bf16_t* dp = jb.dst + (size_t)drow * jb.ldd + k0;
        __syncthreads();
        if (tile + stride < ntiles) tr_load(p, tile + stride, j, jhi, v, k0, n0, jb, tid);
#pragma unroll
        for (int g = 0; g < 4; ++g) { const int k8 = g * 32 + kq * 8;
            u32x4 o;
            o.x = (unsigned)Lb[(k8 + 0) * 132 + nn] | ((unsigned)Lb[(k8 + 1) * 132 + nn] << 16); o.y = (unsigned)Lb[(k8 + 2) * 132 + nn] | ((unsigned)Lb[(k8 + 3) * 132 + nn] << 16);
            o.z = (unsigned)Lb[(k8 + 4) * 132 + nn] | ((unsigned)Lb[(k8 + 5) * 132 + nn] << 16); o.w = (unsigned)Lb[(k8 + 6) * 132 + nn] | ((unsigned)Lb[(k8 + 7) * 132 + nn] << 16);
            *(u32x4*)(dp + k8) = o; }
        __syncthreads();
    }
}
__device__ __forceinline__ void phase_prologue_a(const Params& p, unsigned char* sm) {
    const int cb = blockIdx.x, G = gridDim.x;
    for (int item = cb; item < 194; item += G) {
        if (item < 192) ada_item(p, item, sm);
        else if (item == 192) rope_item(p);
        else s5disc_item(p);
        __syncthreads();
    }
    tr_loop(p, (cb + 62) % G, G, p.nt0, 0, p.nj0, sm);
    if (DUPB(10)) { __syncthreads(); tr_loop(p, (cb + 62) % G, G, p.nt0, 0, p.nj0, sm); }
    if (DUPB(11)) { __syncthreads(); for (int item = cb; item < 192; item += G) { ada_item(p, item, sm); __syncthreads(); } }
}
__device__ __forceinline__ void phase_prologue_b(const Params& p) {
    unsigned char* const ws = ows(p.ws);
    const int tid_ = otid(); const int lane = tid_ & 63, w = tid_ >> 6;
    _Float16* X = (_Float16*)(ws + OFF_X); bf16_t* H = (bf16_t*)(ws + OFF_H); const float* mod = (const float*)(ws + OFF_MOD);
    f32x4 shr[4], scr[4]; int cur_mi = -1;
#pragma unroll
    for (int i = 0; i < 4; ++i) { shr[i] = (f32x4){0.f, 0.f, 0.f, 0.f}; scr[i] = shr[i]; }
    const int nwv = gridDim.x * 8, rpw = (TT + nwv - 1) / nwv, row_lo = (blockIdx.x * 8 + w) * rpw, row_hi = row_lo + rpw < TT ? row_lo + rpw : TT;
    for (int row = row_lo; row < row_hi; ++row) {
        const int b = row / SB, s = row - b * SB; const int mi = s < 256 ? 8 : b;
        const float* src = s < 256 ? p.in[2] + ((size_t)b * 256 + s) * 1024 : p.in[0] + ((size_t)b * 2048 + (s - 256)) * 1024;
        if (mi != cur_mi) { cur_mi = mi; const float* mp = mod + (size_t)mi * 6144;
#pragma unroll
            for (int i = 0; i < 4; ++i) { shr[i] = *(const f32x4*)(mp + 4 * lane + 256 * i); scr[i] = *(const f32x4*)(mp + 1024 + 4 * lane + 256 * i); } }
#pragma unroll
        for (int i = 0; i < 4; ++i) { const int c = 4 * lane + 256 * i; const f32x4 v = *(const f32x4*)(src + c);
            *(u32x2*)(X + (size_t)row * 1024 + c) = f2h4(v * ALPHA);
            const f32x4 sh = shr[i], sc = scr[i];
            u32x2 o; o.x = pk2(v[0] * (1.f + sc[0]) + sh[0], v[1] * (1.f + sc[1]) + sh[1]); o.y = pk2(v[2] * (1.f + sc[2]) + sh[2], v[3] * (1.f + sc[3]) + sh[3]);
            *(u32x2*)(H + (size_t)row * 1024 + c) = o; }
    }
}

template <int MODE, bool ROUTE, bool DRY = false>
__device__ __forceinline__ void phase_ln(const Params& p, int layer, size_t part_off, int nsplit, unsigned char* sm) {
    unsigned char* const ws = ows(p.ws);
    const int tid_ = otid(); const int lane = tid_ & 63, w = tid_ >> 6;
    _Float16* X = (_Float16*)(ws + OFF_X); bf16_t* H = (bf16_t*)(ws + OFF_H); const float* mod = (const float*)(ws + OFF_MOD);
    const int which = MODE == 0 ? 0 : 1;
    const float* lg = p.in[6] + (size_t)(layer * 2 + which) * 1024; const float* lbp = p.in[7] + (size_t)(layer * 2 + which) * 1024;
    const bool last = (layer == 3);
    const int jo = layer >> 1;
    unsigned* route = (unsigned*)(ws + OFF_ROUTE);
    unsigned* cnt = (unsigned*)(ws + OFF_CNT) + jo * 512;
    int offs[8];
    int split_row = 0x7fffffff;
    if (MODE == 2) { int acc = 0;
#pragma unroll
        for (int e = 0; e < 8; ++e) { offs[e] = acc; acc += (((int)cnt[e * 64] + 255) >> 8) << 8; }
        const int npan = acc >> 8, G_ = gridDim.x; split_row = ((((npan * 4) / G_) * G_) >> 2) << 8; }
    f32x4 rwr[4][4][2];
    if (ROUTE) { const float* rwg = p.in[38] + (size_t)jo * 8192;
#pragma unroll
        for (int i = 0; i < 4; ++i)
#pragma unroll
            for (int q = 0; q < 4; ++q) { const float* rp = rwg + (size_t)(4 * lane + 256 * i + q) * 8; rwr[i][q][0] = *(const f32x4*)rp; rwr[i][q][1] = *(const f32x4*)(rp + 4); } }
    f32x4 g4r[4], b4r[4], shr[4], scr[4];
#pragma unroll
    for (int i = 0; i < 4; ++i) { g4r[i] = *(const f32x4*)(lg + 4 * lane + 256 * i); b4r[i] = *(const f32x4*)(lbp + 4 * lane + 256 * i); shr[i] = (f32x4){0.f, 0.f, 0.f, 0.f}; scr[i] = shr[i]; }
    int cur_mi = -1, cur_gi = -1; f32x4 gtr[4];
#pragma unroll
    for (int i = 0; i < 4; ++i) gtr[i] = (f32x4){0.f, 0.f, 0.f, 0.f};
    const int nwv = gridDim.x * 8, rpw = (TT + nwv - 1) / nwv, row_lo = (blockIdx.x * 8 + w) * rpw, row_hi = row_lo + rpw < TT ? row_lo + rpw : TT;
    for (int row = row_lo; row < row_hi; ++row) {
        const int b = row / SB, s = row - b * SB; const int mi = s < 256 ? 8 : b;
        if (last && s < 256 && (MODE != 0 || ROUTE)) {
            if (ROUTE && lane == 0 && !DRY) route[(size_t)row * 8] = 0xffffffffu;
            continue;
        }
        f32x4 v[4];
        _Float16* xr = X + (size_t)row * 1024;
        _Float16* xw = DRY ? (_Float16*)(ws + OFF_S5F) + (size_t)row * 1024 : xr; bf16_t* hw = DRY ? (bf16_t*)(ws + OFF_S5B) + (size_t)row * 1024 : H + (size_t)row * 1024;
#pragma unroll
        for (int i = 0; i < 4; ++i) v[i] = h2f4(*(const u32x2*)(xr + 4 * lane + 256 * i));
        if (MODE != 2) {
            const bf16_t* d0 = (const bf16_t*)(ws + part_off) + (size_t)row * 1024 + 4 * lane;
            const bool two = (s < 256 && nsplit > 0);
#pragma unroll
            for (int i = 0; i < 4; ++i) { v[i] += unpk4v(*(const u32x2*)(d0 + 256 * i)); if (two) v[i] += unpk4v(*(const u32x2*)(d0 + (size_t)TT * 1024 + 256 * i)); }
        }
        if (MODE == 2) {
            const unsigned* rt = route + (size_t)row * 8;
            const int e1 = (int)rt[0], e2 = (int)rt[1]; const int r1 = (int)rt[2], r2 = (int)rt[3]; const float p1 = __uint_as_float(rt[4]), p2 = __uint_as_float(rt[5]);
            int o1 = 0, o2 = 0;
#pragma unroll
            for (int e = 0; e < 8; ++e) { o1 = (e == e1) ? offs[e] : o1; o2 = (e == e2) ? offs[e] : o2; }
            const bf16_t* F = (const bf16_t*)(ws + OFF_AR + AM_A);
            const bf16_t* f1 = F + (size_t)(o1 + r1) * 1024; const bf16_t* f2 = F + (size_t)(o2 + r2) * 1024;
            const bf16_t* F2 = (const bf16_t*)(ws + OFF_GE);
            const bool s1 = (o1 + r1) >= split_row, s2 = (o2 + r2) >= split_row;
            if (mi != cur_gi) { cur_gi = mi; const float* gt = mod + (size_t)(layer * 9 + mi) * 6144 + 5120;
#pragma unroll
                for (int i = 0; i < 4; ++i) gtr[i] = *(const f32x4*)(gt + 4 * lane + 256 * i); }
#pragma unroll
            for (int i = 0; i < 4; ++i) { const int c = 4 * lane + 256 * i; float a[4], bb[4]; unpk4(*(const u32x2*)(f1 + c), a); unpk4(*(const u32x2*)(f2 + c), bb);
                if (s1) { float t_[4]; unpk4(*(const u32x2*)(F2 + (size_t)(o1 + r1) * 1024 + c), t_); a[0] += t_[0]; a[1] += t_[1]; a[2] += t_[2]; a[3] += t_[3]; }
                if (s2) { float t_[4]; unpk4(*(const u32x2*)(F2 + (size_t)(o2 + r2) * 1024 + c), t_); bb[0] += t_[0]; bb[1] += t_[1]; bb[2] += t_[2]; bb[3] += t_[3]; }
                const f32x4 g4 = gtr[i];
#pragma unroll
                for (int q = 0; q < 4; ++q) v[i][q] = v[i][q] + g4[q] * (p1 * a[q] + p2 * bb[q]); }
        }
        float sm_ = 0.f;
#pragma unroll
        for (int i = 0; i < 4; ++i) sm_ += (v[i][0] + v[i][1]) + (v[i][2] + v[i][3]);
        const float mean = sum64(sm_) * (1.0f / 1024.0f);
        float sq = 0.f;
#pragma unroll
        for (int i = 0; i < 4; ++i) { const f32x4 d = v[i] - mean; sq += (d[0] * d[0] + d[1] * d[1]) + (d[2] * d[2] + d[3] * d[3]); }
        const float rstd = rsqrtf(sum64(sq) * (1.0f / 1024.0f) + 1e-5f);
        if (mi != cur_mi) { cur_mi = mi;
            const float* mp = (MODE == 0) ? mod + (size_t)(layer * 9 + mi) * 6144 + 3072 : mod + (size_t)((last ? 0 : layer + 1) * 9 + mi) * 6144;
#pragma unroll
            for (int i = 0; i < 4; ++i) { shr[i] = *(const f32x4*)(mp + 4 * lane + 256 * i); scr[i] = *(const f32x4*)(mp + 1024 + 4 * lane + 256 * i); } }
        float lg8[8];
#pragma unroll
        for (int e = 0; e < 8; ++e) lg8[e] = 0.f;
#pragma unroll
        for (int i = 0; i < 4; ++i) { const int c = 4 * lane + 256 * i;
            const f32x4 y = (v[i] - mean) * rstd * g4r[i] + b4r[i];
            if (MODE != 0 && last) { if (!DRY) *(f32x4*)(p.out + ((size_t)b * 2048 + (s - 256)) * 1024 + c) = y; else *(u32x2*)(xw + c) = f2h4(y); }
            else {
                *(u32x2*)(xw + c) = f2h4(y * ALPHA);
                const f32x4 h = y * (1.0f + scr[i]) + shr[i];
                u32x2 o; o.x = pk2(h[0], h[1]); o.y = pk2(h[2], h[3]);
                *(u32x2*)(hw + c) = o;
                if (ROUTE) {
#pragma unroll
                    for (int e = 0; e < 8; ++e) lg8[e] += (h[0] * rwr[i][0][e >> 2][e & 3] + h[1] * rwr[i][1][e >> 2][e & 3]) + (h[2] * rwr[i][2][e >> 2][e & 3] + h[3] * rwr[i][3][e >> 2][e & 3]); }
            }
        }
        if (ROUTE) {
#pragma unroll
            for (int e = 0; e < 8; ++e) lg8[e] = sum64(lg8[e]) + p.in[39][jo * 8 + e];
            int e1 = 0; float v1 = lg8[0];
#pragma unroll
            for (int e = 1; e < 8; ++e) if (lg8[e] > v1) { v1 = lg8[e]; e1 = e; }
            int e2 = -1; float v2 = -3.0e38f;
#pragma unroll
            for (int e = 0; e < 8; ++e) if (e != e1 && lg8[e] > v2) { v2 = lg8[e]; e2 = e; }
            if (lane == 0 && !DRY) {
                const float p1 = 1.0f / (1.0f + __expf(v2 - v1)), p2 = 1.0f - p1;
                const unsigned r1 = atomicAdd(&cnt[e1 * 64], 1u), r2 = atomicAdd(&cnt[e2 * 64], 1u);
                unsigned* rt = route + (size_t)row * 8;
                rt[0] = (unsigned)e1; rt[1] = (unsigned)e2; rt[2] = r1; rt[3] = r2; rt[4] = __float_as_uint(p1); rt[5] = __float_as_uint(p2);
                unsigned* inv = (unsigned*)(ws + OFF_INV); inv[(size_t)e1 * TT + r1] = (unsigned)row; inv[(size_t)e2 * TT + r2] = (unsigned)row;
            }
        }
    }
}
__device__ __forceinline__ int scan_row(int dir, int n) { return dir == 0 ? n : (n < 256 ? 255 - n : 2559 - n); }
__device__ __forceinline__ void hgrn_chunk_unit(const Params& p, int j, int u, unsigned char* sm) {
    unsigned char* const ws = ows(p.ws);
    const int tid = otid(), lane = tid & 63, w = tid >> 6, l15 = lane & 15, kg = lane >> 4;
    const int chf = u & 1, dir = (u >> 1) & 1, h = (u >> 2) & 3, b = u >> 4;
    const int ct = 4 * chf + (w & 3);
    const bf16_t* P = (const bf16_t*)(ws + OFF_AR + AE_P);
    bf16_t* O = (bf16_t*)(ws + OFF_AR + (dir ? AE_OB : AE_OF));
    const size_t rb = (size_t)b * SB;
    const int pd = tid >> 2, tq = tid & 3;
    const int ppos = (pd & ~31) + 8 * ((pd & 15) >> 2) + 4 * ((pd >> 4) & 1) + (pd & 3);
    const int rstep = dir ? -1 : 1;
    constexpr int RAW0 = 2 * 21504, RAWSZ = 3 * 16 * 136 * 2;
    const int t4 = tid & 255, lt = t4 >> 4, lc = t4 & 15;
    u32x4 gq, gf, gv;
#define HG_LOAD(c) do { const size_t row = rb + scan_row(dir, (c) * 16 + lt); const bf16_t* pr = P + row * 3328 + h * 128 + 8 * lc; \
        gq = *(const u32x4*)pr; gf = *(const u32x4*)(pr + 512 + dir * 512); gv = *(const u32x4*)(pr + 1536); } while (0)
#define HG_RAWW(bi) do { bf16_t* rw = (bf16_t*)(sm + RAW0 + (bi) * RAWSZ) + lt * 136 + 8 * lc; \
        *(u32x4*)rw = gq; *(u32x4*)(rw + 16 * 136) = gf; *(u32x4*)(rw + 32 * 136) = gv; } while (0)
    unsigned short rq[4], rf[4], rv[4];
#define HG_RAWR(bi) do { const bf16_t* rr_ = (const bf16_t*)(sm + RAW0 + (bi) * RAWSZ) + (4 * tq) * 136 + pd; \
        _Pragma("unroll") for (int k = 0; k < 4; ++k) { rq[k] = rr_[k * 136]; rf[k] = rr_[(16 + k) * 136]; rv[k] = rr_[(32 + k) * 136]; } } while (0)
#define HG_PREP(bufi) do { \
        bf16_t* Qd = (bf16_t*)(sm + (bufi) * 21504); bf16_t* Kd = Qd + 16 * 136; bf16_t* KeT = Kd + 16 * 136; bf16_t* Vt = KeT + 128 * 24; float* dec = (float*)(Vt + 128 * 24); \
        float qv[4], kk[4], cl[4]; float run = 0.f; \
        _Pragma("unroll") for (int k = 0; k < 4; ++k) { const float lg = bf2f(rf[k]); \
            qv[k] = bf2f(rq[k]); kk[k] = 1.0f - __builtin_amdgcn_exp2f(lg); run += lg; cl[k] = run; } \
        float x1 = dppf<0x93>(run); x1 = (tq >= 1) ? x1 : 0.f;            \
        float s2 = run + x1; float x2 = dppf<0x4E>(s2); x2 = (tq >= 2) ? x2 : 0.f; \
        const float incl = s2 + x2; const float off = incl - run; \
        const float btot = dppf<0xFF>(incl);                                  \
        const float etot = __builtin_amdgcn_exp2f(btot); \
        float ke[4]; \
        _Pragma("unroll") for (int k = 0; k < 4; ++k) { const float bl = off + cl[k]; const float E = __builtin_amdgcn_exp2f(bl); const float iE = __builtin_amdgcn_rcpf(E); \
            const float qd = qv[k] * E, kd = kk[k] * iE; ke[k] = kd * etot; \
            Qd[(4 * tq + k) * 136 + ppos] = (bf16_t)(pk2(qd, 0.f) & 0xffff); Kd[(4 * tq + k) * 136 + ppos] = (bf16_t)(pk2(kd, 0.f) & 0xffff); } \
        { u32x2 w2; w2.x = pk2(ke[0], ke[1]); w2.y = pk2(ke[2], ke[3]); *(u32x2*)(KeT + pd * 24 + 4 * tq) = w2; \
          u32x2 v2; v2.x = (unsigned)rv[0] | ((unsigned)rv[1] << 16); v2.y = (unsigned)rv[2] | ((unsigned)rv[3] << 16); *(u32x2*)(Vt + pd * 24 + 4 * tq) = v2; } \
        if (tq == 0) dec[pd] = etot; } while (0)
    f32x4 S[8];
#pragma unroll
    for (int i = 0; i < 8; ++i) S[i] = (f32x4){0.f, 0.f, 0.f, 0.f};
    if (w >= 4) { HG_LOAD(0); HG_RAWW(0); HG_LOAD(1); }
    LDS_BARRIER();
    HG_RAWR(0); HG_PREP(0);
    if (w >= 4) { HG_RAWW(1); HG_LOAD(2); }
    LDS_BARRIER();
    for (int c = 0; c < 144; ++c) {
        if (c + 1 < 144) { HG_RAWR((c + 1) & 1); HG_PREP((c + 1) & 1); }
        if (w >= 4) { if (c + 2 < 144) { HG_RAWW(c & 1); } if (c + 3 < 144) { HG_LOAD(c + 3); } }
        if (w < 4) {
            const bf16_t* Qd = (const bf16_t*)(sm + (c & 1) * 21504); const bf16_t* Kd = Qd + 16 * 136; const bf16_t* KeT = Kd + 16 * 136; const bf16_t* Vt = KeT + 128 * 24; const float* dec = (const float*)(Vt + 128 * 24);
            f32x4 AT = {0.f, 0.f, 0.f, 0.f};
            bf16x8 qf[4];
#pragma unroll
            for (int ks = 0; ks < 4; ++ks) { const bf16x8 kf = *(const bf16x8*)(Kd + l15 * 136 + 32 * ks + 8 * kg); qf[ks] = *(const bf16x8*)(Qd + l15 * 136 + 32 * ks + 8 * kg);
                AT = __builtin_amdgcn_mfma_f32_16x16x32_bf16(kf, qf[ks], AT, 0, 0, 0); }
            u32x4 aw;
            aw.x = pk2((4 * kg + 0 <= l15) ? AT[0] : 0.f, (4 * kg + 1 <= l15) ? AT[1] : 0.f); aw.y = pk2((4 * kg + 2 <= l15) ? AT[2] : 0.f, (4 * kg + 3 <= l15) ? AT[3] : 0.f); aw.z = 0u; aw.w = 0u;
            const bf16x8 afrag = __builtin_bit_cast(bf16x8, aw);
            u32x4 vw; { const u32x2 v2 = *(const u32x2*)(Vt + (16 * ct + l15) * 24 + 4 * kg); vw.x = v2.x; vw.y = v2.y; vw.z = 0u; vw.w = 0u; }
            const bf16x8 vfrag = __builtin_bit_cast(bf16x8, vw);
            f32x4 Oa = {0.f, 0.f, 0.f, 0.f};
            Oa = __builtin_amdgcn_mfma_f32_16x16x32_bf16(afrag, vfrag, Oa, 0, 0, 0);
#pragma unroll
            for (int pi = 0; pi < 4; ++pi) {
                u32x4 sw; sw.x = pk2(S[2 * pi][0], S[2 * pi][1]); sw.y = pk2(S[2 * pi][2], S[2 * pi][3]); sw.z = pk2(S[2 * pi + 1][0], S[2 * pi + 1][1]); sw.w = pk2(S[2 * pi + 1][2], S[2 * pi + 1][3]);
                Oa = __builtin_amdgcn_mfma_f32_16x16x32_bf16(qf[pi], __builtin_bit_cast(bf16x8, sw), Oa, 0, 0, 0);
            }
            { bf16_t* op = O + (rb + scan_row(dir, c * 16 + 4 * kg)) * 512 + h * 128 + 16 * ct + l15;
#pragma unroll
              for (int i = 0; i < 4; ++i) op[(ptrdiff_t)(rstep * i) * 512] = (bf16_t)(pk2(Oa[i], 0.f) & 0xffff); }
#pragma unroll
            for (int dt = 0; dt < 8; ++dt) {
                const f32x4 dv = *(const f32x4*)(dec + 16 * dt + 4 * kg);
                u32x4 kw; { const u32x2 k2 = *(const u32x2*)(KeT + (16 * dt + l15) * 24 + 4 * kg); kw.x = k2.x; kw.y = k2.y; kw.z = 0u; kw.w = 0u; }
                S[dt] = __builtin_amdgcn_mfma_f32_16x16x32_bf16(__builtin_bit_cast(bf16x8, kw), vfrag, S[dt] * dv, 0, 0, 0);
            }
        }
        LDS_BARRIER();
    }
#undef HG_LOAD
#undef HG_RAWW
#undef HG_RAWR
#undef HG_PREP
}
__device__ __forceinline__ void hgrn_finish_rows(const Params& p, int j) {
    unsigned char* const ws = ows(p.ws);
    const int tid_ = otid(); const int lane = tid_ & 63, w = tid_ >> 6;
    const bf16_t* P = (const bf16_t*)(ws + OFF_AR + AE_P);
    const bf16_t* OF = (const bf16_t*)(ws + OFF_AR + AE_OF); const bf16_t* OB = (const bf16_t*)(ws + OFF_AR + AE_OB);
    bf16_t* Y = (bf16_t*)(ws + OFF_AR + AE_Y);
    const int c0 = lane * 8;
    const int nwv = gridDim.x * 8, rpw = (TT + nwv - 1) / nwv, row_lo = (blockIdx.x * 8 + w) * rpw, row_hi = (row_lo + rpw < TT) ? row_lo + rpw : TT;
    const f32x4 ng0 = *(const f32x4*)(p.in[11] + j * 512 + c0), ng1 = *(const f32x4*)(p.in[11] + j * 512 + c0 + 4);
    for (int row = row_lo; row < row_hi; ++row) {
        float o[8], g[8];
        { float fa[8], fb[8]; unpk8(*(const u32x4*)(OF + (size_t)row * 512 + c0), fa); unpk8(*(const u32x4*)(OB + (size_t)row * 512 + c0), fb);
#pragma unroll
          for (int i = 0; i < 8; ++i) o[i] = fa[i] + fb[i]; }
        unpk8(*(const u32x4*)(P + (size_t)row * 3328 + 2048 + c0), g);
        float ssq = 0.f;
#pragma unroll
        for (int i = 0; i < 8; ++i) ssq += o[i] * o[i];
        ssq = sum16(ssq);
        const float r = rsqrtf(ssq * (1.0f / 128.0f) + 1e-6f);
        float y[8];
#pragma unroll
        for (int i = 0; i < 4; ++i) { y[i] = o[i] * r * ng0[i] * g[i]; y[4 + i] = o[4 + i] * r * ng1[i] * g[4 + i]; }
        *(u32x4*)(Y + (size_t)row * 1024 + c0) = pk8(y);
    }
}

__device__ __forceinline__ void attn_unit(const Params& p, int j, int u, unsigned char* sm) {
    unsigned char* const ws = ows(p.ws);
    const int tid = otid(), lane = tid & 63, w = tid >> 6;
    const int b = u / 72, rem = u - b * 72, g = rem / 36, qb = rem - g * 36;
    const int r4 = w & 3, sub = w >> 2, hh = g * 4 + r4, l31 = lane & 31, hf = lane >> 5;
    bf16_t* Ks = (bf16_t*)sm; bf16_t* Vt = Ks + 64 * 72;
    const bf16_t* P = (const bf16_t*)(ws + OFF_AR + AE_P); bf16_t* Y = (bf16_t*)(ws + OFF_AR + AE_Y);
    const float* COS = (const float*)(ws + OFF_COS); const float* SIN = (const float*)(ws + OFF_SIN);
    const bool isl = qb < 32;
    const int q0 = isl ? qb * 64 : (qb - 32) * 64;
    const size_t rb = (size_t)b * SB;
    const int qpos = q0 + sub * 32 + l31;
    const size_t qrow = rb + (isl ? 256 : 0) + qpos;
    bf16x8 qf[4];
    {
        const bf16_t* qp = P + qrow * 3328 + 2560 + hh * 64;
        float x1a[8], x1b[8], x2a[8], x2b[8];
        unpk8(*(const u32x4*)(qp + 8 * hf), x1a); unpk8(*(const u32x4*)(qp + 16 + 8 * hf), x1b);
        unpk8(*(const u32x4*)(qp + 32 + 8 * hf), x2a); unpk8(*(const u32x4*)(qp + 48 + 8 * hf), x2b);
        const float sc = 0.125f * 1.4426950408889634f;
        float o0[8], o1[8], o2[8], o3[8];
        if (isl) {
            const float* cp = COS + qpos * 32 + 8 * hf; const float* sp = SIN + qpos * 32 + 8 * hf;
#pragma unroll
            for (int i = 0; i < 8; ++i) { const float ca = cp[i], sa = sp[i], cb = cp[16 + i], sb = sp[16 + i];
                o0[i] = (x1a[i] * ca - x2a[i] * sa) * sc; o2[i] = (x1a[i] * sa + x2a[i] * ca) * sc;
                o1[i] = (x1b[i] * cb - x2b[i] * sb) * sc; o3[i] = (x1b[i] * sb + x2b[i] * cb) * sc; }
        } else {
#pragma unroll
            for (int i = 0; i < 8; ++i) { o0[i] = x1a[i] * sc; o1[i] = x1b[i] * sc; o2[i] = x2a[i] * sc; o3[i] = x2b[i] * sc; }
        }
        qf[0] = __builtin_bit_cast(bf16x8, pk8(o0)); qf[1] = __builtin_bit_cast(bf16x8, pk8(o1)); qf[2] = __builtin_bit_cast(bf16x8, pk8(o2)); qf[3] = __builtin_bit_cast(bf16x8, pk8(o3));
    }
    float m = p.in[12][j * 8 + hh] * 1.4426950408889634f;
    float lsum = hf == 0 ? 1.0f : 0.0f;
    f32x16 O0, O1;
#pragma unroll
    for (int i = 0; i < 16; ++i) { O0[i] = 0.f; O1[i] = 0.f; }
    const int nch = isl ? 9 : 4;
    for (int ci = 0; ci < nch; ++ci) {
        const bool win = isl && ci < 5;
        int w0 = 0; size_t krow0;
        if (win) { w0 = q0 - 128 + 64 * ci; if (w0 < 0 || w0 >= 2048) continue; krow0 = rb + 256 + w0; }
        else { const int cc = isl ? ci - 5 : ci; krow0 = rb + cc * 64; }
        __syncthreads();
        if (tid < 256) {
            const int key = tid >> 2, dq = tid & 3;
            const bf16_t* src = P + (krow0 + key) * 3328 + 2560 + 512 + g * 64;
            u32x4 r1 = *(const u32x4*)(src + dq * 8), r2 = *(const u32x4*)(src + 32 + dq * 8);
            if (win) {
                float x1[8], x2[8], y1[8], y2[8]; unpk8(r1, x1); unpk8(r2, x2);
                const float* cp = COS + (w0 + key) * 32 + dq * 8; const float* sp = SIN + (w0 + key) * 32 + dq * 8;
#pragma unroll
                for (int i = 0; i < 8; ++i) { const float c_ = cp[i], s_ = sp[i]; y1[i] = x1[i] * c_ - x2[i] * s_; y2[i] = x1[i] * s_ + x2[i] * c_; }
                r1 = pk8(y1); r2 = pk8(y2);
            }
            *(u32x4*)(Ks + key * 72 + dq * 8) = r1; *(u32x4*)(Ks + key * 72 + 32 + dq * 8) = r2;
        } else {
            const int t2 = tid - 256, key = t2 >> 2, dq = t2 & 3;
            const bf16_t* src = P + (krow0 + key) * 3328 + 2560 + 640 + g * 64 + dq * 16;
            const u32x4 r1 = *(const u32x4*)src, r2 = *(const u32x4*)(src + 8);
            bf16_t* vp = Vt + (dq * 16) * 72 + key;
            vp[0 * 72] = (bf16_t)(r1.x & 0xffff); vp[1 * 72] = (bf16_t)(r1.x >> 16); vp[2 * 72] = (bf16_t)(r1.y & 0xffff); vp[3 * 72] = (bf16_t)(r1.y >> 16);
            vp[4 * 72] = (bf16_t)(r1.z & 0xffff); vp[5 * 72] = (bf16_t)(r1.z >> 16); vp[6 * 72] = (bf16_t)(r1.w & 0xffff); vp[7 * 72] = (bf16_t)(r1.w >> 16);
            vp[8 * 72] = (bf16_t)(r2.x & 0xffff); vp[9 * 72] = (bf16_t)(r2.x >> 16); vp[10 * 72] = (bf16_t)(r2.y & 0xffff); vp[11 * 72] = (bf16_t)(r2.y >> 16);
            vp[12 * 72] = (bf16_t)(r2.z & 0xffff); vp[13 * 72] = (bf16_t)(r2.z >> 16); vp[14 * 72] = (bf16_t)(r2.w & 0xffff); vp[15 * 72] = (bf16_t)(r2.w >> 16);
        }
        __syncthreads();
        f32x16 s0, s1;
#pragma unroll
        for (int i = 0; i < 16; ++i) { s0[i] = 0.f; s1[i] = 0.f; }
#pragma unroll
        for (int s = 0; s < 4; ++s) {
            const bf16x8 a0 = *(const bf16x8*)(Ks + l31 * 72 + 16 * s + 8 * hf), a1 = *(const bf16x8*)(Ks + (32 + l31) * 72 + 16 * s + 8 * hf);
            s0 = __builtin_amdgcn_mfma_f32_32x32x16_bf16(a0, qf[s], s0, 0, 0, 0);
            s1 = __builtin_amdgcn_mfma_f32_32x32x16_bf16(a1, qf[s], s1, 0, 0, 0);
        }
        if (win) {
#pragma unroll
            for (int i = 0; i < 16; ++i) { const int key = 8 * (i >> 2) + 4 * hf + (i & 3); const int d0 = qpos - (w0 + key), d1 = d0 - 32;
                if (d0 > 128 || d0 < -128) s0[i] = -INFINITY;
                if (d1 > 128 || d1 < -128) s1[i] = -INFINITY; }
        }
        float mt = s0[0];
#pragma unroll
        for (int i = 1; i < 16; ++i) mt = fmaxf(mt, s0[i]);
#pragma unroll
        for (int i = 0; i < 16; ++i) mt = fmaxf(mt, s1[i]);
        mt = fmaxf(mt, __shfl_xor(mt, 32));
        const float mnew = fmaxf(m, mt), alpha = __builtin_amdgcn_exp2f(m - mnew);
        m = mnew;
        float rs = 0.f;
#pragma unroll
        for (int i = 0; i < 16; ++i) { s0[i] = __builtin_amdgcn_exp2f(s0[i] - mnew); s1[i] = __builtin_amdgcn_exp2f(s1[i] - mnew); rs += s0[i] + s1[i]; }
        lsum = lsum * alpha + rs;
#pragma unroll
        for (int i = 0; i < 16; ++i) { O0[i] *= alpha; O1[i] *= alpha; }
#pragma unroll
        for (int kt = 0; kt < 2; ++kt)
#pragma unroll
            for (int s2 = 0; s2 < 2; ++s2) {
                u32x4 pw;
                if (kt == 0) { pw.x = pk2(s0[8 * s2], s0[8 * s2 + 1]); pw.y = pk2(s0[8 * s2 + 2], s0[8 * s2 + 3]); pw.z = pk2(s0[8 * s2 + 4], s0[8 * s2 + 5]); pw.w = pk2(s0[8 * s2 + 6], s0[8 * s2 + 7]); }
                else { pw.x = pk2(s1[8 * s2], s1[8 * s2 + 1]); pw.y = pk2(s1[8 * s2 + 2], s1[8 * s2 + 3]); pw.z = pk2(s1[8 * s2 + 4], s1[8 * s2 + 5]); pw.w = pk2(s1[8 * s2 + 6], s1[8 * s2 + 7]); }
                const bf16x8 pf = __builtin_bit_cast(bf16x8, pw);
#pragma unroll
                for (int mt2 = 0; mt2 < 2; ++mt2) {
                    const bf16_t* vp = Vt + (mt2 * 32 + l31) * 72 + kt * 32 + 16 * s2 + 4 * hf;
                    const u32x2 lo = *(const u32x2*)vp, hi = *(const u32x2*)(vp + 8);
                    u32x4 vv; vv.x = lo.x; vv.y = lo.y; vv.z = hi.x; vv.w = hi.y;
                    const bf16x8 vf = __builtin_bit_cast(bf16x8, vv);
                    if (mt2 == 0) O0 = __builtin_amdgcn_mfma_f32_32x32x16_bf16(vf, pf, O0, 0, 0, 0);
                    else O1 = __builtin_amdgcn_mfma_f32_32x32x16_bf16(vf, pf, O1, 0, 0, 0);
                }
            }
    }
    const float ltot = lsum + __shfl_xor(lsum, 32);
    const float inv = 1.0f / ltot;
    bf16_t* yp = Y + qrow * 1024 + 512 + hh * 64;
#pragma unroll
    for (int ib = 0; ib < 4; ++ib) {
        u32x2 o; o.x = pk2(O0[4 * ib] * inv, O0[4 * ib + 1] * inv); o.y = pk2(O0[4 * ib + 2] * inv, O0[4 * ib + 3] * inv);
        *(u32x2*)(yp + 8 * ib + 4 * hf) = o;
        u32x2 o2; o2.x = pk2(O1[4 * ib] * inv, O1[4 * ib + 1] * inv); o2.y = pk2(O1[4 * ib + 2] * inv, O1[4 * ib + 3] * inv);
        *(u32x2*)(yp + 32 + 8 * ib + 4 * hf) = o2;
    }
    __syncthreads();
}

__device__ __forceinline__ float partner32(float x) {
    const unsigned xb = __builtin_bit_cast(unsigned, x);
    auto r = __builtin_amdgcn_permlane32_swap(xb, xb, false, false);
    const unsigned pb = (r[0] == xb) ? r[1] : r[0];
    return __builtin_bit_cast(float, pb);
}
__device__ __forceinline__ void s5_scan_task(const Params& p, int jo, int task, unsigned char* smw) {
    unsigned char* const ws = ows(p.ws);
    const int lane = otid() & 63, l31 = lane & 31, hf = lane >> 5, l15 = lane & 15, kg = lane >> 4;
    const int dir = task & 1, g = (task >> 1) & 31, b = task >> 6;
    bf16_t* Xs = (bf16_t*)smw;
    const bf16_t* P = (const bf16_t*)(ws + OFF_AR + AO_YG);
    bf16_t* Yd = (bf16_t*)(ws + (dir ? OFF_S5B : OFF_S5F));
    const size_t rb = (size_t)b * SB;
    const int idx0 = ((jo * 2 + dir) * 32 + g) * 64 + l31, idx1 = idx0 + 32;
    const float* AB = (const float*)(ws + OFF_AB);
    const float ar0 = AB[idx0 * 2], ai0 = AB[idx0 * 2 + 1], ar1 = AB[idx1 * 2], ai1 = AB[idx1 * 2 + 1];
    bf16x8 bbf[4];
    { const float* BR = (const float*)(ws + OFF_BBR); const float* BI = (const float*)(ws + OFF_BBI);
      float t8[8];
#pragma unroll
      for (int j = 0; j < 8; ++j) t8[j] = BR[(size_t)idx0 * 16 + 8 * hf + j];
      bbf[0] = __builtin_bit_cast(bf16x8, pk8(t8));
#pragma unroll
      for (int j = 0; j < 8; ++j) t8[j] = BR[(size_t)idx1 * 16 + 8 * hf + j];
      bbf[1] = __builtin_bit_cast(bf16x8, pk8(t8));
#pragma unroll
      for (int j = 0; j < 8; ++j) t8[j] = BI[(size_t)idx0 * 16 + 8 * hf + j];
      bbf[2] = __builtin_bit_cast(bf16x8, pk8(t8));
#pragma unroll
      for (int j = 0; j < 8; ++j) t8[j] = BI[(size_t)idx1 * 16 + 8 * hf + j];
      bbf[3] = __builtin_bit_cast(bf16x8, pk8(t8)); }
    bf16x8 cmf[4], dskf;
    { const float* c1 = p.in[23] + (size_t)((jo * 32 + g) * 16 + l15) * 64; const float* c2 = p.in[24] + (size_t)((jo * 32 + g) * 16 + l15) * 64;
#pragma unroll
      for (int ks = 0; ks < 4; ++ks) { float t8[8];
#pragma unroll
          for (int j = 0; j < 8; ++j) { const int n = 8 * ks + 2 * kg + (j >> 2), q = j & 3; const int pp = n + 32 * (q & 1); t8[j] = (q < 2) ? c1[pp] : -c2[pp]; }
          cmf[ks] = __builtin_bit_cast(bf16x8, pk8(t8)); }
      float t8[8]; const float dv = p.in[25][jo * 512 + g * 16 + l15];
#pragma unroll
      for (int j = 0; j < 8; ++j) t8[j] = (kg < 2 && 8 * kg + j == l15) ? dv : 0.f;
      dskf = __builtin_bit_cast(bf16x8, pk8(t8)); }
    float xr0 = 0.f, xi0 = 0.f, xr1 = 0.f, xi1 = 0.f;
    u32x4 ua = *(const u32x4*)(P + (rb + scan_row(dir, l31)) * 512 + g * 16 + 8 * hf);
    for (int c = 0; c < 72; ++c) {
        f32x16 D0, D1, D2, D3;
#pragma unroll
        for (int i = 0; i < 16; ++i) { D0[i] = 0.f; D1[i] = 0.f; D2[i] = 0.f; D3[i] = 0.f; }
        { const bf16x8 uf = __builtin_bit_cast(bf16x8, ua);
          D0 = __builtin_amdgcn_mfma_f32_32x32x16_bf16(uf, bbf[0], D0, 0, 0, 0); D1 = __builtin_amdgcn_mfma_f32_32x32x16_bf16(uf, bbf[1], D1, 0, 0, 0);
          D2 = __builtin_amdgcn_mfma_f32_32x32x16_bf16(uf, bbf[2], D2, 0, 0, 0); D3 = __builtin_amdgcn_mfma_f32_32x32x16_bf16(uf, bbf[3], D3, 0, 0, 0); }
        if (c + 1 < 72) ua = *(const u32x4*)(P + (rb + scan_row(dir, (c + 1) * 32 + l31)) * 512 + g * 16 + 8 * hf);
#pragma unroll
        for (int m = 0; m < 4; ++m) {
            float A_[4][4], B_[4][4];
#pragma unroll
            for (int k = 0; k < 4; ++k) { const int i = 4 * m + k;
                const float n0r = ar0 * xr0 - ai0 * xi0 + D0[i], n0i = ar0 * xi0 + ai0 * xr0 + D2[i];
                const float n1r = ar1 * xr1 - ai1 * xi1 + D1[i], n1i = ar1 * xi1 + ai1 * xr1 + D3[i];
                xr0 = n0r; xi0 = n0i; xr1 = n1r; xi1 = n1i; A_[k][0] = xr0; A_[k][1] = xr1; A_[k][2] = xi0; A_[k][3] = xi1; }
            { const float q0 = partner32(xr0), q1 = partner32(xi0), q2 = partner32(xr1), q3 = partner32(xi1);
              xr0 = hf ? q0 : xr0; xi0 = hf ? q1 : xi0; xr1 = hf ? q2 : xr1; xi1 = hf ? q3 : xi1; }
#pragma unroll
            for (int k = 0; k < 4; ++k) { const int i = 4 * m + k;
                const float n0r = ar0 * xr0 - ai0 * xi0 + D0[i], n0i = ar0 * xi0 + ai0 * xr0 + D2[i];
                const float n1r = ar1 * xr1 - ai1 * xi1 + D1[i], n1i = ar1 * xi1 + ai1 * xr1 + D3[i];
                xr0 = n0r; xi0 = n0i; xr1 = n1r; xi1 = n1i; B_[k][0] = xr0; B_[k][1] = xr1; B_[k][2] = xi0; B_[k][3] = xi1; }
            { const float q0 = partner32(xr0), q1 = partner32(xi0), q2 = partner32(xr1), q3 = partner32(xi1);
              xr0 = hf ? xr0 : q0; xi0 = hf ? xi0 : q1; xr1 = hf ? xr1 : q2; xi1 = hf ? xi1 : q3; }
#pragma unroll
            for (int k = 0; k < 4; ++k) { const int t = 8 * m + 4 * hf + k;
                u32x2 w2; w2.x = pk2(hf ? B_[k][0] : A_[k][0], hf ? B_[k][1] : A_[k][1]); w2.y = pk2(hf ? B_[k][2] : A_[k][2], hf ? B_[k][3] : A_[k][3]);
                *(u32x2*)(Xs + t * 136 + 4 * l31) = w2; }
        }
        asm volatile("s_waitcnt lgkmcnt(0)" ::: "memory"); __builtin_amdgcn_wave_barrier();
#pragma unroll
        for (int tt = 0; tt < 2; ++tt) {
            f32x4 acc = {0.f, 0.f, 0.f, 0.f};
#pragma unroll
            for (int ks = 0; ks < 4; ++ks) { const bf16x8 a = *(const bf16x8*)(Xs + (16 * tt + l15) * 136 + 32 * ks + 8 * kg);
                acc = __builtin_amdgcn_mfma_f32_16x16x32_bf16(a, cmf[ks], acc, 0, 0, 0); }
#pragma unroll
            for (int i = 0; i < 4; ++i) { const size_t row = rb + scan_row(dir, c * 32 + 16 * tt + 4 * kg + i); Yd[row * 512 + g * 16 + l15] = (bf16_t)(pk2(acc[i], 0.f) & 0xffff); }
        }
        asm volatile("s_waitcnt lgkmcnt(0)" ::: "memory"); __builtin_amdgcn_wave_barrier();
    }
}
__device__ __forceinline__ void rwkv_prep_rows(const Params& p, int jo) {
    unsigned char* const ws = ows(p.ws);
    const int tid_ = otid(); const int lane = tid_ & 63, w = tid_ >> 6;
    const bf16_t* P = (const bf16_t*)(ws + OFF_AR + AO_P);
    bf16_t* PR = (bf16_t*)(ws + OFF_AR + AO_PR); bf16_t* Lb = (bf16_t*)(ws + OFF_AR + AO_L);
    bf16_t* YGu = (bf16_t*)(ws + OFF_AR + AO_YG);
    float* KN = (float*)(ws + OFF_KN);
    const int nwv = gridDim.x * 8, rpw = (TT + nwv - 1) / nwv, row_lo = (blockIdx.x * 8 + w) * rpw, row_hi = (row_lo + rpw < TT) ? row_lo + rpw : TT;
    if (row_lo >= row_hi) return;
    const bool l3 = lane < 48;
    f32x4 mu4[4][2];
#pragma unroll
    for (int it = 0; it < 4; ++it) { const int c0 = (lane + 64 * it) * 8;
        if (it < 3 || l3) { mu4[it][0] = *(const f32x4*)(p.in[27] + jo * 1920 + c0); mu4[it][1] = *(const f32x4*)(p.in[27] + jo * 1920 + c0 + 4); }
        else { mu4[it][0] = f32x4{0.f, 0.f, 0.f, 0.f}; mu4[it][1] = mu4[it][0]; } }
    const f32x4 kk0 = *(const f32x4*)(p.in[33] + jo * 512 + lane * 8), kk1 = *(const f32x4*)(p.in[33] + jo * 512 + lane * 8 + 4);
    u32x4 pa[4], px[4], pn[4];
    { const int rp = row_lo > 0 ? row_lo - 1 : 0;
#pragma unroll
      for (int it = 0; it < 4; ++it) { const int c0 = (lane + 64 * it) * 8;
        if (it < 3 || l3) { pa[it] = *(const u32x4*)(P + (size_t)rp * 2560 + 512 + c0); px[it] = *(const u32x4*)(P + (size_t)row_lo * 2560 + 512 + c0); }
        else { pa[it] = u32x4{0u, 0u, 0u, 0u}; px[it] = pa[it]; } } }
    for (int row = row_lo; row < row_hi; ++row) {
        const int s = row % SB;
        const float hp = (s != 0 && s != 256) ? 0.5f : 0.f, hn = (s != 255 && s != 2303) ? 0.5f : 0.f;
        const int rn = row + 1 < TT ? row + 1 : TT - 1;
#pragma unroll
        for (int it = 0; it < 4; ++it) { const int c0 = (lane + 64 * it) * 8;
            if (it < 3 || l3) pn[it] = *(const u32x4*)(P + (size_t)rn * 2560 + 512 + c0); else pn[it] = u32x4{0u, 0u, 0u, 0u}; }
        *(u32x4*)(YGu + (size_t)row * 512 + lane * 8) = *(const u32x4*)(P + (size_t)row * 2560 + lane * 8);
#pragma unroll
        for (int it = 0; it < 4; ++it) {
            const int c0 = (lane + 64 * it) * 8;
            float x[8], a[8], bq[8], o[8];
            unpk8(px[it], x); unpk8(pa[it], a); unpk8(pn[it], bq);
#pragma unroll
            for (int i = 0; i < 8; ++i) { const float m = (i < 4) ? mu4[it][0][i & 3] : mu4[it][1][i & 3];
                o[i] = x[i] + m * (hp * a[i] + hn * bq[i] - x[i]); }
            if (it == 3) {
                if (lane < 16) {
#pragma unroll
                    for (int i = 0; i < 8; ++i) o[i] = tanh_f(o[i]); }
                else if (lane >= 32) {
#pragma unroll
                    for (int i = 0; i < 8; ++i) o[i] = sigm(o[i]); } }
            if (it == 1) { float ssq = 0.f;
#pragma unroll
                for (int i = 0; i < 8; ++i) { const float t_ = o[i] * ((i < 4) ? kk0[i & 3] : kk1[i & 3]); ssq += t_ * t_; }
                ssq = sum8(ssq);
                if ((lane & 7) == 0) KN[(size_t)row * 8 + (lane >> 3)] = 1.0f / fmaxf(sqrtf(ssq), 1e-12f); }
            if (it < 3) *(u32x4*)(PR + (size_t)row * 1536 + c0) = pk8(o);
            else if (l3) *(u32x4*)(Lb + (size_t)row * 384 + (c0 - 1536)) = pk8(o);
        }
#pragma unroll
        for (int it = 0; it < 4; ++it) { pa[it] = px[it]; px[it] = pn[it]; }
    }
}
__device__ __forceinline__ void rwkv_stage_loop(const Params& p, int jo, int first, int stride, int nitems, unsigned char* sm) {
    unsigned char* const ws = ows(p.ws);
    const int tid = otid();
    if (first >= nitems) return;
    const bf16_t* PR = (const bf16_t*)(ws + OFF_AR + AO_PR); const bf16_t* LO = (const bf16_t*)(ws + OFF_AR + AO_P);
    const float* KN = (const float*)(ws + OFF_KN);
    float* L_lw = (float*)sm; float* L_av = L_lw + 64 * 68; float* L_bv = L_av + 64 * 68; float* L_kd = L_bv + 64 * 68; float* L_rr = L_kd + 64 * 68;
    const int t64 = tid >> 3, c8 = (tid & 7) * 8;
    u32x4 gr, gk, gw, ga; float inn;
#define RS_LOAD(IT_) do { const int u_ = (IT_) / 36, R_ = (IT_) - u_ * 36, dir_ = u_ & 1, hd_ = (u_ >> 1) & 7, b_ = u_ >> 4; \
        const size_t row = (size_t)b_ * SB + scan_row(dir_, 64 * R_ + t64); const int ch_ = hd_ * 64 + c8; \
        gr = *(const u32x4*)(PR + row * 1536 + ch_); gk = *(const u32x4*)(PR + row * 1536 + 512 + ch_); \
        gw = *(const u32x4*)(LO + row * 2560 + dir_ * 512 + ch_); ga = *(const u32x4*)(LO + row * 2560 + 1024 + dir_ * 512 + ch_); inn = KN[row * 8 + hd_]; } while (0)
    f32x4 w0r[2], a0r[2], kkr[2], kar[2]; int cur_u = -1;
#pragma unroll
    for (int i = 0; i < 2; ++i) { w0r[i] = (f32x4){0.f, 0.f, 0.f, 0.f}; a0r[i] = w0r[i]; kkr[i] = w0r[i]; kar[i] = w0r[i]; }
    RS_LOAD(first);
    for (int item = first; item < nitems; item += stride) {
    const int u = item / 36, R = item - u * 36;
    const int dir = u & 1, hd = (u >> 1) & 7;
    {
        const int ch = hd * 64 + c8;
        float r8[8], k8[8], wl8[8], al8[8];
        unpk8(gr, r8); unpk8(gk, k8); unpk8(gw, wl8); unpk8(ga, al8);
        if (u != cur_u) { cur_u = u;
            const float* w0p = p.in[28] + (jo * 2 + dir) * 512 + ch; const float* a0p = p.in[30] + (jo * 2 + dir) * 512 + ch;
            const float* kkp = p.in[33] + jo * 512 + ch; const float* kap = p.in[34] + jo * 512 + ch;
#pragma unroll
            for (int i = 0; i < 2; ++i) { w0r[i] = *(const f32x4*)(w0p + 4 * i); a0r[i] = *(const f32x4*)(a0p + 4 * i); kkr[i] = *(const f32x4*)(kkp + 4 * i); kar[i] = *(const f32x4*)(kap + 4 * i); } }
        float lw[8], av[8], bv[8], kd[8];
#pragma unroll
        for (int i = 0; i < 8; ++i) {
            const float w0v = w0r[i >> 2][i & 3], a0v = a0r[i >> 2][i & 3], kkv = kkr[i >> 2][i & 3], kav = kar[i >> 2][i & 3];
            const float z = -(w0v + wl8[i]);
            const float sp = fmaxf(z, 0.f) + 0.6931471805599453f * __builtin_amdgcn_logf(1.0f + __builtin_amdgcn_exp2f(-1.4426950408889634f * fabsf(z)));
            lw[i] = -__builtin_amdgcn_exp2f(-1.4426950408889634f * (sp + 0.5f)) * 1.4426950408889634f;
            const float a = sigm(a0v + al8[i]);
            const float kn = k8[i] * kkv * inn;
            kd[i] = k8[i] * (1.0f + (a - 1.0f) * kav); av[i] = -kn; bv[i] = kn * a;
        }
        const int o = t64 * 68 + c8;
        *(f32x4*)(L_lw + o) = (f32x4){lw[0], lw[1], lw[2], lw[3]}; *(f32x4*)(L_lw + o + 4) = (f32x4){lw[4], lw[5], lw[6], lw[7]};
        *(f32x4*)(L_av + o) = (f32x4){av[0], av[1], av[2], av[3]}; *(f32x4*)(L_av + o + 4) = (f32x4){av[4], av[5], av[6], av[7]};
        *(f32x4*)(L_bv + o) = (f32x4){bv[0], bv[1], bv[2], bv[3]}; *(f32x4*)(L_bv + o + 4) = (f32x4){bv[4], bv[5], bv[6], bv[7]};
        *(f32x4*)(L_kd + o) = (f32x4){kd[0], kd[1], kd[2], kd[3]}; *(f32x4*)(L_kd + o + 4) = (f32x4){kd[4], kd[5], kd[6], kd[7]};
        *(f32x4*)(L_rr + o) = (f32x4){r8[0], r8[1], r8[2], r8[3]}; *(f32x4*)(L_rr + o + 4) = (f32x4){r8[4], r8[5], r8[6], r8[7]};
    }
    LDS_BARRIER();
    if (item + stride < nitems) { RS_LOAD(item + stride); }
    {
        const int sq = tid >> 7, tl = tid & 127, sj = tl >> 1, th = tl & 1;
        float cw[8], lwk[8]; float run = 0.f;
#pragma unroll
        for (int k = 0; k < 8; ++k) { lwk[k] = L_lw[(sq * 16 + 8 * th + k) * 68 + sj]; run += lwk[k]; cw[k] = run; }
        const float ptot = dppf<0xB1>(run);
        const float off = th ? ptot : 0.f, cw15 = run + ptot;
        u32x2* GE = (u32x2*)(ws + OFF_GE) + ((size_t)(u * 144 + 4 * R + sq) * 64 + sj) * 16 + 8 * th;
#pragma unroll
        for (int k = 0; k < 8; ++k) {
            const int o = (sq * 16 + 8 * th + k) * 68 + sj;
            const float c = off + cw[k];
            const float Ec = __builtin_amdgcn_exp2f(c), Ep = __builtin_amdgcn_exp2f(c - lwk[k]), iE = __builtin_amdgcn_rcpf(Ec);
            u32x2 ov; ov.x = pk2(L_av[o] * Ep, L_rr[o] * Ec); ov.y = pk2(L_bv[o] * iE, L_kd[o] * iE);
            GE[k] = ov;
        }
        ((float*)(ws + OFF_GW))[(size_t)(u * 144 + 4 * R + sq) * 64 + sj] = __builtin_amdgcn_exp2f(cw15);
    }
    LDS_BARRIER();
    }
#undef RS_LOAD
}
__device__ __forceinline__ bf16x8 frag_lo(const f32x4 v) { u32x4 w; w.x = pk2(v[0], v[1]); w.y = pk2(v[2], v[3]); w.z = 0u; w.w = 0u; return __builtin_bit_cast(bf16x8, w); }
__device__ __forceinline__ bf16x8 frag_b64(const bf16_t* pz) { const u32x2 v = *(const u32x2*)pz; u32x4 w; w.x = v.x; w.y = v.y; w.z = 0u; w.w = 0u; return __builtin_bit_cast(bf16x8, w); }
__device__ __forceinline__ u32x2 pk4v(const f32x4 v) { u32x2 r; r.x = pk2(v[0], v[1]); r.y = pk2(v[2], v[3]); return r; }
#define MF16(a, b, c) __builtin_amdgcn_mfma_f32_16x16x32_bf16((a), (b), (c), 0, 0, 0)
constexpr int RW_SCR = 19712, RW_SLOT = 5120, RW_SLOT0 = 4 * RW_SCR;
__device__ __forceinline__ void rwkv_chunk_unit(const Params& p, int jo, int u, unsigned char* sm) {
    unsigned char* const ws = ows(p.ws);
    const int tid = otid(), lane = tid & 63, w = tid >> 6, l15 = lane & 15, kg = lane >> 4;
    const int dir = u & 1, hd = (u >> 1) & 7, b = u >> 4;
    const bf16_t* PR = (const bf16_t*)(ws + OFF_AR + AO_PR); const bf16_t* LO = (const bf16_t*)(ws + OFF_AR + AO_P);
    const float* KN = (const float*)(ws + OFF_KN);
    bf16_t* O = (bf16_t*)(ws + OFF_AR + (dir ? AO_OB : AO_OF));
    const size_t rb = (size_t)b * SB;
    const int sq = tid >> 7, tl = tid & 127, sj = tl >> 1, th = tl & 1, ch = hd * 64 + sj;
    const u32x4* GEb = (const u32x4*)(ws + OFF_GE); const float* GWb = (const float*)(ws + OFF_GW);
    f32x4 S[4];
#pragma unroll
    for (int i = 0; i < 4; ++i) S[i] = (f32x4){0.f, 0.f, 0.f, 0.f};
    u32x4 ge[4], ge2[4]; float e15, e152; unsigned vv[8], vv2[8];
#define RW_LOADX(R_, ge_, e_, vv_) do { const size_t cidx = (size_t)(u * 144 + 4 * (R_) + sq) * 64 + sj; const u32x4* gp = GEb + cidx * 8 + 4 * th; \
        ge_[0] = gp[0]; ge_[1] = gp[1]; ge_[2] = gp[2]; ge_[3] = gp[3]; e_ = GWb[cidx]; \
        _Pragma("unroll") for (int k = 0; k < 8; ++k) { const size_t row = rb + scan_row(dir, (4 * (R_) + sq) * 16 + 8 * th + k); vv_[k] = *(const unsigned*)(PR + row * 1536 + 1024 + (ch & ~1)); } } while (0)
#define RW_LOAD(R_) RW_LOADX(R_, ge2, e152, vv2)
    RW_LOADX(0, ge, e15, vv); RW_LOADX(1, ge2, e152, vv2);
    for (int R = 0; R < 36; ++R) {
        for (int rep1 = 0; rep1 < 1 + DUPB(20); ++rep1) {
            unsigned char* sc = sm + sq * RW_SCR;
            bf16_t* At_ = (bf16_t*)sc; bf16_t* Rt_ = At_ + 16 * 72; bf16_t* Bt_ = Rt_ + 16 * 72; bf16_t* Kt_ = Bt_ + 16 * 72;
            bf16_t* AtT = Kt_ + 16 * 72; bf16_t* BhT = AtT + 64 * 16; bf16_t* KhT = BhT + 64 * 16; bf16_t* Vt_ = KhT + 64 * 16;
            float* WC = (float*)(sc + 18432);
            unsigned at2[4], bh2[4], kh2[4];
#pragma unroll
            for (int k2 = 0; k2 < 4; ++k2) {
                const unsigned x0 = ge[k2].x, y0 = ge[k2].y, x1 = ge[k2].z, y1 = ge[k2].w;
                const int t0 = 8 * th + 2 * k2;
                At_[t0 * 72 + sj] = (bf16_t)(x0 & 0xffff); Rt_[t0 * 72 + sj] = (bf16_t)(x0 >> 16); Bt_[t0 * 72 + sj] = (bf16_t)(y0 & 0xffff); Kt_[t0 * 72 + sj] = (bf16_t)(y0 >> 16);
                At_[(t0 + 1) * 72 + sj] = (bf16_t)(x1 & 0xffff); Rt_[(t0 + 1) * 72 + sj] = (bf16_t)(x1 >> 16); Bt_[(t0 + 1) * 72 + sj] = (bf16_t)(y1 & 0xffff); Kt_[(t0 + 1) * 72 + sj] = (bf16_t)(y1 >> 16);
                at2[k2] = (x0 & 0xffffu) | (x1 << 16);
                bh2[k2] = pk2(bf2f(y0 & 0xffff) * e15, bf2f(y1 & 0xffff) * e15);
                kh2[k2] = pk2(bf2f(y0 >> 16) * e15, bf2f(y1 >> 16) * e15);
            }
            *(u32x4*)(AtT + sj * 16 + 8 * th) = (u32x4){at2[0], at2[1], at2[2], at2[3]};
            *(u32x4*)(BhT + sj * 16 + 8 * th) = (u32x4){bh2[0], bh2[1], bh2[2], bh2[3]};
            *(u32x4*)(KhT + sj * 16 + 8 * th) = (u32x4){kh2[0], kh2[1], kh2[2], kh2[3]};
            { const int vs = (ch & 1) * 16; u32x4 v4; v4.x = ((vv[0] >> vs) & 0xffffu) | ((vv[1] >> vs) << 16); v4.y = ((vv[2] >> vs) & 0xffffu) | ((vv[3] >> vs) << 16); v4.z = ((vv[4] >> vs) & 0xffffu) | ((vv[5] >> vs) << 16); v4.w = ((vv[6] >> vs) & 0xffffu) | ((vv[7] >> vs) << 16);
              *(u32x4*)(Vt_ + sj * 16 + 8 * th) = v4; }
            if (th == 0) WC[sj] = e15;
        }
#pragma unroll
        for (int k = 0; k < 4; ++k) ge[k] = ge2[k];
#pragma unroll
        for (int k = 0; k < 8; ++k) vv[k] = vv2[k];
        e15 = e152;
        if (R + 2 < 36) { RW_LOAD(R + 2); }
        LDS_BARRIER();
        for (int rep2 = 0; rep2 < 1 + DUPB(21); ++rep2) if (w < 4) {
            unsigned char* sc = sm + w * RW_SCR;
            const bf16_t* At_ = (const bf16_t*)sc; const bf16_t* Rt_ = At_ + 16 * 72; const bf16_t* Bt_ = Rt_ + 16 * 72; const bf16_t* Kt_ = Bt_ + 16 * 72;
            const bf16_t* AtT = Kt_ + 16 * 72; const bf16_t* Vt_ = AtT + 3 * 64 * 16;
            float* Lm = (float*)(sc + 17408);
            unsigned char* sl = sm + RW_SLOT0 + w * RW_SLOT;
            u32x2* ATs = (u32x2*)sl; u32x2* GTs = (u32x2*)(sl + 2048); u32x4* MfS = (u32x4*)(sl + 4096);
            const f32x4 z4 = {0.f, 0.f, 0.f, 0.f};
            f32x4 Lab = z4, LakT = z4, Mbr = z4, Mkr = z4;
#pragma unroll
            for (int ks = 0; ks < 2; ++ks) {
                const bf16x8 af = *(const bf16x8*)(At_ + l15 * 72 + 32 * ks + 8 * kg), rf = *(const bf16x8*)(Rt_ + l15 * 72 + 32 * ks + 8 * kg);
                const bf16x8 bf = *(const bf16x8*)(Bt_ + l15 * 72 + 32 * ks + 8 * kg), kf = *(const bf16x8*)(Kt_ + l15 * 72 + 32 * ks + 8 * kg);
                Lab = MF16(bf, af, Lab); LakT = MF16(af, kf, LakT); Mbr = MF16(bf, rf, Mbr); Mkr = MF16(kf, rf, Mkr);
            }
#pragma unroll
            for (int i = 0; i < 4; ++i) { const int rrow = 4 * kg + i;
                Lab[i] = (rrow < l15) ? Lab[i] : 0.f;
                LakT[i] = (l15 < rrow) ? LakT[i] : 0.f;
                Mbr[i] = (rrow <= l15) ? Mbr[i] : 0.f; Mkr[i] = (rrow <= l15) ? Mkr[i] : 0.f;
                Lm[rrow * 16 + l15] = Lab[i]; }
            { u32x4 mw; mw.x = pk2(Mbr[0], Mbr[1]); mw.y = pk2(Mbr[2], Mbr[3]); mw.z = pk2(Mkr[0], Mkr[1]); mw.w = pk2(Mkr[2], Mkr[3]); MfS[lane] = mw; }
            asm volatile("s_waitcnt lgkmcnt(0)" ::: "memory"); __builtin_amdgcn_wave_barrier();
            float T[16];
#pragma unroll
            for (int r = 15; r >= 0; --r) {
                float acc = (r == l15) ? 1.0f : 0.0f;
                const f32x4 L0 = *(const f32x4*)(Lm + r * 16), L1 = *(const f32x4*)(Lm + r * 16 + 4), L2 = *(const f32x4*)(Lm + r * 16 + 8), L3 = *(const f32x4*)(Lm + r * 16 + 12);
#pragma unroll
                for (int m = r + 1; m < 16; ++m) { const float lv = (m < 4) ? L0[m & 3] : (m < 8) ? L1[m & 3] : (m < 12) ? L2[m & 3] : L3[m & 3]; acc += lv * T[m]; }
                T[r] = acc;
            }
            f32x4 Tsel;
#pragma unroll
            for (int i = 0; i < 4; ++i) Tsel[i] = (kg == 0) ? T[i] : (kg == 1) ? T[4 + i] : (kg == 2) ? T[8 + i] : T[12 + i];
            const bf16x8 Tf = frag_lo(Tsel);
            const f32x4 LT = MF16(frag_lo(LakT), Tf, z4);
            const bf16x8 LTf = frag_lo(LT);
#pragma unroll
            for (int t1 = 0; t1 < 4; ++t1) {
                const f32x4 at = MF16(frag_b64(AtT + (16 * t1 + l15) * 16 + 4 * kg), Tf, z4);
                ATs[t1 * 64 + lane] = pk4v(at);
                const f32x4 gt = MF16(LTf, frag_b64(Vt_ + (16 * t1 + l15) * 16 + 4 * kg), z4);
                GTs[t1 * 64 + lane] = pk4v(gt);
            }
        }
        LDS_BARRIER();
        if (w < 4) {
#pragma unroll
            for (int q = 0; q < 4; ++q) {
                const unsigned char* sc = sm + q * RW_SCR;
                const bf16_t* Rt_ = (const bf16_t*)sc + 16 * 72; const bf16_t* BhT = (const bf16_t*)sc + 4 * 16 * 72 + 64 * 16; const bf16_t* KhT = BhT + 64 * 16; const bf16_t* Vt_ = KhT + 64 * 16;
                const float* WC = (const float*)(sc + 18432);
                const unsigned char* sl = sm + RW_SLOT0 + q * RW_SLOT;
                const u32x2* ATs = (const u32x2*)sl; const u32x2* GTs = (const u32x2*)(sl + 2048); const u32x4* MfS = (const u32x4*)(sl + 4096);
                bf16x8 Sf[2];
#pragma unroll
                for (int pi = 0; pi < 2; ++pi) { u32x4 sw; sw.x = pk2(S[2 * pi][0], S[2 * pi][1]); sw.y = pk2(S[2 * pi][2], S[2 * pi][3]); sw.z = pk2(S[2 * pi + 1][0], S[2 * pi + 1][1]); sw.w = pk2(S[2 * pi + 1][2], S[2 * pi + 1][3]);
                    Sf[pi] = __builtin_bit_cast(bf16x8, sw); }
                f32x4 ut = unpk4v(GTs[w * 64 + lane]);
#pragma unroll
                for (int pi = 0; pi < 2; ++pi) { const u32x2 a0 = ATs[(2 * pi) * 64 + lane], a1 = ATs[(2 * pi + 1) * 64 + lane]; u32x4 aw; aw.x = a0.x; aw.y = a0.y; aw.z = a1.x; aw.w = a1.y;
                    ut = MF16(__builtin_bit_cast(bf16x8, aw), Sf[pi], ut); }
                const u32x2 v2 = *(const u32x2*)(Vt_ + (16 * w + l15) * 16 + 4 * kg);
                u32x4 uvw; uvw.x = pk2(ut[0], ut[1]); uvw.y = pk2(ut[2], ut[3]); uvw.z = v2.x; uvw.w = v2.y;
                const bf16x8 UVf = __builtin_bit_cast(bf16x8, uvw);
                f32x4 oa = MF16(__builtin_bit_cast(bf16x8, MfS[lane]), UVf, ((f32x4){0.f, 0.f, 0.f, 0.f}));
#pragma unroll
                for (int pi = 0; pi < 2; ++pi) { const u32x2 r0 = *(const u32x2*)(Rt_ + l15 * 72 + 32 * pi + 4 * kg), r1 = *(const u32x2*)(Rt_ + l15 * 72 + 32 * pi + 16 + 4 * kg);
                    u32x4 rw; rw.x = r0.x; rw.y = r0.y; rw.z = r1.x; rw.w = r1.y;
                    oa = MF16(__builtin_bit_cast(bf16x8, rw), Sf[pi], oa); }
#pragma unroll
                for (int i = 0; i < 4; ++i) { const size_t row = rb + scan_row(dir, (4 * R + q) * 16 + 4 * kg + i); O[row * 512 + hd * 64 + 16 * w + l15] = (bf16_t)(pk2(oa[i], 0.f) & 0xffff); }
#pragma unroll
                for (int t2 = 0; t2 < 4; ++t2) {
                    const u32x2 b2 = *(const u32x2*)(BhT + (16 * t2 + l15) * 16 + 4 * kg), k2 = *(const u32x2*)(KhT + (16 * t2 + l15) * 16 + 4 * kg);
                    u32x4 bw; bw.x = b2.x; bw.y = b2.y; bw.z = k2.x; bw.w = k2.y;
                    const f32x4 dv = *(const f32x4*)(WC + 16 * t2 + 4 * kg);
                    S[t2] = MF16(__builtin_bit_cast(bf16x8, bw), UVf, S[t2] * dv);
                }
            }
        }
        LDS_BARRIER();
    }
#undef RW_LOAD
#undef RW_LOADX
}
__device__ __forceinline__ void odd_finish_rows(const Params& p, int jo, bool skip_ctx) {
    unsigned char* const ws = ows(p.ws);
    const int tid_ = otid(); const int lane = tid_ & 63, w = tid_ >> 6;
    const bf16_t* YF = (const bf16_t*)(ws + OFF_S5F); const bf16_t* YB = (const bf16_t*)(ws + OFF_S5B);
    bf16_t* YG = (bf16_t*)(ws + OFF_AR + AO_YG);
    const bf16_t* OF = (const bf16_t*)(ws + OFF_AR + AO_OF); const bf16_t* OB = (const bf16_t*)(ws + OFF_AR + AO_OB);
    const bf16_t* PR = (const bf16_t*)(ws + OFF_AR + AO_PR); const bf16_t* LO = (const bf16_t*)(ws + OFF_AR + AO_P);
    bf16_t* Y = (bf16_t*)(ws + OFF_AR + AO_Y);
    const int c0 = lane * 8;
    const int nwv = gridDim.x * 8, rpw = (TT + nwv - 1) / nwv, row_lo = (blockIdx.x * 8 + w) * rpw, row_hi = (row_lo + rpw < TT) ? row_lo + rpw : TT;
    const f32x4 ds0 = *(const f32x4*)(p.in[25] + jo * 512 + c0), ds1 = *(const f32x4*)(p.in[25] + jo * 512 + c0 + 4);
    const f32x4 rk0 = *(const f32x4*)(p.in[35] + jo * 512 + c0), rk1 = *(const f32x4*)(p.in[35] + jo * 512 + c0 + 4);
    const f32x4 lg0 = *(const f32x4*)(p.in[36] + jo * 512 + c0), lg1 = *(const f32x4*)(p.in[36] + jo * 512 + c0 + 4);
    const f32x4 lb0 = *(const f32x4*)(p.in[37] + jo * 512 + c0), lb1 = *(const f32x4*)(p.in[37] + jo * 512 + c0 + 4);
    for (int row = row_lo; row < row_hi; ++row) {
        if (skip_ctx && (row % SB) < 256) continue;
        {
            float fa[8], fb[8], uu[8], o[8];
            unpk8(*(const u32x4*)(YF + (size_t)row * 512 + c0), fa); unpk8(*(const u32x4*)(YB + (size_t)row * 512 + c0), fb);
            unpk8(*(const u32x4*)(YG + (size_t)row * 512 + c0), uu);
#pragma unroll
            for (int i = 0; i < 4; ++i) { o[i] = fa[i] + fb[i] + ds0[i] * uu[i]; o[4 + i] = fa[4 + i] + fb[4 + i] + ds1[i] * uu[4 + i]; }
#pragma unroll
            for (int i = 0; i < 8; ++i) { const float x = o[i]; o[i] = 0.5f * x * (1.0f + tanh_f(0.7978845608028654f * (x + 0.044715f * x * x * x))); }
            *(u32x4*)(YG + (size_t)row * 512 + c0) = pk8(o);
        }
        {
            float o[8], r[8], k[8], v[8], g[8];
            { float fa[8], fb[8]; unpk8(*(const u32x4*)(OF + (size_t)row * 512 + c0), fa); unpk8(*(const u32x4*)(OB + (size_t)row * 512 + c0), fb);
#pragma unroll
              for (int i = 0; i < 8; ++i) o[i] = fa[i] + fb[i]; }
            unpk8(*(const u32x4*)(PR + (size_t)row * 1536 + c0), r); unpk8(*(const u32x4*)(PR + (size_t)row * 1536 + 512 + c0), k); unpk8(*(const u32x4*)(PR + (size_t)row * 1536 + 1024 + c0), v);
            unpk8(*(const u32x4*)(LO + (size_t)row * 2560 + 2048 + c0), g);
            float sm_ = 0.f, bo = 0.f;
#pragma unroll
            for (int i = 0; i < 8; ++i) { sm_ += o[i]; bo += r[i] * k[i] * ((i < 4) ? rk0[i & 3] : rk1[i & 3]); }
            const float mean = sum8(sm_) * (1.0f / 64.0f); bo = sum8(bo);
            float sq = 0.f;
#pragma unroll
            for (int i = 0; i < 8; ++i) { const float d = o[i] - mean; sq += d * d; }
            const float rstd = rsqrtf(sum8(sq) * (1.0f / 64.0f) + 64e-5f);
            float y[8];
#pragma unroll
            for (int i = 0; i < 8; ++i) y[i] = ((o[i] - mean) * rstd * ((i < 4) ? lg0[i & 3] : lg1[i & 3]) + ((i < 4) ? lb0[i & 3] : lb1[i & 3]) + bo * v[i]) * g[i];
            *(u32x4*)(Y + (size_t)row * 1024 + 512 + c0) = pk8(y);
        }
    }
}

#define PHB unsigned char* const ws = ows(p.ws); bf16_t* const H = (bf16_t*)(ws + OFF_H); _Float16* const X = (_Float16*)(ws + OFF_X); const float* const mod = (const float*)(ws + OFF_MOD); bf16_t* const PbE = (bf16_t*)(ws + OFF_AR + AE_P); bf16_t* const YbE = (bf16_t*)(ws + OFF_AR + AE_Y); bf16_t* const PbO = (bf16_t*)(ws + OFF_AR + AO_P); bf16_t* const YbO = (bf16_t*)(ws + OFF_AR + AO_Y); const unsigned* const cnt0 = (const unsigned*)(ws + OFF_CNT); (void)H; (void)X; (void)mod; (void)PbE; (void)YbE; (void)PbO; (void)YbO; (void)cnt0;
#define LAYER_PAIR_BODY(lp) {  \
         \
        { \
            const int layer = 2 * lp, j = lp; \
            if (RUN) { PHB    \
                pg8::Gemm g{H, (const bf16_t*)(ws + OFF_WINE + j * SZ_WINE), 1024, 0}; pg8::StaticOrder S; S.init(TT, 3328, G, cb, 1024); \
                { LAS float* lbl = (LAS float*)(lds + LDS_MAIN + 64); lbl[threadIdx.x] = ((const float*)(ws + OFF_LB))[j * 512 + threadIdx.x]; __syncthreads(); } \
                pg8::EpiEvenIn E{PbE, (const LAS float*)(lds + LDS_MAIN + 64)}; REP(8) pg8::gemm_phase(lds, g, S, E); SYNC; } ++ph; \
            if (RUN) { PHB    \
                if (cb < 128) { hgrn_chunk_unit(p, j, cb, smem); __syncthreads(); } \
                else { for (int it = cb - 128; it < 576; it += G - 128) attn_unit(p, j, it, smem); } \
                if (DUPB(1)) { __syncthreads(); if (cb < 128) { hgrn_chunk_unit(p, j, cb, smem); __syncthreads(); } } \
                if (DUPB(2)) { __syncthreads(); if (cb >= 128) { for (int it = cb - 128; it < 576; it += G - 128) attn_unit(p, j, it, smem); } } SYNC; } ++ph; \
            if (RUN) { PHB    \
                const int nextra = (layer == 2) ? p.ntc : 0; \
                hgrn_finish_rows(p, j); \
                if (DUPB(13)) { hgrn_finish_rows(p, j); } \
                if (nextra > 0) { __syncthreads(); tr_loop(p, cb, G, nextra, p.njm, p.nj1, smem); } \
                SYNC; } ++ph; \
            if (RUN) { PHB    \
                pg8::Gemm g{YbE, (const bf16_t*)(ws + OFF_WOUTE + j * SZ_WSQ), 1024, 0}; pg8::CtxSplitOrder S; S.init(G, cb, 1024, SPLIT_S); \
                pg8::EpiResid E{(bf16_t*)(ws + OFF_AR + AE_P), mod + (size_t)layer * 9 * 6144 + 2048, (bf16_t*)(ws + OFF_AR + AE_P) + (size_t)TT * 1024}; if (DUPB(18)) pg8::gemm_phase(lds, g, S, E); pg8::gemm_phase(lds, g, S, E); SYNC; } ++ph; \
            if (RUN) { PHB if (DUPB(17)) phase_ln<0, false, true>(p, layer, OFF_AR + AE_P, SPLIT_S, smem); phase_ln<0, false>(p, layer, OFF_AR + AE_P, SPLIT_S, smem); SYNC; } ++ph; \
            if (RUN) { PHB    \
                pg8::Gemm g{H, (const bf16_t*)(ws + OFF_WFFN1 + j * SZ_WFFN1), 1024, 0}; pg8::StaticOrder S; S.init(TT, 5632, G, cb, 1024); \
                pg8::EpiSwiGLU E{PbE, 2816}; REP(5) pg8::gemm_phase(lds, g, S, E); SYNC; } ++ph; \
            if (RUN) { PHB    \
                pg8::Gemm g{PbE, (const bf16_t*)(ws + OFF_WFFN2 + j * SZ_WFFN2), 2816, 0}; pg8::CtxSplitOrder S; S.init(G, cb, 2816, SPLIT_S); \
                pg8::EpiResid E{(bf16_t*)(ws + OFF_AR + AE_OF), mod + (size_t)layer * 9 * 6144 + 5120, (bf16_t*)(ws + OFF_AR + AE_OF) + (size_t)TT * 1024}; if (DUPB(18)) pg8::gemm_phase(lds, g, S, E); pg8::gemm_phase(lds, g, S, E); SYNC; } ++ph; \
            if (RUN) { PHB if (DUPB(17)) phase_ln<1, false, true>(p, layer, OFF_AR + AE_OF, SPLIT_S, smem); phase_ln<1, false>(p, layer, OFF_AR + AE_OF, SPLIT_S, smem); SYNC; } ++ph; \
        } \
         \
        { \
            const int layer = 2 * lp + 1, jo = lp; \
            if (RUN) { PHB    \
                pg8::Gemm g{H, (const bf16_t*)(ws + OFF_WINO + jo * SZ_WINO), 1024, 0}; pg8::StaticOrder S; S.init(TT, 2560, G, cb, 1024); \
                pg8::EpiBf16 E{PbO, 2560, nullptr}; if (DUPB(19)) pg8::gemm_phase(lds, g, S, E); pg8::gemm_phase(lds, g, S, E); SYNC; } ++ph; \
            if (RUN) { PHB    \
                rwkv_prep_rows(p, jo); \
                if (DUPB(14)) { rwkv_prep_rows(p, jo); } \
                SYNC; } ++ph; \
            if (RUN) { PHB    \
                pg8::Gemm g{(const bf16_t*)(ws + OFF_AR + AO_L), (const bf16_t*)(ws + OFF_WLORA + jo * SZ_WLORA), 384, 0}; pg8::LoraOrder S; S.init(TT, 2560, G, cb, 384); \
                pg8::EpiBf16 E{PbO, 2560, nullptr}; if (DUPB(19)) pg8::gemm_phase(lds, g, S, E); pg8::gemm_phase(lds, g, S, E); \
                SYNC; } ++ph; \
            if (RUN) { PHB   \
                { const int per = (4608 + G - 1) / G, i0 = cb * per, i1 = (i0 + per < 4608) ? i0 + per : 4608; rwkv_stage_loop(p, jo, i0, 1, i1, smem); } \
                SYNC; } ++ph; \
            if (RUN) { PHB    \
                if (cb < 128) { rwkv_chunk_unit(p, jo, cb, smem); if (DUPB(4)) { __syncthreads(); rwkv_chunk_unit(p, jo, cb, smem); } } \
                else { if (wv < 4) { s5_scan_task(p, jo, (cb - 128) * 4 + wv, smem + wv * 20480); } \
                       if (layer == 1 && p.ntm > 0) { __syncthreads(); tr_loop(p, cb - 128, G - 128, p.ntm, p.nj0, p.njm, smem); } \
                       if (layer == 3 && p.nt1 > p.ntc) { __syncthreads(); tr_loop(p, p.ntc + (cb - 128), G - 128, p.nt1, p.njm, p.nj1, smem); } } \
                SYNC; } ++ph; \
            if (RUN) { PHB odd_finish_rows(p, jo, layer == 3); SYNC; } ++ph; \
            if (RUN) { PHB    \
                pg8::Gemm g{(const bf16_t*)(ws + OFF_AR + AO_YG), (const bf16_t*)(ws + OFF_WGLU + jo * SZ_WGLU), 512, 0}; pg8::StaticOrder S; S.init(TT, 512, G, cb, 512); \
                pg8::EpiGLU E{(const bf16_t*)(ws + OFF_AR + AO_YG), YbO}; if (DUPB(19)) pg8::gemm_phase(lds, g, S, E); pg8::gemm_phase(lds, g, S, E); \
                SYNC; } ++ph; \
            if (RUN) { PHB    \
                pg8::Gemm g{YbO, (const bf16_t*)(ws + OFF_WOUTO + jo * SZ_WSQ), 1024, 0}; pg8::CtxSplitOrder S; S.init(G, cb, 1024, layer == 3 ? 0 : SPLIT_S); \
                pg8::EpiResid E{(bf16_t*)(ws + OFF_GE), mod + (size_t)layer * 9 * 6144 + 2048, (bf16_t*)(ws + OFF_GE) + (size_t)TT * 1024}; if (DUPB(18)) pg8::gemm_phase(lds, g, S, E); pg8::gemm_phase(lds, g, S, E); SYNC; } ++ph; \
            if (RUN) { PHB if (DUPB(17)) phase_ln<0, true, true>(p, layer, OFF_GE, SPLIT_S, smem); phase_ln<0, true>(p, layer, OFF_GE, SPLIT_S, smem); SYNC; } ++ph; \
            if (RUN) { PHB    \
                pg8::Gemm g{H, (const bf16_t*)(ws + OFF_WMOE1), 1024, SZ_WFFN1}; pg8::MoeOrder S; S.init((cnt0 + jo * 512), 22, G, cb, 1024); \
                LAS int* ridx = (LAS int*)(lds + LDS_MAIN + 64 + 2048); \
                { const unsigned* inv = (const unsigned*)(ws + OFF_INV); pg8::Unit u; \
                  for (int i = 0; i < 16 && S.next(i, u); ++i) { if (threadIdx.x < 256) { int pst = 0; _Pragma("unroll") for (int k = 0; k < 7; ++k) pst = (u.e > k) ? S.pend[k] : pst; \
                      const int r = (u.pm - pst) * 256 + (int)threadIdx.x; ridx[i * 256 + threadIdx.x] = (r < (int)(cnt0 + jo * 512)[u.e * 64]) ? (int)inv[(size_t)u.e * TT + r] : 0; } } \
                  __syncthreads(); } \
                pg8::EpiSwiGLU E{(bf16_t*)(ws + OFF_AR + AM_H), 2816}; pg8::gemm_phase<pg8::EpiSwiGLU, pg8::MoeOrder, true>(lds, g, S, E, ridx); SYNC; } ++ph; \
            if (RUN) { PHB    \
                pg8::Gemm g{(const bf16_t*)(ws + OFF_AR + AM_H), (const bf16_t*)(ws + OFF_WMOE2), 2816, SZ_WFFN2}; pg8::MoeOrder S; S.init((cnt0 + jo * 512), 4, G, cb, 2816, true); \
                pg8::EpiBf16 E{(bf16_t*)(ws + OFF_AR + AM_A), 1024, (bf16_t*)(ws + OFF_GE)}; REP(7) pg8::gemm_phase(lds, g, S, E); SYNC; } ++ph; \
            if (RUN) { PHB if (DUPB(17)) phase_ln<2, false, true>(p, layer, 0, 0, smem); phase_ln<2, false>(p, layer, 0, 0, smem); SYNC; } ++ph; \
        } \
     }
constexpr int LDS_MAIN = 131072;
constexpr int LDS_BYTES = LDS_MAIN + 64 + 2048 + 16384;
__global__ void __launch_bounds__(512, 2) mega(const Params p) {
    extern __shared__ __attribute__((aligned(16))) unsigned char smem[];
    LAS unsigned char* lds = (LAS unsigned char*)smem;
    volatile LAS unsigned* xbw = (volatile LAS unsigned*)(lds + LDS_MAIN);
    if (threadIdx.x == 0) { xbw[0] = 0u; xbw[1] = 0u; xbw[2] = 0u; xbw[3] = 0u; }
    __syncthreads();
    const bool multi = (p.hi - p.lo) > 1;
    XcdBarrier bar; bar.bar = (unsigned*)(p.ws + OFF_BAR); bar.x = 0; bar.st = xbw;
    if (multi) bar = xcd_barrier_post((unsigned*)(p.ws + OFF_BAR), xbw);
    const int G = gridDim.x, cb = blockIdx.x, wv = threadIdx.x >> 6;
    int ph = 0;
#define RUN (ph >= p.lo && ph < p.hi)
#define SYNC do { if (multi && ph + 1 < p.hi) { xcd_barrier(bar); if (DUPB(12)) xcd_barrier(bar); } else __syncthreads(); } while (0)

    if (RUN) { REP(0) { phase_prologue_a(p, smem); __syncthreads(); } SYNC; } ++ph;
    if (RUN) { phase_prologue_b(p); SYNC; } ++ph;

    LAYER_PAIR_BODY(0)
    LAYER_PAIR_BODY(1)
#undef RUN
#undef SYNC
}

static void add_job(Params& P, int& nj, int& nt, const float* src, bf16_t* dst, int K, int N, int ldd, int mode, int aux) {
    Job& j = P.jobs[nj++]; j.src = src; j.dst = dst; j.K = K; j.N = N; j.ldd = ldd; j.mode = mode; j.tile0 = nt; j.aux = aux; nt += (K / 128) * (N / 128);
}
extern "C" void kernel_launch(void* const* d_in, const int* in_sizes, int n_in, void* d_out, int out_size, void* d_ws, size_t ws_size, hipStream_t stream) {
    static int ready = 0;
    if (ready == 0) {
        if (n_in != 43 || ws_size < WS_END) { fprintf(stderr, "kernel_launch: need 43 inputs and %zu bytes of workspace, got %d / %zu\n", (size_t)WS_END, n_in, ws_size); ready = -1; return; }
        if (hipFuncSetAttribute((const void*)mega, hipFuncAttributeMaxDynamicSharedMemorySize, LDS_BYTES) != hipSuccess) { fprintf(stderr, "kernel_launch: hipFuncSetAttribute failed\n"); ready = -1; return; }
        ready = 1;
    }
    if (ready < 0) return;
    unsigned char* ws = (unsigned char*)d_ws;
    (void)hipMemsetAsync(ws, 0, ZERO_BYTES, stream);
    Params P; memset(&P, 0, sizeof(P));
    for (int i = 0; i < 43; ++i) P.in[i] = (const float*)d_in[i];
    P.out = (float*)d_out; P.ws = ws;
    int nj = 0, nt = 0;
    for (int j = 0; j < 2; ++j) {
        if (j == 1) { P.nj0 = nj; P.nt0 = nt; nt = 0; }
        add_job(P, nj, nt, P.in[8] + (size_t)j * 1024 * 3328, (bf16_t*)(ws + OFF_WINE + j * SZ_WINE), 1024, 3328, 1024, 0, 0);
        add_job(P, nj, nt, P.in[9] + (size_t)j * 1024 * 1024, (bf16_t*)(ws + OFF_WOUTE + j * SZ_WSQ), 1024, 1024, 1024, 0, 0);
        add_job(P, nj, nt, P.in[13] + (size_t)j * 1024 * 2816, (bf16_t*)(ws + OFF_WFFN1 + j * SZ_WFFN1), 1024, 2816, 1024, 1, 0);
        add_job(P, nj, nt, P.in[14] + (size_t)j * 1024 * 2816, (bf16_t*)(ws + OFF_WFFN1 + j * SZ_WFFN1), 1024, 2816, 1024, 2, 0);
        add_job(P, nj, nt, P.in[15] + (size_t)j * 2816 * 1024, (bf16_t*)(ws + OFF_WFFN2 + j * SZ_WFFN2), 2816, 1024, 2816, 0, 0);
        add_job(P, nj, nt, P.in[16] + (size_t)j * 1024 * 2432, (bf16_t*)(ws + OFF_WINO + j * SZ_WINO), 1024, 2432, 1024, 0, 0);
        add_job(P, nj, nt, nullptr, (bf16_t*)(ws + OFF_WINO + j * SZ_WINO) + (size_t)2432 * 1024, 1024, 128, 1024, 3, 0);
        add_job(P, nj, nt, P.in[17] + (size_t)j * 1024 * 1024, (bf16_t*)(ws + OFF_WOUTO + j * SZ_WSQ), 1024, 1024, 1024, 0, 0);
        add_job(P, nj, nt, nullptr, (bf16_t*)(ws + OFF_WLORA + j * SZ_WLORA), 384, 2560, 384, 4, j);
        add_job(P, nj, nt, P.in[26] + (size_t)j * 512 * 512, (bf16_t*)(ws + OFF_WGLU + j * SZ_WGLU), 512, 512, 512, 0, 0);
        if (j == 1) { P.njm = nj; P.ntm = nt; nt = 0; }
        { const int L = j;
        for (int e = 0; e < 8; ++e) {
            const size_t eo = (size_t)(L * 8 + e) * 1024 * 2816;
            add_job(P, nj, nt, P.in[40] + eo, (bf16_t*)(ws + OFF_WMOE1 + e * SZ_WFFN1), 1024, 2816, 1024, 1, 0);
            add_job(P, nj, nt, P.in[41] + eo, (bf16_t*)(ws + OFF_WMOE1 + e * SZ_WFFN1), 1024, 2816, 1024, 2, 0);
            add_job(P, nj, nt, P.in[42] + eo, (bf16_t*)(ws + OFF_WMOE2 + e * SZ_WFFN2), 2816, 1024, 2816, 0, 0);
        }
        }
    }
    P.nj1 = nj; P.nt1 = nt; P.ntc = nt / 2;
#if MK_SINGLE
    P.lo = 0; P.hi = NPH;
    hipLaunchKernelGGL(mega, dim3(256), dim3(512), LDS_BYTES, stream, P);
#else
    for (int ph = 0; ph < NPH; ++ph) { P.lo = ph; P.hi = ph + 1; hipLaunchKernelGGL(mega, dim3(256), dim3(512), LDS_BYTES, stream, P); }
#endif
}
```

```cpp
#include <hip/hip_runtime.h>
#include <stdint.h>
#include <stdio.h>
#include <string.h>

#ifndef PROBE_DUP
#define PROBE_DUP 0
#endif
#define REP(k) for (int rep_ = 0; rep_ < 1 + ((PROBE_DUP >> (k)) & 1); ++rep_)
#define DUPB(k) ((PROBE_DUP >> (k)) & 1)
#ifndef MK_SINGLE
#define MK_SINGLE 1
#endif

#define LAS __attribute__((address_space(3)))
typedef unsigned short bf16_t;
typedef short bf16x8 __attribute__((ext_vector_type(8)));
typedef short s16x4 __attribute__((ext_vector_type(4)));
typedef float f32x2 __attribute__((ext_vector_type(2)));
typedef float f32x4 __attribute__((ext_vector_type(4)));
typedef float f32x16 __attribute__((ext_vector_type(16)));
typedef unsigned u32x2 __attribute__((ext_vector_type(2)));
typedef unsigned u32x4 __attribute__((ext_vector_type(4)));
typedef __bf16 bfv2 __attribute__((ext_vector_type(2)));

constexpr int TT = 18432;
constexpr int SB = 2304;
constexpr int DM = 1024;
constexpr int NPH = 42;
constexpr float ALPHA = 1.6817928305074290f;
constexpr int SPLIT_S = 2;

constexpr size_t OFF_BAR = 0;
constexpr size_t OFF_CNT = 16384;
constexpr size_t ZERO_BYTES = 32768;
constexpr size_t OFF_MOD = 32768;
constexpr size_t OFF_COS = OFF_MOD + 884736;
constexpr size_t OFF_SIN = OFF_COS + 262144;
constexpr size_t OFF_LB = OFF_SIN + 262144;
constexpr size_t OFF_AB = OFF_LB + 4096;
constexpr size_t OFF_BBR = OFF_AB + 65536;
constexpr size_t OFF_BBI = OFF_BBR + 524288;
constexpr size_t OFF_ROUTE = OFF_BBI + 524288;
constexpr size_t OFF_WINE = OFF_ROUTE + 589824;
constexpr size_t SZ_WINE = (size_t)3328 * 1024 * 2;
constexpr size_t OFF_WOUTE = OFF_WINE + 2 * SZ_WINE;
constexpr size_t SZ_WSQ = (size_t)1024 * 1024 * 2;
constexpr size_t OFF_WFFN1 = OFF_WOUTE + 2 * SZ_WSQ;
constexpr size_t SZ_WFFN1 = (size_t)5632 * 1024 * 2;
constexpr size_t OFF_WFFN2 = OFF_WFFN1 + 2 * SZ_WFFN1;
constexpr size_t SZ_WFFN2 = (size_t)1024 * 2816 * 2;
constexpr size_t OFF_WINO = OFF_WFFN2 + 2 * SZ_WFFN2;
constexpr size_t SZ_WINO = (size_t)2560 * 1024 * 2;
constexpr size_t OFF_WOUTO = OFF_WINO + 2 * SZ_WINO;
constexpr size_t OFF_WLORA = OFF_WOUTO + 2 * SZ_WSQ;
constexpr size_t SZ_WLORA = (size_t)2560 * 384 * 2;
constexpr size_t OFF_WGLU = OFF_WLORA + 2 * SZ_WLORA;
constexpr size_t SZ_WGLU = (size_t)512 * 512 * 2;
constexpr size_t OFF_WMOE1 = OFF_WGLU + 2 * SZ_WGLU;
constexpr size_t OFF_WMOE2 = OFF_WMOE1 + 8 * SZ_WFFN1;
constexpr size_t OFF_X = OFF_WMOE2 + 8 * SZ_WFFN2;
constexpr size_t OFF_H = OFF_X + (size_t)TT * 1024 * 4;
constexpr size_t OFF_AR = OFF_H + (size_t)TT * 1024 * 2;
constexpr size_t AE_P = 0, AE_OF = 122683392, AE_OB = AE_OF + 37748736, AE_Y = AE_OB + 37748736;
constexpr size_t AO_P = 0, AO_OF = 94371840, AO_OB = AO_OF + 37748736, AO_PR = AO_OB + 37748736, AO_L = AO_PR + 56623104, AO_YG = AO_L + 14155776, AO_Y = AO_YG + 18874368;
constexpr size_t AM_A = 0, AM_H = 79691776;
constexpr size_t AR_SIZE = 298844160;
constexpr size_t OFF_KN = OFF_AR + AR_SIZE;
constexpr size_t OFF_GE = OFF_KN + 589824;
constexpr size_t OFF_GW = OFF_GE + (size_t)18432 * 8192;
constexpr size_t OFF_S5F = OFF_GW + (size_t)18432 * 256;
constexpr size_t OFF_S5B = OFF_S5F + (size_t)TT * 512 * 4;
constexpr size_t OFF_INV = OFF_S5B + (size_t)TT * 512 * 4;
constexpr size_t WS_END = OFF_INV + (size_t)8 * TT * 4;

struct Job { const float* src; bf16_t* dst; int K, N, ldd, mode, tile0, aux; };
constexpr int MAXJOBS = 72;
struct Params {
    const float* in[43];
    float* out;
    unsigned char* ws;
    int lo, hi;
    int nj0, njm, nj1;
    int nt0, ntm, nt1;
    int ntc;
    Job jobs[MAXJOBS];
};

__device__ __forceinline__ float bf2f(unsigned v) { return __uint_as_float(v << 16); }
__device__ __forceinline__ unsigned pk2(float lo, float hi) { f32x2 v = {lo, hi}; bfv2 b = __builtin_convertvector(v, bfv2); return __builtin_bit_cast(unsigned, b); }
__device__ __forceinline__ void unpk8(const u32x4 v, float* f) {
    f[0] = __uint_as_float(v.x << 16); f[1] = __uint_as_float(v.x & 0xffff0000u);
    f[2] = __uint_as_float(v.y << 16); f[3] = __uint_as_float(v.y & 0xffff0000u);
    f[4] = __uint_as_float(v.z << 16); f[5] = __uint_as_float(v.z & 0xffff0000u);
    f[6] = __uint_as_float(v.w << 16); f[7] = __uint_as_float(v.w & 0xffff0000u);
}
__device__ __forceinline__ void unpk4(const u32x2 v, float* f) {
    f[0] = __uint_as_float(v.x << 16); f[1] = __uint_as_float(v.x & 0xffff0000u);
    f[2] = __uint_as_float(v.y << 16); f[3] = __uint_as_float(v.y & 0xffff0000u);
}
__device__ __forceinline__ f32x4 unpk4v(const u32x2 v) { f32x4 r; r[0] = __uint_as_float(v.x << 16); r[1] = __uint_as_float(v.x & 0xffff0000u); r[2] = __uint_as_float(v.y << 16); r[3] = __uint_as_float(v.y & 0xffff0000u); return r; }
typedef _Float16 hf4 __attribute__((ext_vector_type(4)));
__device__ __forceinline__ u32x2 f2h4(const f32x4 v) { const hf4 h = __builtin_convertvector(v, hf4); return __builtin_bit_cast(u32x2, h); }
__device__ __forceinline__ f32x4 h2f4(const u32x2 u) { const hf4 h = __builtin_bit_cast(hf4, u); return __builtin_convertvector(h, f32x4); }
__device__ __forceinline__ u32x4 pk8(const float* f) { u32x4 r; r.x = pk2(f[0], f[1]); r.y = pk2(f[2], f[3]); r.z = pk2(f[4], f[5]); r.w = pk2(f[6], f[7]); return r; }
template <int CTRL> __device__ __forceinline__ float dppf(float v) { return __builtin_bit_cast(float, __builtin_amdgcn_update_dpp(0, __builtin_bit_cast(int, v), CTRL, 0xF, 0xF, true)); }
__device__ __forceinline__ float sum8(float v) { v += dppf<0xB1>(v); v += dppf<0x4E>(v); v += dppf<0x141>(v); return v; }
__device__ __forceinline__ float sum16(float v) { v = sum8(v); v += dppf<0x140>(v); return v; }
__device__ __forceinline__ float xsum16(float x) { const unsigned xb = __builtin_bit_cast(unsigned, x); auto r = __builtin_amdgcn_permlane16_swap(xb, xb, false, false);
    return __builtin_bit_cast(float, (unsigned)r[0]) + __builtin_bit_cast(float, (unsigned)r[1]); }
__device__ __forceinline__ float xsum32(float x) { const unsigned xb = __builtin_bit_cast(unsigned, x); auto r = __builtin_amdgcn_permlane32_swap(xb, xb, false, false);
    return __builtin_bit_cast(float, (unsigned)r[0]) + __builtin_bit_cast(float, (unsigned)r[1]); }
__device__ __forceinline__ float sum64(float v) { v = sum16(v); v = xsum16(v); v = xsum32(v); return v; }
__device__ __forceinline__ float sigm(float x) { return __builtin_amdgcn_rcpf(1.0f + __builtin_amdgcn_exp2f(-1.4426950408889634f * x)); }
__device__ __forceinline__ float siluf(float x) { return x * __builtin_amdgcn_rcpf(1.0f + __builtin_amdgcn_exp2f(-1.4426950408889634f * x)); }
__device__ __forceinline__ float tanh_f(float x) { const float e = __builtin_amdgcn_exp2f(-2.8853900817779268f * fabsf(x)); const float t = (1.0f - e) * __builtin_amdgcn_rcpf(1.0f + e); return x < 0.f ? -t : t; }
__device__ __forceinline__ void my_sincos(float x, float& s, float& c) {
    const float q = rintf(x * 0.636619772f);
    float r = fmaf(-q, 1.57079637f, x); r = fmaf(-q, -4.37113883e-8f, r);
    const float r2 = r * r;
    const float sp = r + r * r2 * (-1.6666654611e-1f + r2 * (8.3321608736e-3f + r2 * (-1.9515295891e-4f)));
    const float cp = 1.0f - 0.5f * r2 + r2 * r2 * (4.166664568298827e-2f + r2 * (-1.388731625493765e-3f + r2 * 2.443315711809948e-5f));
    const int qi = ((int)q) & 3;
    s = (qi == 0) ? sp : (qi == 1) ? cp : (qi == 2) ? -sp : -cp;
    c = (qi == 0) ? cp : (qi == 1) ? -sp : (qi == 2) ? -cp : sp;
}
__device__ __forceinline__ unsigned char* ows(unsigned char* q) { const unsigned long long t0 = (unsigned long long)q; unsigned lo = __builtin_amdgcn_readfirstlane((unsigned)t0), hi = __builtin_amdgcn_readfirstlane((unsigned)(t0 >> 32)); asm volatile("" : "+s"(lo), "+s"(hi)); const unsigned long long t = ((unsigned long long)hi << 32) | lo; return (unsigned char*)(__attribute__((address_space(1))) unsigned char*)t; }
#define LDS_BARRIER() do { asm volatile("s_waitcnt lgkmcnt(0)" ::: "memory"); __builtin_amdgcn_s_barrier(); asm volatile("" ::: "memory"); } while (0)
__device__ __forceinline__ int otid() { int t = threadIdx.x; asm volatile("" : "+v"(t)); return t; }
__device__ __forceinline__ int mod_index(int row) { const int b = row / SB, s = row - b * SB; return s < 256 ? 8 : b; }

#define XB_TMO      128
#define XB_XCNT(j)  (256  + 64 * (j))
#define XB_XSUB(j)  (1280 + 64 * (j))
#define XB_XGEN(j)  (2304 + 64 * (j))
#define XB_TOP      3328
#define XB_TOPGEN   3392
#define XCD_BAR_WORDS 3456
#define XB_SPIN_CAP (1u << 18)
__device__ __forceinline__ unsigned xb_ld(unsigned* p)              { return __hip_atomic_load(p, __ATOMIC_RELAXED, __HIP_MEMORY_SCOPE_AGENT); }
__device__ __forceinline__ unsigned xb_add(unsigned* p, unsigned v) { return __hip_atomic_fetch_add(p, v, __ATOMIC_RELAXED, __HIP_MEMORY_SCOPE_AGENT); }
__device__ __forceinline__ unsigned xb_xcc_id() { return (unsigned)__builtin_amdgcn_s_getreg((3 << 11) | 20) & 0xFu; }
#define XB_SPIN(cond, bar) do { unsigned _sp = 0; while (cond) { __builtin_amdgcn_s_sleep(12); \
    if ((++_sp & 255u) == 0u) { if (xb_ld(&(bar)[XB_TMO])) break; if (_sp > XB_SPIN_CAP) { atomicAdd(&(bar)[XB_TMO], 1u); break; } } } } while (0)
struct XcdBarrier { unsigned* bar; unsigned x; volatile LAS unsigned* st; };
__device__ __forceinline__ XcdBarrier xcd_barrier_post(unsigned* bar, volatile LAS unsigned* st) {
    XcdBarrier b; b.bar = bar; b.x = xb_xcc_id(); b.st = st;
    if (threadIdx.x == 0) (void)xb_add(&bar[XB_XCNT(b.x)], 1u);
    return b;
}
__device__ __forceinline__ void xcd_barrier_complete(unsigned* bar, unsigned x, unsigned& nloc, unsigned& nx) {
    const unsigned G = gridDim.x * gridDim.y * gridDim.z;
    unsigned sum, cnt, mine, sp = 0u;
    for (;;) {
        sum = 0u; cnt = 0u; mine = 0u;
#pragma unroll
        for (unsigned j = 0; j < 16; ++j) { const unsigned c = xb_ld(&bar[XB_XCNT(j)]); sum += c; cnt += (c > 0u) ? 1u : 0u; mine = (j == x) ? c : mine; }
        if (sum == G) break;
        __builtin_amdgcn_s_sleep(1);
        if ((++sp & 255u) == 0u) { if (xb_ld(&bar[XB_TMO])) break; if (sp > XB_SPIN_CAP) { atomicAdd(&bar[XB_TMO], 1u); break; } }
    }
    nloc = mine > 0u ? mine : 1u; nx = cnt > 0u ? cnt : 1u;
}
__device__ __forceinline__ void xcd_barrier(const XcdBarrier& b) {
    asm volatile("s_waitcnt vmcnt(0)" ::: "memory");
    __syncthreads();
    if (threadIdx.x == 0) {
        unsigned* bar = b.bar;
        __builtin_amdgcn_s_waitcnt(0);
        unsigned nloc = b.st[0], nx = b.st[1];
        if (nloc == 0u) { xcd_barrier_complete(bar, b.x, nloc, nx); b.st[0] = nloc; b.st[1] = nx; }
        const unsigned old = xb_add(&bar[XB_XSUB(b.x)], 1u);
        const unsigned gen = old / nloc;
        if (old + 1u == (gen + 1u) * nloc) {
            __builtin_amdgcn_fence(__ATOMIC_RELEASE, "agent");
            asm volatile("s_waitcnt vmcnt(0)" ::: "memory");
            (void)xb_add(&bar[XB_TOP], 1u);
        }
        XB_SPIN(xb_ld(&bar[XB_TOP]) < (gen + 1u) * nx, bar);
        __builtin_amdgcn_fence(__ATOMIC_ACQUIRE, "agent");
        asm volatile("s_waitcnt vmcnt(0)" ::: "memory");
    }
    __syncthreads();
}

namespace pg8 {
constexpr int BM = 256, BK = 64, HALF = 128, HTB = HALF * BK * 2, STAGE_BYTES = 8 * HTB, NXCD = 8, WGM = 8;
__device__ __forceinline__ int lds_byte(int r, int c) { const int st = (r >> 4) * 2 + (c >> 5), rr = r & 15, cc = c & 31, ob = rr * 64 + cc * 2; return st * 1024 + (ob ^ (((ob >> 9) & 1) << 5)); }
__device__ __forceinline__ void stage_rc(int b, int& R, int& C) { const int st = b / 1024, sb = b % 1024, swz = sb ^ (((sb >> 9) & 1) << 5); R = (st >> 1) * 16 + swz / 64; C = (st & 1) * 32 + (swz % 64) / 2; }
__device__ __forceinline__ int perm32(int rho) { const int n = rho >> 4, i = rho & 15; return 8 * (i >> 2) + 4 * n + (i & 3); }
struct Unit { int pm, pn, e, kt0, nkt, ks; };
struct Gemm { const bf16_t* A; const bf16_t* Bt; int K; size_t bstride; };
struct StaticOrder {
    int nM, nN, nwg, G, c, nkt;
    __device__ __forceinline__ void init(int M, int N, int G_, int c_, int K_) { nM = M / BM; nN = N / BM; nwg = nM * nN; G = G_; c = c_; nkt = K_ / BK; }
    __device__ __forceinline__ bool next(int i, Unit& u) const {
        const long L = (long)i * G + c; if (L >= nwg) return false;
        int wgid = (int)L; { const int q = nwg / NXCD, r = nwg % NXCD, xcd = wgid % NXCD, off = wgid / NXCD; wgid = (xcd < r ? xcd * (q + 1) : r * (q + 1) + (xcd - r) * q) + off; }
        const int nig = WGM * nN, gid = wgid / nig, fm = gid * WGM, gsz = (nM - fm) < WGM ? (nM - fm) : WGM;
        u.pm = fm + ((wgid % nig) % gsz); u.pn = (wgid % nig) / gsz; u.e = 0; u.kt0 = 0; u.nkt = nkt; u.ks = -1; return true;
    }
};
struct LoraOrder {
    StaticOrder so;
    __device__ __forceinline__ void init(int M, int N, int G_, int c_, int K_) { so.init(M, N, G_, c_, K_); }
    __device__ __forceinline__ bool next(int i, Unit& u) const {
        if (!so.next(i, u)) return false;
        u.kt0 = (u.pn >> 2) * 2; u.nkt = 2; return true;
    }
};
struct MoeOrder {
    int nN, G, c, npan, nkt, nfullU; int pend[8];
    __device__ __forceinline__ void init(const unsigned* cnt, int nN_, int G_, int c_, int K_, bool split = false) {
        nN = nN_; G = G_; c = c_; nkt = K_ / BK; int acc = 0;
#pragma unroll
        for (int e = 0; e < 8; ++e) { acc += ((int)cnt[e * 64] + 255) >> 8; pend[e] = acc; }
        npan = acc; nfullU = split ? ((npan * nN) / G) * G : 0x40000000;
    }
    __device__ __forceinline__ bool next(int i, Unit& u) const {
        const int q0 = i * G + (c & 7) * (G >> 3) + (c >> 3);
        const bool sub = q0 >= nfullU;
        const int q = sub ? nfullU + ((q0 - nfullU) >> 1) : q0, ksub = (q0 - nfullU) & 1;
        const int per = 4 * nN, nfull = npan >> 2, g4 = q / per;
        int pan, pn; bool ok = true;
        if (g4 < nfull) { const int r = q - g4 * per; pn = r >> 2; pan = g4 * 4 + (r & 3); }
        else { const int q2 = q - nfull * per, gp = npan - 4 * nfull; const int gpd = gp > 0 ? gp : 1; ok = q2 < gp * nN; pn = q2 / gpd; pan = 4 * nfull + (q2 - pn * gpd); }
        int e = 0;
#pragma unroll
        for (int k = 0; k < 7; ++k) e += (pan >= pend[k]) ? 1 : 0;
        u.pm = pan; u.pn = pn; u.e = e; u.kt0 = sub ? ksub * (nkt >> 1) : 0; u.nkt = sub ? (nkt >> 1) : nkt; u.ks = sub ? ksub : -1;
        return ok;
    }
};
struct CtxSplitOrder {
    StaticOrder lat; int G, c, nkt, S;
    __device__ __forceinline__ void init(int G_, int c_, int K_, int S_) { lat.init(64 * BM, 1024, G_, c_, K_); G = G_; c = c_; nkt = K_ / BK; S = S_; }
    __device__ __forceinline__ bool next(int i, Unit& u) const {
        const int L = i * G + c;
        const bool islat = L < 256;
        Unit r; const bool okl = lat.next(islat ? i : 0, r);
        r.pm = (r.pm >> 3) * 9 + 1 + (r.pm & 7);
        const int L2 = islat ? 0 : L - 256, Sd = S > 0 ? S : 1, uid = L2 / Sd, ks = L2 - uid * Sd, sub = nkt / Sd;
        u.pm = islat ? r.pm : (uid >> 2) * 9; u.pn = islat ? r.pn : (uid & 3); u.e = 0;
        u.kt0 = islat ? 0 : ks * sub; u.nkt = islat ? nkt : sub; u.ks = islat ? -1 : ks;
        return islat ? okl : (L2 < 32 * S);
    }
};
template <class Epi, class Sched, bool GA = false>
__device__ __forceinline__ void gemm_phase(LAS unsigned char* lds, const Gemm g, const Sched& S, const Epi& E, const LAS int* ridx = nullptr) {
    const int tid = otid(), wid = __builtin_amdgcn_readfirstlane(tid >> 6), lane = tid & 63, wr = wid >> 2, wc = wid & 3, fr = lane & 15, fq = lane >> 4;
    const int K = g.K;
    unsigned voffA[2], voffB[2]; int RA[2]; unsigned CA2[2];
#pragma unroll
    for (int i = 0; i < 2; ++i) { int R, C; stage_rc(tid * 16 + i * 8192, R, C); const int Rb = Epi::PERM ? ((R & ~31) + perm32(R & 31)) : R;
        voffA[i] = (unsigned)(R * K + C) * 2u; voffB[i] = (unsigned)(Rb * K + C) * 2u; RA[i] = R; CA2[i] = (unsigned)C * 2u; }
    unsigned vA[2][2], nvA[2][2], v2[2][2];
#define PG8_GIDX(dst, ui_) do { _Pragma("unroll") for (int _h = 0; _h < 2; ++_h) _Pragma("unroll") for (int _i = 0; _i < 2; ++_i) \
        dst[_h][_i] = (unsigned)ridx[(ui_) * 256 + _h * HALF + RA[_i]] * (unsigned)(K * 2) + CA2[_i]; } while (0)
#define PG8_STGA(bufoff, abase, h, vsel) do { if (GA) PG8_STAGE(bufoff, abase, vsel[h]); else PG8_STAGE(bufoff, (abase) + (h) * hstep, voffA); } while (0)
    const size_t kstep = (size_t)(BK * 2);
    const size_t hstep = (size_t)HALF * K * 2;
    const size_t tstep = 2 * hstep;
    const unsigned ldsw = (unsigned)wid * 1024u;
    const int aoff = lds_byte(wr * 64 + fr, fq * 8), boff = lds_byte(wc * 32 + fr, fq * 8);
#define PG8_SA(b, h) (((b) * 2 + (h)) * HTB)
#define PG8_SB(b, h) ((4 + (b) * 2 + (h)) * HTB)
#define PG8_STAGE(bufoff, gbase, voff) do { _Pragma("unroll") for (int _i = 0; _i < 2; ++_i) \
        __builtin_amdgcn_global_load_lds((const unsigned*)((const char*)(gbase) + (voff)[_i]), (LAS unsigned*)(lds + (bufoff) + ldsw + _i * 8192), 16, 0, 0); } while (0)
#define PG8_LDA(dst, b, h) do { _Pragma("unroll") for (int m = 0; m < 4; ++m) _Pragma("unroll") for (int k = 0; k < 2; ++k) dst[m][k] = *(const LAS bf16x8*)(lds + PG8_SA(b, h) + aoff + m * 2048 + k * 1024); } while (0)
#define PG8_LDB(dst, b, h) do { _Pragma("unroll") for (int n = 0; n < 2; ++n) _Pragma("unroll") for (int k = 0; k < 2; ++k) dst[n][k] = *(const LAS bf16x8*)(lds + PG8_SB(b, h) + boff + n * 2048 + k * 1024); } while (0)
#define PG8_MMA(ai, bj, At, Bt) do { __builtin_amdgcn_s_setprio(1); _Pragma("unroll") for (int m = 0; m < 4; ++m) _Pragma("unroll") for (int n = 0; n < 2; ++n) _Pragma("unroll") for (int k = 0; k < 2; ++k) \
        acc[ai][bj][m][n] = __builtin_amdgcn_mfma_f32_16x16x32_bf16(Bt[n][k], At[m][k], acc[ai][bj][m][n], 0, 0, 0); __builtin_amdgcn_s_setprio(0); } while (0)
#define PG8_WAIT_V(n) asm volatile("s_waitcnt vmcnt(" #n ")" ::: "memory")
#define PG8_WAIT_L(n) asm volatile("s_waitcnt lgkmcnt(" #n ")" ::: "memory")
#define PG8_BAR __builtin_amdgcn_s_barrier()
#define PG8_SCHED __builtin_amdgcn_sched_barrier(0)
    Unit cur, nxt; int ui = 0;
    if (!S.next(0, cur)) return;
    f32x4 acc[2][2][4][2];
#pragma unroll
    for (int a = 0; a < 2; ++a)
#pragma unroll
        for (int b = 0; b < 2; ++b)
#pragma unroll
            for (int m = 0; m < 4; ++m)
#pragma unroll
                for (int n = 0; n < 2; ++n) acc[a][b][m][n] = (f32x4){0.f, 0.f, 0.f, 0.f};
    bf16x8 At[4][2], B0[2][2], B1[2][2];
    const char* cA = (const char*)g.A + (GA ? (size_t)0 : (size_t)cur.pm * tstep) + (size_t)cur.kt0 * kstep; const char* cB = (const char*)g.Bt + (size_t)cur.e * g.bstride + (size_t)cur.pn * tstep + (size_t)cur.kt0 * kstep;
    if (GA) PG8_GIDX(vA, 0);
    PG8_STAGE(PG8_SB(0, 0), cB, voffB); PG8_STGA(PG8_SA(0, 0), cA, 0, vA); PG8_STAGE(PG8_SB(0, 1), cB + hstep, voffB); PG8_STGA(PG8_SA(0, 1), cA, 1, vA);
    if (wr == 1) PG8_BAR;
    PG8_WAIT_V(4); PG8_BAR;
    PG8_STAGE(PG8_SB(1, 0), cB + kstep, voffB); PG8_STGA(PG8_SA(1, 0), cA + kstep, 0, vA); PG8_STAGE(PG8_SB(1, 1), cB + hstep + kstep, voffB);
    PG8_WAIT_V(6); PG8_BAR;
    for (;;) {
        const bool has_next = S.next(ui + 1, nxt);
        const char* nA = has_next ? (const char*)g.A + (GA ? (size_t)0 : (size_t)nxt.pm * tstep) + (size_t)nxt.kt0 * kstep : cA; const char* nB = has_next ? (const char*)g.Bt + (size_t)nxt.e * g.bstride + (size_t)nxt.pn * tstep + (size_t)nxt.kt0 * kstep : cB;
        const int nt = cur.nkt;
        if (GA) { if (has_next) PG8_GIDX(nvA, ui + 1); else {
#pragma unroll
            for (int _h = 0; _h < 2; ++_h) { nvA[_h][0] = vA[_h][0]; nvA[_h][1] = vA[_h][1]; } } }
        for (int t = 0; t < nt; t += 2) {
            const bool last = (t == nt - 2);
            if (GA) {
#pragma unroll
                for (int _h = 0; _h < 2; ++_h) { v2[_h][0] = last ? nvA[_h][0] : vA[_h][0]; v2[_h][1] = last ? nvA[_h][1] : vA[_h][1]; } }
            const char* a1 = cA + (size_t)(t + 1) * kstep;
            const char* a2 = last ? nA : cA + (size_t)(t + 2) * kstep; const char* b2 = last ? nB : cB + (size_t)(t + 2) * kstep;
            const char* a3 = a2 + kstep; const char* b3 = b2 + kstep;
            PG8_LDB(B0, 0, 0); PG8_SCHED; PG8_LDA(At, 0, 0); PG8_STGA(PG8_SA(1, 1), a1, 1, vA);
            PG8_WAIT_L(8); PG8_BAR; PG8_WAIT_L(0); PG8_MMA(0, 0, At, B0); PG8_BAR; PG8_SCHED;
            PG8_LDB(B1, 0, 1); PG8_STAGE(PG8_SB(0, 0), b2, voffB);
            PG8_BAR; PG8_WAIT_L(0); PG8_MMA(0, 1, At, B1); PG8_BAR;
            PG8_LDA(At, 0, 1); PG8_STGA(PG8_SA(0, 0), a2, 0, v2);
            PG8_BAR; PG8_WAIT_L(0); PG8_MMA(1, 0, At, B0); PG8_BAR; PG8_SCHED;
            PG8_STAGE(PG8_SB(0, 1), b2 + hstep, voffB);
            PG8_WAIT_V(6); PG8_BAR; PG8_MMA(1, 1, At, B1); PG8_BAR;
            PG8_LDB(B0, 1, 0); PG8_SCHED; PG8_LDA(At, 1, 0); PG8_STGA(PG8_SA(0, 1), a2, 1, v2);
            PG8_WAIT_L(8); PG8_BAR; PG8_WAIT_L(0); PG8_MMA(0, 0, At, B0); PG8_BAR; PG8_SCHED;
            PG8_LDB(B1, 1, 1); PG8_STAGE(PG8_SB(1, 0), b3, voffB);
            PG8_BAR; PG8_WAIT_L(0); PG8_MMA(0, 1, At, B1); PG8_BAR;
            PG8_LDA(At, 1, 1); PG8_STGA(PG8_SA(1, 0), a3, 0, v2);
            PG8_BAR; PG8_WAIT_L(0); PG8_MMA(1, 0, At, B0); PG8_BAR; PG8_SCHED;
            PG8_STAGE(PG8_SB(1, 1), b3 + hstep, voffB);
            PG8_WAIT_V(6); PG8_BAR; PG8_MMA(1, 1, At, B1); PG8_BAR;
        }
        E(acc, cur, wr, wc, fr, fq);
        if (!has_next) break;
#pragma unroll
        for (int a = 0; a < 2; ++a)
#pragma unroll
            for (int b = 0; b < 2; ++b)
#pragma unroll
                for (int m = 0; m < 4; ++m)
#pragma unroll
                    for (int n = 0; n < 2; ++n) acc[a][b][m][n] = (f32x4){0.f, 0.f, 0.f, 0.f};
        cur = nxt; cA = nA; cB = nB; ++ui;
        if (GA) {
#pragma unroll
            for (int _h = 0; _h < 2; ++_h) { vA[_h][0] = nvA[_h][0]; vA[_h][1] = nvA[_h][1]; } }
    }
    PG8_WAIT_V(0);
    if (wr == 0) PG8_BAR;
    PG8_BAR;
#undef PG8_SA
#undef PG8_SB
#undef PG8_STAGE
#undef PG8_STGA
#undef PG8_GIDX
#undef PG8_LDA
#undef PG8_LDB
#undef PG8_MMA
#undef PG8_WAIT_V
#undef PG8_WAIT_L
#undef PG8_BAR
#undef PG8_SCHED
}

struct EpiBf16 {
    static constexpr bool PERM = true;
    bf16_t* O; int ldc; bf16_t* O2;
    __device__ __forceinline__ void operator()(const f32x4 (&acc)[2][2][4][2], const Unit& u, int wr, int wc, int fr, int fq) const {
        const int row0 = u.pm * BM + wr * 64 + fr, col0 = u.pn * BM + wc * 32 + 8 * fq;
        bf16_t* Ob = (u.ks == 1) ? O2 : O;
#pragma unroll
        for (int ai = 0; ai < 2; ++ai)
#pragma unroll
            for (int m = 0; m < 4; ++m) { bf16_t* rowp = Ob + (size_t)(row0 + ai * HALF + m * 16) * ldc + col0;
#pragma unroll
                for (int bj = 0; bj < 2; ++bj) { const f32x4 v0 = acc[ai][bj][m][0], v1 = acc[ai][bj][m][1];
                    u32x4 w; w.x = pk2(v0[0], v0[1]); w.y = pk2(v0[2], v0[3]); w.z = pk2(v1[0], v1[1]); w.w = pk2(v1[2], v1[3]);
                    *(u32x4*)(rowp + bj * HALF) = w; } }
    }
};
struct EpiEvenIn {
    static constexpr bool PERM = true;
    bf16_t* O; const LAS float* lb;
    __device__ __forceinline__ void operator()(const f32x4 (&acc)[2][2][4][2], const Unit& u, int wr, int wc, int fr, int fq) const {
        const int row0 = u.pm * BM + wr * 64 + fr, col0 = u.pn * BM + wc * 32 + 8 * fq;
        const int kind = (u.pn < 2) ? 1 : (u.pn < 6) ? 2 : (u.pn == 8 || u.pn == 9) ? 3 : 0;
        float lbv[2][8];
        if (kind == 2) {
#pragma unroll
            for (int bj = 0; bj < 2; ++bj)
#pragma unroll
                for (int j = 0; j < 8; ++j) lbv[bj][j] = lb[(col0 + bj * HALF + j) & 511];
        }
#pragma unroll
        for (int ai = 0; ai < 2; ++ai)
#pragma unroll
            for (int m = 0; m < 4; ++m) { bf16_t* rowp = O + (size_t)(row0 + ai * HALF + m * 16) * 3328 + col0;
#pragma unroll
                for (int bj = 0; bj < 2; ++bj) { float v[8];
#pragma unroll
                    for (int j = 0; j < 4; ++j) { v[j] = acc[ai][bj][m][0][j]; v[4 + j] = acc[ai][bj][m][1][j]; }
                    if (kind == 1) {
#pragma unroll
                        for (int j = 0; j < 8; ++j) v[j] = siluf(v[j]) * 0.08838834764831845f; }
                    else if (kind == 2) {
#pragma unroll
                        for (int j = 0; j < 8; ++j) v[j] = __builtin_amdgcn_logf(lbv[bj][j] + (1.0f - lbv[bj][j]) * sigm(v[j])); }
                    else if (kind == 3) {
#pragma unroll
                        for (int j = 0; j < 8; ++j) v[j] = siluf(v[j]); }
                    *(u32x4*)(rowp + bj * HALF) = pk8(v); } }
    }
};
struct EpiResid {
    static constexpr bool PERM = true;
    bf16_t* D0; const float* gate; bf16_t* D1;
    __device__ __forceinline__ void operator()(const f32x4 (&acc)[2][2][4][2], const Unit& u, int wr, int wc, int fr, int fq) const {
        const int row0 = u.pm * BM + wr * 64 + fr, col0 = u.pn * BM + wc * 32 + 8 * fq;
        const int b = u.pm / 9, isctx = (u.pm - b * 9 == 0), mi = isctx ? 8 : b;
        const float* gp = gate + (size_t)mi * 6144 + col0;
        f32x4 gv[2][2];
#pragma unroll
        for (int bj = 0; bj < 2; ++bj)
#pragma unroll
            for (int n = 0; n < 2; ++n) gv[bj][n] = *(const f32x4*)(gp + bj * HALF + 4 * n);
        bf16_t* Db = (u.ks == 1) ? D1 : D0;
#pragma unroll
        for (int ai = 0; ai < 2; ++ai)
#pragma unroll
            for (int m = 0; m < 4; ++m) { bf16_t* rowp = Db + (size_t)(row0 + ai * HALF + m * 16) * 1024 + col0;
#pragma unroll
                for (int bj = 0; bj < 2; ++bj) { const f32x4 v0 = acc[ai][bj][m][0] * gv[bj][0], v1 = acc[ai][bj][m][1] * gv[bj][1];
                    u32x4 w; w.x = pk2(v0[0], v0[1]); w.y = pk2(v0[2], v0[3]); w.z = pk2(v1[0], v1[1]); w.w = pk2(v1[2], v1[3]);
                    *(u32x4*)(rowp + bj * HALF) = w; } }
    }
};
struct EpiSwiGLU {
    static constexpr bool PERM = true;
    bf16_t* O; int ldc;
    __device__ __forceinline__ void operator()(const f32x4 (&acc)[2][2][4][2], const Unit& u, int wr, int wc, int fr, int fq) const {
        const int row0 = u.pm * BM + wr * 64 + fr, col0 = u.pn * HALF + wc * 32 + 8 * fq;
#pragma unroll
        for (int ai = 0; ai < 2; ++ai)
#pragma unroll
            for (int m = 0; m < 4; ++m) { bf16_t* rowp = O + (size_t)(row0 + ai * HALF + m * 16) * ldc + col0;
                float o[8];
#pragma unroll
                for (int n = 0; n < 2; ++n)
#pragma unroll
                    for (int j = 0; j < 4; j += 2) {
                        const f32x2 g2 = {acc[ai][0][m][n][j], acc[ai][0][m][n][j + 1]}, u2 = {acc[ai][1][m][n][j], acc[ai][1][m][n][j + 1]};
                        const f32x2 t = g2 * (-1.4426950408889634f);
                        f32x2 e; e.x = __builtin_amdgcn_exp2f(t.x); e.y = __builtin_amdgcn_exp2f(t.y);
                        const f32x2 d = e + 1.0f;
                        f32x2 r; r.x = __builtin_amdgcn_rcpf(d.x); r.y = __builtin_amdgcn_rcpf(d.y);
                        const f32x2 y = (g2 * u2) * r;
                        o[n * 4 + j] = y.x; o[n * 4 + j + 1] = y.y; }
                *(u32x4*)rowp = pk8(o); }
    }
};
struct EpiGLU {
    static constexpr bool PERM = true;
    const bf16_t* YG; bf16_t* Y;
    __device__ __forceinline__ void operator()(const f32x4 (&acc)[2][2][4][2], const Unit& u, int wr, int wc, int fr, int fq) const {
        const int row0 = u.pm * BM + wr * 64 + fr, col0 = u.pn * BM + wc * 32 + 8 * fq;
#pragma unroll
        for (int ai = 0; ai < 2; ++ai)
#pragma unroll
            for (int m = 0; m < 4; ++m) { const size_t row = (size_t)(row0 + ai * HALF + m * 16);
#pragma unroll
                for (int bj = 0; bj < 2; ++bj) { const int col = col0 + bj * HALF;
                    float y[8], o[8]; unpk8(*(const u32x4*)(YG + row * 512 + col), y);
#pragma unroll
                    for (int n = 0; n < 2; ++n)
#pragma unroll
                        for (int j = 0; j < 4; ++j) o[n * 4 + j] = y[n * 4 + j] * sigm(acc[ai][bj][m][n][j]);
                    *(u32x4*)(Y + row * 1024 + col) = pk8(o); } }
    }
};
}

__device__ __forceinline__ void ada_item(const Params& p, int item, unsigned char* sm) {
    unsigned char* const ws = ows(p.ws);
    const int tid = otid();
    const int l = item / 48, n0 = (item % 48) * 128;
    float* sc = (float*)sm;
    float* red = (float*)(sm + 49152);
    for (int i = tid; i < 9 * 1024; i += 512) { const int m = i >> 10, k = i & 1023; const float v = (m < 8) ? p.in[1][m * 1024 + k] : p.in[3][k]; sc[k * 12 + m] = siluf(v); }
    __syncthreads();
    const int col = tid & 127, kg = tid >> 7;
    float a0 = 0, a1 = 0, a2 = 0, a3 = 0, a4 = 0, a5 = 0, a6 = 0, a7 = 0, a8 = 0;
    const float* w = p.in[4] + (size_t)l * 1024 * 6144 + n0 + col;
#pragma unroll 8
    for (int k = kg * 256; k < kg * 256 + 256; ++k) {
        const float wv = w[(size_t)k * 6144];
        const f32x4 s0 = *(const f32x4*)&sc[k * 12], s1 = *(const f32x4*)&sc[k * 12 + 4]; const float s8 = sc[k * 12 + 8];
        a0 += s0[0] * wv; a1 += s0[1] * wv; a2 += s0[2] * wv; a3 += s0[3] * wv; a4 += s1[0] * wv; a5 += s1[1] * wv; a6 += s1[2] * wv; a7 += s1[3] * wv; a8 += s8 * wv;
    }
    float* rp = red + (kg * 9) * 128 + col;
    rp[0] = a0; rp[128] = a1; rp[256] = a2; rp[384] = a3; rp[512] = a4; rp[640] = a5; rp[768] = a6; rp[896] = a7; rp[1024] = a8;
    __syncthreads();
    float* mod = (float*)(ws + OFF_MOD);
    for (int i = tid; i < 9 * 128; i += 512) { const int m = i >> 7, cc = i & 127;
        const float s = red[(0 * 9 + m) * 128 + cc] + red[(1 * 9 + m) * 128 + cc] + red[(2 * 9 + m) * 128 + cc] + red[(3 * 9 + m) * 128 + cc];
        mod[(size_t)(l * 9 + m) * 6144 + n0 + cc] = s + p.in[5][l * 6144 + n0 + cc]; }
}
__device__ __forceinline__ void rope_item(const Params& p) {
    unsigned char* const ws = ows(p.ws);
    float* COS = (float*)(ws + OFF_COS); float* SIN = (float*)(ws + OFF_SIN);
    for (int i = threadIdx.x; i < 2048 * 32; i += 512) { const int pos = i >> 5, f = i & 31, fi = f & 15;
        const float inv = exp2f(-(float)fi * (13.287712379549449f / 16.0f));
        const float ang = (float)(f < 16 ? (pos >> 6) : (pos & 63)) * inv;
        float s, c; my_sincos(ang, s, c); COS[i] = c; SIN[i] = s; }
}
__device__ __forceinline__ void s5disc_item(const Params& p) {
    unsigned char* const ws = ows(p.ws);
    float* AB = (float*)(ws + OFF_AB); float* BBR = (float*)(ws + OFF_BBR); float* BBI = (float*)(ws + OFF_BBI); float* LB = (float*)(ws + OFF_LB);
    for (int idx = threadIdx.x; idx < 8192; idx += 512) {
        const int pp = idx & 63, g = (idx >> 6) & 31, jd = idx >> 11, jo = jd >> 1;
        const float lr = fminf(p.in[18][idx], -1e-4f), li = p.in[19][idx];
        const float dt = expf(p.in[20][jd * 32 + g]);
        const float mag = expf(lr * dt); float s, c; my_sincos(li * dt, s, c);
        const float abr = mag * c, abi = mag * s, den = lr * lr + li * li, nr = abr - 1.0f;
        const float cor = (nr * lr + abi * li) / den, coi = (abi * lr - nr * li) / den;
        AB[idx * 2] = abr; AB[idx * 2 + 1] = abi;
        const float* br = p.in[21] + (size_t)((jo * 32 + g) * 64 + pp) * 16; const float* bi = p.in[22] + (size_t)((jo * 32 + g) * 64 + pp) * 16;
        for (int h = 0; h < 16; ++h) { BBR[idx * 16 + h] = cor * br[h] - coi * bi[h]; BBI[idx * 16 + h] = cor * bi[h] + coi * br[h]; }
    }
    for (int c = threadIdx.x; c < 512; c += 512) { const float e0 = expf(p.in[10][c]), e1 = expf(p.in[10][512 + c]); LB[c] = 0.f; LB[512 + c] = e1 / (e0 + e1); }
}
struct TrTile { bf16_t* dp; int mode; };
__device__ __forceinline__ void tr_load(const Params& p, int tile, int& j, int jhi, f32x4 (&v)[8], int& k0, int& n0, Job& jb, int tid) {
    while (j + 1 < jhi && tile >= p.jobs[j + 1].tile0) ++j;
    jb = p.jobs[j]; const int t = tile - jb.tile0;
    const int nkt = jb.K >> 7, kt = t % nkt, ntl = t / nkt; k0 = kt * 128; n0 = ntl * 128;
    if (jb.mode == 3) {
#pragma unroll
        for (int i = 0; i < 8; ++i) v[i] = (f32x4){0.f, 0.f, 0.f, 0.f};
    } else if (jb.mode == 4) {
        const int blk = n0 >> 9, jo = jb.aux, sn0 = n0 & 511;
        const float* src = (blk < 4) ? (blk < 2 ? p.in[29] : p.in[31]) + (size_t)(jo * 2 + (blk & 1)) * 64 * 512 : p.in[32] + (size_t)jo * 128 * 512;
        const int klo = (blk < 4) ? 64 * blk : 256, khi = (blk < 4) ? 64 * blk + 64 : 384;
#pragma unroll
        for (int i = 0; i < 8; ++i) { const int idx = tid + 512 * i, kk = k0 + (idx >> 5), n4 = (idx & 31) * 4;
            v[i] = (kk >= klo && kk < khi) ? *(const f32x4*)(src + (size_t)(kk - klo) * 512 + sn0 + n4) : (f32x4){0.f, 0.f, 0.f, 0.f}; }
    } else {
#pragma unroll
        for (int i = 0; i < 8; ++i) { const int idx = tid + 512 * i, kk = idx >> 5, n4 = (idx & 31) * 4;
            v[i] = *(const f32x4*)(jb.src + (size_t)(k0 + kk) * jb.N + n0 + n4); }
    }
}
__device__ __forceinline__ void tr_loop(const Params& p, int first, int stride, int ntiles, int jlo, int jhi, unsigned char* sm) {
    const int tid = otid();
    bf16_t* Lb = (bf16_t*)sm;
    if (first >= ntiles) return;
    int j = jlo, k0, n0; Job jb; f32x4 v[8];
    tr_load(p, first, j, jhi, v, k0, n0, jb, tid);
    for (int tile = first; tile < ntiles; tile += stride) {
#pragma unroll
        for (int i = 0; i < 8; ++i) { const int idx = tid + 512 * i, kk = idx >> 5, n4 = (idx & 31) * 4;
            u32x2 w2; w2.x = pk2(v[i][0], v[i][1]); w2.y = pk2(v[i][2], v[i][3]); *(u32x2*)(Lb + kk * 132 + n4) = w2; }
        const int nn = tid >> 2, kq = tid & 3, ng = n0 + nn;
        int drow = ng;
        if (jb.mode == 1) drow = (ng >> 7) * 256 + (ng & 127);
        else if (jb.mode == 2) drow = (ng >> 7) * 256 + 128 + (ng & 127);
        bf16_t* dp = jb.dst + (size_t)drow * jb.ldd + k0;
        __syncthreads();
        if (tile + stride < ntiles) tr_load(p, tile + stride, j, jhi, v, k0, n0, jb, tid);
#pragma unroll
        for (int g = 0; g < 4; ++g) { const int k8 = g * 32 + kq * 8;
            u32x4 o;
            o.x = (unsigned)Lb[(k8 + 0) * 132 + nn] | ((unsigned)Lb[(k8 + 1) * 132 + nn] << 16); o.y = (unsigned)Lb[(k8 + 2) * 132 + nn] | ((unsigned)Lb[(k8 + 3) * 132 + nn] << 16);
            o.z = (unsigned)Lb[(k8 + 4) * 132 + nn] | ((unsigned)Lb[(k8 + 5) * 132 + nn] << 16); o.w = (unsigned)Lb[(k8 + 6) * 132 + nn] | ((unsigned)Lb[(k8 + 7) * 132 + nn] << 16);
            *(u32x4*)(dp + k8) = o; }
        __syncthreads();
    }
}
__device__ __forceinline__ void phase_prologue_a(const Params& p, unsigned char* sm) {
    const int cb = blockIdx.x, G = gridDim.x;
    for (int item = cb; item < 194; item += G) {
        if (item < 192) ada_item(p, item, sm);
        else if (item == 192) rope_item(p);
        else s5disc_item(p);
        __syncthreads();
    }
    tr_loop(p, (cb + 62) % G, G, p.nt0, 0, p.nj0, sm);
    if (DUPB(10)) { __syncthreads(); tr_loop(p, (cb + 62) % G, G, p.nt0, 0, p.nj0, sm); }
    if (DUPB(11)) { __syncthreads(); for (int item = cb; item < 192; item += G) { ada_item(p, item, sm); __syncthreads(); } }
}
__device__ __forceinline__ void phase_prologue_b(const Params& p) {
    unsigned char* const ws = ows(p.ws);
    const int tid_ = otid(); const int lane = tid_ & 63, w = tid_ >> 6;
    _Float16* X = (_Float16*)(ws + OFF_X); bf16_t* H = (bf16_t*)(ws + OFF_H); const float* mod = (const float*)(ws + OFF_MOD);
    f32x4 shr[4], scr[4]; int cur_mi = -1;
#pragma unroll
    for (int i = 0; i < 4; ++i) { shr[i] = (f32x4){0.f, 0.f, 0.f, 0.f}; scr[i] = shr[i]; }
    const int nwv = gridDim.x * 8, rpw = (TT + nwv - 1) / nwv, row_lo = (blockIdx.x * 8 + w) * rpw, row_hi = row_lo + rpw < TT ? row_lo + rpw : TT;
    for (int row = row_lo; row < row_hi; ++row) {
        const int b = row / SB, s = row - b * SB; const int mi = s < 256 ? 8 : b;
        const float* src = s < 256 ? p.in[2] + ((size_t)b * 256 + s) * 1024 : p.in[0] + ((size_t)b * 2048 + (s - 256)) * 1024;
        if (mi != cur_mi) { cur_mi = mi; const float* mp = mod + (size_t)mi * 6144;
#pragma unroll
            for (int i = 0; i < 4; ++i) { shr[i] = *(const f32x4*)(mp + 4 * lane + 256 * i); scr[i] = *(const f32x4*)(mp + 1024 + 4 * lane + 256 * i); } }
#pragma unroll
        for (int i = 0; i < 4; ++i) { const int c = 4 * lane + 256 * i; const f32x4 v = *(const f32x4*)(src + c);
            *(u32x2*)(X + (size_t)row * 1024 + c) = f2h4(v * ALPHA);
            const f32x4 sh = shr[i], sc = scr[i];
            u32x2 o; o.x = pk2(v[0] * (1.f + sc[0]) + sh[0], v[1] * (1.f + sc[1]) + sh[1]); o.y = pk2(v[2] * (1.f + sc[2]) + sh[2], v[3] * (1.f + sc[3]) + sh[3]);
            *(u32x2*)(H + (size_t)row * 1024 + c) = o; }
    }
}

template <int MODE, bool ROUTE, bool DRY = false>
__device__ __forceinline__ void phase_ln(const Params& p, int layer, size_t part_off, int nsplit, unsigned char* sm) {
    unsigned char* const ws = ows(p.ws);
    const int tid_ = otid(); const int lane = tid_ & 63, w = tid_ >> 6;
    _Float16* X = (_Float16*)(ws + OFF_X); bf16_t* H = (bf16_t*)(ws + OFF_H); const float* mod = (const float*)(ws + OFF_MOD);
    const int which = MODE == 0 ? 0 : 1;
    const float* lg = p.in[6] + (size_t)(layer * 2 + which) * 1024; const float* lbp = p.in[7] + (size_t)(layer * 2 + which) * 1024;
    const bool last = (layer == 3);
    const int jo = layer >> 1;
    unsigned* route = (unsigned*)(ws + OFF_ROUTE);
    unsigned* cnt = (unsigned*)(ws + OFF_CNT) + jo * 512;
    int offs[8];
    int split_row = 0x7fffffff;
    if (MODE == 2) { int acc = 0;
#pragma unroll
        for (int e = 0; e < 8; ++e) { offs[e] = acc; acc += (((int)cnt[e * 64] + 255) >> 8) << 8; }
        const int npan = acc >> 8, G_ = gridDim.x; split_row = ((((npan * 4) / G_) * G_) >> 2) << 8; }
    f32x4 rwr[4][4][2];
    if (ROUTE) { const float* rwg = p.in[38] + (size_t)jo * 8192;
#pragma unroll
        for (int i = 0; i < 4; ++i)
#pragma unroll
            for (int q = 0; q < 4; ++q) { const float* rp = rwg + (size_t)(4 * lane + 256 * i + q) * 8; rwr[i][q][0] = *(const f32x4*)rp; rwr[i][q][1] = *(const f32x4*)(rp + 4); } }
    f32x4 g4r[4], b4r[4], shr[4], scr[4];
#pragma unroll
    for (int i = 0; i < 4; ++i) { g4r[i] = *(const f32x4*)(lg + 4 * lane + 256 * i); b4r[i] = *(const f32x4*)(lbp + 4 * lane + 256 * i); shr[i] = (f32x4){0.f, 0.f, 0.f, 0.f}; scr[i] = shr[i]; }
    int cur_mi = -1, cur_gi = -1; f32x4 gtr[4];
#pragma unroll
    for (int i = 0; i < 4; ++i) gtr[i] = (f32x4){0.f, 0.f, 0.f, 0.f};
    const int nwv = gridDim.x * 8, rpw = (TT + nwv - 1) / nwv, row_lo = (blockIdx.x * 8 + w) * rpw, row_hi = row_lo + rpw < TT ? row_lo + rpw : TT;
    for (int row = row_lo; row < row_hi; ++row) {
        const int b = row / SB, s = row - b * SB; const int mi = s < 256 ? 8 : b;
        if (last && s < 256 && (MODE != 0 || ROUTE)) {
            if (ROUTE && lane == 0 && !DRY) route[(size_t)row * 8] = 0xffffffffu;
            continue;
        }
        f32x4 v[4];
        _Float16* xr = X + (size_t)row * 1024;
        _Float16* xw = DRY ? (_Float16*)(ws + OFF_S5F) + (size_t)row * 1024 : xr; bf16_t* hw = DRY ? (bf16_t*)(ws + OFF_S5B) + (size_t)row * 1024 : H + (size_t)row * 1024;
#pragma unroll
        for (int i = 0; i < 4; ++i) v[i] = h2f4(*(const u32x2*)(xr + 4 * lane + 256 * i));
        if (MODE != 2) {
            const bf16_t* d0 = (const bf16_t*)(ws + part_off) + (size_t)row * 1024 + 4 * lane;
            const bool two = (s < 256 && nsplit > 0);
#pragma unroll
            for (int i = 0; i < 4; ++i) { v[i] += unpk4v(*(const u32x2*)(d0 + 256 * i)); if (two) v[i] += unpk4v(*(const u32x2*)(d0 + (size_t)TT * 1024 + 256 * i)); }
        }
        if (MODE == 2) {
            const unsigned* rt = route + (size_t)row * 8;
            const int e1 = (int)rt[0], e2 = (int)rt[1]; const int r1 = (int)rt[2], r2 = (int)rt[3]; const float p1 = __uint_as_float(rt[4]), p2 = __uint_as_float(rt[5]);
            int o1 = 0, o2 = 0;
#pragma unroll
            for (int e = 0; e < 8; ++e) { o1 = (e == e1) ? offs[e] : o1; o2 = (e == e2) ? offs[e] : o2; }
            const bf16_t* F = (const bf16_t*)(ws + OFF_AR + AM_A);
            const bf16_t* f1 = F + (size_t)(o1 + r1) * 1024; const bf16_t* f2 = F + (size_t)(o2 + r2) * 1024;
            const bf16_t* F2 = (const bf16_t*)(ws + OFF_GE);
            const bool s1 = (o1 + r1) >= split_row, s2 = (o2 + r2) >= split_row;
            if (mi != cur_gi) { cur_gi = mi; const float* gt = mod + (size_t)(layer * 9 + mi) * 6144 + 5120;
#pragma unroll
                for (int i = 0; i < 4; ++i) gtr[i] = *(const f32x4*)(gt + 4 * lane + 256 * i); }
#pragma unroll
            for (int i = 0; i < 4; ++i) { const int c = 4 * lane + 256 * i; float a[4], bb[4]; unpk4(*(const u32x2*)(f1 + c), a); unpk4(*(const u32x2*)(f2 + c), bb);
                if (s1) { float t_[4]; unpk4(*(const u32x2*)(F2 + (size_t)(o1 + r1) * 1024 + c), t_); a[0] += t_[0]; a[1] += t_[1]; a[2] += t_[2]; a[3] += t_[3]; }
                if (s2) { float t_[4]; unpk4(*(const u32x2*)(F2 + (size_t)(o2 + r2) * 1024 + c), t_); bb[0] += t_[0]; bb[1] += t_[1]; bb[2] += t_[2]; bb[3] += t_[3]; }
                const f32x4 g4 = gtr[i];
#pragma unroll
                for (int q = 0; q < 4; ++q) v[i][q] = v[i][q] + g4[q] * (p1 * a[q] + p2 * bb[q]); }
        }
        float sm_ = 0.f;
#pragma unroll
        for (int i = 0; i < 4; ++i) sm_ += (v[i][0] + v[i][1]) + (v[i][2] + v[i][3]);
        const float mean = sum64(sm_) * (1.0f / 1024.0f);
        float sq = 0.f;
#pragma unroll
        for (int i = 0; i < 4; ++i) { const f32x4 d = v[i] - mean; sq += (d[0] * d[0] + d[1] * d[1]) + (d[2] * d[2] + d[3] * d[3]); }
        const float rstd = rsqrtf(sum64(sq) * (1.0f / 1024.0f) + 1e-5f);
        if (mi != cur_mi) { cur_mi = mi;
            const float* mp = (MODE == 0) ? mod + (size_t)(layer * 9 + mi) * 6144 + 3072 : mod + (size_t)((last ? 0 : layer + 1) * 9 + mi) * 6144;
#pragma unroll
            for (int i = 0; i < 4; ++i) { shr[i] = *(const f32x4*)(mp + 4 * lane + 256 * i); scr[i] = *(const f32x4*)(mp + 1024 + 4 * lane + 256 * i); } }
        float lg8[8];
#pragma unroll
        for (int e = 0; e < 8; ++e) lg8[e] = 0.f;
#pragma unroll
        for (int i = 0; i < 4; ++i) { const int c = 4 * lane + 256 * i;
            const f32x4 y = (v[i] - mean) * rstd * g4r[i] + b4r[i];
            if (MODE != 0 && last) { if (!DRY) *(f32x4*)(p.out + ((size_t)b * 2048 + (s - 256)) * 1024 + c) = y; else *(u32x2*)(xw + c) = f2h4(y); }
            else {
                *(u32x2*)(xw + c) = f2h4(y * ALPHA);
                const f32x4 h = y * (1.0f + scr[i]) + shr[i];
                u32x2 o; o.x = pk2(h[0], h[1]); o.y = pk2(h[2], h[3]);
                *(u32x2*)(hw + c) = o;
                if (ROUTE) {
#pragma unroll
                    for (int e = 0; e < 8; ++e) lg8[e] += (h[0] * rwr[i][0][e >> 2][e & 3] + h[1] * rwr[i][1][e >> 2][e & 3]) + (h[2] * rwr[i][2][e >> 2][e & 3] + h[3] * rwr[i][3][e >> 2][e & 3]); }
            }
        }
        if (ROUTE) {
#pragma unroll
            for (int e = 0; e < 8; ++e) lg8[e] = sum64(lg8[e]) + p.in[39][jo * 8 + e];
            int e1 = 0; float v1 = lg8[0];
#pragma unroll
            for (int e = 1; e < 8; ++e) if (lg8[e] > v1) { v1 = lg8[e]; e1 = e; }
            int e2 = -1; float v2 = -3.0e38f;
#pragma unroll
            for (int e = 0; e < 8; ++e) if (e != e1 && lg8[e] > v2) { v2 = lg8[e]; e2 = e; }
            if (lane == 0 && !DRY) {
                const float p1 = 1.0f / (1.0f + __expf(v2 - v1)), p2 = 1.0f - p1;
                const unsigned r1 = atomicAdd(&cnt[e1 * 64], 1u), r2 = atomicAdd(&cnt[e2 * 64], 1u);
                unsigned* rt = route + (size_t)row * 8;
                rt[0] = (unsigned)e1; rt[1] = (unsigned)e2; rt[2] = r1; rt[3] = r2; rt[4] = __float_as_uint(p1); rt[5] = __float_as_uint(p2);
                unsigned* inv = (unsigned*)(ws + OFF_INV); inv[(size_t)e1 * TT + r1] = (unsigned)row; inv[(size_t)e2 * TT + r2] = (unsigned)row;
            }
        }
    }
}
__device__ __forceinline__ int scan_row(int dir, int n) { return dir == 0 ? n : (n < 256 ? 255 - n : 2559 - n); }
__device__ __forceinline__ void hgrn_chunk_unit(const Params& p, int j, int u, unsigned char* sm) {
    unsigned char* const ws = ows(p.ws);
    const int tid = otid(), lane = tid & 63, w = tid >> 6, l15 = lane & 15, kg = lane >> 4;
    const int chf = u & 1, dir = (u >> 1) & 1, h = (u >> 2) & 3, b = u >> 4;
    const int ct = 4 * chf + (w & 3);
    const bf16_t* P = (const bf16_t*)(ws + OFF_AR + AE_P);
    bf16_t* O = (bf16_t*)(ws + OFF_AR + (dir ? AE_OB : AE_OF));
    const size_t rb = (size_t)b * SB;
    const int pd = tid >> 2, tq = tid & 3;
    const int ppos = (pd & ~31) + 8 * ((pd & 15) >> 2) + 4 * ((pd >> 4) & 1) + (pd & 3);
    const int rstep = dir ? -1 : 1;
    constexpr int RAW0 = 2 * 21504, RAWSZ = 3 * 16 * 136 * 2;
    const int t4 = tid & 255, lt = t4 >> 4, lc = t4 & 15;
    u32x4 gq, gf, gv;
#define HG_LOAD(c) do { const size_t row = rb + scan_row(dir, (c) * 16 + lt); const bf16_t* pr = P + row * 3328 + h * 128 + 8 * lc; \
        gq = *(const u32x4*)pr; gf = *(const u32x4*)(pr + 512 + dir * 512); gv = *(const u32x4*)(pr + 1536); } while (0)
#define HG_RAWW(bi) do { bf16_t* rw = (bf16_t*)(sm + RAW0 + (bi) * RAWSZ) + lt * 136 + 8 * lc; \
        *(u32x4*)rw = gq; *(u32x4*)(rw + 16 * 136) = gf; *(u32x4*)(rw + 32 * 136) = gv; } while (0)
    unsigned short rq[4], rf[4], rv[4];
#define HG_RAWR(bi) do { const bf16_t* rr_ = (const bf16_t*)(sm + RAW0 + (bi) * RAWSZ) + (4 * tq) * 136 + pd; \
        _Pragma("unroll") for (int k = 0; k < 4; ++k) { rq[k] = rr_[k * 136]; rf[k] = rr_[(16 + k) * 136]; rv[k] = rr_[(32 + k) * 136]; } } while (0)
#define HG_PREP(bufi) do { \
        bf16_t* Qd = (bf16_t*)(sm + (bufi) * 21504); bf16_t* Kd = Qd + 16 * 136; bf16_t* KeT = Kd + 16 * 136; bf16_t* Vt = KeT + 128 * 24; float* dec = (float*)(Vt + 128 * 24); \
        float qv[4], kk[4], cl[4]; float run = 0.f; \
        _Pragma("unroll") for (int k = 0; k < 4; ++k) { const float lg = bf2f(rf[k]); \
            qv[k] = bf2f(rq[k]); kk[k] = 1.0f - __builtin_amdgcn_exp2f(lg); run += lg; cl[k] = run; } \
        float x1 = dppf<0x93>(run); x1 = (tq >= 1) ? x1 : 0.f;            \
        float s2 = run + x1; float x2 = dppf<0x4E>(s2); x2 = (tq >= 2) ? x2 : 0.f; \
        const float incl = s2 + x2; const float off = incl - run; \
        const float btot = dppf<0xFF>(incl);                                  \
        const float etot = __builtin_amdgcn_exp2f(btot); \
        float ke[4]; \
        _Pragma("unroll") for (int k = 0; k < 4; ++k) { const float bl = off + cl[k]; const float E = __builtin_amdgcn_exp2f(bl); const float iE = __builtin_amdgcn_rcpf(E); \
            const float qd = qv[k] * E, kd = kk[k] * iE; ke[k] = kd * etot; \
            Qd[(4 * tq + k) * 136 + ppos] = (bf16_t)(pk2(qd, 0.f) & 0xffff); Kd[(4 * tq + k) * 136 + ppos] = (bf16_t)(pk2(kd, 0.f) & 0xffff); } \
        { u32x2 w2; w2.x = pk2(ke[0], ke[1]); w2.y = pk2(ke[2], ke[3]); *(u32x2*)(KeT + pd * 24 + 4 * tq) = w2; \
          u32x2 v2; v2.x = (unsigned)rv[0] | ((unsigned)rv[1] << 16); v2.y = (unsigned)rv[2] | ((unsigned)rv[3] << 16); *(u32x2*)(Vt + pd * 24 + 4 * tq) = v2; } \
        if (tq == 0) dec[pd] = etot; } while (0)
    f32x4 S[8];
#pragma unroll
    for (int i = 0; i < 8; ++i) S[i] = (f32x4){0.f, 0.f, 0.f, 0.f};
    if (w >= 4) { HG_LOAD(0); HG_RAWW(0); HG_LOAD(1); }
    LDS_BARRIER();
    HG_RAWR(0); HG_PREP(0);
    if (w >= 4) { HG_RAWW(1); HG_LOAD(2); }
    LDS_BARRIER();
    for (int c = 0; c < 144; ++c) {
        if (c + 1 < 144) { HG_RAWR((c + 1) & 1); HG_PREP((c + 1) & 1); }
        if (w >= 4) { if (c + 2 < 144) { HG_RAWW(c & 1); } if (c + 3 < 144) { HG_LOAD(c + 3); } }
        if (w < 4) {
            const bf16_t* Qd = (const bf16_t*)(sm + (c & 1) * 21504); const bf16_t* Kd = Qd + 16 * 136; const bf16_t* KeT = Kd + 16 * 136; const bf16_t* Vt = KeT + 128 * 24; const float* dec = (const float*)(Vt + 128 * 24);
            f32x4 AT = {0.f, 0.f, 0.f, 0.f};
            bf16x8 qf[4];
#pragma unroll
            for (int ks = 0; ks < 4; ++ks) { const bf16x8 kf = *(const bf16x8*)(Kd + l15 * 136 + 32 * ks + 8 * kg); qf[ks] = *(const bf16x8*)(Qd + l15 * 136 + 32 * ks + 8 * kg);
                AT = __builtin_amdgcn_mfma_f32_16x16x32_bf16(kf, qf[ks], AT, 0, 0, 0); }
            u32x4 aw;
            aw.x = pk2((4 * kg + 0 <= l15) ? AT[0] : 0.f, (4 * kg + 1 <= l15) ? AT[1] : 0.f); aw.y = pk2((4 * kg + 2 <= l15) ? AT[2] : 0.f, (4 * kg + 3 <= l15) ? AT[3] : 0.f); aw.z = 0u; aw.w = 0u;
            const bf16x8 afrag = __builtin_bit_cast(bf16x8, aw);
            u32x4 vw; { const u32x2 v2 = *(const u32x2*)(Vt + (16 * ct + l15) * 24 + 4 * kg); vw.x = v2.x; vw.y = v2.y; vw.z = 0u; vw.w = 0u; }
            const bf16x8 vfrag = __builtin_bit_cast(bf16x8, vw);
            f32x4 Oa = {0.f, 0.f, 0.f, 0.f};
            Oa = __builtin_amdgcn_mfma_f32_16x16x32_bf16(afrag, vfrag, Oa, 0, 0, 0);
#pragma unroll
            for (int pi = 0; pi < 4; ++pi) {
                u32x4 sw; sw.x = pk2(S[2 * pi][0], S[2 * pi][1]); sw.y = pk2(S[2 * pi][2], S[2 * pi][3]); sw.z = pk2(S[2 * pi + 1][0], S[2 * pi + 1][1]); sw.w = pk2(S[2 * pi + 1][2], S[2 * pi + 1][3]);
                Oa = __builtin_amdgcn_mfma_f32_16x16x32_bf16(qf[pi], __builtin_bit_cast(bf16x8, sw), Oa, 0, 0, 0);
            }
            { bf16_t* op = O + (rb + scan_row(dir, c * 16 + 4 * kg)) * 512 + h * 128 + 16 * ct + l15;
#pragma unroll
              for (int i = 0; i < 4; ++i) op[(ptrdiff_t)(rstep * i) * 512] = (bf16_t)(pk2(Oa[i], 0.f) & 0xffff); }
#pragma unroll
            for (int dt = 0; dt < 8; ++dt) {
                const f32x4 dv = *(const f32x4*)(dec + 16 * dt + 4 * kg);
                u32x4 kw; { const u32x2 k2 = *(const u32x2*)(KeT + (16 * dt + l15) * 24 + 4 * kg); kw.x = k2.x; kw.y = k2.y; kw.z = 0u; kw.w = 0u; }
                S[dt] = __builtin_amdgcn_mfma_f32_16x16x32_bf16(__builtin_bit_cast(bf16x8, kw), vfrag, S[dt] * dv, 0, 0, 0);
            }
        }
        LDS_BARRIER();
    }
#undef HG_LOAD
#undef HG_RAWW
#undef HG_RAWR
#undef HG_PREP
}
__device__ __forceinline__ void hgrn_finish_rows(const Params& p, int j) {
    unsigned char* const ws = ows(p.ws);
    const int tid_ = otid(); const int lane = tid_ & 63, w = tid_ >> 6;
    const bf16_t* P = (const bf16_t*)(ws + OFF_AR + AE_P);
    const bf16_t* OF = (const bf16_t*)(ws + OFF_AR + AE_OF); const bf16_t* OB = (const bf16_t*)(ws + OFF_AR + AE_OB);
    bf16_t* Y = (bf16_t*)(ws + OFF_AR + AE_Y);
    const int c0 = lane * 8;
    const int nwv = gridDim.x * 8, rpw = (TT + nwv - 1) / nwv, row_lo = (blockIdx.x * 8 + w) * rpw, row_hi = (row_lo + rpw < TT) ? row_lo + rpw : TT;
    const f32x4 ng0 = *(const f32x4*)(p.in[11] + j * 512 + c0), ng1 = *(const f32x4*)(p.in[11] + j * 512 + c0 + 4);
    for (int row = row_lo; row < row_hi; ++row) {
        float o[8], g[8];
        { float fa[8], fb[8]; unpk8(*(const u32x4*)(OF + (size_t)row * 512 + c0), fa); unpk8(*(const u32x4*)(OB + (size_t)row * 512 + c0), fb);
#pragma unroll
          for (int i = 0; i < 8; ++i) o[i] = fa[i] + fb[i]; }
        unpk8(*(const u32x4*)(P + (size_t)row * 3328 + 2048 + c0), g);
        float ssq = 0.f;
#pragma unroll
        for (int i = 0; i < 8; ++i) ssq += o[i] * o[i];
        ssq = sum16(ssq);
        const float r = rsqrtf(ssq * (1.0f / 128.0f) + 1e-6f);
        float y[8];
#pragma unroll
        for (int i = 0; i < 4; ++i) { y[i] = o[i] * r * ng0[i] * g[i]; y[4 + i] = o[4 + i] * r * ng1[i] * g[4 + i]; }
        *(u32x4*)(Y + (size_t)row * 1024 + c0) = pk8(y);
    }
}

__device__ __forceinline__ void attn_unit(const Params& p, int j, int u, unsigned char* sm) {
    unsigned char* const ws = ows(p.ws);
    const int tid = otid(), lane = tid & 63, w = tid >> 6;
    const int b = u / 72, rem = u - b * 72, g = rem / 36, qb = rem - g * 36;
    const int r4 = w & 3, sub = w >> 2, hh = g * 4 + r4, l31 = lane & 31, hf = lane >> 5;
    bf16_t* Ks = (bf16_t*)sm; bf16_t* Vt = Ks + 64 * 72;
    const bf16_t* P = (const bf16_t*)(ws + OFF_AR + AE_P); bf16_t* Y = (bf16_t*)(ws + OFF_AR + AE_Y);
    const float* COS = (const float*)(ws + OFF_COS); const float* SIN = (const float*)(ws + OFF_SIN);
    const bool isl = qb < 32;
    const int q0 = isl ? qb * 64 : (qb - 32) * 64;
    const size_t rb = (size_t)b * SB;
    const int qpos = q0 + sub * 32 + l31;
    const size_t qrow = rb + (isl ? 256 : 0) + qpos;
    bf16x8 qf[4];
    {
        const bf16_t* qp = P + qrow * 3328 + 2560 + hh * 64;
        float x1a[8], x1b[8], x2a[8], x2b[8];
        unpk8(*(const u32x4*)(qp + 8 * hf), x1a); unpk8(*(const u32x4*)(qp + 16 + 8 * hf), x1b);
        unpk8(*(const u32x4*)(qp + 32 + 8 * hf), x2a); unpk8(*(const u32x4*)(qp + 48 + 8 * hf), x2b);
        const float sc = 0.125f * 1.4426950408889634f;
        float o0[8], o1[8], o2[8], o3[8];
        if (isl) {
            const float* cp = COS + qpos * 32 + 8 * hf; const float* sp = SIN + qpos * 32 + 8 * hf;
#pragma unroll
            for (int i = 0; i < 8; ++i) { const float ca = cp[i], sa = sp[i], cb = cp[16 + i], sb = sp[16 + i];
                o0[i] = (x1a[i] * ca - x2a[i] * sa) * sc; o2[i] = (x1a[i] * sa + x2a[i] * ca) * sc;
                o1[i] = (x1b[i] * cb - x2b[i] * sb) * sc; o3[i] = (x1b[i] * sb + x2b[i] * cb) * sc; }
        } else {
#pragma unroll
            for (int i = 0; i < 8; ++i) { o0[i] = x1a[i] * sc; o1[i] = x1b[i] * sc; o2[i] = x2a[i] * sc; o3[i] = x2b[i] * sc; }
        }
        qf[0] = __builtin_bit_cast(bf16x8, pk8(o0)); qf[1] = __builtin_bit_cast(bf16x8, pk8(o1)); qf[2] = __builtin_bit_cast(bf16x8, pk8(o2)); qf[3] = __builtin_bit_cast(bf16x8, pk8(o3));
    }
    float m = p.in[12][j * 8 + hh] * 1.4426950408889634f;
    float lsum = hf == 0 ? 1.0f : 0.0f;
    f32x16 O0, O1;
#pragma unroll
    for (int i = 0; i < 16; ++i) { O0[i] = 0.f; O1[i] = 0.f; }
    const int nch = isl ? 9 : 4;
    for (int ci = 0; ci < nch; ++ci) {
        const bool win = isl && ci < 5;
        int w0 = 0; size_t krow0;
        if (win) { w0 = q0 - 128 + 64 * ci; if (w0 < 0 || w0 >= 2048) continue; krow0 = rb + 256 + w0; }
        else { const int cc = isl ? ci - 5 : ci; krow0 = rb + cc * 64; }
        __syncthreads();
        if (tid < 256) {
            const int key = tid >> 2, dq = tid & 3;
            const bf16_t* src = P + (krow0 + key) * 3328 + 2560 + 512 + g * 64;
            u32x4 r1 = *(const u32x4*)(src + dq * 8), r2 = *(const u32x4*)(src + 32 + dq * 8);
            if (win) {
                float x1[8], x2[8], y1[8], y2[8]; unpk8(r1, x1); unpk8(r2, x2);
                const float* cp = COS + (w0 + key) * 32 + dq * 8; const float* sp = SIN + (w0 + key) * 32 + dq * 8;
#pragma unroll
                for (int i = 0; i < 8; ++i) { const float c_ = cp[i], s_ = sp[i]; y1[i] = x1[i] * c_ - x2[i] * s_; y2[i] = x1[i] * s_ + x2[i] * c_; }
                r1 = pk8(y1); r2 = pk8(y2);
            }
            *(u32x4*)(Ks + key * 72 + dq * 8) = r1; *(u32x4*)(Ks + key * 72 + 32 + dq * 8) = r2;
        } else {
            const int t2 = tid - 256, key = t2 >> 2, dq = t2 & 3;
            const bf16_t* src = P + (krow0 + key) * 3328 + 2560 + 640 + g * 64 + dq * 16;
            const u32x4 r1 = *(const u32x4*)src, r2 = *(const u32x4*)(src + 8);
            bf16_t* vp = Vt + (dq * 16) * 72 + key;
            vp[0 * 72] = (bf16_t)(r1.x & 0xffff); vp[1 * 72] = (bf16_t)(r1.x >> 16); vp[2 * 72] = (bf16_t)(r1.y & 0xffff); vp[3 * 72] = (bf16_t)(r1.y >> 16);
            vp[4 * 72] = (bf16_t)(r1.z & 0xffff); vp[5 * 72] = (bf16_t)(r1.z >> 16); vp[6 * 72] = (bf16_t)(r1.w & 0xffff); vp[7 * 72] = (bf16_t)(r1.w >> 16);
            vp[8 * 72] = (bf16_t)(r2.x & 0xffff); vp[9 * 72] = (bf16_t)(r2.x >> 16); vp[10 * 72] = (bf16_t)(r2.y & 0xffff); vp[11 * 72] = (bf16_t)(r2.y >> 16);
            vp[12 * 72] = (bf16_t)(r2.z & 0xffff); vp[13 * 72] = (bf16_t)(r2.z >> 16); vp[14 * 72] = (bf16_t)(r2.w & 0xffff); vp[15 * 72] = (bf16_t)(r2.w >> 16);
        }
        __syncthreads();
        f32x16 s0, s1;
#pragma unroll
        for (int i = 0; i < 16; ++i) { s0[i] = 0.f; s1[i] = 0.f; }
#pragma unroll
        for (int s = 0; s < 4; ++s) {
            const bf16x8 a0 = *(const bf16x8*)(Ks + l31 * 72 + 16 * s + 8 * hf), a1 = *(const bf16x8*)(Ks + (32 + l31) * 72 + 16 * s + 8 * hf);
            s0 = __builtin_amdgcn_mfma_f32_32x32x16_bf16(a0, qf[s], s0, 0, 0, 0);
            s1 = __builtin_amdgcn_mfma_f32_32x32x16_bf16(a1, qf[s], s1, 0, 0, 0);
        }
        if (win) {
#pragma unroll
            for (int i = 0; i < 16; ++i) { const int key = 8 * (i >> 2) + 4 * hf + (i & 3); const int d0 = qpos - (w0 + key), d1 = d0 - 32;
                if (d0 > 128 || d0 < -128) s0[i] = -INFINITY;
                if (d1 > 128 || d1 < -128) s1[i] = -INFINITY; }
        }
        float mt = s0[0];
#pragma unroll
        for (int i = 1; i < 16; ++i) mt = fmaxf(mt, s0[i]);
#pragma unroll
        for (int i = 0; i < 16; ++i) mt = fmaxf(mt, s1[i]);
        mt = fmaxf(mt, __shfl_xor(mt, 32));
        const float mnew = fmaxf(m, mt), alpha = __builtin_amdgcn_exp2f(m - mnew);
        m = mnew;
        float rs = 0.f;
#pragma unroll
        for (int i = 0; i < 16; ++i) { s0[i] = __builtin_amdgcn_exp2f(s0[i] - mnew); s1[i] = __builtin_amdgcn_exp2f(s1[i] - mnew); rs += s0[i] + s1[i]; }
        lsum = lsum * alpha + rs;
#pragma unroll
        for (int i = 0; i < 16; ++i) { O0[i] *= alpha; O1[i] *= alpha; }
#pragma unroll
        for (int kt = 0; kt < 2; ++kt)
#pragma unroll
            for (int s2 = 0; s2 < 2; ++s2) {
                u32x4 pw;
                if (kt == 0) { pw.x = pk2(s0[8 * s2], s0[8 * s2 + 1]); pw.y = pk2(s0[8 * s2 + 2], s0[8 * s2 + 3]); pw.z = pk2(s0[8 * s2 + 4], s0[8 * s2 + 5]); pw.w = pk2(s0[8 * s2 + 6], s0[8 * s2 + 7]); }
                else { pw.x = pk2(s1[8 * s2], s1[8 * s2 + 1]); pw.y = pk2(s1[8 * s2 + 2], s1[8 * s2 + 3]); pw.z = pk2(s1[8 * s2 + 4], s1[8 * s2 + 5]); pw.w = pk2(s1[8 * s2 + 6], s1[8 * s2 + 7]); }
                const bf16x8 pf = __builtin_bit_cast(bf16x8, pw);
#pragma unroll
                for (int mt2 = 0; mt2 < 2; ++mt2) {
                    const bf16_t* vp = Vt + (mt2 * 32 + l31) * 72 + kt * 32 + 16 * s2 + 4 * hf;
                    const u32x2 lo = *(const u32x2*)vp, hi = *(const u32x2*)(vp + 8);
                    u32x4 vv; vv.x = lo.x; vv.y = lo.y; vv.z = hi.x; vv.w = hi.y;
                    const bf16x8 vf = __builtin_bit_cast(bf16x8, vv);
                    if (mt2 == 0) O0 = __builtin_amdgcn_mfma_f32_32x32x16_bf16(vf, pf, O0, 0, 0, 0);
                    else O1 = __builtin_amdgcn_mfma_f32_32x32x16_bf16(vf, pf, O1, 0, 0, 0);
                }
            }
    }
    const float ltot = lsum + __shfl_xor(lsum, 32);
    const float inv = 1.0f / ltot;
    bf16_t* yp = Y + qrow * 1024 + 512 + hh * 64;
#pragma unroll
    for (int ib = 0; ib < 4; ++ib) {
        u32x2 o; o.x = pk2(O0[4 * ib] * inv, O0[4 * ib + 1] * inv); o.y = pk2(O0[4 * ib + 2] * inv, O0[4 * ib + 3] * inv);
        *(u32x2*)(yp + 8 * ib + 4 * hf) = o;
        u32x2 o2; o2.x = pk2(O1[4 * ib] * inv, O1[4 * ib + 1] * inv); o2.y = pk2(O1[4 * ib + 2] * inv, O1[4 * ib + 3] * inv);
        *(u32x2*)(yp + 32 + 8 * ib + 4 * hf) = o2;
    }
    __syncthreads();
}

__device__ __forceinline__ float partner32(float x) {
    const unsigned xb = __builtin_bit_cast(unsigned, x);
    auto r = __builtin_amdgcn_permlane32_swap(xb, xb, false, false);
    const unsigned pb = (r[0] == xb) ? r[1] : r[0];
    return __builtin_bit_cast(float, pb);
}
__device__ __forceinline__ void s5_scan_task(const Params& p, int jo, int task, unsigned char* smw) {
    unsigned char* const ws = ows(p.ws);
    const int lane = otid() & 63, l31 = lane & 31, hf = lane >> 5, l15 = lane & 15, kg = lane >> 4;
    const int dir = task & 1, g = (task >> 1) & 31, b = task >> 6;
    bf16_t* Xs = (bf16_t*)smw;
    const bf16_t* P = (const bf16_t*)(ws + OFF_AR + AO_YG);
    bf16_t* Yd = (bf16_t*)(ws + (dir ? OFF_S5B : OFF_S5F));
    const size_t rb = (size_t)b * SB;
    const int idx0 = ((jo * 2 + dir) * 32 + g) * 64 + l31, idx1 = idx0 + 32;
    const float* AB = (const float*)(ws + OFF_AB);
    const float ar0 = AB[idx0 * 2], ai0 = AB[idx0 * 2 + 1], ar1 = AB[idx1 * 2], ai1 = AB[idx1 * 2 + 1];
    bf16x8 bbf[4];
    { const float* BR = (const float*)(ws + OFF_BBR); const float* BI = (const float*)(ws + OFF_BBI);
      float t8[8];
#pragma unroll
      for (int j = 0; j < 8; ++j) t8[j] = BR[(size_t)idx0 * 16 + 8 * hf + j];
      bbf[0] = __builtin_bit_cast(bf16x8, pk8(t8));
#pragma unroll
      for (int j = 0; j < 8; ++j) t8[j] = BR[(size_t)idx1 * 16 + 8 * hf + j];
      bbf[1] = __builtin_bit_cast(bf16x8, pk8(t8));
#pragma unroll
      for (int j = 0; j < 8; ++j) t8[j] = BI[(size_t)idx0 * 16 + 8 * hf + j];
      bbf[2] = __builtin_bit_cast(bf16x8, pk8(t8));
#pragma unroll
      for (int j = 0; j < 8; ++j) t8[j] = BI[(size_t)idx1 * 16 + 8 * hf + j];
      bbf[3] = __builtin_bit_cast(bf16x8, pk8(t8)); }
    bf16x8 cmf[4], dskf;
    { const float* c1 = p.in[23] + (size_t)((jo * 32 + g) * 16 + l15) * 64; const float* c2 = p.in[24] + (size_t)((jo * 32 + g) * 16 + l15) * 64;
#pragma unroll
      for (int ks = 0; ks < 4; ++ks) { float t8[8];
#pragma unroll
          for (int j = 0; j < 8; ++j) { const int n = 8 * ks + 2 * kg + (j >> 2), q = j & 3; const int pp = n + 32 * (q & 1); t8[j] = (q < 2) ? c1[pp] : -c2[pp]; }
          cmf[ks] = __builtin_bit_cast(bf16x8, pk8(t8)); }
      float t8[8]; const float dv = p.in[25][jo * 512 + g * 16 + l15];
#pragma unroll
      for (int j = 0; j < 8; ++j) t8[j] = (kg < 2 && 8 * kg + j == l15) ? dv : 0.f;
      dskf = __builtin_bit_cast(bf16x8, pk8(t8)); }
    float xr0 = 0.f, xi0 = 0.f, xr1 = 0.f, xi1 = 0.f;
    u32x4 ua = *(const u32x4*)(P + (rb + scan_row(dir, l31)) * 512 + g * 16 + 8 * hf);
    for (int c = 0; c < 72; ++c) {
        f32x16 D0, D1, D2, D3;
#pragma unroll
        for (int i = 0; i < 16; ++i) { D0[i] = 0.f; D1[i] = 0.f; D2[i] = 0.f; D3[i] = 0.f; }
        { const bf16x8 uf = __builtin_bit_cast(bf16x8, ua);
          D0 = __builtin_amdgcn_mfma_f32_32x32x16_bf16(uf, bbf[0], D0, 0, 0, 0); D1 = __builtin_amdgcn_mfma_f32_32x32x16_bf16(uf, bbf[1], D1, 0, 0, 0);
          D2 = __builtin_amdgcn_mfma_f32_32x32x16_bf16(uf, bbf[2], D2, 0, 0, 0); D3 = __builtin_amdgcn_mfma_f32_32x32x16_bf16(uf, bbf[3], D3, 0, 0, 0); }
        if (c + 1 < 72) ua = *(const u32x4*)(P + (rb + scan_row(dir, (c + 1) * 32 + l31)) * 512 + g * 16 + 8 * hf);
#pragma unroll
        for (int m = 0; m < 4; ++m) {
            float A_[4][4], B_[4][4];
#pragma unroll
            for (int k = 0; k < 4; ++k) { const int i = 4 * m + k;
                const float n0r = ar0 * xr0 - ai0 * xi0 + D0[i], n0i = ar0 * xi0 + ai0 * xr0 + D2[i];
                const float n1r = ar1 * xr1 - ai1 * xi1 + D1[i], n1i = ar1 * xi1 + ai1 * xr1 + D3[i];
                xr0 = n0r; xi0 = n0i; xr1 = n1r; xi1 = n1i; A_[k][0] = xr0; A_[k][1] = xr1; A_[k][2] = xi0; A_[k][3] = xi1; }
            { const float q0 = partner32(xr0), q1 = partner32(xi0), q2 = partner32(xr1), q3 = partner32(xi1);
              xr0 = hf ? q0 : xr0; xi0 = hf ? q1 : xi0; xr1 = hf ? q2 : xr1; xi1 = hf ? q3 : xi1; }
#pragma unroll
            for (int k = 0; k < 4; ++k) { const int i = 4 * m + k;
                const float n0r = ar0 * xr0 - ai0 * xi0 + D0[i], n0i = ar0 * xi0 + ai0 * xr0 + D2[i];
                const float n1r = ar1 * xr1 - ai1 * xi1 + D1[i], n1i = ar1 * xi1 + ai1 * xr1 + D3[i];
                xr0 = n0r; xi0 = n0i; xr1 = n1r; xi1 = n1i; B_[k][0] = xr0; B_[k][1] = xr1; B_[k][2] = xi0; B_[k][3] = xi1; }
            { const float q0 = partner32(xr0), q1 = partner32(xi0), q2 = partner32(xr1), q3 = partner32(xi1);
              xr0 = hf ? xr0 : q0; xi0 = hf ? xi0 : q1; xr1 = hf ? xr1 : q2; xi1 = hf ? xi1 : q3; }
#pragma unroll
            for (int k = 0; k < 4; ++k) { const int t = 8 * m + 4 * hf + k;
                u32x2 w2; w2.x = pk2(hf ? B_[k][0] : A_[k][0], hf ? B_[k][1] : A_[k][1]); w2.y = pk2(hf ? B_[k][2] : A_[k][2], hf ? B_[k][3] : A_[k][3]);
                *(u32x2*)(Xs + t * 136 + 4 * l31) = w2; }
        }
        asm volatile("s_waitcnt lgkmcnt(0)" ::: "memory"); __builtin_amdgcn_wave_barrier();
#pragma unroll
        for (int tt = 0; tt < 2; ++tt) {
            f32x4 acc = {0.f, 0.f, 0.f, 0.f};
#pragma unroll
            for (int ks = 0; ks < 4; ++ks) { const bf16x8 a = *(const bf16x8*)(Xs + (16 * tt + l15) * 136 + 32 * ks + 8 * kg);
                acc = __builtin_amdgcn_mfma_f32_16x16x32_bf16(a, cmf[ks], acc, 0, 0, 0); }
#pragma unroll
            for (int i = 0; i < 4; ++i) { const size_t row = rb + scan_row(dir, c * 32 + 16 * tt + 4 * kg + i); Yd[row * 512 + g * 16 + l15] = (bf16_t)(pk2(acc[i], 0.f) & 0xffff); }
        }
        asm volatile("s_waitcnt lgkmcnt(0)" ::: "memory"); __builtin_amdgcn_wave_barrier();
    }
}
__device__ __forceinline__ void rwkv_prep_rows(const Params& p, int jo) {
    unsigned char* const ws = ows(p.ws);
    const int tid_ = otid(); const int lane = tid_ & 63, w = tid_ >> 6;
    const bf16_t* P = (const bf16_t*)(ws + OFF_AR + AO_P);
    bf16_t* PR = (bf16_t*)(ws + OFF_AR + AO_PR); bf16_t* Lb = (bf16_t*)(ws + OFF_AR + AO_L);
    bf16_t* YGu = (bf16_t*)(ws + OFF_AR + AO_YG);
    float* KN = (float*)(ws + OFF_KN);
    const int nwv = gridDim.x * 8, rpw = (TT + nwv - 1) / nwv, row_lo = (blockIdx.x * 8 + w) * rpw, row_hi = (row_lo + rpw < TT) ? row_lo + rpw : TT;
    if (row_lo >= row_hi) return;
    const bool l3 = lane < 48;
    f32x4 mu4[4][2];
#pragma unroll
    for (int it = 0; it < 4; ++it) { const int c0 = (lane + 64 * it) * 8;
        if (it < 3 || l3) { mu4[it][0] = *(const f32x4*)(p.in[27] + jo * 1920 + c0); mu4[it][1] = *(const f32x4*)(p.in[27] + jo * 1920 + c0 + 4); }
        else { mu4[it][0] = f32x4{0.f, 0.f, 0.f, 0.f}; mu4[it][1] = mu4[it][0]; } }
    const f32x4 kk0 = *(const f32x4*)(p.in[33] + jo * 512 + lane * 8), kk1 = *(const f32x4*)(p.in[33] + jo * 512 + lane * 8 + 4);
    u32x4 pa[4], px[4], pn[4];
    { const int rp = row_lo > 0 ? row_lo - 1 : 0;
#pragma unroll
      for (int it = 0; it < 4; ++it) { const int c0 = (lane + 64 * it) * 8;
        if (it < 3 || l3) { pa[it] = *(const u32x4*)(P + (size_t)rp * 2560 + 512 + c0); px[it] = *(const u32x4*)(P + (size_t)row_lo * 2560 + 512 + c0); }
        else { pa[it] = u32x4{0u, 0u, 0u, 0u}; px[it] = pa[it]; } } }
    for (int row = row_lo; row < row_hi; ++row) {
        const int s = row % SB;
        const float hp = (s != 0 && s != 256) ? 0.5f : 0.f, hn = (s != 255 && s != 2303) ? 0.5f : 0.f;
        const int rn = row + 1 < TT ? row + 1 : TT - 1;
#pragma unroll
        for (int it = 0; it < 4; ++it) { const int c0 = (lane + 64 * it) * 8;
            if (it < 3 || l3) pn[it] = *(const u32x4*)(P + (size_t)rn * 2560 + 512 + c0); else pn[it] = u32x4{0u, 0u, 0u, 0u}; }
        *(u32x4*)(YGu + (size_t)row * 512 + lane * 8) = *(const u32x4*)(P + (size_t)row * 2560 + lane * 8);
#pragma unroll
        for (int it = 0; it < 4; ++it) {
            const int c0 = (lane + 64 * it) * 8;
            float x[8], a[8], bq[8], o[8];
            unpk8(px[it], x); unpk8(pa[it], a); unpk8(pn[it], bq);
#pragma unroll
            for (int i = 0; i < 8; ++i) { const float m = (i < 4) ? mu4[it][0][i & 3] : mu4[it][1][i & 3];
                o[i] = x[i] + m * (hp * a[i] + hn * bq[i] - x[i]); }
            if (it == 3) {
                if (lane < 16) {
#pragma unroll
                    for (int i = 0; i < 8; ++i) o[i] = tanh_f(o[i]); }
                else if (lane >= 32) {
#pragma unroll
                    for (int i = 0; i < 8; ++i) o[i] = sigm(o[i]); } }
            if (it == 1) { float ssq = 0.f;
#pragma unroll
                for (int i = 0; i < 8; ++i) { const float t_ = o[i] * ((i < 4) ? kk0[i & 3] : kk1[i & 3]); ssq += t_ * t_; }
                ssq = sum8(ssq);
                if ((lane & 7) == 0) KN[(size_t)row * 8 + (lane >> 3)] = 1.0f / fmaxf(sqrtf(ssq), 1e-12f); }
            if (it < 3) *(u32x4*)(PR + (size_t)row * 1536 + c0) = pk8(o);
            else if (l3) *(u32x4*)(Lb + (size_t)row * 384 + (c0 - 1536)) = pk8(o);
        }
#pragma unroll
        for (int it = 0; it < 4; ++it) { pa[it] = px[it]; px[it] = pn[it]; }
    }
}
__device__ __forceinline__ void rwkv_stage_loop(const Params& p, int jo, int first, int stride, int nitems, unsigned char* sm) {
    unsigned char* const ws = ows(p.ws);
    const int tid = otid();
    if (first >= nitems) return;
    const bf16_t* PR = (const bf16_t*)(ws + OFF_AR + AO_PR); const bf16_t* LO = (const bf16_t*)(ws + OFF_AR + AO_P);
    const float* KN = (const float*)(ws + OFF_KN);
    float* L_lw = (float*)sm; float* L_av = L_lw + 64 * 68; float* L_bv = L_av + 64 * 68; float* L_kd = L_bv + 64 * 68; float* L_rr = L_kd + 64 * 68;
    const int t64 = tid >> 3, c8 = (tid & 7) * 8;
    u32x4 gr, gk, gw, ga; float inn;
#define RS_LOAD(IT_) do { const int u_ = (IT_) / 36, R_ = (IT_) - u_ * 36, dir_ = u_ & 1, hd_ = (u_ >> 1) & 7, b_ = u_ >> 4; \
        const size_t row = (size_t)b_ * SB + scan_row(dir_, 64 * R_ + t64); const int ch_ = hd_ * 64 + c8; \
        gr = *(const u32x4*)(PR + row * 1536 + ch_); gk = *(const u32x4*)(PR + row * 1536 + 512 + ch_); \
        gw = *(const u32x4*)(LO + row * 2560 + dir_ * 512 + ch_); ga = *(const u32x4*)(LO + row * 2560 + 1024 + dir_ * 512 + ch_); inn = KN[row * 8 + hd_]; } while (0)
    f32x4 w0r[2], a0r[2], kkr[2], kar[2]; int cur_u = -1;
#pragma unroll
    for (int i = 0; i < 2; ++i) { w0r[i] = (f32x4){0.f, 0.f, 0.f, 0.f}; a0r[i] = w0r[i]; kkr[i] = w0r[i]; kar[i] = w0r[i]; }
    RS_LOAD(first);
    for (int item = first; item < nitems; item += stride) {
    const int u = item / 36, R = item - u * 36;
    const int dir = u & 1, hd = (u >> 1) & 7;
    {
        const int ch = hd * 64 + c8;
        float r8[8], k8[8], wl8[8], al8[8];
        unpk8(gr, r8); unpk8(gk, k8); unpk8(gw, wl8); unpk8(ga, al8);
        if (u != cur_u) { cur_u = u;
            const float* w0p = p.in[28] + (jo * 2 + dir) * 512 + ch; const float* a0p = p.in[30] + (jo * 2 + dir) * 512 + ch;
            const float* kkp = p.in[33] + jo * 512 + ch; const float* kap = p.in[34] + jo * 512 + ch;
#pragma unroll
            for (int i = 0; i < 2; ++i) { w0r[i] = *(const f32x4*)(w0p + 4 * i); a0r[i] = *(const f32x4*)(a0p + 4 * i); kkr[i] = *(const f32x4*)(kkp + 4 * i); kar[i] = *(const f32x4*)(kap + 4 * i); } }
        float lw[8], av[8], bv[8], kd[8];
#pragma unroll
        for (int i = 0; i < 8; ++i) {
            const float w0v = w0r[i >> 2][i & 3], a0v = a0r[i >> 2][i & 3], kkv = kkr[i >> 2][i & 3], kav = kar[i >> 2][i & 3];
            const float z = -(w0v + wl8[i]);
            const float sp = fmaxf(z, 0.f) + 0.6931471805599453f * __builtin_amdgcn_logf(1.0f + __builtin_amdgcn_exp2f(-1.4426950408889634f * fabsf(z)));
            lw[i] = -__builtin_amdgcn_exp2f(-1.4426950408889634f * (sp + 0.5f)) * 1.4426950408889634f;
            const float a = sigm(a0v + al8[i]);
            const float kn = k8[i] * kkv * inn;
            kd[i] = k8[i] * (1.0f + (a - 1.0f) * kav); av[i] = -kn; bv[i] = kn * a;
        }
        const int o = t64 * 68 + c8;
        *(f32x4*)(L_lw + o) = (f32x4){lw[0], lw[1], lw[2], lw[3]}; *(f32x4*)(L_lw + o + 4) = (f32x4){lw[4], lw[5], lw[6], lw[7]};
        *(f32x4*)(L_av + o) = (f32x4){av[0], av[1], av[2], av[3]}; *(f32x4*)(L_av + o + 4) = (f32x4){av[4], av[5], av[6], av[7]};
        *(f32x4*)(L_bv + o) = (f32x4){bv[0], bv[1], bv[2], bv[3]}; *(f32x4*)(L_bv + o + 4) = (f32x4){bv[4], bv[5], bv[6], bv[7]};
        *(f32x4*)(L_kd + o) = (f32x4){kd[0], kd[1], kd[2], kd[3]}; *(f32x4*)(L_kd + o + 4) = (f32x4){kd[4], kd[5], kd[6], kd[7]};
        *(f32x4*)(L_rr + o) = (f32x4){r8[0], r8[1], r8[2], r8[3]}; *(f32x4*)(L_rr + o + 4) = (f32x4){r8[4], r8[5], r8[6], r8[7]};
    }
    LDS_BARRIER();
    if (item + stride < nitems) { RS_LOAD(item + stride); }
    {
        const int sq = tid >> 7, tl = tid & 127, sj = tl >> 1, th = tl & 1;
        float cw[8], lwk[8]; float run = 0.f;
#pragma unroll
        for (int k = 0; k < 8; ++k) { lwk[k] = L_lw[(sq * 16 + 8 * th + k) * 68 + sj]; run += lwk[k]; cw[k] = run; }
        const float ptot = dppf<0xB1>(run);
        const float off = th ? ptot : 0.f, cw15 = run + ptot;
        u32x2* GE = (u32x2*)(ws + OFF_GE) + ((size_t)(u * 144 + 4 * R + sq) * 64 + sj) * 16 + 8 * th;
#pragma unroll
        for (int k = 0; k < 8; ++k) {
            const int o = (sq * 16 + 8 * th + k) * 68 + sj;
            const float c = off + cw[k];
            const float Ec = __builtin_amdgcn_exp2f(c), Ep = __builtin_amdgcn_exp2f(c - lwk[k]), iE = __builtin_amdgcn_rcpf(Ec);
            u32x2 ov; ov.x = pk2(L_av[o] * Ep, L_rr[o] * Ec); ov.y = pk2(L_bv[o] * iE, L_kd[o] * iE);
            GE[k] = ov;
        }
        ((float*)(ws + OFF_GW))[(size_t)(u * 144 + 4 * R + sq) * 64 + sj] = __builtin_amdgcn_exp2f(cw15);
    }
    LDS_BARRIER();
    }
#undef RS_LOAD
}
__device__ __forceinline__ bf16x8 frag_lo(const f32x4 v) { u32x4 w; w.x = pk2(v[0], v[1]); w.y = pk2(v[2], v[3]); w.z = 0u; w.w = 0u; return __builtin_bit_cast(bf16x8, w); }
__device__ __forceinline__ bf16x8 frag_b64(const bf16_t* pz) { const u32x2 v = *(const u32x2*)pz; u32x4 w; w.x = v.x; w.y = v.y; w.z = 0u; w.w = 0u; return __builtin_bit_cast(bf16x8, w); }
__device__ __forceinline__ u32x2 pk4v(const f32x4 v) { u32x2 r; r.x = pk2(v[0], v[1]); r.y = pk2(v[2], v[3]); return r; }
#define MF16(a, b, c) __builtin_amdgcn_mfma_f32_16x16x32_bf16((a), (b), (c), 0, 0, 0)
constexpr int RW_SCR = 19712, RW_SLOT = 5120, RW_SLOT0 = 4 * RW_SCR;
__device__ __forceinline__ void rwkv_chunk_unit(const Params& p, int jo, int u, unsigned char* sm) {
    unsigned char* const ws = ows(p.ws);
    const int tid = otid(), lane = tid & 63, w = tid >> 6, l15 = lane & 15, kg = lane >> 4;
    const int dir = u & 1, hd = (u >> 1) & 7, b = u >> 4;
    const bf16_t* PR = (const bf16_t*)(ws + OFF_AR + AO_PR); const bf16_t* LO = (const bf16_t*)(ws + OFF_AR + AO_P);
    const float* KN = (const float*)(ws + OFF_KN);
    bf16_t* O = (bf16_t*)(ws + OFF_AR + (dir ? AO_OB : AO_OF));
    const size_t rb = (size_t)b * SB;
    const int sq = tid >> 7, tl = tid & 127, sj = tl >> 1, th = tl & 1, ch = hd * 64 + sj;
    const u32x4* GEb = (const u32x4*)(ws + OFF_GE); const float* GWb = (const float*)(ws + OFF_GW);
    f32x4 S[4];
#pragma unroll
    for (int i = 0; i < 4; ++i) S[i] = (f32x4){0.f, 0.f, 0.f, 0.f};
    u32x4 ge[4], ge2[4]; float e15, e152; unsigned vv[8], vv2[8];
#define RW_LOADX(R_, ge_, e_, vv_) do { const size_t cidx = (size_t)(u * 144 + 4 * (R_) + sq) * 64 + sj; const u32x4* gp = GEb + cidx * 8 + 4 * th; \
        ge_[0] = gp[0]; ge_[1] = gp[1]; ge_[2] = gp[2]; ge_[3] = gp[3]; e_ = GWb[cidx]; \
        _Pragma("unroll") for (int k = 0; k < 8; ++k) { const size_t row = rb + scan_row(dir, (4 * (R_) + sq) * 16 + 8 * th + k); vv_[k] = *(const unsigned*)(PR + row * 1536 + 1024 + (ch & ~1)); } } while (0)
#define RW_LOAD(R_) RW_LOADX(R_, ge2, e152, vv2)
    RW_LOADX(0, ge, e15, vv); RW_LOADX(1, ge2, e152, vv2);
    for (int R = 0; R < 36; ++R) {
        for (int rep1 = 0; rep1 < 1 + DUPB(20); ++rep1) {
            unsigned char* sc = sm + sq * RW_SCR;
            bf16_t* At_ = (bf16_t*)sc; bf16_t* Rt_ = At_ + 16 * 72; bf16_t* Bt_ = Rt_ + 16 * 72; bf16_t* Kt_ = Bt_ + 16 * 72;
            bf16_t* AtT = Kt_ + 16 * 72; bf16_t* BhT = AtT + 64 * 16; bf16_t* KhT = BhT + 64 * 16; bf16_t* Vt_ = KhT + 64 * 16;
            float* WC = (float*)(sc + 18432);
            unsigned at2[4], bh2[4], kh2[4];
#pragma unroll
            for (int k2 = 0; k2 < 4; ++k2) {
                const unsigned x0 = ge[k2].x, y0 = ge[k2].y, x1 = ge[k2].z, y1 = ge[k2].w;
                const int t0 = 8 * th + 2 * k2;
                At_[t0 * 72 + sj] = (bf16_t)(x0 & 0xffff); Rt_[t0 * 72 + sj] = (bf16_t)(x0 >> 16); Bt_[t0 * 72 + sj] = (bf16_t)(y0 & 0xffff); Kt_[t0 * 72 + sj] = (bf16_t)(y0 >> 16);
                At_[(t0 + 1) * 72 + sj] = (bf16_t)(x1 & 0xffff); Rt_[(t0 + 1) * 72 + sj] = (bf16_t)(x1 >> 16); Bt_[(t0 + 1) * 72 + sj] = (bf16_t)(y1 & 0xffff); Kt_[(t0 + 1) * 72 + sj] = (bf16_t)(y1 >> 16);
                at2[k2] = (x0 & 0xffffu) | (x1 << 16);
                bh2[k2] = pk2(bf2f(y0 & 0xffff) * e15, bf2f(y1 & 0xffff) * e15);
                kh2[k2] = pk2(bf2f(y0 >> 16) * e15, bf2f(y1 >> 16) * e15);
            }
            *(u32x4*)(AtT + sj * 16 + 8 * th) = (u32x4){at2[0], at2[1], at2[2], at2[3]};
            *(u32x4*)(BhT + sj * 16 + 8 * th) = (u32x4){bh2[0], bh2[1], bh2[2], bh2[3]};
            *(u32x4*)(KhT + sj * 16 + 8 * th) = (u32x4){kh2[0], kh2[1], kh2[2], kh2[3]};
            { const int vs = (ch & 1) * 16; u32x4 v4; v4.x = ((vv[0] >> vs) & 0xffffu) | ((vv[1] >> vs) << 16); v4.y = ((vv[2] >> vs) & 0xffffu) | ((vv[3] >> vs) << 16); v4.z = ((vv[4] >> vs) & 0xffffu) | ((vv[5] >> vs) << 16); v4.w = ((vv[6] >> vs) & 0xffffu) | ((vv[7] >> vs) << 16);
              *(u32x4*)(Vt_ + sj * 16 + 8 * th) = v4; }
            if (th == 0) WC[sj] = e15;
        }
#pragma unroll
        for (int k = 0; k < 4; ++k) ge[k] = ge2[k];
#pragma unroll
        for (int k = 0; k < 8; ++k) vv[k] = vv2[k];
        e15 = e152;
        if (R + 2 < 36) { RW_LOAD(R + 2); }
        LDS_BARRIER();
        for (int rep2 = 0; rep2 < 1 + DUPB(21); ++rep2) if (w < 4) {
            unsigned char* sc = sm + w * RW_SCR;
            const bf16_t* At_ = (const bf16_t*)sc; const bf16_t* Rt_ = At_ + 16 * 72; const bf16_t* Bt_ = Rt_ + 16 * 72; const bf16_t* Kt_ = Bt_ + 16 * 72;
            const bf16_t* AtT = Kt_ + 16 * 72; const bf16_t* Vt_ = AtT + 3 * 64 * 16;
            float* Lm = (float*)(sc + 17408);
            unsigned char* sl = sm + RW_SLOT0 + w * RW_SLOT;
            u32x2* ATs = (u32x2*)sl; u32x2* GTs = (u32x2*)(sl + 2048); u32x4* MfS = (u32x4*)(sl + 4096);
            const f32x4 z4 = {0.f, 0.f, 0.f, 0.f};
            f32x4 Lab = z4, LakT = z4, Mbr = z4, Mkr = z4;
#pragma unroll
            for (int ks = 0; ks < 2; ++ks) {
                const bf16x8 af = *(const bf16x8*)(At_ + l15 * 72 + 32 * ks + 8 * kg), rf = *(const bf16x8*)(Rt_ + l15 * 72 + 32 * ks + 8 * kg);
                const bf16x8 bf = *(const bf16x8*)(Bt_ + l15 * 72 + 32 * ks + 8 * kg), kf = *(const bf16x8*)(Kt_ + l15 * 72 + 32 * ks + 8 * kg);
                Lab = MF16(bf, af, Lab); LakT = MF16(af, kf, LakT); Mbr = MF16(bf, rf, Mbr); Mkr = MF16(kf, rf, Mkr);
            }
#pragma unroll
            for (int i = 0; i < 4; ++i) { const int rrow = 4 * kg + i;
                Lab[i] = (rrow < l15) ? Lab[i] : 0.f;
                LakT[i] = (l15 < rrow) ? LakT[i] : 0.f;
                Mbr[i] = (rrow <= l15) ? Mbr[i] : 0.f; Mkr[i] = (rrow <= l15) ? Mkr[i] : 0.f;
                Lm[rrow * 16 + l15] = Lab[i]; }
            { u32x4 mw; mw.x = pk2(Mbr[0], Mbr[1]); mw.y = pk2(Mbr[2], Mbr[3]); mw.z = pk2(Mkr[0], Mkr[1]); mw.w = pk2(Mkr[2], Mkr[3]); MfS[lane] = mw; }
            asm volatile("s_waitcnt lgkmcnt(0)" ::: "memory"); __builtin_amdgcn_wave_barrier();
            float T[16];
#pragma unroll
            for (int r = 15; r >= 0; --r) {
                float acc = (r == l15) ? 1.0f : 0.0f;
                const f32x4 L0 = *(const f32x4*)(Lm + r * 16), L1 = *(const f32x4*)(Lm + r * 16 + 4), L2 = *(const f32x4*)(Lm + r * 16 + 8), L3 = *(const f32x4*)(Lm + r * 16 + 12);
#pragma unroll
                for (int m = r + 1; m < 16; ++m) { const float lv = (m < 4) ? L0[m & 3] : (m < 8) ? L1[m & 3] : (m < 12) ? L2[m & 3] : L3[m & 3]; acc += lv * T[m]; }
                T[r] = acc;
            }
            f32x4 Tsel;
#pragma unroll
            for (int i = 0; i < 4; ++i) Tsel[i] = (kg == 0) ? T[i] : (kg == 1) ? T[4 + i] : (kg == 2) ? T[8 + i] : T[12 + i];
            const bf16x8 Tf = frag_lo(Tsel);
            const f32x4 LT = MF16(frag_lo(LakT), Tf, z4);
            const bf16x8 LTf = frag_lo(LT);
#pragma unroll
            for (int t1 = 0; t1 < 4; ++t1) {
                const f32x4 at = MF16(frag_b64(AtT + (16 * t1 + l15) * 16 + 4 * kg), Tf, z4);
                ATs[t1 * 64 + lane] = pk4v(at);
                const f32x4 gt = MF16(LTf, frag_b64(Vt_ + (16 * t1 + l15) * 16 + 4 * kg), z4);
                GTs[t1 * 64 + lane] = pk4v(gt);
            }
        }
        LDS_BARRIER();
        if (w < 4) {
#pragma unroll
            for (int q = 0; q < 4; ++q) {
                const unsigned char* sc = sm + q * RW_SCR;
                const bf16_t* Rt_ = (const bf16_t*)sc + 16 * 72; const bf16_t* BhT = (const bf16_t*)sc + 4 * 16 * 72 + 64 * 16; const bf16_t* KhT = BhT + 64 * 16; const bf16_t* Vt_ = KhT + 64 * 16;
                const float* WC = (const float*)(sc + 18432);
                const unsigned char* sl = sm + RW_SLOT0 + q * RW_SLOT;
                const u32x2* ATs = (const u32x2*)sl; const u32x2* GTs = (const u32x2*)(sl + 2048); const u32x4* MfS = (const u32x4*)(sl + 4096);
                bf16x8 Sf[2];
#pragma unroll
                for (int pi = 0; pi < 2; ++pi) { u32x4 sw; sw.x = pk2(S[2 * pi][0], S[2 * pi][1]); sw.y = pk2(S[2 * pi][2], S[2 * pi][3]); sw.z = pk2(S[2 * pi + 1][0], S[2 * pi + 1][1]); sw.w = pk2(S[2 * pi + 1][2], S[2 * pi + 1][3]);
                    Sf[pi] = __builtin_bit_cast(bf16x8, sw); }
                f32x4 ut = unpk4v(GTs[w * 64 + lane]);
#pragma unroll
                for (int pi = 0; pi < 2; ++pi) { const u32x2 a0 = ATs[(2 * pi) * 64 + lane], a1 = ATs[(2 * pi + 1) * 64 + lane]; u32x4 aw; aw.x = a0.x; aw.y = a0.y; aw.z = a1.x; aw.w = a1.y;
                    ut = MF16(__builtin_bit_cast(bf16x8, aw), Sf[pi], ut); }
                const u32x2 v2 = *(const u32x2*)(Vt_ + (16 * w + l15) * 16 + 4 * kg);
                u32x4 uvw; uvw.x = pk2(ut[0], ut[1]); uvw.y = pk2(ut[2], ut[3]); uvw.z = v2.x; uvw.w = v2.y;
                const bf16x8 UVf = __builtin_bit_cast(bf16x8, uvw);
                f32x4 oa = MF16(__builtin_bit_cast(bf16x8, MfS[lane]), UVf, ((f32x4){0.f, 0.f, 0.f, 0.f}));
#pragma unroll
                for (int pi = 0; pi < 2; ++pi) { const u32x2 r0 = *(const u32x2*)(Rt_ + l15 * 72 + 32 * pi + 4 * kg), r1 = *(const u32x2*)(Rt_ + l15 * 72 + 32 * pi + 16 + 4 * kg);
                    u32x4 rw; rw.x = r0.x; rw.y = r0.y; rw.z = r1.x; rw.w = r1.y;
                    oa = MF16(__builtin_bit_cast(bf16x8, rw), Sf[pi], oa); }
#pragma unroll
                for (int i = 0; i < 4; ++i) { const size_t row = rb + scan_row(dir, (4 * R + q) * 16 + 4 * kg + i); O[row * 512 + hd * 64 + 16 * w + l15] = (bf16_t)(pk2(oa[i], 0.f) & 0xffff); }
#pragma unroll
                for (int t2 = 0; t2 < 4; ++t2) {
                    const u32x2 b2 = *(const u32x2*)(BhT + (16 * t2 + l15) * 16 + 4 * kg), k2 = *(const u32x2*)(KhT + (16 * t2 + l15) * 16 + 4 * kg);
                    u32x4 bw; bw.x = b2.x; bw.y = b2.y; bw.z = k2.x; bw.w = k2.y;
                    const f32x4 dv = *(const f32x4*)(WC + 16 * t2 + 4 * kg);
                    S[t2] = MF16(__builtin_bit_cast(bf16x8, bw), UVf, S[t2] * dv);
                }
            }
        }
        LDS_BARRIER();
    }
#undef RW_LOAD
#undef RW_LOADX
}
__device__ __forceinline__ void odd_finish_rows(const Params& p, int jo, bool skip_ctx) {
    unsigned char* const ws = ows(p.ws);
    const int tid_ = otid(); const int lane = tid_ & 63, w = tid_ >> 6;
    const bf16_t* YF = (const bf16_t*)(ws + OFF_S5F); const bf16_t* YB = (const bf16_t*)(ws + OFF_S5B);
    bf16_t* YG = (bf16_t*)(ws + OFF_AR + AO_YG);
    const bf16_t* OF = (const bf16_t*)(ws + OFF_AR + AO_OF); const bf16_t* OB = (const bf16_t*)(ws + OFF_AR + AO_OB);
    const bf16_t* PR = (const bf16_t*)(ws + OFF_AR + AO_PR); const bf16_t* LO = (const bf16_t*)(ws + OFF_AR + AO_P);
    bf16_t* Y = (bf16_t*)(ws + OFF_AR + AO_Y);
    const int c0 = lane * 8;
    const int nwv = gridDim.x * 8, rpw = (TT + nwv - 1) / nwv, row_lo = (blockIdx.x * 8 + w) * rpw, row_hi = (row_lo + rpw < TT) ? row_lo + rpw : TT;
    const f32x4 ds0 = *(const f32x4*)(p.in[25] + jo * 512 + c0), ds1 = *(const f32x4*)(p.in[25] + jo * 512 + c0 + 4);
    const f32x4 rk0 = *(const f32x4*)(p.in[35] + jo * 512 + c0), rk1 = *(const f32x4*)(p.in[35] + jo * 512 + c0 + 4);
    const f32x4 lg0 = *(const f32x4*)(p.in[36] + jo * 512 + c0), lg1 = *(const f32x4*)(p.in[36] + jo * 512 + c0 + 4);
    const f32x4 lb0 = *(const f32x4*)(p.in[37] + jo * 512 + c0), lb1 = *(const f32x4*)(p.in[37] + jo * 512 + c0 + 4);
    for (int row = row_lo; row < row_hi; ++row) {
        if (skip_ctx && (row % SB) < 256) continue;
        {
            float fa[8], fb[8], uu[8], o[8];
            unpk8(*(const u32x4*)(YF + (size_t)row * 512 + c0), fa); unpk8(*(const u32x4*)(YB + (size_t)row * 512 + c0), fb);
            unpk8(*(const u32x4*)(YG + (size_t)row * 512 + c0), uu);
#pragma unroll
            for (int i = 0; i < 4; ++i) { o[i] = fa[i] + fb[i] + ds0[i] * uu[i]; o[4 + i] = fa[4 + i] + fb[4 + i] + ds1[i] * uu[4 + i]; }
#pragma unroll
            for (int i = 0; i < 8; ++i) { const float x = o[i]; o[i] = 0.5f * x * (1.0f + tanh_f(0.7978845608028654f * (x + 0.044715f * x * x * x))); }
            *(u32x4*)(YG + (size_t)row * 512 + c0) = pk8(o);
        }
        {
            float o[8], r[8], k[8], v[8], g[8];
            { float fa[8], fb[8]; unpk8(*(const u32x4*)(OF + (size_t)row * 512 + c0), fa); unpk8(*(const u32x4*)(OB + (size_t)row * 512 + c0), fb);
#pragma unroll
              for (int i = 0; i < 8; ++i) o[i] = fa[i] + fb[i]; }
            unpk8(*(const u32x4*)(PR + (size_t)row * 1536 + c0), r); unpk8(*(const u32x4*)(PR + (size_t)row * 1536 + 512 + c0), k); unpk8(*(const u32x4*)(PR + (size_t)row * 1536 + 1024 + c0), v);
            unpk8(*(const u32x4*)(LO + (size_t)row * 2560 + 2048 + c0), g);
            float sm_ = 0.f, bo = 0.f;
#pragma unroll
            for (int i = 0; i < 8; ++i) { sm_ += o[i]; bo += r[i] * k[i] * ((i < 4) ? rk0[i & 3] : rk1[i & 3]); }
            const float mean = sum8(sm_) * (1.0f / 64.0f); bo = sum8(bo);
            float sq = 0.f;
#pragma unroll
            for (int i = 0; i < 8; ++i) { const float d = o[i] - mean; sq += d * d; }
            const float rstd = rsqrtf(sum8(sq) * (1.0f / 64.0f) + 64e-5f);
            float y[8];
#pragma unroll
            for (int i = 0; i < 8; ++i) y[i] = ((o[i] - mean) * rstd * ((i < 4) ? lg0[i & 3] : lg1[i & 3]) + ((i < 4) ? lb0[i & 3] : lb1[i & 3]) + bo * v[i]) * g[i];
            *(u32x4*)(Y + (size_t)row * 1024 + 512 + c0) = pk8(y);
        }
    }
}

#define PHB unsigned char* const ws = ows(p.ws); bf16_t* const H = (bf16_t*)(ws + OFF_H); _Float16* const X = (_Float16*)(ws + OFF_X); const float* const mod = (const float*)(ws + OFF_MOD); bf16_t* const PbE = (bf16_t*)(ws + OFF_AR + AE_P); bf16_t* const YbE = (bf16_t*)(ws + OFF_AR + AE_Y); bf16_t* const PbO = (bf16_t*)(ws + OFF_AR + AO_P); bf16_t* const YbO = (bf16_t*)(ws + OFF_AR + AO_Y); const unsigned* const cnt0 = (const unsigned*)(ws + OFF_CNT); (void)H; (void)X; (void)mod; (void)PbE; (void)YbE; (void)PbO; (void)YbO; (void)cnt0;
#define LAYER_PAIR_BODY(lp) {  \
         \
        { \
            const int layer = 2 * lp, j = lp; \
            if (RUN) { PHB    \
                pg8::Gemm g{H, (const bf16_t*)(ws + OFF_WINE + j * SZ_WINE), 1024, 0}; pg8::StaticOrder S; S.init(TT, 3328, G, cb, 1024); \
                { LAS float* lbl = (LAS float*)(lds + LDS_MAIN + 64); lbl[threadIdx.x] = ((const float*)(ws + OFF_LB))[j * 512 + threadIdx.x]; __syncthreads(); } \
                pg8::EpiEvenIn E{PbE, (const LAS float*)(lds + LDS_MAIN + 64)}; REP(8) pg8::gemm_phase(lds, g, S, E); SYNC; } ++ph; \
            if (RUN) { PHB    \
                if (cb < 128) { hgrn_chunk_unit(p, j, cb, smem); __syncthreads(); } \
                else { for (int it = cb - 128; it < 576; it += G - 128) attn_unit(p, j, it, smem); } \
                if (DUPB(1)) { __syncthreads(); if (cb < 128) { hgrn_chunk_unit(p, j, cb, smem); __syncthreads(); } } \
                if (DUPB(2)) { __syncthreads(); if (cb >= 128) { for (int it = cb - 128; it < 576; it += G - 128) attn_unit(p, j, it, smem); } } SYNC; } ++ph; \
            if (RUN) { PHB    \
                const int nextra = (layer == 2) ? p.ntc : 0; \
                hgrn_finish_rows(p, j); \
                if (DUPB(13)) { hgrn_finish_rows(p, j); } \
                if (nextra > 0) { __syncthreads(); tr_loop(p, cb, G, nextra, p.njm, p.nj1, smem); } \
                SYNC; } ++ph; \
            if (RUN) { PHB    \
                pg8::Gemm g{YbE, (const bf16_t*)(ws + OFF_WOUTE + j * SZ_WSQ), 1024, 0}; pg8::CtxSplitOrder S; S.init(G, cb, 1024, SPLIT_S); \
                pg8::EpiResid E{(bf16_t*)(ws + OFF_AR + AE_P), mod + (size_t)layer * 9 * 6144 + 2048, (bf16_t*)(ws + OFF_AR + AE_P) + (size_t)TT * 1024}; if (DUPB(18)) pg8::gemm_phase(lds, g, S, E); pg8::gemm_phase(lds, g, S, E); SYNC; } ++ph; \
            if (RUN) { PHB if (DUPB(17)) phase_ln<0, false, true>(p, layer, OFF_AR + AE_P, SPLIT_S, smem); phase_ln<0, false>(p, layer, OFF_AR + AE_P, SPLIT_S, smem); SYNC; } ++ph; \
            if (RUN) { PHB    \
                pg8::Gemm g{H, (const bf16_t*)(ws + OFF_WFFN1 + j * SZ_WFFN1), 1024, 0}; pg8::StaticOrder S; S.init(TT, 5632, G, cb, 1024); \
                pg8::EpiSwiGLU E{PbE, 2816}; REP(5) pg8::gemm_phase(lds, g, S, E); SYNC; } ++ph; \
            if (RUN) { PHB    \
                pg8::Gemm g{PbE, (const bf16_t*)(ws + OFF_WFFN2 + j * SZ_WFFN2), 2816, 0}; pg8::CtxSplitOrder S; S.init(G, cb, 2816, SPLIT_S); \
                pg8::EpiResid E{(bf16_t*)(ws + OFF_AR + AE_OF), mod + (size_t)layer * 9 * 6144 + 5120, (bf16_t*)(ws + OFF_AR + AE_OF) + (size_t)TT * 1024}; if (DUPB(18)) pg8::gemm_phase(lds, g, S, E); pg8::gemm_phase(lds, g, S, E); SYNC; } ++ph; \
            if (RUN) { PHB if (DUPB(17)) phase_ln<1, false, true>(p, layer, OFF_AR + AE_OF, SPLIT_S, smem); phase_ln<1, false>(p, layer, OFF_AR + AE_OF, SPLIT_S, smem); SYNC; } ++ph; \
        } \
         \
        { \
            const int layer = 2 * lp + 1, jo = lp; \
            if (RUN) { PHB    \
                pg8::Gemm g{H, (const bf16_t*)(ws + OFF_WINO + jo * SZ_WINO), 1024, 0}; pg8::StaticOrder S; S.init(TT, 2560, G, cb, 1024); \
                pg8::EpiBf16 E{PbO, 2560, nullptr}; if (DUPB(19)) pg8::gemm_phase(lds, g, S, E); pg8::gemm_phase(lds, g, S, E); SYNC; } ++ph; \
            if (RUN) { PHB    \
                rwkv_prep_rows(p, jo); \
                if (DUPB(14)) { rwkv_prep_rows(p, jo); } \
                SYNC; } ++ph; \
            if (RUN) { PHB    \
                pg8::Gemm g{(const bf16_t*)(ws + OFF_AR + AO_L), (const bf16_t*)(ws + OFF_WLORA + jo * SZ_WLORA), 384, 0}; pg8::LoraOrder S; S.init(TT, 2560, G, cb, 384); \
                pg8::EpiBf16 E{PbO, 2560, nullptr}; if (DUPB(19)) pg8::gemm_phase(lds, g, S, E); pg8::gemm_phase(lds, g, S, E); \
                SYNC; } ++ph; \
            if (RUN) { PHB   \
                { const int per = (4608 + G - 1) / G, i0 = cb * per, i1 = (i0 + per < 4608) ? i0 + per : 4608; rwkv_stage_loop(p, jo, i0, 1, i1, smem); } \
                SYNC; } ++ph; \
            if (RUN) { PHB    \
                if (cb < 128) { rwkv_chunk_unit(p, jo, cb, smem); if (DUPB(4)) { __syncthreads(); rwkv_chunk_unit(p, jo, cb, smem); } } \
                else { if (wv < 4) { s5_scan_task(p, jo, (cb - 128) * 4 + wv, smem + wv * 20480); } \
                       if (layer == 1 && p.ntm > 0) { __syncthreads(); tr_loop(p, cb - 128, G - 128, p.ntm, p.nj0, p.njm, smem); } \
                       if (layer == 3 && p.nt1 > p.ntc) { __syncthreads(); tr_loop(p, p.ntc + (cb - 128), G - 128, p.nt1, p.njm, p.nj1, smem); } } \
                SYNC; } ++ph; \
            if (RUN) { PHB odd_finish_rows(p, jo, layer == 3); SYNC; } ++ph; \
            if (RUN) { PHB    \
                pg8::Gemm g{(const bf16_t*)(ws + OFF_AR + AO_YG), (const bf16_t*)(ws + OFF_WGLU + jo * SZ_WGLU), 512, 0}; pg8::StaticOrder S; S.init(TT, 512, G, cb, 512); \
                pg8::EpiGLU E{(const bf16_t*)(ws + OFF_AR + AO_YG), YbO}; if (DUPB(19)) pg8::gemm_phase(lds, g, S, E); pg8::gemm_phase(lds, g, S, E); \
                SYNC; } ++ph; \
            if (RUN) { PHB    \
                pg8::Gemm g{YbO, (const bf16_t*)(ws + OFF_WOUTO + jo * SZ_WSQ), 1024, 0}; pg8::CtxSplitOrder S; S.init(G, cb, 1024, layer == 3 ? 0 : SPLIT_S); \
                pg8::EpiResid E{(bf16_t*)(ws + OFF_GE), mod + (size_t)layer * 9 * 6144 + 2048, (bf16_t*)(ws + OFF_GE) + (size_t)TT * 1024}; if (DUPB(18)) pg8::gemm_phase(lds, g, S, E); pg8::gemm_phase(lds, g, S, E); SYNC; } ++ph; \
            if (RUN) { PHB if (DUPB(17)) phase_ln<0, true, true>(p, layer, OFF_GE, SPLIT_S, smem); phase_ln<0, true>(p, layer, OFF_GE, SPLIT_S, smem); SYNC; } ++ph; \
            if (RUN) { PHB    \
                pg8::Gemm g{H, (const bf16_t*)(ws + OFF_WMOE1), 1024, SZ_WFFN1}; pg8::MoeOrder S; S.init((cnt0 + jo * 512), 22, G, cb, 1024); \
                LAS int* ridx = (LAS int*)(lds + LDS_MAIN + 64 + 2048); \
                { const unsigned* inv = (const unsigned*)(ws + OFF_INV); pg8::Unit u; \
                  for (int i = 0; i < 16 && S.next(i, u); ++i) { if (threadIdx.x < 256) { int pst = 0; _Pragma("unroll") for (int k = 0; k < 7; ++k) pst = (u.e > k) ? S.pend[k] : pst; \
                      const int r = (u.pm - pst) * 256 + (int)threadIdx.x; ridx[i * 256 + threadIdx.x] = (r < (int)(cnt0 + jo * 512)[u.e * 64]) ? (int)inv[(size_t)u.e * TT + r] : 0; } } \
                  __syncthreads(); } \
                pg8::EpiSwiGLU E{(bf16_t*)(ws + OFF_AR + AM_H), 2816}; pg8::gemm_phase<pg8::EpiSwiGLU, pg8::MoeOrder, true>(lds, g, S, E, ridx); SYNC; } ++ph; \
            if (RUN) { PHB    \
                pg8::Gemm g{(const bf16_t*)(ws + OFF_AR + AM_H), (const bf16_t*)(ws + OFF_WMOE2), 2816, SZ_WFFN2}; pg8::MoeOrder S; S.init((cnt0 + jo * 512), 4, G, cb, 2816, true); \
                pg8::EpiBf16 E{(bf16_t*)(ws + OFF_AR + AM_A), 1024, (bf16_t*)(ws + OFF_GE)}; REP(7) pg8::gemm_phase(lds, g, S, E); SYNC; } ++ph; \
            if (RUN) { PHB if (DUPB(17)) phase_ln<2, false, true>(p, layer, 0, 0, smem); phase_ln<2, false>(p, layer, 0, 0, smem); SYNC; } ++ph; \
        } \
     }
constexpr int LDS_MAIN = 131072;
constexpr int LDS_BYTES = LDS_MAIN + 64 + 2048 + 16384;
__global__ void __launch_bounds__(512, 2) mega(const Params p) {
    extern __shared__ __attribute__((aligned(16))) unsigned char smem[];
    LAS unsigned char* lds = (LAS unsigned char*)smem;
    volatile LAS unsigned* xbw = (volatile LAS unsigned*)(lds + LDS_MAIN);
    if (threadIdx.x == 0) { xbw[0] = 0u; xbw[1] = 0u; xbw[2] = 0u; xbw[3] = 0u; }
    __syncthreads();
    const bool multi = (p.hi - p.lo) > 1;
    XcdBarrier bar; bar.bar = (unsigned*)(p.ws + OFF_BAR); bar.x = 0; bar.st = xbw;
    if (multi) bar = xcd_barrier_post((unsigned*)(p.ws + OFF_BAR), xbw);
    const int G = gridDim.x, cb = blockIdx.x, wv = threadIdx.x >> 6;
    int ph = 0;
#define RUN (ph >= p.lo && ph < p.hi)
#define SYNC do { if (multi && ph + 1 < p.hi) { xcd_barrier(bar); if (DUPB(12)) xcd_barrier(bar); } else __syncthreads(); } while (0)

    if (RUN) { REP(0) { phase_prologue_a(p, smem); __syncthreads(); } SYNC; } ++ph;
    if (RUN) { phase_prologue_b(p); SYNC; } ++ph;

    LAYER_PAIR_BODY(0)
    LAYER_PAIR_BODY(1)
#undef RUN
#undef SYNC
}

static void add_job(Params& P, int& nj, int& nt, const float* src, bf16_t* dst, int K, int N, int ldd, int mode, int aux) {
    Job& j = P.jobs[nj++]; j.src = src; j.dst = dst; j.K = K; j.N = N; j.ldd = ldd; j.mode = mode; j.tile0 = nt; j.aux = aux; nt += (K / 128) * (N / 128);
}
extern "C" void kernel_launch(void* const* d_in, const int* in_sizes, int n_in, void* d_out, int out_size, void* d_ws, size_t ws_size, hipStream_t stream) {
    static int ready = 0;
    if (ready == 0) {
        if (n_in != 43 || ws_size < WS_END) { fprintf(stderr, "kernel_launch: need 43 inputs and %zu bytes of workspace, got %d / %zu\n", (size_t)WS_END, n_in, ws_size); ready = -1; return; }
        if (hipFuncSetAttribute((const void*)mega, hipFuncAttributeMaxDynamicSharedMemorySize, LDS_BYTES) != hipSuccess) { fprintf(stderr, "kernel_launch: hipFuncSetAttribute failed\n"); ready = -1; return; }
        ready = 1;
    }
    if (ready < 0) return;
    unsigned char* ws = (unsigned char*)d_ws;
    (void)hipMemsetAsync(ws, 0, ZERO_BYTES, stream);
    Params P; memset(&P, 0, sizeof(P));
    for (int i = 0; i < 43; ++i) P.in[i] = (const float*)d_in[i];
    P.out = (float*)d_out; P.ws = ws;
    int nj = 0, nt = 0;
    for (int j = 0; j < 2; ++j) {
        if (j == 1) { P.nj0 = nj; P.nt0 = nt; nt = 0; }
        add_job(P, nj, nt, P.in[8] + (size_t)j * 1024 * 3328, (bf16_t*)(ws + OFF_WINE + j * SZ_WINE), 1024, 3328, 1024, 0, 0);
        add_job(P, nj, nt, P.in[9] + (size_t)j * 1024 * 1024, (bf16_t*)(ws + OFF_WOUTE + j * SZ_WSQ), 1024, 1024, 1024, 0, 0);
        add_job(P, nj, nt, P.in[13] + (size_t)j * 1024 * 2816, (bf16_t*)(ws + OFF_WFFN1 + j * SZ_WFFN1), 1024, 2816, 1024, 1, 0);
        add_job(P, nj, nt, P.in[14] + (size_t)j * 1024 * 2816, (bf16_t*)(ws + OFF_WFFN1 + j * SZ_WFFN1), 1024, 2816, 1024, 2, 0);
        add_job(P, nj, nt, P.in[15] + (size_t)j * 2816 * 1024, (bf16_t*)(ws + OFF_WFFN2 + j * SZ_WFFN2), 2816, 1024, 2816, 0, 0);
        add_job(P, nj, nt, P.in[16] + (size_t)j * 1024 * 2432, (bf16_t*)(ws + OFF_WINO + j * SZ_WINO), 1024, 2432, 1024, 0, 0);
        add_job(P, nj, nt, nullptr, (bf16_t*)(ws + OFF_WINO + j * SZ_WINO) + (size_t)2432 * 1024, 1024, 128, 1024, 3, 0);
        add_job(P, nj, nt, P.in[17] + (size_t)j * 1024 * 1024, (bf16_t*)(ws + OFF_WOUTO + j * SZ_WSQ), 1024, 1024, 1024, 0, 0);
        add_job(P, nj, nt, nullptr, (bf16_t*)(ws + OFF_WLORA + j * SZ_WLORA), 384, 2560, 384, 4, j);
        add_job(P, nj, nt, P.in[26] + (size_t)j * 512 * 512, (bf16_t*)(ws + OFF_WGLU + j * SZ_WGLU), 512, 512, 512, 0, 0);
        if (j == 1) { P.njm = nj; P.ntm = nt; nt = 0; }
        { const int L = j;
        for (int e = 0; e < 8; ++e) {
            const size_t eo = (size_t)(L * 8 + e) * 1024 * 2816;
            add_job(P, nj, nt, P.in[40] + eo, (bf16_t*)(ws + OFF_WMOE1 + e * SZ_WFFN1), 1024, 2816, 1024, 1, 0);
            add_job(P, nj, nt, P.in[41] + eo, (bf16_t*)(ws + OFF_WMOE1 + e * SZ_WFFN1), 1024, 2816, 1024, 2, 0);
            add_job(P, nj, nt, P.in[42] + eo, (bf16_t*)(ws + OFF_WMOE2 + e * SZ_WFFN2), 2816, 1024, 2816, 0, 0);
        }
        }
    }
    P.nj1 = nj; P.nt1 = nt; P.ntc = nt / 2;
#if MK_SINGLE
    P.lo = 0; P.hi = NPH;
    hipLaunchKernelGGL(mega, dim3(256), dim3(512), LDS_BYTES, stream, P);
#else
    for (int ph = 0; ph < NPH; ++ph) { P.lo = ph; P.hi = ph + 1; hipLaunchKernelGGL(mega, dim3(256), dim3(512), LDS_BYTES, stream, P); }
#endif
}
```

```cpp
#include <hip/hip_runtime.h>
#include <stdint.h>
#include <stdio.h>
#include <string.h>

#ifndef PROBE_DUP
#define PROBE_DUP 0
#endif
#define REP(k) for (int rep_ = 0; rep_ < 1 + ((PROBE_DUP >> (k)) & 1); ++rep_)
#define DUPB(k) ((PROBE_DUP >> (k)) & 1)
#ifndef MK_SINGLE
#define MK_SINGLE 1
#endif

#define LAS __attribute__((address_space(3)))
typedef unsigned short bf16_t;
typedef short bf16x8 __attribute__((ext_vector_type(8)));
typedef short s16x4 __attribute__((ext_vector_type(4)));
typedef float f32x2 __attribute__((ext_vector_type(2)));
typedef float f32x4 __attribute__((ext_vector_type(4)));
typedef float f32x16 __attribute__((ext_vector_type(16)));
typedef unsigned u32x2 __attribute__((ext_vector_type(2)));
typedef unsigned u32x4 __attribute__((ext_vector_type(4)));
typedef __bf16 bfv2 __attribute__((ext_vector_type(2)));

constexpr int TT = 18432;
constexpr int SB = 2304;
constexpr int DM = 1024;
constexpr int NPH = 42;
constexpr float ALPHA = 1.6817928305074290f;
constexpr int SPLIT_S = 2;

constexpr size_t OFF_BAR = 0;
constexpr size_t OFF_CNT = 16384;
constexpr size_t ZERO_BYTES = 32768;
constexpr size_t OFF_MOD = 32768;
constexpr size_t OFF_COS = OFF_MOD + 884736;
constexpr size_t OFF_SIN = OFF_COS + 262144;
constexpr size_t OFF_LB = OFF_SIN + 262144;
constexpr size_t OFF_AB = OFF_LB + 4096;
constexpr size_t OFF_BBR = OFF_AB + 65536;
constexpr size_t OFF_BBI = OFF_BBR + 524288;
constexpr size_t OFF_ROUTE = OFF_BBI + 524288;
constexpr size_t OFF_WINE = OFF_ROUTE + 589824;
constexpr size_t SZ_WINE = (size_t)3328 * 1024 * 2;
constexpr size_t OFF_WOUTE = OFF_WINE + 2 * SZ_WINE;
constexpr size_t SZ_WSQ = (size_t)1024 * 1024 * 2;
constexpr size_t OFF_WFFN1 = OFF_WOUTE + 2 * SZ_WSQ;
constexpr size_t SZ_WFFN1 = (size_t)5632 * 1024 * 2;
constexpr size_t OFF_WFFN2 = OFF_WFFN1 + 2 * SZ_WFFN1;
constexpr size_t SZ_WFFN2 = (size_t)1024 * 2816 * 2;
constexpr size_t OFF_WINO = OFF_WFFN2 + 2 * SZ_WFFN2;
constexpr size_t SZ_WINO = (size_t)2560 * 1024 * 2;
constexpr size_t OFF_WOUTO = OFF_WINO + 2 * SZ_WINO;
constexpr size_t OFF_WLORA = OFF_WOUTO + 2 * SZ_WSQ;
constexpr size_t SZ_WLORA = (size_t)2560 * 384 * 2;
constexpr size_t OFF_WGLU = OFF_WLORA + 2 * SZ_WLORA;
constexpr size_t SZ_WGLU = (size_t)512 * 512 * 2;
constexpr size_t OFF_WMOE1 = OFF_WGLU + 2 * SZ_WGLU;
constexpr size_t OFF_WMOE2 = OFF_WMOE1 + 8 * SZ_WFFN1;
constexpr size_t OFF_X = OFF_WMOE2 + 8 * SZ_WFFN2;
constexpr size_t OFF_H = OFF_X + (size_t)TT * 1024 * 4;
constexpr size_t OFF_AR = OFF_H + (size_t)TT * 1024 * 2;
constexpr size_t AE_P = 0, AE_OF = 122683392, AE_OB = AE_OF + 37748736, AE_Y = AE_OB + 37748736;
constexpr size_t AO_P = 0, AO_OF = 94371840, AO_OB = AO_OF + 37748736, AO_PR = AO_OB + 37748736, AO_L = AO_PR + 56623104, AO_YG = AO_L + 14155776, AO_Y = AO_YG + 18874368;
constexpr size_t AM_A = 0, AM_H = 79691776;
constexpr size_t AR_SIZE = 298844160;
constexpr size_t OFF_KN = OFF_AR + AR_SIZE;
constexpr size_t OFF_GE = OFF_KN + 589824;
constexpr size_t OFF_GW = OFF_GE + (size_t)18432 * 8192;
constexpr size_t OFF_S5F = OFF_GW + (size_t)18432 * 256;
constexpr size_t OFF_S5B = OFF_S5F + (size_t)TT * 512 * 4;
constexpr size_t OFF_INV = OFF_S5B + (size_t)TT * 512 * 4;
constexpr size_t WS_END = OFF_INV + (size_t)8 * TT * 4;

struct Job { const float* src; bf16_t* dst; int K, N, ldd, mode, tile0, aux; };
constexpr int MAXJOBS = 72;
struct Params {
    const float* in[43];
    float* out;
    unsigned char* ws;
    int lo, hi;
    int nj0, njm, nj1;
    int nt0, ntm, nt1;
    int ntc;
    Job jobs[MAXJOBS];
};

__device__ __forceinline__ float bf2f(unsigned v) { return __uint_as_float(v << 16); }
__device__ __forceinline__ unsigned pk2(float lo, float hi) { f32x2 v = {lo, hi}; bfv2 b = __builtin_convertvector(v, bfv2); return __builtin_bit_cast(unsigned, b); }
__device__ __forceinline__ void unpk8(const u32x4 v, float* f) {
    f[0] = __uint_as_float(v.x << 16); f[1] = __uint_as_float(v.x & 0xffff0000u);
    f[2] = __uint_as_float(v.y << 16); f[3] = __uint_as_float(v.y & 0xffff0000u);
    f[4] = __uint_as_float(v.z << 16); f[5] = __uint_as_float(v.z & 0xffff0000u);
    f[6] = __uint_as_float(v.w << 16); f[7] = __uint_as_float(v.w & 0xffff0000u);
}
__device__ __forceinline__ void unpk4(const u32x2 v, float* f) {
    f[0] = __uint_as_float(v.x << 16); f[1] = __uint_as_float(v.x & 0xffff0000u);
    f[2] = __uint_as_float(v.y << 16); f[3] = __uint_as_float(v.y & 0xffff0000u);
}
__device__ __forceinline__ f32x4 unpk4v(const u32x2 v) { f32x4 r; r[0] = __uint_as_float(v.x << 16); r[1] = __uint_as_float(v.x & 0xffff0000u); r[2] = __uint_as_float(v.y << 16); r[3] = __uint_as_float(v.y & 0xffff0000u); return r; }
typedef _Float16 hf4 __attribute__((ext_vector_type(4)));
__device__ __forceinline__ u32x2 f2h4(const f32x4 v) { const hf4 h = __builtin_convertvector(v, hf4); return __builtin_bit_cast(u32x2, h); }
__device__ __forceinline__ f32x4 h2f4(const u32x2 u) { const hf4 h = __builtin_bit_cast(hf4, u); return __builtin_convertvector(h, f32x4); }
__device__ __forceinline__ u32x4 pk8(const float* f) { u32x4 r; r.x = pk2(f[0], f[1]); r.y = pk2(f[2], f[3]); r.z = pk2(f[4], f[5]); r.w = pk2(f[6], f[7]); return r; }
template <int CTRL> __device__ __forceinline__ float dppf(float v) { return __builtin_bit_cast(float, __builtin_amdgcn_update_dpp(0, __builtin_bit_cast(int, v), CTRL, 0xF, 0xF, true)); }
__device__ __forceinline__ float sum8(float v) { v += dppf<0xB1>(v); v += dppf<0x4E>(v); v += dppf<0x141>(v); return v; }
__device__ __forceinline__ float sum16(float v) { v = sum8(v); v += dppf<0x140>(v); return v; }
__device__ __forceinline__ float xsum16(float x) { const unsigned xb = __builtin_bit_cast(unsigned, x); auto r = __builtin_amdgcn_permlane16_swap(xb, xb, false, false);
    return __builtin_bit_cast(float, (unsigned)r[0]) + __builtin_bit_cast(float, (unsigned)r[1]); }
__device__ __forceinline__ float xsum32(float x) { const unsigned xb = __builtin_bit_cast(unsigned, x); auto r = __builtin_amdgcn_permlane32_swap(xb, xb, false, false);
    return __builtin_bit_cast(float, (unsigned)r[0]) + __builtin_bit_cast(float, (unsigned)r[1]); }
__device__ __forceinline__ float sum64(float v) { v = sum16(v); v = xsum16(v); v = xsum32(v); return v; }
__device__ __forceinline__ unsigned pair_rows(float a0, float a1, bool odd) {
    const float r = dppf<0xB1>(odd ? a0 : a1);
    return odd ? pk2(r, a1) : pk2(a0, r);
}
__device__ __forceinline__ float sigm(float x) { return __builtin_amdgcn_rcpf(1.0f + __builtin_amdgcn_exp2f(-1.4426950408889634f * x)); }
__device__ __forceinline__ float siluf(float x) { return x * __builtin_amdgcn_rcpf(1.0f + __builtin_amdgcn_exp2f(-1.4426950408889634f * x)); }
__device__ __forceinline__ float tanh_f(float x) { const float e = __builtin_amdgcn_exp2f(-2.8853900817779268f * fabsf(x)); const float t = (1.0f - e) * __builtin_amdgcn_rcpf(1.0f + e); return x < 0.f ? -t : t; }
__device__ __forceinline__ void my_sincos(float x, float& s, float& c) {
    const float q = rintf(x * 0.636619772f);
    float r = fmaf(-q, 1.57079637f, x); r = fmaf(-q, -4.37113883e-8f, r);
    const float r2 = r * r;
    const float sp = r + r * r2 * (-1.6666654611e-1f + r2 * (8.3321608736e-3f + r2 * (-1.9515295891e-4f)));
    const float cp = 1.0f - 0.5f * r2 + r2 * r2 * (4.166664568298827e-2f + r2 * (-1.388731625493765e-3f + r2 * 2.443315711809948e-5f));
    const int qi = ((int)q) & 3;
    s = (qi == 0) ? sp : (qi == 1) ? cp : (qi == 2) ? -sp : -cp;
    c = (qi == 0) ? cp : (qi == 1) ? -sp : (qi == 2) ? -cp : sp;
}
__device__ __forceinline__ unsigned char* ows(unsigned char* q) { const unsigned long long t0 = (unsigned long long)q; unsigned lo = __builtin_amdgcn_readfirstlane((unsigned)t0), hi = __builtin_amdgcn_readfirstlane((unsigned)(t0 >> 32)); asm volatile("" : "+s"(lo), "+s"(hi)); const unsigned long long t = ((unsigned long long)hi << 32) | lo; return (unsigned char*)(__attribute__((address_space(1))) unsigned char*)t; }
#define LDS_BARRIER() do { asm volatile("s_waitcnt lgkmcnt(0)" ::: "memory"); __builtin_amdgcn_s_barrier(); asm volatile("" ::: "memory"); } while (0)
__device__ __forceinline__ int otid() { int t = threadIdx.x; asm volatile("" : "+v"(t)); return t; }
__device__ __forceinline__ int mod_index(int row) { const int b = row / SB, s = row - b * SB; return s < 256 ? 8 : b; }

#define XB_TMO      128
#define XB_XCNT(j)  (256  + 64 * (j))
#define XB_XSUB(j)  (1280 + 64 * (j))
#define XB_XGEN(j)  (2304 + 64 * (j))
#define XB_TOP      3328
#define XB_TOPGEN   3392
#define XCD_BAR_WORDS 3456
#define XB_SPIN_CAP (1u << 18)
__device__ __forceinline__ unsigned xb_ld(unsigned* p)              { return __hip_atomic_load(p, __ATOMIC_RELAXED, __HIP_MEMORY_SCOPE_AGENT); }
__device__ __forceinline__ unsigned xb_add(unsigned* p, unsigned v) { return __hip_atomic_fetch_add(p, v, __ATOMIC_RELAXED, __HIP_MEMORY_SCOPE_AGENT); }
__device__ __forceinline__ unsigned xb_xcc_id() { return (unsigned)__builtin_amdgcn_s_getreg((3 << 11) | 20) & 0xFu; }
#define XB_SPIN(cond, bar) do { unsigned _sp = 0; while (cond) { __builtin_amdgcn_s_sleep(12); \
    if ((++_sp & 255u) == 0u) { if (xb_ld(&(bar)[XB_TMO])) break; if (_sp > XB_SPIN_CAP) { atomicAdd(&(bar)[XB_TMO], 1u); break; } } } } while (0)
struct XcdBarrier { unsigned* bar; unsigned x; volatile LAS unsigned* st; };
__device__ __forceinline__ XcdBarrier xcd_barrier_post(unsigned* bar, volatile LAS unsigned* st) {
    XcdBarrier b; b.bar = bar; b.x = xb_xcc_id(); b.st = st;
    if (threadIdx.x == 0) (void)xb_add(&bar[XB_XCNT(b.x)], 1u);
    return b;
}
__device__ __forceinline__ void xcd_barrier_complete(unsigned* bar, unsigned x, unsigned& nloc, unsigned& nx) {
    const unsigned G = gridDim.x * gridDim.y * gridDim.z;
    unsigned sum, cnt, mine, sp = 0u;
    for (;;) {
        sum = 0u; cnt = 0u; mine = 0u;
#pragma unroll
        for (unsigned j = 0; j < 16; ++j) { const unsigned c = xb_ld(&bar[XB_XCNT(j)]); sum += c; cnt += (c > 0u) ? 1u : 0u; mine = (j == x) ? c : mine; }
        if (sum == G) break;
        __builtin_amdgcn_s_sleep(1);
        if ((++sp & 255u) == 0u) { if (xb_ld(&bar[XB_TMO])) break; if (sp > XB_SPIN_CAP) { atomicAdd(&bar[XB_TMO], 1u); break; } }
    }
    nloc = mine > 0u ? mine : 1u; nx = cnt > 0u ? cnt : 1u;
}
__device__ __forceinline__ void xcd_barrier(const XcdBarrier& b) {
    asm volatile("s_waitcnt vmcnt(0)" ::: "memory");
    __syncthreads();
    if (threadIdx.x == 0) {
        unsigned* bar = b.bar;
        __builtin_amdgcn_s_waitcnt(0);
        unsigned nloc = b.st[0], nx = b.st[1];
        if (nloc == 0u) { xcd_barrier_complete(bar, b.x, nloc, nx); b.st[0] = nloc; b.st[1] = nx; }
        const unsigned old = xb_add(&bar[XB_XSUB(b.x)], 1u);
        const unsigned gen = old / nloc;
        if (old + 1u == (gen + 1u) * nloc) {
            __builtin_amdgcn_fence(__ATOMIC_RELEASE, "agent");
            asm volatile("s_waitcnt vmcnt(0)" ::: "memory");
            (void)xb_add(&bar[XB_TOP], 1u);
        }
        XB_SPIN(xb_ld(&bar[XB_TOP]) < (gen + 1u) * nx, bar);
        __builtin_amdgcn_fence(__ATOMIC_ACQUIRE, "agent");
        asm volatile("s_waitcnt vmcnt(0)" ::: "memory");
    }
    __syncthreads();
}

namespace pg8 {
constexpr int BM = 256, BK = 64, HALF = 128, HTB = HALF * BK * 2, STAGE_BYTES = 8 * HTB, NXCD = 8, WGM = 8;
__device__ __forceinline__ int lds_byte(int r, int c) { const int st = (r >> 4) * 2 + (c >> 5), rr = r & 15, cc = c & 31, ob = rr * 64 + cc * 2; return st * 1024 + (ob ^ (((ob >> 9) & 1) << 5)); }
__device__ __forceinline__ void stage_rc(int b, int& R, int& C) { const int st = b / 1024, sb = b % 1024, swz = sb ^ (((sb >> 9) & 1) << 5); R = (st >> 1) * 16 + swz / 64; C = (st & 1) * 32 + (swz % 64) / 2; }
__device__ __forceinline__ int perm32(int rho) { const int n = rho >> 4, i = rho & 15; return 8 * (i >> 2) + 4 * n + (i & 3); }
struct Unit { int pm, pn, e, kt0, nkt, ks; };
struct Gemm { const bf16_t* A; const bf16_t* Bt; int K; size_t bstride; };
struct StaticOrder {
    int nM, nN, nwg, G, c, nkt;
    __device__ __forceinline__ void init(int M, int N, int G_, int c_, int K_) { nM = M / BM; nN = N / BM; nwg = nM * nN; G = G_; c = c_; nkt = K_ / BK; }
    __device__ __forceinline__ bool next(int i, Unit& u) const {
        const long L = (long)i * G + c; if (L >= nwg) return false;
        int wgid = (int)L; { const int q = nwg / NXCD, r = nwg % NXCD, xcd = wgid % NXCD, off = wgid / NXCD; wgid = (xcd < r ? xcd * (q + 1) : r * (q + 1) + (xcd - r) * q) + off; }
        const int nig = WGM * nN, gid = wgid / nig, fm = gid * WGM, gsz = (nM - fm) < WGM ? (nM - fm) : WGM;
        u.pm = fm + ((wgid % nig) % gsz); u.pn = (wgid % nig) / gsz; u.e = 0; u.kt0 = 0; u.nkt = nkt; u.ks = -1; return true;
    }
};
struct LoraOrder {
    StaticOrder so;
    __device__ __forceinline__ void init(int M, int N, int G_, int c_, int K_) { so.init(M, N, G_, c_, K_); }
    __device__ __forceinline__ bool next(int i, Unit& u) const {
        if (!so.next(i, u)) return false;
        u.kt0 = (u.pn >> 2) * 2; u.nkt = 2; return true;
    }
};
struct MoeOrder {
    int nN, G, c, npan, nkt, nfullU; int pend[8];
    __device__ __forceinline__ void init(const unsigned* cnt, int nN_, int G_, int c_, int K_, bool split = false) {
        nN = nN_; G = G_; c = c_; nkt = K_ / BK; int acc = 0;
#pragma unroll
        for (int e = 0; e < 8; ++e) { acc += ((int)cnt[e * 64] + 255) >> 8; pend[e] = acc; }
        npan = acc; nfullU = split ? ((npan * nN) / G) * G : 0x40000000;
    }
    __device__ __forceinline__ bool next(int i, Unit& u) const {
        const int q0 = i * G + (c & 7) * (G >> 3) + (c >> 3);
        const bool sub = q0 >= nfullU;
        const int q = sub ? nfullU + ((q0 - nfullU) >> 1) : q0, ksub = (q0 - nfullU) & 1;
        const int per = 4 * nN, nfull = npan >> 2, g4 = q / per;
        int pan, pn; bool ok = true;
        if (g4 < nfull) { const int r = q - g4 * per; pn = r >> 2; pan = g4 * 4 + (r & 3); }
        else { const int q2 = q - nfull * per, gp = npan - 4 * nfull; const int gpd = gp > 0 ? gp : 1; ok = q2 < gp * nN; pn = q2 / gpd; pan = 4 * nfull + (q2 - pn * gpd); }
        int e = 0;
#pragma unroll
        for (int k = 0; k < 7; ++k) e += (pan >= pend[k]) ? 1 : 0;
        u.pm = pan; u.pn = pn; u.e = e; u.kt0 = sub ? ksub * (nkt >> 1) : 0; u.nkt = sub ? (nkt >> 1) : nkt; u.ks = sub ? ksub : -1;
        return ok;
    }
};
struct CtxSplitOrder {
    StaticOrder lat; int G, c, nkt, S;
    __device__ __forceinline__ void init(int G_, int c_, int K_, int S_) { lat.init(64 * BM, 1024, G_, c_, K_); G = G_; c = c_; nkt = K_ / BK; S = S_; }
    __device__ __forceinline__ bool next(int i, Unit& u) const {
        const int L = i * G + c;
        const bool islat = L < 256;
        Unit r; const bool okl = lat.next(islat ? i : 0, r);
        r.pm = (r.pm >> 3) * 9 + 1 + (r.pm & 7);
        const int L2 = islat ? 0 : L - 256, Sd = S > 0 ? S : 1, uid = L2 / Sd, ks = L2 - uid * Sd, sub = nkt / Sd;
        u.pm = islat ? r.pm : (uid >> 2) * 9; u.pn = islat ? r.pn : (uid & 3); u.e = 0;
        u.kt0 = islat ? 0 : ks * sub; u.nkt = islat ? nkt : sub; u.ks = islat ? -1 : ks;
        return islat ? okl : (L2 < 32 * S);
    }
};
template <class Epi, class Sched, bool GA = false>
__device__ __forceinline__ void gemm_phase(LAS unsigned char* lds, const Gemm g, const Sched& S, const Epi& E, const LAS int* ridx = nullptr) {
    const int tid = otid(), wid = __builtin_amdgcn_readfirstlane(tid >> 6), lane = tid & 63, wr = wid >> 2, wc = wid & 3, fr = lane & 15, fq = lane >> 4;
    const int K = g.K;
    unsigned voffA[2], voffB[2]; int RA[2]; unsigned CA2[2];
#pragma unroll
    for (int i = 0; i < 2; ++i) { int R, C; stage_rc(tid * 16 + i * 8192, R, C); const int Rb = Epi::PERM ? ((R & ~31) + perm32(R & 31)) : R;
        voffA[i] = (unsigned)(R * K + C) * 2u; voffB[i] = (unsigned)(Rb * K + C) * 2u; RA[i] = R; CA2[i] = (unsigned)C * 2u; }
    unsigned vA[2][2], nvA[2][2], v2[2][2];
#define PG8_GIDX(dst, ui_) do { _Pragma("unroll") for (int _h = 0; _h < 2; ++_h) _Pragma("unroll") for (int _i = 0; _i < 2; ++_i) \
        dst[_h][_i] = (unsigned)ridx[(ui_) * 256 + _h * HALF + RA[_i]] * (unsigned)(K * 2) + CA2[_i]; } while (0)
#define PG8_STGA(bufoff, abase, h, vsel) do { if (GA) PG8_STAGE(bufoff, abase, vsel[h]); else PG8_STAGE(bufoff, (abase) + (h) * hstep, voffA); } while (0)
    const size_t kstep = (size_t)(BK * 2);
    const size_t hstep = (size_t)HALF * K * 2;
    const size_t tstep = 2 * hstep;
    const unsigned ldsw = (unsigned)wid * 1024u;
    const int aoff = lds_byte(wr * 64 + fr, fq * 8), boff = lds_byte(wc * 32 + fr, fq * 8);
#define PG8_SA(b, h) (((b) * 2 + (h)) * HTB)
#define PG8_SB(b, h) ((4 + (b) * 2 + (h)) * HTB)
#define PG8_STAGE(bufoff, gbase, voff) do { _Pragma("unroll") for (int _i = 0; _i < 2; ++_i) \
        __builtin_amdgcn_global_load_lds((const unsigned*)((const char*)(gbase) + (voff)[_i]), (LAS unsigned*)(lds + (bufoff) + ldsw + _i * 8192), 16, 0, 0); } while (0)
#define PG8_LDA(dst, b, h) do { _Pragma("unroll") for (int m = 0; m < 4; ++m) _Pragma("unroll") for (int k = 0; k < 2; ++k) dst[m][k] = *(const LAS bf16x8*)(lds + PG8_SA(b, h) + aoff + m * 2048 + k * 1024); } while (0)
#define PG8_LDB(dst, b, h) do { _Pragma("unroll") for (int n = 0; n < 2; ++n) _Pragma("unroll") for (int k = 0; k < 2; ++k) dst[n][k] = *(const LAS bf16x8*)(lds + PG8_SB(b, h) + boff + n * 2048 + k * 1024); } while (0)
#define PG8_MMA(ai, bj, At, Bt) do { __builtin_amdgcn_s_setprio(1); _Pragma("unroll") for (int m = 0; m < 4; ++m) _Pragma("unroll") for (int n = 0; n < 2; ++n) _Pragma("unroll") for (int k = 0; k < 2; ++k) \
        acc[ai][bj][m][n] = __builtin_amdgcn_mfma_f32_16x16x32_bf16(Bt[n][k], At[m][k], acc[ai][bj][m][n], 0, 0, 0); __builtin_amdgcn_s_setprio(0); } while (0)
#define PG8_WAIT_V(n) asm volatile("s_waitcnt vmcnt(" #n ")" ::: "memory")
#define PG8_WAIT_L(n) asm volatile("s_waitcnt lgkmcnt(" #n ")" ::: "memory")
#define PG8_BAR __builtin_amdgcn_s_barrier()
#define PG8_SCHED __builtin_amdgcn_sched_barrier(0)
    Unit cur, nxt; int ui = 0;
    if (!S.next(0, cur)) return;
    f32x4 acc[2][2][4][2];
#pragma unroll
    for (int a = 0; a < 2; ++a)
#pragma unroll
        for (int b = 0; b < 2; ++b)
#pragma unroll
            for (int m = 0; m < 4; ++m)
#pragma unroll
                for (int n = 0; n < 2; ++n) acc[a][b][m][n] = (f32x4){0.f, 0.f, 0.f, 0.f};
    bf16x8 At[4][2], B0[2][2], B1[2][2];
    const char* cA = (const char*)g.A + (GA ? (size_t)0 : (size_t)cur.pm * tstep) + (size_t)cur.kt0 * kstep; const char* cB = (const char*)g.Bt + (size_t)cur.e * g.bstride + (size_t)cur.pn * tstep + (size_t)cur.kt0 * kstep;
    if (GA) PG8_GIDX(vA, 0);
    PG8_STAGE(PG8_SB(0, 0), cB, voffB); PG8_STGA(PG8_SA(0, 0), cA, 0, vA); PG8_STAGE(PG8_SB(0, 1), cB + hstep, voffB); PG8_STGA(PG8_SA(0, 1), cA, 1, vA);
    if (wr == 1) PG8_BAR;
    PG8_WAIT_V(4); PG8_BAR;
    PG8_STAGE(PG8_SB(1, 0), cB + kstep, voffB); PG8_STGA(PG8_SA(1, 0), cA + kstep, 0, vA); PG8_STAGE(PG8_SB(1, 1), cB + hstep + kstep, voffB);
    PG8_WAIT_V(6); PG8_BAR;
    for (;;) {
        const bool has_next = S.next(ui + 1, nxt);
        const char* nA = has_next ? (const char*)g.A + (GA ? (size_t)0 : (size_t)nxt.pm * tstep) + (size_t)nxt.kt0 * kstep : cA; const char* nB = has_next ? (const char*)g.Bt + (size_t)nxt.e * g.bstride + (size_t)nxt.pn * tstep + (size_t)nxt.kt0 * kstep : cB;
        const int nt = cur.nkt;
        if (GA) { if (has_next) PG8_GIDX(nvA, ui + 1); else {
#pragma unroll
            for (int _h = 0; _h < 2; ++_h) { nvA[_h][0] = vA[_h][0]; nvA[_h][1] = vA[_h][1]; } } }
        for (int t = 0; t < nt; t += 2) {
            const bool last = (t == nt - 2);
            if (GA) {
#pragma unroll
                for (int _h = 0; _h < 2; ++_h) { v2[_h][0] = last ? nvA[_h][0] : vA[_h][0]; v2[_h][1] = last ? nvA[_h][1] : vA[_h][1]; } }
            const char* a1 = cA + (size_t)(t + 1) * kstep;
            const char* a2 = last ? nA : cA + (size_t)(t + 2) * kstep; const char* b2 = last ? nB : cB + (size_t)(t + 2) * kstep;
            const char* a3 = a2 + kstep; const char* b3 = b2 + kstep;
            PG8_LDB(B0, 0, 0); PG8_SCHED; PG8_LDA(At, 0, 0); PG8_STGA(PG8_SA(1, 1), a1, 1, vA);
            PG8_WAIT_L(8); PG8_BAR; PG8_WAIT_L(0); PG8_MMA(0, 0, At, B0); PG8_BAR; PG8_SCHED;
            PG8_LDB(B1, 0, 1); PG8_STAGE(PG8_SB(0, 0), b2, voffB);
            PG8_BAR; PG8_WAIT_L(0); PG8_MMA(0, 1, At, B1); PG8_BAR;
            PG8_LDA(At, 0, 1); PG8_STGA(PG8_SA(0, 0), a2, 0, v2);
            PG8_BAR; PG8_WAIT_L(0); PG8_MMA(1, 0, At, B0); PG8_BAR; PG8_SCHED;
            PG8_STAGE(PG8_SB(0, 1), b2 + hstep, voffB);
            PG8_WAIT_V(6); PG8_BAR; PG8_MMA(1, 1, At, B1); PG8_BAR;
            PG8_LDB(B0, 1, 0); PG8_SCHED; PG8_LDA(At, 1, 0); PG8_STGA(PG8_SA(0, 1), a2, 1, v2);
            PG8_WAIT_L(8); PG8_BAR; PG8_WAIT_L(0); PG8_MMA(0, 0, At, B0); PG8_BAR; PG8_SCHED;
            PG8_LDB(B1, 1, 1); PG8_STAGE(PG8_SB(1, 0), b3, voffB);
            PG8_BAR; PG8_WAIT_L(0); PG8_MMA(0, 1, At, B1); PG8_BAR;
            PG8_LDA(At, 1, 1); PG8_STGA(PG8_SA(1, 0), a3, 0, v2);
            PG8_BAR; PG8_WAIT_L(0); PG8_MMA(1, 0, At, B0); PG8_BAR; PG8_SCHED;
            PG8_STAGE(PG8_SB(1, 1), b3 + hstep, voffB);
            PG8_WAIT_V(6); PG8_BAR; PG8_MMA(1, 1, At, B1); PG8_BAR;
        }
        E(acc, cur, wr, wc, fr, fq);
        if (!has_next) break;
#pragma unroll
        for (int a = 0; a < 2; ++a)
#pragma unroll
            for (int b = 0; b < 2; ++b)
#pragma unroll
                for (int m = 0; m < 4; ++m)
#pragma unroll
                    for (int n = 0; n < 2; ++n) acc[a][b][m][n] = (f32x4){0.f, 0.f, 0.f, 0.f};
        cur = nxt; cA = nA; cB = nB; ++ui;
        if (GA) {
#pragma unroll
            for (int _h = 0; _h < 2; ++_h) { vA[_h][0] = nvA[_h][0]; vA[_h][1] = nvA[_h][1]; } }
    }
    PG8_WAIT_V(0);
    if (wr == 0) PG8_BAR;
    PG8_BAR;
#undef PG8_SA
#undef PG8_SB
#undef PG8_STAGE
#undef PG8_STGA
#undef PG8_GIDX
#undef PG8_LDA
#undef PG8_LDB
#undef PG8_MMA
#undef PG8_WAIT_V
#undef PG8_WAIT_L
#undef PG8_BAR
#undef PG8_SCHED
}

struct EpiBf16 {
    static constexpr bool PERM = true;
    bf16_t* O; int ldc; bf16_t* O2;
    __device__ __forceinline__ void operator()(const f32x4 (&acc)[2][2][4][2], const Unit& u, int wr, int wc, int fr, int fq) const {
        const int row0 = u.pm * BM + wr * 64 + fr, col0 = u.pn * BM + wc * 32 + 8 * fq;
        bf16_t* Ob = (u.ks == 1) ? O2 : O;
#pragma unroll
        for (int ai = 0; ai < 2; ++ai)
#pragma unroll
            for (int m = 0; m < 4; ++m) { bf16_t* rowp = Ob + (size_t)(row0 + ai * HALF + m * 16) * ldc + col0;
#pragma unroll
                for (int bj = 0; bj < 2; ++bj) { const f32x4 v0 = acc[ai][bj][m][0], v1 = acc[ai][bj][m][1];
                    u32x4 w; w.x = pk2(v0[0], v0[1]); w.y = pk2(v0[2], v0[3]); w.z = pk2(v1[0], v1[1]); w.w = pk2(v1[2], v1[3]);
                    *(u32x4*)(rowp + bj * HALF) = w; } }
    }
};
struct EpiEvenIn {
    static constexpr bool PERM = true;
    bf16_t* O; const LAS float* lb;
    __device__ __forceinline__ void operator()(const f32x4 (&acc)[2][2][4][2], const Unit& u, int wr, int wc, int fr, int fq) const {
        const int row0 = u.pm * BM + wr * 64 + fr, col0 = u.pn * BM + wc * 32 + 8 * fq;
        const int kind = (u.pn < 2) ? 1 : (u.pn < 6) ? 2 : (u.pn == 8 || u.pn == 9) ? 3 : 0;
        float lbv[2][8];
        if (kind == 2) {
#pragma unroll
            for (int bj = 0; bj < 2; ++bj)
#pragma unroll
                for (int j = 0; j < 8; ++j) lbv[bj][j] = lb[(col0 + bj * HALF + j) & 511];
        }
#pragma unroll
        for (int ai = 0; ai < 2; ++ai)
#pragma unroll
            for (int m = 0; m < 4; ++m) { bf16_t* rowp = O + (size_t)(row0 + ai * HALF + m * 16) * 3328 + col0;
#pragma unroll
                for (int bj = 0; bj < 2; ++bj) { float v[8];
#pragma unroll
                    for (int j = 0; j < 4; ++j) { v[j] = acc[ai][bj][m][0][j]; v[4 + j] = acc[ai][bj][m][1][j]; }
                    if (kind == 1) {
#pragma unroll
                        for (int j = 0; j < 8; ++j) v[j] = siluf(v[j]) * 0.08838834764831845f; }
                    else if (kind == 2) {
#pragma unroll
                        for (int j = 0; j < 8; ++j) v[j] = __builtin_amdgcn_logf(lbv[bj][j] + (1.0f - lbv[bj][j]) * sigm(v[j])); }
                    else if (kind == 3) {
#pragma unroll
                        for (int j = 0; j < 8; ++j) v[j] = siluf(v[j]); }
                    *(u32x4*)(rowp + bj * HALF) = pk8(v); } }
    }
};
struct EpiResid {
    static constexpr bool PERM = true;
    bf16_t* D0; const float* gate; bf16_t* D1;
    __device__ __forceinline__ void operator()(const f32x4 (&acc)[2][2][4][2], const Unit& u, int wr, int wc, int fr, int fq) const {
        const int row0 = u.pm * BM + wr * 64 + fr, col0 = u.pn * BM + wc * 32 + 8 * fq;
        const int b = u.pm / 9, isctx = (u.pm - b * 9 == 0), mi = isctx ? 8 : b;
        const float* gp = gate + (size_t)mi * 6144 + col0;
        f32x4 gv[2][2];
#pragma unroll
        for (int bj = 0; bj < 2; ++bj)
#pragma unroll
            for (int n = 0; n < 2; ++n) gv[bj][n] = *(const f32x4*)(gp + bj * HALF + 4 * n);
        bf16_t* Db = (u.ks == 1) ? D1 : D0;
#pragma unroll
        for (int ai = 0; ai < 2; ++ai)
#pragma unroll
            for (int m = 0; m < 4; ++m) { bf16_t* rowp = Db + (size_t)(row0 + ai * HALF + m * 16) * 1024 + col0;
#pragma unroll
                for (int bj = 0; bj < 2; ++bj) { const f32x4 v0 = acc[ai][bj][m][0] * gv[bj][0], v1 = acc[ai][bj][m][1] * gv[bj][1];
                    u32x4 w; w.x = pk2(v0[0], v0[1]); w.y = pk2(v0[2], v0[3]); w.z = pk2(v1[0], v1[1]); w.w = pk2(v1[2], v1[3]);
                    *(u32x4*)(rowp + bj * HALF) = w; } }
    }
};
struct EpiSwiGLU {
    static constexpr bool PERM = true;
    bf16_t* O; int ldc;
    __device__ __forceinline__ void operator()(const f32x4 (&acc)[2][2][4][2], const Unit& u, int wr, int wc, int fr, int fq) const {
        const int row0 = u.pm * BM + wr * 64 + fr, col0 = u.pn * HALF + wc * 32 + 8 * fq;
#pragma unroll
        for (int ai = 0; ai < 2; ++ai)
#pragma unroll
            for (int m = 0; m < 4; ++m) { bf16_t* rowp = O + (size_t)(row0 + ai * HALF + m * 16) * ldc + col0;
                float o[8];
#pragma unroll
                for (int n = 0; n < 2; ++n)
#pragma unroll
                    for (int j = 0; j < 4; j += 2) {
                        const f32x2 g2 = {acc[ai][0][m][n][j], acc[ai][0][m][n][j + 1]}, u2 = {acc[ai][1][m][n][j], acc[ai][1][m][n][j + 1]};
                        const f32x2 t = g2 * (-1.4426950408889634f);
                        f32x2 e; e.x = __builtin_amdgcn_exp2f(t.x); e.y = __builtin_amdgcn_exp2f(t.y);
                        const f32x2 d = e + 1.0f;
                        f32x2 r; r.x = __builtin_amdgcn_rcpf(d.x); r.y = __builtin_amdgcn_rcpf(d.y);
                        const f32x2 y = (g2 * u2) * r;
                        o[n * 4 + j] = y.x; o[n * 4 + j + 1] = y.y; }
                *(u32x4*)rowp = pk8(o); }
    }
};
struct EpiGLU {
    static constexpr bool PERM = true;
    const bf16_t* YG; bf16_t* Y;
    __device__ __forceinline__ void operator()(const f32x4 (&acc)[2][2][4][2], const Unit& u, int wr, int wc, int fr, int fq) const {
        const int row0 = u.pm * BM + wr * 64 + fr, col0 = u.pn * BM + wc * 32 + 8 * fq;
#pragma unroll
        for (int ai = 0; ai < 2; ++ai)
#pragma unroll
            for (int m = 0; m < 4; ++m) { const size_t row = (size_t)(row0 + ai * HALF + m * 16);
#pragma unroll
                for (int bj = 0; bj < 2; ++bj) { const int col = col0 + bj * HALF;
                    float y[8], o[8]; unpk8(*(const u32x4*)(YG + row * 512 + col), y);
#pragma unroll
                    for (int n = 0; n < 2; ++n)
#pragma unroll
                        for (int j = 0; j < 4; ++j) o[n * 4 + j] = y[n * 4 + j] * sigm(acc[ai][bj][m][n][j]);
                    *(u32x4*)(Y + row * 1024 + col) = pk8(o); } }
    }
};
}

__device__ __forceinline__ void ada_item(const Params& p, int item, unsigned char* sm) {
    unsigned char* const ws = ows(p.ws);
    const int tid = otid();
    const int l = item / 48, n0 = (item % 48) * 128;
    float* sc = (float*)sm;
    float* red = (float*)(sm + 49152);
    for (int i = tid; i < 9 * 1024; i += 512) { const int m = i >> 10, k = i & 1023; const float v = (m < 8) ? p.in[1][m * 1024 + k] : p.in[3][k]; sc[k * 12 + m] = siluf(v); }
    __syncthreads();
    const int col = tid & 127, kg = tid >> 7;
    float a0 = 0, a1 = 0, a2 = 0, a3 = 0, a4 = 0, a5 = 0, a6 = 0, a7 = 0, a8 = 0;
    const float* w = p.in[4] + (size_t)l * 1024 * 6144 + n0 + col;
#pragma unroll 8
    for (int k = kg * 256; k < kg * 256 + 256; ++k) {
        const float wv = w[(size_t)k * 6144];
        const f32x4 s0 = *(const f32x4*)&sc[k * 12], s1 = *(const f32x4*)&sc[k * 12 + 4]; const float s8 = sc[k * 12 + 8];
        a0 += s0[0] * wv; a1 += s0[1] * wv; a2 += s0[2] * wv; a3 += s0[3] * wv; a4 += s1[0] * wv; a5 += s1[1] * wv; a6 += s1[2] * wv; a7 += s1[3] * wv; a8 += s8 * wv;
    }
    float* rp = red + (kg * 9) * 128 + col;
    rp[0] = a0; rp[128] = a1; rp[256] = a2; rp[384] = a3; rp[512] = a4; rp[640] = a5; rp[768] = a6; rp[896] = a7; rp[1024] = a8;
    __syncthreads();
    float* mod = (float*)(ws + OFF_MOD);
    for (int i = tid; i < 9 * 128; i += 512) { const int m = i >> 7, cc = i & 127;
        const float s = red[(0 * 9 + m) * 128 + cc] + red[(1 * 9 + m) * 128 + cc] + red[(2 * 9 + m) * 128 + cc] + red[(3 * 9 + m) * 128 + cc];
        mod[(size_t)(l * 9 + m) * 6144 + n0 + cc] = s + p.in[5][l * 6144 + n0 + cc]; }
}
__device__ __forceinline__ void rope_item(const Params& p) {
    unsigned char* const ws = ows(p.ws);
    float* COS = (float*)(ws + OFF_COS); float* SIN = (float*)(ws + OFF_SIN);
    for (int i = threadIdx.x; i < 2048 * 32; i += 512) { const int pos = i >> 5, f = i & 31, fi = f & 15;
        const float inv = exp2f(-(float)fi * (13.287712379549449f / 16.0f));
        const float ang = (float)(f < 16 ? (pos >> 6) : (pos & 63)) * inv;
        float s, c; my_sincos(ang, s, c); COS[i] = c; SIN[i] = s; }
}
__device__ __forceinline__ void s5disc_item(const Params& p) {
    unsigned char* const ws = ows(p.ws);
    float* AB = (float*)(ws + OFF_AB); float* BBR = (float*)(ws + OFF_BBR); float* BBI = (float*)(ws + OFF_BBI); float* LB = (float*)(ws + OFF_LB);
    for (int idx = threadIdx.x; idx < 8192; idx += 512) {
        const int pp = idx & 63, g = (idx >> 6) & 31, jd = idx >> 11, jo = jd >> 1;
        const float lr = fminf(p.in[18][idx], -1e-4f), li = p.in[19][idx];
        const float dt = expf(p.in[20][jd * 32 + g]);
        const float mag = expf(lr * dt); float s, c; my_sincos(li * dt, s, c);
        const float abr = mag * c, abi = mag * s, den = lr * lr + li * li, nr = abr - 1.0f;
        const float cor = (nr * lr + abi * li) / den, coi = (abi * lr - nr * li) / den;
        AB[idx * 2] = abr; AB[idx * 2 + 1] = abi;
        const float* br = p.in[21] + (size_t)((jo * 32 + g) * 64 + pp) * 16; const float* bi = p.in[22] + (size_t)((jo * 32 + g) * 64 + pp) * 16;
        for (int h = 0; h < 16; ++h) { BBR[idx * 16 + h] = cor * br[h] - coi * bi[h]; BBI[idx * 16 + h] = cor * bi[h] + coi * br[h]; }
    }
    for (int c = threadIdx.x; c < 512; c += 512) { const float e0 = expf(p.in[10][c]), e1 = expf(p.in[10][512 + c]); LB[c] = 0.f; LB[512 + c] = e1 / (e0 + e1); }
}
struct TrTile { bf16_t* dp; int mode; };
__device__ __forceinline__ void tr_load(const Params& p, int tile, int& j, int jhi, f32x4 (&v)[8], int& k0, int& n0, Job& jb, int tid) {
    while (j + 1 < jhi && tile >= p.jobs[j + 1].tile0) ++j;
    jb = p.jobs[j]; const int t = tile - jb.tile0;
    const int nkt = jb.K >> 7, kt = t % nkt, ntl = t / nkt; k0 = kt * 128; n0 = ntl * 128;
    if (jb.mode == 3) {
#pragma unroll
        for (int i = 0; i < 8; ++i) v[i] = (f32x4){0.f, 0.f, 0.f, 0.f};
    } else if (jb.mode == 4) {
        const int blk = n0 >> 9, jo = jb.aux, sn0 = n0 & 511;
        const float* src = (blk < 4) ? (blk < 2 ? p.in[29] : p.in[31]) + (size_t)(jo * 2 + (blk & 1)) * 64 * 512 : p.in[32] + (size_t)jo * 128 * 512;
        const int klo = (blk < 4) ? 64 * blk : 256, khi = (blk < 4) ? 64 * blk + 64 : 384;
#pragma unroll
        for (int i = 0; i < 8; ++i) { const int idx = tid + 512 * i, kk = k0 + (idx >> 5), n4 = (idx & 31) * 4;
            v[i] = (kk >= klo && kk < khi) ? *(const f32x4*)(src + (size_t)(kk - klo) * 512 + sn0 + n4) : (f32x4){0.f, 0.f, 0.f, 0.f}; }
    } else {
#pragma unroll
        for (int i = 0; i < 8; ++i) { const int idx = tid + 512 * i, kk = idx >> 5, n4 = (idx & 31) * 4;
            v[i] = *(const f32x4*)(jb.src + (size_t)(k0 + kk) * jb.N + n0 + n4); }
    }
}
__device__ __forceinline__ void tr_loop(const Params& p, int first, int stride, int ntiles, int jlo, int jhi, unsigned char* sm) {
    const int tid = otid();
    bf16_t* Lb = (bf16_t*)sm;
    if (first >= ntiles) return;
    int j = jlo, k0, n0; Job jb; f32x4 v[8];
    tr_load(p, first, j, jhi, v, k0, n0, jb, tid);
    for (int tile = first; tile < ntiles; tile += stride) {
#pragma unroll
        for (int i = 0; i < 8; ++i) { const int idx = tid + 512 * i, kk = idx >> 5, n4 = (idx & 31) * 4;
            u32x2 w2; w2.x = pk2(v[i][0], v[i][1]); w2.y = pk2(v[i][2], v[i][3]); *(u32x2*)(Lb + kk * 132 + n4) = w2; }
        const int nn = tid >> 2, kq = tid & 3, ng = n0 + nn;
        int drow = ng;
        if (jb.mode == 1) drow = (ng >> 7) * 256 + (ng & 127);
        else if (jb.mode == 2) drow = (ng >> 7) * 256 + 128 + (ng & 127);
        bf16_t* dp = jb.dst + (size_t)drow * jb.ldd + k0;
        __syncthreads();
        if (tile + stride < ntiles) tr_load(p, tile + stride, j, jhi, v, k0, n0, jb, tid);
#pragma unroll
        for (int g = 0; g < 4; ++g) { const int k8 = g * 32 + kq * 8;
            u32x4 o;
            o.x = (unsigned)Lb[(k8 + 0) * 132 + nn] | ((unsigned)Lb[(k8 + 1) * 132 + nn] << 16); o.y = (unsigned)Lb[(k8 + 2) * 132 + nn] | ((unsigned)Lb[(k8 + 3) * 132 + nn] << 16);
            o.z = (unsigned)Lb[(k8 + 4) * 132 + nn] | ((unsigned)Lb[(k8 + 5) * 132 + nn] << 16); o.w = (unsigned)Lb[(k8 + 6) * 132 + nn] | ((unsigned)Lb[(k8 + 7) * 132 + nn] << 16);
            *(u32x4*)(dp + k8) = o; }
        __syncthreads();
    }
}
__device__ __forceinline__ void phase_prologue_a(const Params& p, unsigned char* sm) {
    const int cb = blockIdx.x, G = gridDim.x;
    for (int item = cb; item < 194; item += G) {
        if (item < 192) ada_item(p, item, sm);
        else if (item == 192) rope_item(p);
        else s5disc_item(p);
        __syncthreads();
    }
    tr_loop(p, (cb + 62) % G, G, p.nt0, 0, p.nj0, sm);
    if (DUPB(10)) { __syncthreads(); tr_loop(p, (cb + 62) % G, G, p.nt0, 0, p.nj0, sm); }
    if (DUPB(11)) { __syncthreads(); for (int item = cb; item < 192; item += G) { ada_item(p, item, sm); __syncthreads(); } }
}
__device__ __forceinline__ void phase_prologue_b(const Params& p) {
    unsigned char* const ws = ows(p.ws);
    const int tid_ = otid(); const int lane = tid_ & 63, w = tid_ >> 6;
    _Float16* X = (_Float16*)(ws + OFF_X); bf16_t* H = (bf16_t*)(ws + OFF_H); const float* mod = (const float*)(ws + OFF_MOD);
    f32x4 shr[4], scr[4]; int cur_mi = -1;
#pragma unroll
    for (int i = 0; i < 4; ++i) { shr[i] = (f32x4){0.f, 0.f, 0.f, 0.f}; scr[i] = shr[i]; }
    const int nwv = gridDim.x * 8, rpw = (TT + nwv - 1) / nwv, row_lo = (blockIdx.x * 8 + w) * rpw, row_hi = row_lo + rpw < TT ? row_lo + rpw : TT;
    for (int row = row_lo; row < row_hi; ++row) {
        const int b = row / SB, s = row - b * SB; const int mi = s < 256 ? 8 : b;
        const float* src = s < 256 ? p.in[2] + ((size_t)b * 256 + s) * 1024 : p.in[0] + ((size_t)b * 2048 + (s - 256)) * 1024;
        if (mi != cur_mi) { cur_mi = mi; const float* mp = mod + (size_t)mi * 6144;
#pragma unroll
            for (int i = 0; i < 4; ++i) { const int c = 8 * lane + 512 * (i >> 1) + 4 * (i & 1); shr[i] = *(const f32x4*)(mp + c); scr[i] = *(const f32x4*)(mp + 1024 + c); } }
#pragma unroll
        for (int k = 0; k < 2; ++k) { u32x2 xo[2], ho[2]; const int c8 = 8 * lane + 512 * k;
#pragma unroll
            for (int j = 0; j < 2; ++j) { const int i = 2 * k + j; const f32x4 v = *(const f32x4*)(src + c8 + 4 * j);
                xo[j] = f2h4(v * ALPHA);
                const f32x4 sh = shr[i], sc = scr[i];
                ho[j].x = pk2(v[0] * (1.f + sc[0]) + sh[0], v[1] * (1.f + sc[1]) + sh[1]); ho[j].y = pk2(v[2] * (1.f + sc[2]) + sh[2], v[3] * (1.f + sc[3]) + sh[3]); }
            *(u32x4*)(X + (size_t)row * 1024 + c8) = (u32x4){xo[0].x, xo[0].y, xo[1].x, xo[1].y};
            *(u32x4*)(H + (size_t)row * 1024 + c8) = (u32x4){ho[0].x, ho[0].y, ho[1].x, ho[1].y}; }
    }
}

template <int MODE, bool ROUTE, bool DRY = false>
__device__ __forceinline__ void phase_ln(const Params& p, int layer, size_t part_off, int nsplit, unsigned char* sm) {
    unsigned char* const ws = ows(p.ws);
    const int tid_ = otid(); const int lane = tid_ & 63, w = tid_ >> 6;
#define LN_CI(i) (8 * lane + 512 * ((i) >> 1) + 4 * ((i) & 1))
    _Float16* X = (_Float16*)(ws + OFF_X); bf16_t* H = (bf16_t*)(ws + OFF_H); const float* mod = (const float*)(ws + OFF_MOD);
    const int which = MODE == 0 ? 0 : 1;
    const float* lg = p.in[6] + (size_t)(layer * 2 + which) * 1024; const float* lbp = p.in[7] + (size_t)(layer * 2 + which) * 1024;
    const bool last = (layer == 3);
    const int jo = layer >> 1;
    unsigned* route = (unsigned*)(ws + OFF_ROUTE);
    unsigned* cnt = (unsigned*)(ws + OFF_CNT) + jo * 512;
    int offs[8];
    int split_row = 0x7fffffff;
    if (MODE == 2) { int acc = 0;
#pragma unroll
        for (int e = 0; e < 8; ++e) { offs[e] = acc; acc += (((int)cnt[e * 64] + 255) >> 8) << 8; }
        const int npan = acc >> 8, G_ = gridDim.x; split_row = ((((npan * 4) / G_) * G_) >> 2) << 8; }
    f32x4 rwr[4][4][2];
    if (ROUTE) { const float* rwg = p.in[38] + (size_t)jo * 8192;
#pragma unroll
        for (int i = 0; i < 4; ++i)
#pragma unroll
            for (int q = 0; q < 4; ++q) { const float* rp = rwg + (size_t)(LN_CI(i) + q) * 8; rwr[i][q][0] = *(const f32x4*)rp; rwr[i][q][1] = *(const f32x4*)(rp + 4); } }
    f32x4 g4r[4], b4r[4], shr[4], scr[4];
#pragma unroll
    for (int i = 0; i < 4; ++i) { g4r[i] = *(const f32x4*)(lg + LN_CI(i)); b4r[i] = *(const f32x4*)(lbp + LN_CI(i)); shr[i] = (f32x4){0.f, 0.f, 0.f, 0.f}; scr[i] = shr[i]; }
    int cur_mi = -1, cur_gi = -1; f32x4 gtr[4];
#pragma unroll
    for (int i = 0; i < 4; ++i) gtr[i] = (f32x4){0.f, 0.f, 0.f, 0.f};
    const int nwv = gridDim.x * 8, rpw = (TT + nwv - 1) / nwv, row_lo = (blockIdx.x * 8 + w) * rpw, row_hi = row_lo + rpw < TT ? row_lo + rpw : TT;
    for (int row = row_lo; row < row_hi; ++row) {
        const int b = row / SB, s = row - b * SB; const int mi = s < 256 ? 8 : b;
        if (last && s < 256 && (MODE != 0 || ROUTE)) {
            if (ROUTE && lane == 0 && !DRY) route[(size_t)row * 8] = 0xffffffffu;
            continue;
        }
        f32x4 v[4];
        _Float16* xr = X + (size_t)row * 1024;
        _Float16* xw = DRY ? (_Float16*)(ws + OFF_S5F) + (size_t)row * 1024 : xr; bf16_t* hw = DRY ? (bf16_t*)(ws + OFF_S5B) + (size_t)row * 1024 : H + (size_t)row * 1024;
#pragma unroll
        for (int k = 0; k < 2; ++k) { const u32x4 xv = *(const u32x4*)(xr + 8 * lane + 512 * k); v[2 * k] = h2f4((u32x2){xv.x, xv.y}); v[2 * k + 1] = h2f4((u32x2){xv.z, xv.w}); }
        if (MODE != 2) {
            const bf16_t* d0 = (const bf16_t*)(ws + part_off) + (size_t)row * 1024 + 8 * lane;
            const bool two = (s < 256 && nsplit > 0);
#pragma unroll
            for (int k = 0; k < 2; ++k) { const u32x4 dv = *(const u32x4*)(d0 + 512 * k); v[2 * k] += unpk4v((u32x2){dv.x, dv.y}); v[2 * k + 1] += unpk4v((u32x2){dv.z, dv.w});
                if (two) { const u32x4 ev = *(const u32x4*)(d0 + (size_t)TT * 1024 + 512 * k); v[2 * k] += unpk4v((u32x2){ev.x, ev.y}); v[2 * k + 1] += unpk4v((u32x2){ev.z, ev.w}); } }
        }
        if (MODE == 2) {
            const unsigned* rt = route + (size_t)row * 8;
            const int e1 = (int)rt[0], e2 = (int)rt[1]; const int r1 = (int)rt[2], r2 = (int)rt[3]; const float p1 = __uint_as_float(rt[4]), p2 = __uint_as_float(rt[5]);
            int o1 = 0, o2 = 0;
#pragma unroll
            for (int e = 0; e < 8; ++e) { o1 = (e == e1) ? offs[e] : o1; o2 = (e == e2) ? offs[e] : o2; }
            const bf16_t* F = (const bf16_t*)(ws + OFF_AR + AM_A);
            const bf16_t* f1 = F + (size_t)(o1 + r1) * 1024; const bf16_t* f2 = F + (size_t)(o2 + r2) * 1024;
            const bf16_t* F2 = (const bf16_t*)(ws + OFF_GE);
            const bool s1 = (o1 + r1) >= split_row, s2 = (o2 + r2) >= split_row;
            if (mi != cur_gi) { cur_gi = mi; const float* gt = mod + (size_t)(layer * 9 + mi) * 6144 + 5120;
#pragma unroll
                for (int i = 0; i < 4; ++i) gtr[i] = *(const f32x4*)(gt + LN_CI(i)); }
#pragma unroll
            for (int k = 0; k < 2; ++k) { const int c8 = 8 * lane + 512 * k;
                const u32x4 fa = *(const u32x4*)(f1 + c8), fb = *(const u32x4*)(f2 + c8);
                u32x4 ta = {0u, 0u, 0u, 0u}, tb = {0u, 0u, 0u, 0u};
                if (s1) ta = *(const u32x4*)(F2 + (size_t)(o1 + r1) * 1024 + c8);
                if (s2) tb = *(const u32x4*)(F2 + (size_t)(o2 + r2) * 1024 + c8);
#pragma unroll
                for (int j = 0; j < 2; ++j) { const int i = 2 * k + j; float a[4], bb[4], t1[4], t2[4];
                    unpk4(j ? (u32x2){fa.z, fa.w} : (u32x2){fa.x, fa.y}, a); unpk4(j ? (u32x2){fb.z, fb.w} : (u32x2){fb.x, fb.y}, bb);
                    unpk4(j ? (u32x2){ta.z, ta.w} : (u32x2){ta.x, ta.y}, t1); unpk4(j ? (u32x2){tb.z, tb.w} : (u32x2){tb.x, tb.y}, t2);
                    const f32x4 g4 = gtr[i];
#pragma unroll
                    for (int q = 0; q < 4; ++q) v[i][q] = v[i][q] + g4[q] * (p1 * (a[q] + t1[q]) + p2 * (bb[q] + t2[q])); } }
        }
        float sm_ = 0.f;
#pragma unroll
        for (int i = 0; i < 4; ++i) sm_ += (v[i][0] + v[i][1]) + (v[i][2] + v[i][3]);
        const float mean = sum64(sm_) * (1.0f / 1024.0f);
        float sq = 0.f;
#pragma unroll
        for (int i = 0; i < 4; ++i) { const f32x4 d = v[i] - mean; sq += (d[0] * d[0] + d[1] * d[1]) + (d[2] * d[2] + d[3] * d[3]); }
        const float rstd = rsqrtf(sum64(sq) * (1.0f / 1024.0f) + 1e-5f);
        if (mi != cur_mi) { cur_mi = mi;
            const float* mp = (MODE == 0) ? mod + (size_t)(layer * 9 + mi) * 6144 + 3072 : mod + (size_t)((last ? 0 : layer + 1) * 9 + mi) * 6144;
#pragma unroll
            for (int i = 0; i < 4; ++i) { shr[i] = *(const f32x4*)(mp + LN_CI(i)); scr[i] = *(const f32x4*)(mp + 1024 + LN_CI(i)); } }
        float lg8[8];
#pragma unroll
        for (int e = 0; e < 8; ++e) lg8[e] = 0.f;
#pragma unroll
        for (int k = 0; k < 2; ++k) { u32x2 xo[2], ho[2];
#pragma unroll
            for (int j = 0; j < 2; ++j) { const int i = 2 * k + j; const int c = LN_CI(i);
                const f32x4 y = (v[i] - mean) * rstd * g4r[i] + b4r[i];
                ho[j] = (u32x2){0u, 0u};
                if (MODE != 0 && last) { if (!DRY) *(f32x4*)(p.out + ((size_t)b * 2048 + (s - 256)) * 1024 + c) = y; xo[j] = f2h4(y); }
                else {
                    xo[j] = f2h4(y * ALPHA);
                    const f32x4 h = y * (1.0f + scr[i]) + shr[i];
                    ho[j].x = pk2(h[0], h[1]); ho[j].y = pk2(h[2], h[3]);
                    if (ROUTE) {
#pragma unroll
                        for (int e = 0; e < 8; ++e) lg8[e] += (h[0] * rwr[i][0][e >> 2][e & 3] + h[1] * rwr[i][1][e >> 2][e & 3]) + (h[2] * rwr[i][2][e >> 2][e & 3] + h[3] * rwr[i][3][e >> 2][e & 3]); }
                }
            }
            const int c8 = 8 * lane + 512 * k;
            if (MODE != 0 && last) { if (DRY) *(u32x4*)(xw + c8) = (u32x4){xo[0].x, xo[0].y, xo[1].x, xo[1].y}; }
            else { *(u32x4*)(xw + c8) = (u32x4){xo[0].x, xo[0].y, xo[1].x, xo[1].y}; *(u32x4*)(hw + c8) = (u32x4){ho[0].x, ho[0].y, ho[1].x, ho[1].y}; }
        }
        if (ROUTE) {
#pragma unroll
            for (int e = 0; e < 8; ++e) lg8[e] = sum64(lg8[e]) + p.in[39][jo * 8 + e];
            int e1 = 0; float v1 = lg8[0];
#pragma unroll
            for (int e = 1; e < 8; ++e) if (lg8[e] > v1) { v1 = lg8[e]; e1 = e; }
            int e2 = -1; float v2 = -3.0e38f;
#pragma unroll
            for (int e = 0; e < 8; ++e) if (e != e1 && lg8[e] > v2) { v2 = lg8[e]; e2 = e; }
            if (lane == 0 && !DRY) {
                const float p1 = 1.0f / (1.0f + __expf(v2 - v1)), p2 = 1.0f - p1;
                const unsigned r1 = atomicAdd(&cnt[e1 * 64], 1u), r2 = atomicAdd(&cnt[e2 * 64], 1u);
                unsigned* rt = route + (size_t)row * 8;
                rt[0] = (unsigned)e1; rt[1] = (unsigned)e2; rt[2] = r1; rt[3] = r2; rt[4] = __float_as_uint(p1); rt[5] = __float_as_uint(p2);
                unsigned* inv = (unsigned*)(ws + OFF_INV); inv[(size_t)e1 * TT + r1] = (unsigned)row; inv[(size_t)e2 * TT + r2] = (unsigned)row;
            }
        }
    }
}
#undef LN_CI
__device__ __forceinline__ int scan_row(int dir, int n) { return dir == 0 ? n : (n < 256 ? 255 - n : 2559 - n); }
__device__ __forceinline__ void hgrn_chunk_unit(const Params& p, int j, int u, unsigned char* sm) {
    unsigned char* const ws = ows(p.ws);
    const int tid = otid(), lane = tid & 63, w = tid >> 6, l15 = lane & 15, kg = lane >> 4;
    const int chf = u & 1, dir = (u >> 1) & 1, h = (u >> 2) & 3, b = u >> 4;
    const int ct = 4 * chf + (w & 3);
    const bf16_t* P = (const bf16_t*)(ws + OFF_AR + AE_P);
    bf16_t* O = (bf16_t*)(ws + OFF_AR + (dir ? AE_OB : AE_OF));
    const size_t rb = (size_t)b * SB;
    const int pd = tid >> 2, tq = tid & 3;
    const int ppos = (pd & ~31) + 8 * ((pd & 15) >> 2) + 4 * ((pd >> 4) & 1) + (pd & 3);
    const int rstep = dir ? -1 : 1;
    constexpr int RAW0 = 2 * 21504, RAWSZ = 3 * 16 * 136 * 2;
    const int t4 = tid & 255, lt = t4 >> 4, lc = t4 & 15;
    u32x4 gq, gf, gv;
#define HG_LOAD(c) do { const size_t row = rb + scan_row(dir, (c) * 16 + lt); const bf16_t* pr = P + row * 3328 + h * 128 + 8 * lc; \
        gq = *(const u32x4*)pr; gf = *(const u32x4*)(pr + 512 + dir * 512); gv = *(const u32x4*)(pr + 1536); } while (0)
#define HG_RAWW(bi) do { bf16_t* rw = (bf16_t*)(sm + RAW0 + (bi) * RAWSZ) + lt * 136 + 8 * lc; \
        *(u32x4*)rw = gq; *(u32x4*)(rw + 16 * 136) = gf; *(u32x4*)(rw + 32 * 136) = gv; } while (0)
    unsigned short rq[4], rf[4], rv[4];
#define HG_RAWR(bi) do { const bf16_t* rr_ = (const bf16_t*)(sm + RAW0 + (bi) * RAWSZ) + (4 * tq) * 136 + pd; \
        _Pragma("unroll") for (int k = 0; k < 4; ++k) { rq[k] = rr_[k * 136]; rf[k] = rr_[(16 + k) * 136]; rv[k] = rr_[(32 + k) * 136]; } } while (0)
#define HG_PREP(bufi) do { \
        bf16_t* Qd = (bf16_t*)(sm + (bufi) * 21504); bf16_t* Kd = Qd + 16 * 136; bf16_t* KeT = Kd + 16 * 136; bf16_t* Vt = KeT + 128 * 24; float* dec = (float*)(Vt + 128 * 24); \
        float qv[4], kk[4], cl[4]; float run = 0.f; \
        _Pragma("unroll") for (int k = 0; k < 4; ++k) { const float lg = bf2f(rf[k]); \
            qv[k] = bf2f(rq[k]); kk[k] = 1.0f - __builtin_amdgcn_exp2f(lg); run += lg; cl[k] = run; } \
        float x1 = dppf<0x93>(run); x1 = (tq >= 1) ? x1 : 0.f;            \
        float s2 = run + x1; float x2 = dppf<0x4E>(s2); x2 = (tq >= 2) ? x2 : 0.f; \
        const float incl = s2 + x2; const float off = incl - run; \
        const float btot = dppf<0xFF>(incl);                                  \
        const float etot = __builtin_amdgcn_exp2f(btot); \
        float ke[4]; \
        _Pragma("unroll") for (int k = 0; k < 4; ++k) { const float bl = off + cl[k]; const float E = __builtin_amdgcn_exp2f(bl); const float iE = __builtin_amdgcn_rcpf(E); \
            const float qd = qv[k] * E, kd = kk[k] * iE; ke[k] = kd * etot; \
            Qd[(4 * tq + k) * 136 + ppos] = (bf16_t)(pk2(qd, 0.f) & 0xffff); Kd[(4 * tq + k) * 136 + ppos] = (bf16_t)(pk2(kd, 0.f) & 0xffff); } \
        { u32x2 w2; w2.x = pk2(ke[0], ke[1]); w2.y = pk2(ke[2], ke[3]); *(u32x2*)(KeT + pd * 24 + 4 * tq) = w2; \
          u32x2 v2; v2.x = (unsigned)rv[0] | ((unsigned)rv[1] << 16); v2.y = (unsigned)rv[2] | ((unsigned)rv[3] << 16); *(u32x2*)(Vt + pd * 24 + 4 * tq) = v2; } \
        if (tq == 0) dec[pd] = etot; } while (0)
    f32x4 S[8];
#pragma unroll
    for (int i = 0; i < 8; ++i) S[i] = (f32x4){0.f, 0.f, 0.f, 0.f};
    if (w >= 4) { HG_LOAD(0); HG_RAWW(0); HG_LOAD(1); }
    LDS_BARRIER();
    HG_RAWR(0); HG_PREP(0);
    if (w >= 4) { HG_RAWW(1); HG_LOAD(2); }
    LDS_BARRIER();
    for (int c = 0; c < 144; ++c) {
        if (c + 1 < 144) { HG_RAWR((c + 1) & 1); HG_PREP((c + 1) & 1); }
        if (w >= 4) { if (c + 2 < 144) { HG_RAWW(c & 1); } if (c + 3 < 144) { HG_LOAD(c + 3); } }
        if (w < 4) {
            const bf16_t* Qd = (const bf16_t*)(sm + (c & 1) * 21504); const bf16_t* Kd = Qd + 16 * 136; const bf16_t* KeT = Kd + 16 * 136; const bf16_t* Vt = KeT + 128 * 24; const float* dec = (const float*)(Vt + 128 * 24);
            f32x4 AT = {0.f, 0.f, 0.f, 0.f};
            bf16x8 qf[4];
#pragma unroll
            for (int ks = 0; ks < 4; ++ks) { const bf16x8 kf = *(const bf16x8*)(Kd + l15 * 136 + 32 * ks + 8 * kg); qf[ks] = *(const bf16x8*)(Qd + l15 * 136 + 32 * ks + 8 * kg);
                AT = __builtin_amdgcn_mfma_f32_16x16x32_bf16(kf, qf[ks], AT, 0, 0, 0); }
            u32x4 aw;
            aw.x = pk2((4 * kg + 0 <= l15) ? AT[0] : 0.f, (4 * kg + 1 <= l15) ? AT[1] : 0.f); aw.y = pk2((4 * kg + 2 <= l15) ? AT[2] : 0.f, (4 * kg + 3 <= l15) ? AT[3] : 0.f); aw.z = 0u; aw.w = 0u;
            const bf16x8 afrag = __builtin_bit_cast(bf16x8, aw);
            u32x4 vw; { const u32x2 v2 = *(const u32x2*)(Vt + (16 * ct + l15) * 24 + 4 * kg); vw.x = v2.x; vw.y = v2.y; vw.z = 0u; vw.w = 0u; }
            const bf16x8 vfrag = __builtin_bit_cast(bf16x8, vw);
            f32x4 Oa = {0.f, 0.f, 0.f, 0.f};
            Oa = __builtin_amdgcn_mfma_f32_16x16x32_bf16(afrag, vfrag, Oa, 0, 0, 0);
#pragma unroll
            for (int pi = 0; pi < 4; ++pi) {
                u32x4 sw; sw.x = pk2(S[2 * pi][0], S[2 * pi][1]); sw.y = pk2(S[2 * pi][2], S[2 * pi][3]); sw.z = pk2(S[2 * pi + 1][0], S[2 * pi + 1][1]); sw.w = pk2(S[2 * pi + 1][2], S[2 * pi + 1][3]);
                Oa = __builtin_amdgcn_mfma_f32_16x16x32_bf16(qf[pi], __builtin_bit_cast(bf16x8, sw), Oa, 0, 0, 0);
            }
            { bf16_t* op = O + (rb + scan_row(dir, c * 16 + 4 * kg)) * 512 + h * 128 + 16 * ct + l15;
#pragma unroll
              for (int p2 = 0; p2 < 2; ++p2) { const int od = l15 & 1; *(unsigned*)(op + (ptrdiff_t)(rstep * (2 * p2 + od)) * 512 - od) = pair_rows(Oa[2 * p2], Oa[2 * p2 + 1], od != 0); } }
#pragma unroll
            for (int dt = 0; dt < 8; ++dt) {
                const f32x4 dv = *(const f32x4*)(dec + 16 * dt + 4 * kg);
                u32x4 kw; { const u32x2 k2 = *(const u32x2*)(KeT + (16 * dt + l15) * 24 + 4 * kg); kw.x = k2.x; kw.y = k2.y; kw.z = 0u; kw.w = 0u; }
                S[dt] = __builtin_amdgcn_mfma_f32_16x16x32_bf16(__builtin_bit_cast(bf16x8, kw), vfrag, S[dt] * dv, 0, 0, 0);
            }
        }
        LDS_BARRIER();
    }
#undef HG_LOAD
#undef HG_RAWW
#undef HG_RAWR
#undef HG_PREP
}
__device__ __forceinline__ void hgrn_finish_rows(const Params& p, int j) {
    unsigned char* const ws = ows(p.ws);
    const int tid_ = otid(); const int lane = tid_ & 63, w = tid_ >> 6;
    const bf16_t* P = (const bf16_t*)(ws + OFF_AR + AE_P);
    const bf16_t* OF = (const bf16_t*)(ws + OFF_AR + AE_OF); const bf16_t* OB = (const bf16_t*)(ws + OFF_AR + AE_OB);
    bf16_t* Y = (bf16_t*)(ws + OFF_AR + AE_Y);
    const int c0 = lane * 8;
    const int nwv = gridDim.x * 8, rpw = (TT + nwv - 1) / nwv, row_lo = (blockIdx.x * 8 + w) * rpw, row_hi = (row_lo + rpw < TT) ? row_lo + rpw : TT;
    const f32x4 ng0 = *(const f32x4*)(p.in[11] + j * 512 + c0), ng1 = *(const f32x4*)(p.in[11] + j * 512 + c0 + 4);
    for (int row = row_lo; row < row_hi; ++row) {
        float o[8], g[8];
        { float fa[8], fb[8]; unpk8(*(const u32x4*)(OF + (size_t)row * 512 + c0), fa); unpk8(*(const u32x4*)(OB + (size_t)row * 512 + c0), fb);
#pragma unroll
          for (int i = 0; i < 8; ++i) o[i] = fa[i] + fb[i]; }
        unpk8(*(const u32x4*)(P + (size_t)row * 3328 + 2048 + c0), g);
        float ssq = 0.f;
#pragma unroll
        for (int i = 0; i < 8; ++i) ssq += o[i] * o[i];
        ssq = sum16(ssq);
        const float r = rsqrtf(ssq * (1.0f / 128.0f) + 1e-6f);
        float y[8];
#pragma unroll
        for (int i = 0; i < 4; ++i) { y[i] = o[i] * r * ng0[i] * g[i]; y[4 + i] = o[4 + i] * r * ng1[i] * g[4 + i]; }
        *(u32x4*)(Y + (size_t)row * 1024 + c0) = pk8(y);
    }
}

__device__ __forceinline__ void attn_unit(const Params& p, int j, int u, unsigned char* sm) {
    unsigned char* const ws = ows(p.ws);
    const int tid = otid(), lane = tid & 63, w = tid >> 6;
    const int b = u / 72, rem = u - b * 72, g = rem / 36, qb = rem - g * 36;
    const int r4 = w & 3, sub = w >> 2, hh = g * 4 + r4, l31 = lane & 31, hf = lane >> 5;
    bf16_t* Ks = (bf16_t*)sm; bf16_t* Vt = Ks + 64 * 72;
    const bf16_t* P = (const bf16_t*)(ws + OFF_AR + AE_P); bf16_t* Y = (bf16_t*)(ws + OFF_AR + AE_Y);
    const float* COS = (const float*)(ws + OFF_COS); const float* SIN = (const float*)(ws + OFF_SIN);
    const bool isl = qb < 32;
    const int q0 = isl ? qb * 64 : (qb - 32) * 64;
    const size_t rb = (size_t)b * SB;
    const int qpos = q0 + sub * 32 + l31;
    const size_t qrow = rb + (isl ? 256 : 0) + qpos;
    bf16x8 qf[4];
    {
        const bf16_t* qp = P + qrow * 3328 + 2560 + hh * 64;
        float x1a[8], x1b[8], x2a[8], x2b[8];
        unpk8(*(const u32x4*)(qp + 8 * hf), x1a); unpk8(*(const u32x4*)(qp + 16 + 8 * hf), x1b);
        unpk8(*(const u32x4*)(qp + 32 + 8 * hf), x2a); unpk8(*(const u32x4*)(qp + 48 + 8 * hf), x2b);
        const float sc = 0.125f * 1.4426950408889634f;
        float o0[8], o1[8], o2[8], o3[8];
        if (isl) {
            const float* cp = COS + qpos * 32 + 8 * hf; const float* sp = SIN + qpos * 32 + 8 * hf;
#pragma unroll
            for (int i = 0; i < 8; ++i) { const float ca = cp[i], sa = sp[i], cb = cp[16 + i], sb = sp[16 + i];
                o0[i] = (x1a[i] * ca - x2a[i] * sa) * sc; o2[i] = (x1a[i] * sa + x2a[i] * ca) * sc;
                o1[i] = (x1b[i] * cb - x2b[i] * sb) * sc; o3[i] = (x1b[i] * sb + x2b[i] * cb) * sc; }
        } else {
#pragma unroll
            for (int i = 0; i < 8; ++i) { o0[i] = x1a[i] * sc; o1[i] = x1b[i] * sc; o2[i] = x2a[i] * sc; o3[i] = x2b[i] * sc; }
        }
        qf[0] = __builtin_bit_cast(bf16x8, pk8(o0)); qf[1] = __builtin_bit_cast(bf16x8, pk8(o1)); qf[2] = __builtin_bit_cast(bf16x8, pk8(o2)); qf[3] = __builtin_bit_cast(bf16x8, pk8(o3));
    }
    float m = p.in[12][j * 8 + hh] * 1.4426950408889634f;
    float lsum = hf == 0 ? 1.0f : 0.0f;
    f32x16 O0, O1;
#pragma unroll
    for (int i = 0; i < 16; ++i) { O0[i] = 0.f; O1[i] = 0.f; }
    const int nch = isl ? 9 : 4;
    for (int ci = 0; ci < nch; ++ci) {
        const bool win = isl && ci < 5;
        int w0 = 0; size_t krow0;
        if (win) { w0 = q0 - 128 + 64 * ci; if (w0 < 0 || w0 >= 2048) continue; krow0 = rb + 256 + w0; }
        else { const int cc = isl ? ci - 5 : ci; krow0 = rb + cc * 64; }
        __syncthreads();
        if (tid < 256) {
            const int key = tid >> 2, dq = tid & 3;
            const bf16_t* src = P + (krow0 + key) * 3328 + 2560 + 512 + g * 64;
            u32x4 r1 = *(const u32x4*)(src + dq * 8), r2 = *(const u32x4*)(src + 32 + dq * 8);
            if (win) {
                float x1[8], x2[8], y1[8], y2[8]; unpk8(r1, x1); unpk8(r2, x2);
                const float* cp = COS + (w0 + key) * 32 + dq * 8; const float* sp = SIN + (w0 + key) * 32 + dq * 8;
#pragma unroll
                for (int i = 0; i < 8; ++i) { const float c_ = cp[i], s_ = sp[i]; y1[i] = x1[i] * c_ - x2[i] * s_; y2[i] = x1[i] * s_ + x2[i] * c_; }
                r1 = pk8(y1); r2 = pk8(y2);
            }
            *(u32x4*)(Ks + key * 72 + dq * 8) = r1; *(u32x4*)(Ks + key * 72 + 32 + dq * 8) = r2;
        } else {
            const int t2 = tid - 256, key = t2 >> 2, dq = t2 & 3;
            const bf16_t* src = P + (krow0 + key) * 3328 + 2560 + 640 + g * 64 + dq * 16;
            const u32x4 r1 = *(const u32x4*)src, r2 = *(const u32x4*)(src + 8);
            bf16_t* vp = Vt + (dq * 16) * 72 + key;
            vp[0 * 72] = (bf16_t)(r1.x & 0xffff); vp[1 * 72] = (bf16_t)(r1.x >> 16); vp[2 * 72] = (bf16_t)(r1.y & 0xffff); vp[3 * 72] = (bf16_t)(r1.y >> 16);
            vp[4 * 72] = (bf16_t)(r1.z & 0xffff); vp[5 * 72] = (bf16_t)(r1.z >> 16); vp[6 * 72] = (bf16_t)(r1.w & 0xffff); vp[7 * 72] = (bf16_t)(r1.w >> 16);
            vp[8 * 72] = (bf16_t)(r2.x & 0xffff); vp[9 * 72] = (bf16_t)(r2.x >> 16); vp[10 * 72] = (bf16_t)(r2.y & 0xffff); vp[11 * 72] = (bf16_t)(r2.y >> 16);
            vp[12 * 72] = (bf16_t)(r2.z & 0xffff); vp[13 * 72] = (bf16_t)(r2.z >> 16); vp[14 * 72] = (bf16_t)(r2.w & 0xffff); vp[15 * 72] = (bf16_t)(r2.w >> 16);
        }
        __syncthreads();
        f32x16 s0, s1;
#pragma unroll
        for (int i = 0; i < 16; ++i) { s0[i] = 0.f; s1[i] = 0.f; }
#pragma unroll
        for (int s = 0; s < 4; ++s) {
            const bf16x8 a0 = *(const bf16x8*)(Ks + l31 * 72 + 16 * s + 8 * hf), a1 = *(const bf16x8*)(Ks + (32 + l31) * 72 + 16 * s + 8 * hf);
            s0 = __builtin_amdgcn_mfma_f32_32x32x16_bf16(a0, qf[s], s0, 0, 0, 0);
            s1 = __builtin_amdgcn_mfma_f32_32x32x16_bf16(a1, qf[s], s1, 0, 0, 0);
        }
        if (win) {
#pragma unroll
            for (int i = 0; i < 16; ++i) { const int key = 8 * (i >> 2) + 4 * hf + (i & 3); const int d0 = qpos - (w0 + key), d1 = d0 - 32;
                if (d0 > 128 || d0 < -128) s0[i] = -INFINITY;
                if (d1 > 128 || d1 < -128) s1[i] = -INFINITY; }
        }
        float mt = s0[0];
#pragma unroll
        for (int i = 1; i < 16; ++i) mt = fmaxf(mt, s0[i]);
#pragma unroll
        for (int i = 0; i < 16; ++i) mt = fmaxf(mt, s1[i]);
        mt = fmaxf(mt, __shfl_xor(mt, 32));
        const float mnew = fmaxf(m, mt), alpha = __builtin_amdgcn_exp2f(m - mnew);
        m = mnew;
        float rs = 0.f;
#pragma unroll
        for (int i = 0; i < 16; ++i) { s0[i] = __builtin_amdgcn_exp2f(s0[i] - mnew); s1[i] = __builtin_amdgcn_exp2f(s1[i] - mnew); rs += s0[i] + s1[i]; }
        lsum = lsum * alpha + rs;
#pragma unroll
        for (int i = 0; i < 16; ++i) { O0[i] *= alpha; O1[i] *= alpha; }
#pragma unroll
        for (int kt = 0; kt < 2; ++kt)
#pragma unroll
            for (int s2 = 0; s2 < 2; ++s2) {
                u32x4 pw;
                if (kt == 0) { pw.x = pk2(s0[8 * s2], s0[8 * s2 + 1]); pw.y = pk2(s0[8 * s2 + 2], s0[8 * s2 + 3]); pw.z = pk2(s0[8 * s2 + 4], s0[8 * s2 + 5]); pw.w = pk2(s0[8 * s2 + 6], s0[8 * s2 + 7]); }
                else { pw.x = pk2(s1[8 * s2], s1[8 * s2 + 1]); pw.y = pk2(s1[8 * s2 + 2], s1[8 * s2 + 3]); pw.z = pk2(s1[8 * s2 + 4], s1[8 * s2 + 5]); pw.w = pk2(s1[8 * s2 + 6], s1[8 * s2 + 7]); }
                const bf16x8 pf = __builtin_bit_cast(bf16x8, pw);
#pragma unroll
                for (int mt2 = 0; mt2 < 2; ++mt2) {
                    const bf16_t* vp = Vt + (mt2 * 32 + l31) * 72 + kt * 32 + 16 * s2 + 4 * hf;
                    const u32x2 lo = *(const u32x2*)vp, hi = *(const u32x2*)(vp + 8);
                    u32x4 vv; vv.x = lo.x; vv.y = lo.y; vv.z = hi.x; vv.w = hi.y;
                    const bf16x8 vf = __builtin_bit_cast(bf16x8, vv);
                    if (mt2 == 0) O0 = __builtin_amdgcn_mfma_f32_32x32x16_bf16(vf, pf, O0, 0, 0, 0);
                    else O1 = __builtin_amdgcn_mfma_f32_32x32x16_bf16(vf, pf, O1, 0, 0, 0);
                }
            }
    }
    const float ltot = lsum + __shfl_xor(lsum, 32);
    const float inv = 1.0f / ltot;
    bf16_t* yp = Y + qrow * 1024 + 512 + hh * 64;
#pragma unroll
    for (int ib = 0; ib < 4; ++ib) {
        u32x2 o; o.x = pk2(O0[4 * ib] * inv, O0[4 * ib + 1] * inv); o.y = pk2(O0[4 * ib + 2] * inv, O0[4 * ib + 3] * inv);
        *(u32x2*)(yp + 8 * ib + 4 * hf) = o;
        u32x2 o2; o2.x = pk2(O1[4 * ib] * inv, O1[4 * ib + 1] * inv); o2.y = pk2(O1[4 * ib + 2] * inv, O1[4 * ib + 3] * inv);
        *(u32x2*)(yp + 32 + 8 * ib + 4 * hf) = o2;
    }
    __syncthreads();
}

__device__ __forceinline__ float partner32(float x) {
    const unsigned xb = __builtin_bit_cast(unsigned, x);
    auto r = __builtin_amdgcn_permlane32_swap(xb, xb, false, false);
    const unsigned pb = (r[0] == xb) ? r[1] : r[0];
    return __builtin_bit_cast(float, pb);
}
__device__ __forceinline__ void s5_scan_task(const Params& p, int jo, int task, unsigned char* smw) {
    unsigned char* const ws = ows(p.ws);
    const int lane = otid() & 63, l31 = lane & 31, hf = lane >> 5, l15 = lane & 15, kg = lane >> 4;
    const int dir = task & 1, g = (task >> 1) & 31, b = task >> 6;
    bf16_t* Xs = (bf16_t*)smw;
    const bf16_t* P = (const bf16_t*)(ws + OFF_AR + AO_YG);
    bf16_t* Yd = (bf16_t*)(ws + (dir ? OFF_S5B : OFF_S5F));
    const size_t rb = (size_t)b * SB;
    const int idx0 = ((jo * 2 + dir) * 32 + g) * 64 + l31, idx1 = idx0 + 32;
    const float* AB = (const float*)(ws + OFF_AB);
    const float ar0 = AB[idx0 * 2], ai0 = AB[idx0 * 2 + 1], ar1 = AB[idx1 * 2], ai1 = AB[idx1 * 2 + 1];
    bf16x8 bbf[4];
    { const float* BR = (const float*)(ws + OFF_BBR); const float* BI = (const float*)(ws + OFF_BBI);
      float t8[8];
#pragma unroll
      for (int j = 0; j < 8; ++j) t8[j] = BR[(size_t)idx0 * 16 + 8 * hf + j];
      bbf[0] = __builtin_bit_cast(bf16x8, pk8(t8));
#pragma unroll
      for (int j = 0; j < 8; ++j) t8[j] = BR[(size_t)idx1 * 16 + 8 * hf + j];
      bbf[1] = __builtin_bit_cast(bf16x8, pk8(t8));
#pragma unroll
      for (int j = 0; j < 8; ++j) t8[j] = BI[(size_t)idx0 * 16 + 8 * hf + j];
      bbf[2] = __builtin_bit_cast(bf16x8, pk8(t8));
#pragma unroll
      for (int j = 0; j < 8; ++j) t8[j] = BI[(size_t)idx1 * 16 + 8 * hf + j];
      bbf[3] = __builtin_bit_cast(bf16x8, pk8(t8)); }
    bf16x8 cmf[4], dskf;
    { const float* c1 = p.in[23] + (size_t)((jo * 32 + g) * 16 + l15) * 64; const float* c2 = p.in[24] + (size_t)((jo * 32 + g) * 16 + l15) * 64;
#pragma unroll
      for (int ks = 0; ks < 4; ++ks) { float t8[8];
#pragma unroll
          for (int j = 0; j < 8; ++j) { const int n = 8 * ks + 2 * kg + (j >> 2), q = j & 3; const int pp = n + 32 * (q & 1); t8[j] = (q < 2) ? c1[pp] : -c2[pp]; }
          cmf[ks] = __builtin_bit_cast(bf16x8, pk8(t8)); }
      float t8[8]; const float dv = p.in[25][jo * 512 + g * 16 + l15];
#pragma unroll
      for (int j = 0; j < 8; ++j) t8[j] = (kg < 2 && 8 * kg + j == l15) ? dv : 0.f;
      dskf = __builtin_bit_cast(bf16x8, pk8(t8)); }
    float xr0 = 0.f, xi0 = 0.f, xr1 = 0.f, xi1 = 0.f;
    u32x4 ua = *(const u32x4*)(P + (rb + scan_row(dir, l31)) * 512 + g * 16 + 8 * hf);
    for (int c = 0; c < 72; ++c) {
        f32x16 D0, D1, D2, D3;
#pragma unroll
        for (int i = 0; i < 16; ++i) { D0[i] = 0.f; D1[i] = 0.f; D2[i] = 0.f; D3[i] = 0.f; }
        { const bf16x8 uf = __builtin_bit_cast(bf16x8, ua);
          D0 = __builtin_amdgcn_mfma_f32_32x32x16_bf16(uf, bbf[0], D0, 0, 0, 0); D1 = __builtin_amdgcn_mfma_f32_32x32x16_bf16(uf, bbf[1], D1, 0, 0, 0);
          D2 = __builtin_amdgcn_mfma_f32_32x32x16_bf16(uf, bbf[2], D2, 0, 0, 0); D3 = __builtin_amdgcn_mfma_f32_32x32x16_bf16(uf, bbf[3], D3, 0, 0, 0); }
        if (c + 1 < 72) ua = *(const u32x4*)(P + (rb + scan_row(dir, (c + 1) * 32 + l31)) * 512 + g * 16 + 8 * hf);
#pragma unroll
        for (int m = 0; m < 4; ++m) {
            float A_[4][4], B_[4][4];
#pragma unroll
            for (int k = 0; k < 4; ++k) { const int i = 4 * m + k;
                const float n0r = ar0 * xr0 - ai0 * xi0 + D0[i], n0i = ar0 * xi0 + ai0 * xr0 + D2[i];
                const float n1r = ar1 * xr1 - ai1 * xi1 + D1[i], n1i = ar1 * xi1 + ai1 * xr1 + D3[i];
                xr0 = n0r; xi0 = n0i; xr1 = n1r; xi1 = n1i; A_[k][0] = xr0; A_[k][1] = xr1; A_[k][2] = xi0; A_[k][3] = xi1; }
            { const float q0 = partner32(xr0), q1 = partner32(xi0), q2 = partner32(xr1), q3 = partner32(xi1);
              xr0 = hf ? q0 : xr0; xi0 = hf ? q1 : xi0; xr1 = hf ? q2 : xr1; xi1 = hf ? q3 : xi1; }
#pragma unroll
            for (int k = 0; k < 4; ++k) { const int i = 4 * m + k;
                const float n0r = ar0 * xr0 - ai0 * xi0 + D0[i], n0i = ar0 * xi0 + ai0 * xr0 + D2[i];
                const float n1r = ar1 * xr1 - ai1 * xi1 + D1[i], n1i = ar1 * xi1 + ai1 * xr1 + D3[i];
                xr0 = n0r; xi0 = n0i; xr1 = n1r; xi1 = n1i; B_[k][0] = xr0; B_[k][1] = xr1; B_[k][2] = xi0; B_[k][3] = xi1; }
            { const float q0 = partner32(xr0), q1 = partner32(xi0), q2 = partner32(xr1), q3 = partner32(xi1);
              xr0 = hf ? xr0 : q0; xi0 = hf ? xi0 : q1; xr1 = hf ? xr1 : q2; xi1 = hf ? xi1 : q3; }
#pragma unroll
            for (int k = 0; k < 4; ++k) { const int t = 8 * m + 4 * hf + k;
                u32x2 w2; w2.x = pk2(hf ? B_[k][0] : A_[k][0], hf ? B_[k][1] : A_[k][1]); w2.y = pk2(hf ? B_[k][2] : A_[k][2], hf ? B_[k][3] : A_[k][3]);
                *(u32x2*)(Xs + t * 136 + 4 * l31) = w2; }
        }
        asm volatile("s_waitcnt lgkmcnt(0)" ::: "memory"); __builtin_amdgcn_wave_barrier();
        if (!(jo == 1 && c < 8)) {
#pragma unroll
        for (int tt = 0; tt < 2; ++tt) {
            f32x4 acc = {0.f, 0.f, 0.f, 0.f};
#pragma unroll
            for (int ks = 0; ks < 4; ++ks) { const bf16x8 a = *(const bf16x8*)(Xs + (16 * tt + l15) * 136 + 32 * ks + 8 * kg);
                acc = __builtin_amdgcn_mfma_f32_16x16x32_bf16(a, cmf[ks], acc, 0, 0, 0); }
#pragma unroll
            for (int p2 = 0; p2 < 2; ++p2) { const int od = l15 & 1; const size_t row = rb + scan_row(dir, c * 32 + 16 * tt + 4 * kg + 2 * p2 + od);
                *(unsigned*)(Yd + row * 512 + g * 16 + l15 - od) = pair_rows(acc[2 * p2], acc[2 * p2 + 1], od != 0); }
        }
        }
        asm volatile("s_waitcnt lgkmcnt(0)" ::: "memory"); __builtin_amdgcn_wave_barrier();
    }
}
__device__ __forceinline__ void rwkv_prep_rows(const Params& p, int jo) {
    unsigned char* const ws = ows(p.ws);
    const int tid_ = otid(); const int lane = tid_ & 63, w = tid_ >> 6;
    const bf16_t* P = (const bf16_t*)(ws + OFF_AR + AO_P);
    bf16_t* PR = (bf16_t*)(ws + OFF_AR + AO_PR); bf16_t* Lb = (bf16_t*)(ws + OFF_AR + AO_L);
    bf16_t* YGu = (bf16_t*)(ws + OFF_AR + AO_YG);
    float* KN = (float*)(ws + OFF_KN);
    const int nwv = gridDim.x * 8, rpw = (TT + nwv - 1) / nwv, row_lo = (blockIdx.x * 8 + w) * rpw, row_hi = (row_lo + rpw < TT) ? row_lo + rpw : TT;
    if (row_lo >= row_hi) return;
    const bool l3 = lane < 48;
    f32x4 mu4[4][2];
#pragma unroll
    for (int it = 0; it < 4; ++it) { const int c0 = (lane + 64 * it) * 8;
        if (it < 3 || l3) { mu4[it][0] = *(const f32x4*)(p.in[27] + jo * 1920 + c0); mu4[it][1] = *(const f32x4*)(p.in[27] + jo * 1920 + c0 + 4); }
        else { mu4[it][0] = f32x4{0.f, 0.f, 0.f, 0.f}; mu4[it][1] = mu4[it][0]; } }
    const f32x4 kk0 = *(const f32x4*)(p.in[33] + jo * 512 + lane * 8), kk1 = *(const f32x4*)(p.in[33] + jo * 512 + lane * 8 + 4);
    u32x4 pa[4], px[4], pn[4];
    { const int rp = row_lo > 0 ? row_lo - 1 : 0;
#pragma unroll
      for (int it = 0; it < 4; ++it) { const int c0 = (lane + 64 * it) * 8;
        if (it < 3 || l3) { pa[it] = *(const u32x4*)(P + (size_t)rp * 2560 + 512 + c0); px[it] = *(const u32x4*)(P + (size_t)row_lo * 2560 + 512 + c0); }
        else { pa[it] = u32x4{0u, 0u, 0u, 0u}; px[it] = pa[it]; } } }
    for (int row = row_lo; row < row_hi; ++row) {
        const int s = row % SB;
        const float hp = (s != 0 && s != 256) ? 0.5f : 0.f, hn = (s != 255 && s != 2303) ? 0.5f : 0.f;
        const int rn = row + 1 < TT ? row + 1 : TT - 1;
#pragma unroll
        for (int it = 0; it < 4; ++it) { const int c0 = (lane + 64 * it) * 8;
            if (it < 3 || l3) pn[it] = *(const u32x4*)(P + (size_t)rn * 2560 + 512 + c0); else pn[it] = u32x4{0u, 0u, 0u, 0u}; }
        *(u32x4*)(YGu + (size_t)row * 512 + lane * 8) = *(const u32x4*)(P + (size_t)row * 2560 + lane * 8);
#pragma unroll
        for (int it = 0; it < 4; ++it) {
            const int c0 = (lane + 64 * it) * 8;
            float x[8], a[8], bq[8], o[8];
            unpk8(px[it], x); unpk8(pa[it], a); unpk8(pn[it], bq);
#pragma unroll
            for (int i = 0; i < 8; ++i) { const float m = (i < 4) ? mu4[it][0][i & 3] : mu4[it][1][i & 3];
                o[i] = x[i] + m * (hp * a[i] + hn * bq[i] - x[i]); }
            if (it == 3) {
                if (lane < 16) {
#pragma unroll
                    for (int i = 0; i < 8; ++i) o[i] = tanh_f(o[i]); }
                else if (lane >= 32) {
#pragma unroll
                    for (int i = 0; i < 8; ++i) o[i] = sigm(o[i]); } }
            if (it == 1) { float ssq = 0.f;
#pragma unroll
                for (int i = 0; i < 8; ++i) { const float t_ = o[i] * ((i < 4) ? kk0[i & 3] : kk1[i & 3]); ssq += t_ * t_; }
                ssq = sum8(ssq);
                if ((lane & 7) == 0) KN[(size_t)row * 8 + (lane >> 3)] = 1.0f / fmaxf(sqrtf(ssq), 1e-12f); }
            if (it < 3) *(u32x4*)(PR + (size_t)row * 1536 + c0) = pk8(o);
            else if (l3) *(u32x4*)(Lb + (size_t)row * 384 + (c0 - 1536)) = pk8(o);
        }
#pragma unroll
        for (int it = 0; it < 4; ++it) { pa[it] = px[it]; px[it] = pn[it]; }
    }
}
__device__ __forceinline__ void rwkv_stage_loop(const Params& p, int jo, int first, int stride, int nitems, unsigned char* sm) {
    unsigned char* const ws = ows(p.ws);
    const int tid = otid();
    if (first >= nitems) return;
    const bf16_t* PR = (const bf16_t*)(ws + OFF_AR + AO_PR); const bf16_t* LO = (const bf16_t*)(ws + OFF_AR + AO_P);
    const float* KN = (const float*)(ws + OFF_KN);
    float* L_lw = (float*)sm; float* L_av = L_lw + 64 * 68; float* L_bv = L_av + 64 * 68; float* L_kd = L_bv + 64 * 68; float* L_rr = L_kd + 64 * 68;
    const int t64 = tid >> 3, c8 = (tid & 7) * 8;
    u32x4 gr, gk, gw, ga; float inn;
#define RS_LOAD(IT_) do { const int u_ = (IT_) / 36, R_ = (IT_) - u_ * 36, dir_ = u_ & 1, hd_ = (u_ >> 1) & 7, b_ = u_ >> 4; \
        const size_t row = (size_t)b_ * SB + scan_row(dir_, 64 * R_ + t64); const int ch_ = hd_ * 64 + c8; \
        gr = *(const u32x4*)(PR + row * 1536 + ch_); gk = *(const u32x4*)(PR + row * 1536 + 512 + ch_); \
        gw = *(const u32x4*)(LO + row * 2560 + dir_ * 512 + ch_); ga = *(const u32x4*)(LO + row * 2560 + 1024 + dir_ * 512 + ch_); inn = KN[row * 8 + hd_]; } while (0)
    f32x4 w0r[2], a0r[2], kkr[2], kar[2]; int cur_u = -1;
#pragma unroll
    for (int i = 0; i < 2; ++i) { w0r[i] = (f32x4){0.f, 0.f, 0.f, 0.f}; a0r[i] = w0r[i]; kkr[i] = w0r[i]; kar[i] = w0r[i]; }
    RS_LOAD(first);
    for (int item = first; item < nitems; item += stride) {
    const int u = item / 36, R = item - u * 36;
    const int dir = u & 1, hd = (u >> 1) & 7;
    {
        const int ch = hd * 64 + c8;
        float r8[8], k8[8], wl8[8], al8[8];
        unpk8(gr, r8); unpk8(gk, k8); unpk8(gw, wl8); unpk8(ga, al8);
        if (u != cur_u) { cur_u = u;
            const float* w0p = p.in[28] + (jo * 2 + dir) * 512 + ch; const float* a0p = p.in[30] + (jo * 2 + dir) * 512 + ch;
            const float* kkp = p.in[33] + jo * 512 + ch; const float* kap = p.in[34] + jo * 512 + ch;
#pragma unroll
            for (int i = 0; i < 2; ++i) { w0r[i] = *(const f32x4*)(w0p + 4 * i); a0r[i] = *(const f32x4*)(a0p + 4 * i); kkr[i] = *(const f32x4*)(kkp + 4 * i); kar[i] = *(const f32x4*)(kap + 4 * i); } }
        float lw[8], av[8], bv[8], kd[8];
#pragma unroll
        for (int i = 0; i < 8; ++i) {
            const float w0v = w0r[i >> 2][i & 3], a0v = a0r[i >> 2][i & 3], kkv = kkr[i >> 2][i & 3], kav = kar[i >> 2][i & 3];
            const float z = -(w0v + wl8[i]);
            const float sp = fmaxf(z, 0.f) + 0.6931471805599453f * __builtin_amdgcn_logf(1.0f + __builtin_amdgcn_exp2f(-1.4426950408889634f * fabsf(z)));
            lw[i] = -__builtin_amdgcn_exp2f(-1.4426950408889634f * (sp + 0.5f)) * 1.4426950408889634f;
            const float a = sigm(a0v + al8[i]);
            const float kn = k8[i] * kkv * inn;
            kd[i] = k8[i] * (1.0f + (a - 1.0f) * kav); av[i] = -kn; bv[i] = kn * a;
        }
        const int o = t64 * 68 + c8;
        *(f32x4*)(L_lw + o) = (f32x4){lw[0], lw[1], lw[2], lw[3]}; *(f32x4*)(L_lw + o + 4) = (f32x4){lw[4], lw[5], lw[6], lw[7]};
        *(f32x4*)(L_av + o) = (f32x4){av[0], av[1], av[2], av[3]}; *(f32x4*)(L_av + o + 4) = (f32x4){av[4], av[5], av[6], av[7]};
        *(f32x4*)(L_bv + o) = (f32x4){bv[0], bv[1], bv[2], bv[3]}; *(f32x4*)(L_bv + o + 4) = (f32x4){bv[4], bv[5], bv[6], bv[7]};
        *(f32x4*)(L_kd + o) = (f32x4){kd[0], kd[1], kd[2], kd[3]}; *(f32x4*)(L_kd + o + 4) = (f32x4){kd[4], kd[5], kd[6], kd[7]};
        *(f32x4*)(L_rr + o) = (f32x4){r8[0], r8[1], r8[2], r8[3]}; *(f32x4*)(L_rr + o + 4) = (f32x4){r8[4], r8[5], r8[6], r8[7]};
    }
    LDS_BARRIER();
    if (item + stride < nitems) { RS_LOAD(item + stride); }
    {
        const int sq = tid >> 7, tl = tid & 127, sj = tl >> 1, th = tl & 1;
        float cw[8], lwk[8]; float run = 0.f;
#pragma unroll
        for (int k = 0; k < 8; ++k) { lwk[k] = L_lw[(sq * 16 + 8 * th + k) * 68 + sj]; run += lwk[k]; cw[k] = run; }
        const float ptot = dppf<0xB1>(run);
        const float off = th ? ptot : 0.f, cw15 = run + ptot;
        u32x2* GE = (u32x2*)(ws + OFF_GE) + ((size_t)(u * 144 + 4 * R + sq) * 64 + sj) * 16 + 8 * th;
#pragma unroll
        for (int k2 = 0; k2 < 4; ++k2) { u32x2 ov[2];
#pragma unroll
            for (int j = 0; j < 2; ++j) { const int k = 2 * k2 + j;
                const int o = (sq * 16 + 8 * th + k) * 68 + sj;
                const float c = off + cw[k];
                const float Ec = __builtin_amdgcn_exp2f(c), Ep = __builtin_amdgcn_exp2f(c - lwk[k]), iE = __builtin_amdgcn_rcpf(Ec);
                ov[j].x = pk2(L_av[o] * Ep, L_rr[o] * Ec); ov[j].y = pk2(L_bv[o] * iE, L_kd[o] * iE); }
            *(u32x4*)(GE + 2 * k2) = (u32x4){ov[0].x, ov[0].y, ov[1].x, ov[1].y};
        }
        ((float*)(ws + OFF_GW))[(size_t)(u * 144 + 4 * R + sq) * 64 + sj] = __builtin_amdgcn_exp2f(cw15);
    }
    LDS_BARRIER();
    }
#undef RS_LOAD
}
__device__ __forceinline__ bf16x8 frag_lo(const f32x4 v) { u32x4 w; w.x = pk2(v[0], v[1]); w.y = pk2(v[2], v[3]); w.z = 0u; w.w = 0u; return __builtin_bit_cast(bf16x8, w); }
__device__ __forceinline__ bf16x8 frag_b64(const bf16_t* pz) { const u32x2 v = *(const u32x2*)pz; u32x4 w; w.x = v.x; w.y = v.y; w.z = 0u; w.w = 0u; return __builtin_bit_cast(bf16x8, w); }
__device__ __forceinline__ u32x2 pk4v(const f32x4 v) { u32x2 r; r.x = pk2(v[0], v[1]); r.y = pk2(v[2], v[3]); return r; }
#define MF16(a, b, c) __builtin_amdgcn_mfma_f32_16x16x32_bf16((a), (b), (c), 0, 0, 0)
constexpr int RW_SCR = 19712, RW_SLOT = 5120, RW_SLOT0 = 4 * RW_SCR;
__device__ __forceinline__ void rwkv_chunk_unit(const Params& p, int jo, int u, unsigned char* sm) {
    unsigned char* const ws = ows(p.ws);
    const int tid = otid(), lane = tid & 63, w = tid >> 6, l15 = lane & 15, kg = lane >> 4;
    const int dir = u & 1, hd = (u >> 1) & 7, b = u >> 4;
    const bf16_t* PR = (const bf16_t*)(ws + OFF_AR + AO_PR); const bf16_t* LO = (const bf16_t*)(ws + OFF_AR + AO_P);
    const float* KN = (const float*)(ws + OFF_KN);
    bf16_t* O = (bf16_t*)(ws + OFF_AR + (dir ? AO_OB : AO_OF));
    const size_t rb = (size_t)b * SB;
    const int sq = tid >> 7, tl = tid & 127, sj = tl >> 1, th = tl & 1, ch = hd * 64 + sj;
    const u32x4* GEb = (const u32x4*)(ws + OFF_GE); const float* GWb = (const float*)(ws + OFF_GW);
    f32x4 S[4];
#pragma unroll
    for (int i = 0; i < 4; ++i) S[i] = (f32x4){0.f, 0.f, 0.f, 0.f};
    u32x4 ge[4], ge2[4]; float e15, e152; unsigned vv[8], vv2[8];
#define RW_LOADX(R_, ge_, e_, vv_) do { const size_t cidx = (size_t)(u * 144 + 4 * (R_) + sq) * 64 + sj; const u32x4* gp = GEb + cidx * 8 + 4 * th; \
        ge_[0] = gp[0]; ge_[1] = gp[1]; ge_[2] = gp[2]; ge_[3] = gp[3]; e_ = GWb[cidx]; \
        _Pragma("unroll") for (int k = 0; k < 8; ++k) { const size_t row = rb + scan_row(dir, (4 * (R_) + sq) * 16 + 8 * th + k); vv_[k] = *(const unsigned*)(PR + row * 1536 + 1024 + (ch & ~1)); } } while (0)
#define RW_LOAD(R_) RW_LOADX(R_, ge2, e152, vv2)
    RW_LOADX(0, ge, e15, vv); RW_LOADX(1, ge2, e152, vv2);
    for (int R = 0; R < 36; ++R) {
        for (int rep1 = 0; rep1 < 1 + DUPB(20); ++rep1) {
            unsigned char* sc = sm + sq * RW_SCR;
            bf16_t* At_ = (bf16_t*)sc; bf16_t* Rt_ = At_ + 16 * 72; bf16_t* Bt_ = Rt_ + 16 * 72; bf16_t* Kt_ = Bt_ + 16 * 72;
            bf16_t* AtT = Kt_ + 16 * 72; bf16_t* BhT = AtT + 64 * 16; bf16_t* KhT = BhT + 64 * 16; bf16_t* Vt_ = KhT + 64 * 16;
            float* WC = (float*)(sc + 18432);
            unsigned at2[4], bh2[4], kh2[4];
#pragma unroll
            for (int k2 = 0; k2 < 4; ++k2) {
                const unsigned x0 = ge[k2].x, y0 = ge[k2].y, x1 = ge[k2].z, y1 = ge[k2].w;
                const int t0 = 8 * th + 2 * k2;
                At_[t0 * 72 + sj] = (bf16_t)(x0 & 0xffff); Rt_[t0 * 72 + sj] = (bf16_t)(x0 >> 16); Bt_[t0 * 72 + sj] = (bf16_t)(y0 & 0xffff); Kt_[t0 * 72 + sj] = (bf16_t)(y0 >> 16);
                At_[(t0 + 1) * 72 + sj] = (bf16_t)(x1 & 0xffff); Rt_[(t0 + 1) * 72 + sj] = (bf16_t)(x1 >> 16); Bt_[(t0 + 1) * 72 + sj] = (bf16_t)(y1 & 0xffff); Kt_[(t0 + 1) * 72 + sj] = (bf16_t)(y1 >> 16);
                at2[k2] = (x0 & 0xffffu) | (x1 << 16);
                bh2[k2] = pk2(bf2f(y0 & 0xffff) * e15, bf2f(y1 & 0xffff) * e15);
                kh2[k2] = pk2(bf2f(y0 >> 16) * e15, bf2f(y1 >> 16) * e15);
            }
            *(u32x4*)(AtT + sj * 16 + 8 * th) = (u32x4){at2[0], at2[1], at2[2], at2[3]};
            *(u32x4*)(BhT + sj * 16 + 8 * th) = (u32x4){bh2[0], bh2[1], bh2[2], bh2[3]};
            *(u32x4*)(KhT + sj * 16 + 8 * th) = (u32x4){kh2[0], kh2[1], kh2[2], kh2[3]};
            { const int vs = (ch & 1) * 16; u32x4 v4; v4.x = ((vv[0] >> vs) & 0xffffu) | ((vv[1] >> vs) << 16); v4.y = ((vv[2] >> vs) & 0xffffu) | ((vv[3] >> vs) << 16); v4.z = ((vv[4] >> vs) & 0xffffu) | ((vv[5] >> vs) << 16); v4.w = ((vv[6] >> vs) & 0xffffu) | ((vv[7] >> vs) << 16);
              *(u32x4*)(Vt_ + sj * 16 + 8 * th) = v4; }
            if (th == 0) WC[sj] = e15;
        }
#pragma unroll
        for (int k = 0; k < 4; ++k) ge[k] = ge2[k];
#pragma unroll
        for (int k = 0; k < 8; ++k) vv[k] = vv2[k];
        e15 = e152;
        if (R + 2 < 36) { RW_LOAD(R + 2); }
        LDS_BARRIER();
        for (int rep2 = 0; rep2 < 1 + DUPB(21); ++rep2) if (w < 4) {
            unsigned char* sc = sm + w * RW_SCR;
            const bf16_t* At_ = (const bf16_t*)sc; const bf16_t* Rt_ = At_ + 16 * 72; const bf16_t* Bt_ = Rt_ + 16 * 72; const bf16_t* Kt_ = Bt_ + 16 * 72;
            const bf16_t* AtT = Kt_ + 16 * 72; const bf16_t* Vt_ = AtT + 3 * 64 * 16;
            float* Lm = (float*)(sc + 17408);
            unsigned char* sl = sm + RW_SLOT0 + w * RW_SLOT;
            u32x2* ATs = (u32x2*)sl; u32x2* GTs = (u32x2*)(sl + 2048); u32x4* MfS = (u32x4*)(sl + 4096);
            const f32x4 z4 = {0.f, 0.f, 0.f, 0.f};
            f32x4 Lab = z4, LakT = z4, Mbr = z4, Mkr = z4;
#pragma unroll
            for (int ks = 0; ks < 2; ++ks) {
                const bf16x8 af = *(const bf16x8*)(At_ + l15 * 72 + 32 * ks + 8 * kg), rf = *(const bf16x8*)(Rt_ + l15 * 72 + 32 * ks + 8 * kg);
                const bf16x8 bf = *(const bf16x8*)(Bt_ + l15 * 72 + 32 * ks + 8 * kg), kf = *(const bf16x8*)(Kt_ + l15 * 72 + 32 * ks + 8 * kg);
                Lab = MF16(bf, af, Lab); LakT = MF16(af, kf, LakT); Mbr = MF16(bf, rf, Mbr); Mkr = MF16(kf, rf, Mkr);
            }
#pragma unroll
            for (int i = 0; i < 4; ++i) { const int rrow = 4 * kg + i;
                Lab[i] = (rrow < l15) ? Lab[i] : 0.f;
                LakT[i] = (l15 < rrow) ? LakT[i] : 0.f;
                Mbr[i] = (rrow <= l15) ? Mbr[i] : 0.f; Mkr[i] = (rrow <= l15) ? Mkr[i] : 0.f;
                Lm[rrow * 16 + l15] = Lab[i]; }
            { u32x4 mw; mw.x = pk2(Mbr[0], Mbr[1]); mw.y = pk2(Mbr[2], Mbr[3]); mw.z = pk2(Mkr[0], Mkr[1]); mw.w = pk2(Mkr[2], Mkr[3]); MfS[lane] = mw; }
            asm volatile("s_waitcnt lgkmcnt(0)" ::: "memory"); __builtin_amdgcn_wave_barrier();
            float T[16];
#pragma unroll
            for (int r = 15; r >= 0; --r) {
                float acc = (r == l15) ? 1.0f : 0.0f;
                const f32x4 L0 = *(const f32x4*)(Lm + r * 16), L1 = *(const f32x4*)(Lm + r * 16 + 4), L2 = *(const f32x4*)(Lm + r * 16 + 8), L3 = *(const f32x4*)(Lm + r * 16 + 12);
#pragma unroll
                for (int m = r + 1; m < 16; ++m) { const float lv = (m < 4) ? L0[m & 3] : (m < 8) ? L1[m & 3] : (m < 12) ? L2[m & 3] : L3[m & 3]; acc += lv * T[m]; }
                T[r] = acc;
            }
            f32x4 Tsel;
#pragma unroll
            for (int i = 0; i < 4; ++i) Tsel[i] = (kg == 0) ? T[i] : (kg == 1) ? T[4 + i] : (kg == 2) ? T[8 + i] : T[12 + i];
            const bf16x8 Tf = frag_lo(Tsel);
            const f32x4 LT = MF16(frag_lo(LakT), Tf, z4);
            const bf16x8 LTf = frag_lo(LT);
#pragma unroll
            for (int t1 = 0; t1 < 4; ++t1) {
                const f32x4 at = MF16(frag_b64(AtT + (16 * t1 + l15) * 16 + 4 * kg), Tf, z4);
                ATs[t1 * 64 + lane] = pk4v(at);
                const f32x4 gt = MF16(LTf, frag_b64(Vt_ + (16 * t1 + l15) * 16 + 4 * kg), z4);
                GTs[t1 * 64 + lane] = pk4v(gt);
            }
        }
        LDS_BARRIER();
        if (w < 4) {
#pragma unroll
            for (int q = 0; q < 4; ++q) {
                const unsigned char* sc = sm + q * RW_SCR;
                const bf16_t* Rt_ = (const bf16_t*)sc + 16 * 72; const bf16_t* BhT = (const bf16_t*)sc + 4 * 16 * 72 + 64 * 16; const bf16_t* KhT = BhT + 64 * 16; const bf16_t* Vt_ = KhT + 64 * 16;
                const float* WC = (const float*)(sc + 18432);
                const unsigned char* sl = sm + RW_SLOT0 + q * RW_SLOT;
                const u32x2* ATs = (const u32x2*)sl; const u32x2* GTs = (const u32x2*)(sl + 2048); const u32x4* MfS = (const u32x4*)(sl + 4096);
                bf16x8 Sf[2];
#pragma unroll
                for (int pi = 0; pi < 2; ++pi) { u32x4 sw; sw.x = pk2(S[2 * pi][0], S[2 * pi][1]); sw.y = pk2(S[2 * pi][2], S[2 * pi][3]); sw.z = pk2(S[2 * pi + 1][0], S[2 * pi + 1][1]); sw.w = pk2(S[2 * pi + 1][2], S[2 * pi + 1][3]);
                    Sf[pi] = __builtin_bit_cast(bf16x8, sw); }
                f32x4 ut = unpk4v(GTs[w * 64 + lane]);
#pragma unroll
                for (int pi = 0; pi < 2; ++pi) { const u32x2 a0 = ATs[(2 * pi) * 64 + lane], a1 = ATs[(2 * pi + 1) * 64 + lane]; u32x4 aw; aw.x = a0.x; aw.y = a0.y; aw.z = a1.x; aw.w = a1.y;
                    ut = MF16(__builtin_bit_cast(bf16x8, aw), Sf[pi], ut); }
                const u32x2 v2 = *(const u32x2*)(Vt_ + (16 * w + l15) * 16 + 4 * kg);
                u32x4 uvw; uvw.x = pk2(ut[0], ut[1]); uvw.y = pk2(ut[2], ut[3]); uvw.z = v2.x; uvw.w = v2.y;
                const bf16x8 UVf = __builtin_bit_cast(bf16x8, uvw);
                if (!(jo == 1 && R < 4)) {
                f32x4 oa = MF16(__builtin_bit_cast(bf16x8, MfS[lane]), UVf, ((f32x4){0.f, 0.f, 0.f, 0.f}));
#pragma unroll
                for (int pi = 0; pi < 2; ++pi) { const u32x2 r0 = *(const u32x2*)(Rt_ + l15 * 72 + 32 * pi + 4 * kg), r1 = *(const u32x2*)(Rt_ + l15 * 72 + 32 * pi + 16 + 4 * kg);
                    u32x4 rw; rw.x = r0.x; rw.y = r0.y; rw.z = r1.x; rw.w = r1.y;
                    oa = MF16(__builtin_bit_cast(bf16x8, rw), Sf[pi], oa); }
#pragma unroll
                for (int p2 = 0; p2 < 2; ++p2) { const int od = l15 & 1; const size_t row = rb + scan_row(dir, (4 * R + q) * 16 + 4 * kg + 2 * p2 + od);
                    *(unsigned*)(O + row * 512 + hd * 64 + 16 * w + l15 - od) = pair_rows(oa[2 * p2], oa[2 * p2 + 1], od != 0); }
                }
#pragma unroll
                for (int t2 = 0; t2 < 4; ++t2) {
                    const u32x2 b2 = *(const u32x2*)(BhT + (16 * t2 + l15) * 16 + 4 * kg), k2 = *(const u32x2*)(KhT + (16 * t2 + l15) * 16 + 4 * kg);
                    u32x4 bw; bw.x = b2.x; bw.y = b2.y; bw.z = k2.x; bw.w = k2.y;
                    const f32x4 dv = *(const f32x4*)(WC + 16 * t2 + 4 * kg);
                    S[t2] = MF16(__builtin_bit_cast(bf16x8, bw), UVf, S[t2] * dv);
                }
            }
        }
        LDS_BARRIER();
    }
#undef RW_LOAD
#undef RW_LOADX
}
__device__ __forceinline__ void odd_finish_rows(const Params& p, int jo, bool skip_ctx) {
    unsigned char* const ws = ows(p.ws);
    const int tid_ = otid(); const int lane = tid_ & 63, w = tid_ >> 6;
    const bf16_t* YF = (const bf16_t*)(ws + OFF_S5F); const bf16_t* YB = (const bf16_t*)(ws + OFF_S5B);
    bf16_t* YG = (bf16_t*)(ws + OFF_AR + AO_YG);
    const bf16_t* OF = (const bf16_t*)(ws + OFF_AR + AO_OF); const bf16_t* OB = (const bf16_t*)(ws + OFF_AR + AO_OB);
    const bf16_t* PR = (const bf16_t*)(ws + OFF_AR + AO_PR); const bf16_t* LO = (const bf16_t*)(ws + OFF_AR + AO_P);
    bf16_t* Y = (bf16_t*)(ws + OFF_AR + AO_Y);
    const int c0 = lane * 8;
    const int nwv = gridDim.x * 8, rpw = (TT + nwv - 1) / nwv, row_lo = (blockIdx.x * 8 + w) * rpw, row_hi = (row_lo + rpw < TT) ? row_lo + rpw : TT;
    const f32x4 ds0 = *(const f32x4*)(p.in[25] + jo * 512 + c0), ds1 = *(const f32x4*)(p.in[25] + jo * 512 + c0 + 4);
    const f32x4 rk0 = *(const f32x4*)(p.in[35] + jo * 512 + c0), rk1 = *(const f32x4*)(p.in[35] + jo * 512 + c0 + 4);
    const f32x4 lg0 = *(const f32x4*)(p.in[36] + jo * 512 + c0), lg1 = *(const f32x4*)(p.in[36] + jo * 512 + c0 + 4);
    const f32x4 lb0 = *(const f32x4*)(p.in[37] + jo * 512 + c0), lb1 = *(const f32x4*)(p.in[37] + jo * 512 + c0 + 4);
    for (int row = row_lo; row < row_hi; ++row) {
        if (skip_ctx && (row % SB) < 256) continue;
        {
            float fa[8], fb[8], uu[8], o[8];
            unpk8(*(const u32x4*)(YF + (size_t)row * 512 + c0), fa); unpk8(*(const u32x4*)(YB + (size_t)row * 512 + c0), fb);
            unpk8(*(const u32x4*)(YG + (size_t)row * 512 + c0), uu);
#pragma unroll
            for (int i = 0; i < 4; ++i) { o[i] = fa[i] + fb[i] + ds0[i] * uu[i]; o[4 + i] = fa[4 + i] + fb[4 + i] + ds1[i] * uu[4 + i]; }
#pragma unroll
            for (int i = 0; i < 8; ++i) { const float x = o[i]; o[i] = 0.5f * x * (1.0f + tanh_f(0.7978845608028654f * (x + 0.044715f * x * x * x))); }
            *(u32x4*)(YG + (size_t)row * 512 + c0) = pk8(o);
        }
        {
            float o[8], r[8], k[8], v[8], g[8];
            { float fa[8], fb[8]; unpk8(*(const u32x4*)(OF + (size_t)row * 512 + c0), fa); unpk8(*(const u32x4*)(OB + (size_t)row * 512 + c0), fb);
#pragma unroll
              for (int i = 0; i < 8; ++i) o[i] = fa[i] + fb[i]; }
            unpk8(*(const u32x4*)(PR + (size_t)row * 1536 + c0), r); unpk8(*(const u32x4*)(PR + (size_t)row * 1536 + 512 + c0), k); unpk8(*(const u32x4*)(PR + (size_t)row * 1536 + 1024 + c0), v);
            unpk8(*(const u32x4*)(LO + (size_t)row * 2560 + 2048 + c0), g);
            float sm_ = 0.f, bo = 0.f;
#pragma unroll
            for (int i = 0; i < 8; ++i) { sm_ += o[i]; bo += r[i] * k[i] * ((i < 4) ? rk0[i & 3] : rk1[i & 3]); }
            const float mean = sum8(sm_) * (1.0f / 64.0f); bo = sum8(bo);
            float sq = 0.f;
#pragma unroll
            for (int i = 0; i < 8; ++i) { const float d = o[i] - mean; sq += d * d; }
            const float rstd = rsqrtf(sum8(sq) * (1.0f / 64.0f) + 64e-5f);
            float y[8];
#pragma unroll
            for (int i = 0; i < 8; ++i) y[i] = ((o[i] - mean) * rstd * ((i < 4) ? lg0[i & 3] : lg1[i & 3]) + ((i < 4) ? lb0[i & 3] : lb1[i & 3]) + bo * v[i]) * g[i];
            *(u32x4*)(Y + (size_t)row * 1024 + 512 + c0) = pk8(y);
        }
    }
}

#define PHB unsigned char* const ws = ows(p.ws); bf16_t* const H = (bf16_t*)(ws + OFF_H); _Float16* const X = (_Float16*)(ws + OFF_X); const float* const mod = (const float*)(ws + OFF_MOD); bf16_t* const PbE = (bf16_t*)(ws + OFF_AR + AE_P); bf16_t* const YbE = (bf16_t*)(ws + OFF_AR + AE_Y); bf16_t* const PbO = (bf16_t*)(ws + OFF_AR + AO_P); bf16_t* const YbO = (bf16_t*)(ws + OFF_AR + AO_Y); const unsigned* const cnt0 = (const unsigned*)(ws + OFF_CNT); (void)H; (void)X; (void)mod; (void)PbE; (void)YbE; (void)PbO; (void)YbO; (void)cnt0;
#define LAYER_PAIR_BODY(lp) {  \
         \
        { \
            const int layer = 2 * lp, j = lp; \
            if (RUN) { PHB    \
                pg8::Gemm g{H, (const bf16_t*)(ws + OFF_WINE + j * SZ_WINE), 1024, 0}; pg8::StaticOrder S; S.init(TT, 3328, G, cb, 1024); \
                { LAS float* lbl = (LAS float*)(lds + LDS_MAIN + 64); lbl[threadIdx.x] = ((const float*)(ws + OFF_LB))[j * 512 + threadIdx.x]; __syncthreads(); } \
                pg8::EpiEvenIn E{PbE, (const LAS float*)(lds + LDS_MAIN + 64)}; REP(8) pg8::gemm_phase(lds, g, S, E); SYNC; } ++ph; \
            if (RUN) { PHB    \
                if (cb < 128) { hgrn_chunk_unit(p, j, cb, smem); __syncthreads(); } \
                else { for (int it = cb - 128; it < 576; it += G - 128) attn_unit(p, j, it, smem); } \
                if (DUPB(1)) { __syncthreads(); if (cb < 128) { hgrn_chunk_unit(p, j, cb, smem); __syncthreads(); } } \
                if (DUPB(2)) { __syncthreads(); if (cb >= 128) { for (int it = cb - 128; it < 576; it += G - 128) attn_unit(p, j, it, smem); } } SYNC; } ++ph; \
            if (RUN) { PHB    \
                const int nextra = (layer == 2) ? p.ntc : 0; \
                hgrn_finish_rows(p, j); \
                if (DUPB(13)) { hgrn_finish_rows(p, j); } \
                if (nextra > 0) { __syncthreads(); tr_loop(p, cb, G, nextra, p.njm, p.nj1, smem); } \
                SYNC; } ++ph; \
            if (RUN) { PHB    \
                pg8::Gemm g{YbE, (const bf16_t*)(ws + OFF_WOUTE + j * SZ_WSQ), 1024, 0}; pg8::CtxSplitOrder S; S.init(G, cb, 1024, SPLIT_S); \
                pg8::EpiResid E{(bf16_t*)(ws + OFF_AR + AE_P), mod + (size_t)layer * 9 * 6144 + 2048, (bf16_t*)(ws + OFF_AR + AE_P) + (size_t)TT * 1024}; if (DUPB(18)) pg8::gemm_phase(lds, g, S, E); pg8::gemm_phase(lds, g, S, E); SYNC; } ++ph; \
            if (RUN) { PHB if (DUPB(17)) phase_ln<0, false, true>(p, layer, OFF_AR + AE_P, SPLIT_S, smem); phase_ln<0, false>(p, layer, OFF_AR + AE_P, SPLIT_S, smem); SYNC; } ++ph; \
            if (RUN) { PHB    \
                pg8::Gemm g{H, (const bf16_t*)(ws + OFF_WFFN1 + j * SZ_WFFN1), 1024, 0}; pg8::StaticOrder S; S.init(TT, 5632, G, cb, 1024); \
                pg8::EpiSwiGLU E{PbE, 2816}; REP(5) pg8::gemm_phase(lds, g, S, E); SYNC; } ++ph; \
            if (RUN) { PHB    \
                pg8::Gemm g{PbE, (const bf16_t*)(ws + OFF_WFFN2 + j * SZ_WFFN2), 2816, 0}; pg8::CtxSplitOrder S; S.init(G, cb, 2816, SPLIT_S); \
                pg8::EpiResid E{(bf16_t*)(ws + OFF_AR + AE_OF), mod + (size_t)layer * 9 * 6144 + 5120, (bf16_t*)(ws + OFF_AR + AE_OF) + (size_t)TT * 1024}; if (DUPB(18)) pg8::gemm_phase(lds, g, S, E); pg8::gemm_phase(lds, g, S, E); SYNC; } ++ph; \
            if (RUN) { PHB if (DUPB(17)) phase_ln<1, false, true>(p, layer, OFF_AR + AE_OF, SPLIT_S, smem); phase_ln<1, false>(p, layer, OFF_AR + AE_OF, SPLIT_S, smem); SYNC; } ++ph; \
        } \
         \
        { \
            const int layer = 2 * lp + 1, jo = lp; \
            if (RUN) { PHB    \
                pg8::Gemm g{H, (const bf16_t*)(ws + OFF_WINO + jo * SZ_WINO), 1024, 0}; pg8::StaticOrder S; S.init(TT, 2560, G, cb, 1024); \
                pg8::EpiBf16 E{PbO, 2560, nullptr}; if (DUPB(19)) pg8::gemm_phase(lds, g, S, E); pg8::gemm_phase(lds, g, S, E); SYNC; } ++ph; \
            if (RUN) { PHB    \
                rwkv_prep_rows(p, jo); \
                if (DUPB(14)) { rwkv_prep_rows(p, jo); } \
                SYNC; } ++ph; \
            if (RUN) { PHB    \
                pg8::Gemm g{(const bf16_t*)(ws + OFF_AR + AO_L), (const bf16_t*)(ws + OFF_WLORA + jo * SZ_WLORA), 384, 0}; pg8::LoraOrder S; S.init(TT, 2560, G, cb, 384); \
                pg8::EpiBf16 E{PbO, 2560, nullptr}; if (DUPB(19)) pg8::gemm_phase(lds, g, S, E); pg8::gemm_phase(lds, g, S, E); \
                SYNC; } ++ph; \
            if (RUN) { PHB   \
                { const int per = (4608 + G - 1) / G, i0 = cb * per, i1 = (i0 + per < 4608) ? i0 + per : 4608; rwkv_stage_loop(p, jo, i0, 1, i1, smem); } \
                SYNC; } ++ph; \
            if (RUN) { PHB    \
                if (cb < 128) { rwkv_chunk_unit(p, jo, cb, smem); if (DUPB(4)) { __syncthreads(); rwkv_chunk_unit(p, jo, cb, smem); } } \
                else { if (wv < 4) { s5_scan_task(p, jo, (cb - 128) * 4 + wv, smem + wv * 20480); } \
                       if (layer == 1 && p.ntm > 0) { __syncthreads(); tr_loop(p, cb - 128, G - 128, p.ntm, p.nj0, p.njm, smem); } \
                       if (layer == 3 && p.nt1 > p.ntc) { __syncthreads(); tr_loop(p, p.ntc + (cb - 128), G - 128, p.nt1, p.njm, p.nj1, smem); } } \
                SYNC; } ++ph; \
            if (RUN) { PHB odd_finish_rows(p, jo, layer == 3); SYNC; } ++ph; \
            if (RUN) { PHB    \
                pg8::Gemm g{(const bf16_t*)(ws + OFF_AR + AO_YG), (const bf16_t*)(ws + OFF_WGLU + jo * SZ_WGLU), 512, 0}; pg8::StaticOrder S; S.init(TT, 512, G, cb, 512); \
                pg8::EpiGLU E{(const bf16_t*)(ws + OFF_AR + AO_YG), YbO}; if (DUPB(19)) pg8::gemm_phase(lds, g, S, E); pg8::gemm_phase(lds, g, S, E); \
                SYNC; } ++ph; \
            if (RUN) { PHB    \
                pg8::Gemm g{YbO, (const bf16_t*)(ws + OFF_WOUTO + jo * SZ_WSQ), 1024, 0}; pg8::CtxSplitOrder S; S.init(G, cb, 1024, layer == 3 ? 0 : SPLIT_S); \
                pg8::EpiResid E{(bf16_t*)(ws + OFF_GE), mod + (size_t)layer * 9 * 6144 + 2048, (bf16_t*)(ws + OFF_GE) + (size_t)TT * 1024}; if (DUPB(18)) pg8::gemm_phase(lds, g, S, E); pg8::gemm_phase(lds, g, S, E); SYNC; } ++ph; \
            if (RUN) { PHB if (DUPB(17)) phase_ln<0, true, true>(p, layer, OFF_GE, SPLIT_S, smem); phase_ln<0, true>(p, layer, OFF_GE, SPLIT_S, smem); SYNC; } ++ph; \
            if (RUN) { PHB    \
                pg8::Gemm g{H, (const bf16_t*)(ws + OFF_WMOE1), 1024, SZ_WFFN1}; pg8::MoeOrder S; S.init((cnt0 + jo * 512), 22, G, cb, 1024); \
                LAS int* ridx = (LAS int*)(lds + LDS_MAIN + 64 + 2048); \
                { const unsigned* inv = (const unsigned*)(ws + OFF_INV); pg8::Unit u; \
                  for (int i = 0; i < 16 && S.next(i, u); ++i) { if (threadIdx.x < 256) { int pst = 0; _Pragma("unroll") for (int k = 0; k < 7; ++k) pst = (u.e > k) ? S.pend[k] : pst; \
                      const int r = (u.pm - pst) * 256 + (int)threadIdx.x; ridx[i * 256 + threadIdx.x] = (r < (int)(cnt0 + jo * 512)[u.e * 64]) ? (int)inv[(size_t)u.e * TT + r] : 0; } } \
                  __syncthreads(); } \
                pg8::EpiSwiGLU E{(bf16_t*)(ws + OFF_AR + AM_H), 2816}; pg8::gemm_phase<pg8::EpiSwiGLU, pg8::MoeOrder, true>(lds, g, S, E, ridx); SYNC; } ++ph; \
            if (RUN) { PHB    \
                pg8::Gemm g{(const bf16_t*)(ws + OFF_AR + AM_H), (const bf16_t*)(ws + OFF_WMOE2), 2816, SZ_WFFN2}; pg8::MoeOrder S; S.init((cnt0 + jo * 512), 4, G, cb, 2816, true); \
                pg8::EpiBf16 E{(bf16_t*)(ws + OFF_AR + AM_A), 1024, (bf16_t*)(ws + OFF_GE)}; REP(7) pg8::gemm_phase(lds, g, S, E); SYNC; } ++ph; \
            if (RUN) { PHB if (DUPB(17)) phase_ln<2, false, true>(p, layer, 0, 0, smem); phase_ln<2, false>(p, layer, 0, 0, smem); SYNC; } ++ph; \
        } \
     }
constexpr int LDS_MAIN = 131072;
constexpr int LDS_BYTES = LDS_MAIN + 64 + 2048 + 16384;
__global__ void __launch_bounds__(512, 2) mega(const Params p) {
    extern __shared__ __attribute__((aligned(16))) unsigned char smem[];
    LAS unsigned char* lds = (LAS unsigned char*)smem;
    volatile LAS unsigned* xbw = (volatile LAS unsigned*)(lds + LDS_MAIN);
    if (threadIdx.x == 0) { xbw[0] = 0u; xbw[1] = 0u; xbw[2] = 0u; xbw[3] = 0u; }
    __syncthreads();
    const bool multi = (p.hi - p.lo) > 1;
    XcdBarrier bar; bar.bar = (unsigned*)(p.ws + OFF_BAR); bar.x = 0; bar.st = xbw;
    if (multi) bar = xcd_barrier_post((unsigned*)(p.ws + OFF_BAR), xbw);
    const int G = gridDim.x, cb = blockIdx.x, wv = threadIdx.x >> 6;
    int ph = 0;
#define RUN (ph >= p.lo && ph < p.hi)
#define SYNC do { if (multi && ph + 1 < p.hi) { xcd_barrier(bar); if (DUPB(12)) xcd_barrier(bar); } else __syncthreads(); } while (0)

    if (RUN) { REP(0) { phase_prologue_a(p, smem); __syncthreads(); } SYNC; } ++ph;
    if (RUN) { phase_prologue_b(p); SYNC; } ++ph;

    LAYER_PAIR_BODY(0)
    LAYER_PAIR_BODY(1)
#undef RUN
#undef SYNC
}

static void add_job(Params& P, int& nj, int& nt, const float* src, bf16_t* dst, int K, int N, int ldd, int mode, int aux) {
    Job& j = P.jobs[nj++]; j.src = src; j.dst = dst; j.K = K; j.N = N; j.ldd = ldd; j.mode = mode; j.tile0 = nt; j.aux = aux; nt += (K / 128) * (N / 128);
}
extern "C" void kernel_launch(void* const* d_in, const int* in_sizes, int n_in, void* d_out, int out_size, void* d_ws, size_t ws_size, hipStream_t stream) {
    static int ready = 0;
    if (ready == 0) {
        if (n_in != 43 || ws_size < WS_END) { fprintf(stderr, "kernel_launch: need 43 inputs and %zu bytes of workspace, got %d / %zu\n", (size_t)WS_END, n_in, ws_size); ready = -1; return; }
        if (hipFuncSetAttribute((const void*)mega, hipFuncAttributeMaxDynamicSharedMemorySize, LDS_BYTES) != hipSuccess) { fprintf(stderr, "kernel_launch: hipFuncSetAttribute failed\n"); ready = -1; return; }
        ready = 1;
    }
    if (ready < 0) return;
    unsigned char* ws = (unsigned char*)d_ws;
    (void)hipMemsetAsync(ws, 0, ZERO_BYTES, stream);
    Params P; memset(&P, 0, sizeof(P));
    for (int i = 0; i < 43; ++i) P.in[i] = (const float*)d_in[i];
    P.out = (float*)d_out; P.ws = ws;
    int nj = 0, nt = 0;
    for (int j = 0; j < 2; ++j) {
        if (j == 1) { P.nj0 = nj; P.nt0 = nt; nt = 0; }
        add_job(P, nj, nt, P.in[8] + (size_t)j * 1024 * 3328, (bf16_t*)(ws + OFF_WINE + j * SZ_WINE), 1024, 3328, 1024, 0, 0);
        add_job(P, nj, nt, P.in[9] + (size_t)j * 1024 * 1024, (bf16_t*)(ws + OFF_WOUTE + j * SZ_WSQ), 1024, 1024, 1024, 0, 0);
        add_job(P, nj, nt, P.in[13] + (size_t)j * 1024 * 2816, (bf16_t*)(ws + OFF_WFFN1 + j * SZ_WFFN1), 1024, 2816, 1024, 1, 0);
        add_job(P, nj, nt, P.in[14] + (size_t)j * 1024 * 2816, (bf16_t*)(ws + OFF_WFFN1 + j * SZ_WFFN1), 1024, 2816, 1024, 2, 0);
        add_job(P, nj, nt, P.in[15] + (size_t)j * 2816 * 1024, (bf16_t*)(ws + OFF_WFFN2 + j * SZ_WFFN2), 2816, 1024, 2816, 0, 0);
        add_job(P, nj, nt, P.in[16] + (size_t)j * 1024 * 2432, (bf16_t*)(ws + OFF_WINO + j * SZ_WINO), 1024, 2432, 1024, 0, 0);
        add_job(P, nj, nt, nullptr, (bf16_t*)(ws + OFF_WINO + j * SZ_WINO) + (size_t)2432 * 1024, 1024, 128, 1024, 3, 0);
        add_job(P, nj, nt, P.in[17] + (size_t)j * 1024 * 1024, (bf16_t*)(ws + OFF_WOUTO + j * SZ_WSQ), 1024, 1024, 1024, 0, 0);
        add_job(P, nj, nt, nullptr, (bf16_t*)(ws + OFF_WLORA + j * SZ_WLORA), 384, 2560, 384, 4, j);
        add_job(P, nj, nt, P.in[26] + (size_t)j * 512 * 512, (bf16_t*)(ws + OFF_WGLU + j * SZ_WGLU), 512, 512, 512, 0, 0);
        if (j == 1) { P.njm = nj; P.ntm = nt; nt = 0; }
        { const int L = j;
        for (int e = 0; e < 8; ++e) {
            const size_t eo = (size_t)(L * 8 + e) * 1024 * 2816;
            add_job(P, nj, nt, P.in[40] + eo, (bf16_t*)(ws + OFF_WMOE1 + e * SZ_WFFN1), 1024, 2816, 1024, 1, 0);
            add_job(P, nj, nt, P.in[41] + eo, (bf16_t*)(ws + OFF_WMOE1 + e * SZ_WFFN1), 1024, 2816, 1024, 2, 0);
            add_job(P, nj, nt, P.in[42] + eo, (bf16_t*)(ws + OFF_WMOE2 + e * SZ_WFFN2), 2816, 1024, 2816, 0, 0);
        }
        }
    }
    P.nj1 = nj; P.nt1 = nt; P.ntc = nt / 2;
#if MK_SINGLE
    P.lo = 0; P.hi = NPH;
    hipLaunchKernelGGL(mega, dim3(256), dim3(512), LDS_BYTES, stream, P);
#else
    for (int ph = 0; ph < NPH; ++ph) { P.lo = ph; P.hi = ph + 1; hipLaunchKernelGGL(mega, dim3(256), dim3(512), LDS_BYTES, stream, P); }
#endif
}
```
